# Optimizing an MI355X kernel written in HIP

```python
import math
import functools
import jax
import jax.numpy as jnp
from jax import lax
import numpy as np

D_MODEL = 1024
BATCH = 4
SEQ = 4096
DEPTH = 1
DEC_BATCH = 128
DEC_SEQ = 4
PAST_LEN = 8192
PAGE_SIZE = 128

MIX_WIDTH = D_MODEL
SSM_WIDTH = MIX_WIDTH // 2
SSM_GROUP = 16
SSM_GROUPS = SSM_WIDTH // SSM_GROUP
SSM_STATE = 64
ATT_WIDTH = MIX_WIDTH - SSM_WIDTH
D_NOPE = 64
D_ROPE = 32
D_V = 64
N_HEADS = ATT_WIDTH // D_V
Q_LORA = 3 * D_MODEL // 8
KV_LORA = D_MODEL // 4
IN_WIDTH = SSM_WIDTH + Q_LORA + KV_LORA + D_ROPE
ROPE_THETA = 10000.0
ATTN_SCALE = 1.0 / math.sqrt(D_NOPE + D_ROPE)
Q_BLOCK = 128
PEER_HEADS = 8
PEER_KEYS = 128
PEER_EXPERTS = PEER_KEYS * PEER_KEYS
PEER_QUERY = 256
PEER_HALF = PEER_QUERY // 2
PEER_TOPK = 16
PEER_BLOCK = 128
EPS = 1e-6

kernel_name = 'hymba_s5_mla_peer_step'


def _rmsnorm(x, g):
    x32 = x.astype(jnp.float32)
    y = x32 * lax.rsqrt(jnp.mean(x32 * x32, axis=-1, keepdims=True) + EPS)
    return (y * g.astype(jnp.float32)).astype(x.dtype)


def _rope_angles(pos):
    inv = ROPE_THETA ** (-jnp.arange(0, D_ROPE, 2, dtype=jnp.float32) / D_ROPE)
    ang = pos.astype(jnp.float32)[:, None] * inv[None, :]
    return jnp.cos(ang), jnp.sin(ang)


def _rope(x, cos, sin):
    half = x.shape[-1] // 2
    x32 = x.astype(jnp.float32)
    x1, x2 = x32[..., :half], x32[..., half:]
    return jnp.concatenate([x1 * cos - x2 * sin, x2 * cos + x1 * sin], axis=-1).astype(x.dtype)


def _linear_combine(e1, e2):
    a1, b1 = e1
    a2, b2 = e2
    return a1 * a2, a2 * b1 + b2


def _s5(u, h0, a_re, a_im, log_dt, b, c, d_skip):
    bsz, t, _ = u.shape
    f32 = jnp.float32
    u32 = u.astype(f32)
    lam = lax.complex(a_re.astype(f32), a_im.astype(f32))
    dt = jnp.exp(log_dt.astype(f32))[:, None]
    a_bar = jnp.exp(lam * dt)
    b_c = lax.complex(b[..., 0].astype(f32), b[..., 1].astype(f32))
    c_c = lax.complex(c[..., 0].astype(f32), c[..., 1].astype(f32))
    b_bar = ((a_bar - 1.0) / lam)[:, :, None] * b_c
    ug = u32.reshape(bsz, t, SSM_GROUPS, SSM_GROUP).astype(jnp.complex64)
    bu = jnp.einsum('btgh,gph->btgp', ug, b_bar)
    bu = bu.at[:, 0].add(a_bar[None] * h0)
    a_seq = jnp.broadcast_to(a_bar, bu.shape)
    _, h = lax.associative_scan(_linear_combine, (a_seq, bu), axis=1)
    y = jnp.einsum('btgp,ghp->btgh', h, c_c).real.reshape(bsz, t, SSM_WIDTH)
    y = y + d_skip.astype(f32) * u32
    return y.astype(u.dtype), h[:, -1]


def _latent_keys(c_kv, w_uk, g_kn):
    return _rmsnorm(jnp.einsum('btc,chd->bthd', c_kv, w_uk), g_kn)


def _attend(qn, qr, kn, kr, ckv, mask):
    s = jnp.einsum('bqhd,bkhd->bhqk', qn, kn) + jnp.einsum('bqhd,bkd->bhqk', qr, kr)
    s = jnp.where(mask, s.astype(jnp.float32) * ATTN_SCALE, -jnp.inf)
    p = jax.nn.softmax(s, axis=-1)
    return jnp.einsum('bhqk,bkc->bqhc', p.astype(ckv.dtype), ckv)


def _prompt_attention(q_nope, q_rope, c_kv, k_rope, w_uk, g_kn):
    bsz, s = q_nope.shape[:2]
    k_nope = _latent_keys(c_kv, w_uk, g_kn)
    kpos = jnp.arange(s)

    def block(i):
        start = i * Q_BLOCK
        qn = lax.dynamic_slice_in_dim(q_nope, start, Q_BLOCK, axis=1)
        qr = lax.dynamic_slice_in_dim(q_rope, start, Q_BLOCK, axis=1)
        mask = kpos[None, :] <= (start + jnp.arange(Q_BLOCK))[:, None]
        return _attend(qn, qr, k_nope, k_rope, c_kv, mask)

    o = lax.map(block, jnp.arange(s // Q_BLOCK))
    return jnp.moveaxis(o, 0, 1).reshape(bsz, s, N_HEADS, KV_LORA)


def _sample_attention(q_nope, q_rope, c_kv, k_rope, w_uk, g_kn, cache_lat, cache_kr, page_table, layer):
    past = page_table.shape[1] * PAGE_SIZE
    t = q_nope.shape[1]
    mask = jnp.arange(past + t)[None, :] <= (past + jnp.arange(t))[:, None]

    def one(args):
        pt, qn, qr, cn, krn = args
        lat = jnp.concatenate([cache_lat[layer, pt].reshape(past, KV_LORA).astype(cn.dtype), cn], axis=0)[None]
        krr = jnp.concatenate([cache_kr[layer, pt].reshape(past, D_ROPE).astype(krn.dtype), krn], axis=0)[None]
        kn = _latent_keys(lat, w_uk, g_kn)
        return _attend(qn[None], qr[None], kn, krr, lat, mask)[0]

    return lax.map(one, (page_table, q_nope, q_rope, c_kv, k_rope))


def _peer(x, wq, keys, u_tab, v_tab):
    shape = x.shape
    xf = x.reshape(-1, shape[-1])
    n = xf.shape[0]
    xf = jnp.pad(xf, ((0, (-n) % PEER_BLOCK), (0, 0)))
    kk = PEER_TOPK * PEER_TOPK

    def block(xb):
        q = (xb @ wq).reshape(PEER_BLOCK, PEER_HEADS, 2, PEER_HALF)
        s = jnp.einsum('qhcd,ckd->qhck', q, keys).astype(jnp.float32)
        s1, i1 = lax.top_k(s[:, :, 0], PEER_TOPK)
        s2, i2 = lax.top_k(s[:, :, 1], PEER_TOPK)
        cand = (s1[..., :, None] + s2[..., None, :]).reshape(PEER_BLOCK, PEER_HEADS, kk)
        cidx = (i1[..., :, None] * PEER_KEYS + i2[..., None, :]).reshape(PEER_BLOCK, PEER_HEADS, kk)
        top, sel = lax.top_k(cand, PEER_TOPK)
        idx = jnp.take_along_axis(cidx, sel, axis=-1)
        g = jax.nn.softmax(top, axis=-1)
        act = jax.nn.gelu(jnp.einsum('qhkd,qd->qhk', jnp.take(u_tab, idx, axis=0), xb).astype(jnp.float32))
        return jnp.einsum('qhk,qhkd->qd', (g * act).astype(xb.dtype), jnp.take(v_tab, idx, axis=0))

    out = lax.map(block, xf.reshape(-1, PEER_BLOCK, shape[-1]))
    return out.reshape(-1, shape[-1])[:n].reshape(shape)


def _layer(x, pos, h0, attend, norm_mix, w_in, norm_q_lora, w_uq, norm_kv_lora, w_uk, w_uv,
           g_qn, g_qr, g_kn, g_kr, a_re, a_im, log_dt, b, c, d_skip, w_glu, w_out,
           norm_ffn, peer_wq, peer_keys, peer_u, peer_v):
    xn = _rmsnorm(x, norm_mix)
    z = xn @ w_in
    u = z[..., :SSM_WIDTH]
    cq = z[..., SSM_WIDTH:SSM_WIDTH + Q_LORA]
    ckv = z[..., SSM_WIDTH + Q_LORA:SSM_WIDTH + Q_LORA + KV_LORA]
    kr = z[..., SSM_WIDTH + Q_LORA + KV_LORA:]
    cos, sin = _rope_angles(pos)
    q = (_rmsnorm(cq, norm_q_lora) @ w_uq).reshape(*cq.shape[:-1], N_HEADS, D_NOPE + D_ROPE)
    q_nope = _rmsnorm(q[..., :D_NOPE], g_qn)
    q_rope = _rope(_rmsnorm(q[..., D_NOPE:], g_qr), cos[:, None], sin[:, None])
    c_kv = _rmsnorm(ckv, norm_kv_lora)
    k_rope = _rope(_rmsnorm(kr, g_kr), cos, sin)
    o_lat = attend(q_nope, q_rope, c_kv, k_rope, w_uk, g_kn)
    o_att = jnp.einsum('bthc,chd->bthd', o_lat, w_uv).reshape(*x.shape[:-1], ATT_WIDTH)
    y_ssm, h_last = _s5(u, h0, a_re, a_im, log_dt, b, c, d_skip)
    gl = jax.nn.gelu(y_ssm) @ w_glu
    glu = gl[..., :SSM_WIDTH] * jax.nn.sigmoid(gl[..., SSM_WIDTH:])
    x = (x + jnp.concatenate([glu, o_att.astype(glu.dtype)], axis=-1) @ w_out).astype(x.dtype)
    x = (x + _peer(_rmsnorm(x, norm_ffn), peer_wq, peer_keys, peer_u, peer_v)).astype(x.dtype)
    return x, c_kv, k_rope, jnp.stack([h_last.real, h_last.imag], axis=-1)


def setup_inputs(seed: int = 0) -> dict:
    key = jax.random.key(seed)
    ks = jax.random.split(key, 32)
    f32 = jnp.float32
    n_pages = PAST_LEN // PAGE_SIZE
    n_used = DEC_BATCH * n_pages
    n_phys = n_used + (n_used + 3) // 4

    def nrm(k, shape, scale):
        return jax.random.normal(k, shape, f32) * scale

    def gain(k, shape):
        return 1.0 + 0.02 * jax.random.normal(k, shape, f32)

    page_table = jax.random.permutation(ks[5], n_phys)[:n_used].reshape(DEC_BATCH, n_pages).astype(jnp.int32)
    n_idx = jnp.arange(SSM_STATE, dtype=f32)
    return {
        'x_prompt': nrm(ks[0], (BATCH, SEQ, D_MODEL), 1.0),
        'x_sample': nrm(ks[1], (DEC_BATCH, DEC_SEQ, D_MODEL), 1.0),
        'cache_kv_latent': nrm(ks[2], (DEPTH, n_phys, PAGE_SIZE, KV_LORA), 1.0),
        'cache_k_rope': nrm(ks[3], (DEPTH, n_phys, PAGE_SIZE, D_ROPE), 1.0),
        'state_ssm': nrm(ks[4], (DEPTH, DEC_BATCH, SSM_GROUPS, SSM_STATE, 2), 0.1),
        'page_table': page_table,
        'norm_mix': gain(ks[6], (DEPTH, D_MODEL)),
        'w_in': nrm(ks[7], (DEPTH, D_MODEL, IN_WIDTH), D_MODEL ** -0.5),
        'norm_q_lora': gain(ks[8], (DEPTH, Q_LORA)),
        'w_uq': nrm(ks[9], (DEPTH, Q_LORA, N_HEADS * (D_NOPE + D_ROPE)), Q_LORA ** -0.5),
        'norm_kv_lora': gain(ks[10], (DEPTH, KV_LORA)),
        'w_uk': nrm(ks[11], (DEPTH, KV_LORA, N_HEADS, D_NOPE), KV_LORA ** -0.5),
        'w_uv': nrm(ks[12], (DEPTH, KV_LORA, N_HEADS, D_V), KV_LORA ** -0.5),
        'qk_gain_q_nope': gain(ks[13], (DEPTH, D_NOPE)),
        'qk_gain_q_rope': gain(ks[14], (DEPTH, D_ROPE)),
        'qk_gain_k_nope': gain(ks[15], (DEPTH, D_NOPE)),
        'qk_gain_k_rope': gain(ks[16], (DEPTH, D_ROPE)),
        'ssm_a_re': -0.5 + nrm(ks[17], (DEPTH, SSM_GROUPS, SSM_STATE), 0.01),
        'ssm_a_im': math.pi * n_idx + nrm(ks[18], (DEPTH, SSM_GROUPS, SSM_STATE), 0.01),
        'ssm_log_dt': jax.random.uniform(ks[19], (DEPTH, SSM_GROUPS), f32, math.log(1e-3), math.log(1e-1)),
        'ssm_b': nrm(ks[20], (DEPTH, SSM_GROUPS, SSM_STATE, SSM_GROUP, 2), (2.0 * SSM_GROUP) ** -0.5),
        'ssm_c': nrm(ks[21], (DEPTH, SSM_GROUPS, SSM_GROUP, SSM_STATE, 2), (2.0 * SSM_STATE) ** -0.5),
        'ssm_d': nrm(ks[22], (DEPTH, SSM_WIDTH), 1.0),
        'w_glu': nrm(ks[23], (DEPTH, SSM_WIDTH, 2 * SSM_WIDTH), SSM_WIDTH ** -0.5),
        'w_out': nrm(ks[24], (DEPTH, MIX_WIDTH, D_MODEL), MIX_WIDTH ** -0.5),
        'norm_ffn': gain(ks[25], (DEPTH, D_MODEL)),
        'peer_wq': nrm(ks[26], (DEPTH, D_MODEL, PEER_HEADS * PEER_QUERY), D_MODEL ** -0.5),
        'peer_keys': nrm(ks[27], (DEPTH, 2, PEER_KEYS, PEER_HALF), PEER_HALF ** -0.5),
        'peer_u': nrm(ks[28], (DEPTH, PEER_EXPERTS, D_MODEL), D_MODEL ** -0.5),
        'peer_v': nrm(ks[29], (DEPTH, PEER_EXPERTS, D_MODEL), (PEER_HEADS * PEER_TOPK) ** -0.5),
    }


def reference(x_prompt, x_sample, cache_kv_latent, cache_k_rope, state_ssm, page_table,
              norm_mix, w_in, norm_q_lora, w_uq, norm_kv_lora, w_uk, w_uv,
              qk_gain_q_nope, qk_gain_q_rope, qk_gain_k_nope, qk_gain_k_rope,
              ssm_a_re, ssm_a_im, ssm_log_dt, ssm_b, ssm_c, ssm_d, w_glu, w_out,
              norm_ffn, peer_wq, peer_keys, peer_u, peer_v):
    seq = x_prompt.shape[1]
    dec_seq = x_sample.shape[1]
    past = page_table.shape[1] * PAGE_SIZE
    pos_p = jnp.arange(seq)
    pos_s = past + jnp.arange(dec_seq)
    h0_p = jnp.zeros((x_prompt.shape[0], SSM_GROUPS, SSM_STATE), jnp.complex64)
    xp, xs = x_prompt, x_sample
    lat_p, kr_p, ssm_p, lat_s, kr_s, ssm_s = [], [], [], [], [], []
    for l in range(DEPTH):
        params = (norm_mix[l], w_in[l], norm_q_lora[l], w_uq[l], norm_kv_lora[l], w_uk[l], w_uv[l],
                  qk_gain_q_nope[l], qk_gain_q_rope[l], qk_gain_k_nope[l], qk_gain_k_rope[l],
                  ssm_a_re[l], ssm_a_im[l], ssm_log_dt[l], ssm_b[l], ssm_c[l], ssm_d[l],
                  w_glu[l], w_out[l], norm_ffn[l], peer_wq[l], peer_keys[l], peer_u[l], peer_v[l])
        st = state_ssm[l].astype(jnp.float32)
        h0_s = lax.complex(st[..., 0], st[..., 1])
        attend_s = functools.partial(_sample_attention, cache_lat=cache_kv_latent, cache_kr=cache_k_rope,
                                     page_table=page_table, layer=l)
        xp, c1, k1, s1 = _layer(xp, pos_p, h0_p, _prompt_attention, *params)
        xs, c2, k2, s2 = _layer(xs, pos_s, h0_s, attend_s, *params)
        lat_p.append(c1)
        kr_p.append(k1)
        ssm_p.append(s1)
        lat_s.append(c2)
        kr_s.append(k2)
        ssm_s.append(s2)
    return (xp, xs, jnp.stack(lat_p), jnp.stack(kr_p), jnp.stack(ssm_p),
            jnp.stack(lat_s), jnp.stack(kr_s), jnp.stack(ssm_s))
```

```cpp
#include <hip/hip_runtime.h>
#include <stdint.h>
#include <stdio.h>

typedef __attribute__((ext_vector_type(8))) short bf16x8;
typedef __attribute__((ext_vector_type(4))) short s16x4;
typedef __attribute__((ext_vector_type(16))) float f32x16;
typedef __attribute__((ext_vector_type(2))) __bf16 bf2;
typedef __attribute__((ext_vector_type(2))) float f2v;
typedef unsigned short bf16_t;

#define NTHR 512
#define D_MODEL 1024
#define NP 16384
#define NS 512
#define NT 16896
#define INW 1184
#define NSUB 1152
#define A2LD 384
#define EPS 1e-6f
#define QSCALE 0.14724466f

#define O_YP 0
#define O_YS 16777216
#define O_LATP 17301504
#define O_KRP 21495808
#define O_SSMP 22020096
#define O_LATS 22036480
#define O_KRS 22167552
#define O_SSMS 22183936

struct Params {
  const float *x_prompt, *x_sample, *cache_lat, *cache_kr, *state_ssm;
  const int* page_table;
  const float *norm_mix, *w_in, *norm_q_lora, *w_uq, *norm_kv_lora, *w_uk, *w_uv, *g_qn, *g_qr, *g_kn, *g_kr;
  const float *a_re, *a_im, *log_dt, *ssm_b, *ssm_c, *ssm_d, *w_glu, *w_out, *norm_ffn, *peer_wq, *peer_keys, *peer_u, *peer_v;
  float* out;
  unsigned* bar;
  bf16_t *WinT, *WuqT, *WukT, *WuvT, *WgluT, *WoutT, *WpqT, *PK, *Utab, *Vtab, *Bt2, *Emat;
  bf16_t *XN, *A2, *CQN, *CKV, *Kcat, *KcatS, *Qb, *VT, *OATT, *G, *CAT, *PQ;
  float *Z, *Qraw, *KNraw, *S, *GL, *X1, *SC, *GW, *Opart, *Lpart;
  int* IDX;
};

__device__ __forceinline__ unsigned pk2(float a, float b) {
  f2v v = {a, b};
  bf2 r = __builtin_convertvector(v, bf2);
  return __builtin_bit_cast(unsigned, r);
}
__device__ __forceinline__ bf16_t f2bf(float a) { return (bf16_t)(pk2(a, 0.f) & 0xffffu); }
__device__ __forceinline__ float bf2f(bf16_t x) { return __uint_as_float(((unsigned)x) << 16); }
__device__ __forceinline__ float bflo(unsigned x) { return __uint_as_float(x << 16); }
__device__ __forceinline__ float bfhi(unsigned x) { return __uint_as_float(x & 0xffff0000u); }
__device__ __forceinline__ float wave_sum(float v) {
  v += __shfl_xor(v, 32); v += __shfl_xor(v, 16); v += __shfl_xor(v, 8);
  v += __shfl_xor(v, 4);  v += __shfl_xor(v, 2);  v += __shfl_xor(v, 1);
  return v;
}
__device__ __forceinline__ float gelu_tanh(float x) {
  float u = 0.7978845608028654f * (x + 0.044715f * x * x * x);
  float e = __expf(2.f * u);
  float t = 1.f - 2.f / (1.f + e);
  return 0.5f * x * (1.f + t);
}
__device__ __forceinline__ void sincos_rev(float ang, float& s, float& c) {
  float rev = ang * 0.15915494309189535f;
  rev = rev - floorf(rev);
  s = __builtin_amdgcn_sinf(rev);
  c = __builtin_amdgcn_cosf(rev);
}
__device__ __forceinline__ f32x16 mfma32(bf16x8 a, bf16x8 b, f32x16 c) {
  return __builtin_amdgcn_mfma_f32_32x32x16_bf16(a, b, c, 0, 0, 0);
}
__device__ __forceinline__ bf16x8 mk8(unsigned a, unsigned b, unsigned c, unsigned d) {
  uint4 u = make_uint4(a, b, c, d);
  return __builtin_bit_cast(bf16x8, u);
}

#define GLD 72
template <int MT, class Epi>
__device__ __forceinline__ void gemm_tile(const bf16_t* __restrict__ A, int lda, const bf16_t* __restrict__ Bt, int ldb,
                                          int K, int m0, int n0, char* smem, Epi epi) {
  constexpr int BM = 128 * MT;
  bf16_t* As = (bf16_t*)smem;
  bf16_t* Bs = As + 2 * BM * GLD;
  const int tid = threadIdx.x, lane = tid & 63, wave = tid >> 6;
  const int wm = wave >> 1, wn = wave & 1, lr = lane & 31, hh = lane >> 5;
  uint4 ra[2 * MT], rb[2];
  f32x16 acc[MT][2];
#pragma unroll
  for (int i = 0; i < MT; ++i)
#pragma unroll
    for (int j = 0; j < 2; ++j)
#pragma unroll
      for (int r = 0; r < 16; ++r) acc[i][j][r] = 0.f;
  const int nk = K / 64;
  auto gload = [&](int k0) {
#pragma unroll
    for (int i = 0; i < 2 * MT; ++i) {
      int c = tid + NTHR * i, row = c >> 3, cc = c & 7;
      ra[i] = *(const uint4*)(A + (size_t)(m0 + row) * lda + k0 + cc * 8);
    }
#pragma unroll
    for (int i = 0; i < 2; ++i) {
      int c = tid + NTHR * i, row = c >> 3, cc = c & 7;
      rb[i] = *(const uint4*)(Bt + (size_t)(n0 + row) * ldb + k0 + cc * 8);
    }
  };
  auto lstore = [&](int buf) {
#pragma unroll
    for (int i = 0; i < 2 * MT; ++i) {
      int c = tid + NTHR * i, row = c >> 3, cc = c & 7;
      *(uint4*)(As + (buf * BM + row) * GLD + cc * 8) = ra[i];
    }
#pragma unroll
    for (int i = 0; i < 2; ++i) {
      int c = tid + NTHR * i, row = c >> 3, cc = c & 7;
      *(uint4*)(Bs + (buf * 128 + row) * GLD + cc * 8) = rb[i];
    }
  };
  gload(0);
  lstore(0);
  __syncthreads();
  for (int kt = 0; kt < nk; ++kt) {
    const int buf = kt & 1;
    if (kt + 1 < nk) gload((kt + 1) * 64);
#pragma unroll
    for (int ks = 0; ks < 4; ++ks) {
      bf16x8 a[MT], b[2];
#pragma unroll
      for (int i = 0; i < MT; ++i) a[i] = *(const bf16x8*)(As + (buf * BM + wm * 32 * MT + i * 32 + lr) * GLD + ks * 16 + hh * 8);
#pragma unroll
      for (int j = 0; j < 2; ++j) b[j] = *(const bf16x8*)(Bs + (buf * 128 + wn * 64 + j * 32 + lr) * GLD + ks * 16 + hh * 8);
#pragma unroll
      for (int i = 0; i < MT; ++i)
#pragma unroll
        for (int j = 0; j < 2; ++j) acc[i][j] = mfma32(a[i], b[j], acc[i][j]);
    }
    if (kt + 1 < nk) lstore(buf ^ 1);
    __syncthreads();
  }
#pragma unroll
  for (int i = 0; i < MT; ++i)
#pragma unroll
    for (int j = 0; j < 2; ++j)
#pragma unroll
      for (int r = 0; r < 16; ++r) {
        int m = m0 + wm * 32 * MT + i * 32 + (r & 3) + 8 * (r >> 2) + 4 * hh;
        int n = n0 + wn * 64 + j * 32 + lr;
        epi(m, n, acc[i][j][r]);
      }
}

struct Cplx { float re, im; };
__device__ __forceinline__ Cplx cmul(Cplx a, Cplx b) { return {a.re * b.re - a.im * b.im, a.re * b.im + a.im * b.re}; }
__device__ __forceinline__ Cplx apow(float are, float aim, float dt, float m) {
  float mag = __expf(m * dt * are);
  float s, c;
  sincos_rev(m * dt * aim, s, c);
  return {mag * c, mag * s};
}
__device__ __forceinline__ Cplx bscale(float are, float aim, float dt) {
  Cplx ab = apow(are, aim, dt, 1.f);
  float nr = ab.re - 1.f, ni = ab.im;
  float den = are * are + aim * aim;
  return {(nr * are + ni * aim) / den, (ni * are - nr * aim) / den};
}

__device__ __forceinline__ void tr_cvt(const float* __restrict__ W, bf16_t* __restrict__ Wt, int K, int N, int Npad, size_t gt, size_t GT) {
  size_t tot = (size_t)K * Npad;
  for (size_t i = gt; i < tot; i += GT) {
    int n = (int)(i / K), k = (int)(i % K);
    Wt[i] = (n < N) ? f2bf(W[(size_t)k * N + n]) : (bf16_t)0;
  }
}
__device__ __forceinline__ void cvt_flat(const float* __restrict__ W, bf16_t* __restrict__ Wb, size_t n4, size_t gt, size_t GT) {
  for (size_t i = gt; i < n4; i += GT) {
    float4 v = ((const float4*)W)[i];
    ((uint2*)Wb)[i] = make_uint2(pk2(v.x, v.y), pk2(v.z, v.w));
  }
}
__device__ void phase0(const Params& p) {
  const size_t gt = (size_t)blockIdx.x * NTHR + threadIdx.x, GT = (size_t)gridDim.x * NTHR;
  tr_cvt(p.w_in, p.WinT, 1024, INW, 1280, gt, GT);
  tr_cvt(p.w_uq, p.WuqT, 384, 768, 768, gt, GT);
  tr_cvt(p.w_uk, p.WukT, 256, 512, 512, gt, GT);
  tr_cvt(p.w_uv, p.WuvT, 256, 512, 512, gt, GT);
  tr_cvt(p.w_glu, p.WgluT, 512, 1024, 1024, gt, GT);
  tr_cvt(p.w_out, p.WoutT, 1024, 1024, 1024, gt, GT);
  tr_cvt(p.peer_wq, p.WpqT, 1024, 2048, 2048, gt, GT);
  cvt_flat(p.peer_keys, p.PK, 2 * 128 * 128 / 4, gt, GT);
  cvt_flat(p.peer_u, p.Utab, (size_t)16384 * 1024 / 4, gt, GT);
  cvt_flat(p.peer_v, p.Vtab, (size_t)16384 * 1024 / 4, gt, GT);
  {
    size_t tot = (size_t)32 * 128 * 256 / 8;
    for (size_t i = gt; i < tot; i += GT) {
      int g = (int)(i / (128 * 32)), rem = (int)(i % (128 * 32)), n = rem / 32, c8 = rem % 32;
      *(uint4*)(p.A2 + ((size_t)g * NSUB + 1024 + n) * A2LD + c8 * 8) = make_uint4(0, 0, 0, 0);
    }
  }
  {
    size_t tot = (size_t)32 * 16 * 256;
    for (size_t i = gt; i < tot; i += GT) {
      int g = (int)(i / 4096), rem = (int)(i % 4096), m = rem >> 8, h = (rem >> 4) & 15, h2 = rem & 15;
      float dt = __expf(p.log_dt[g]);
      float acc = 0.f;
      for (int pp = 0; pp < 64; ++pp) {
        float are = p.a_re[g * 64 + pp], aim = p.a_im[g * 64 + pp];
        Cplx am = apow(are, aim, dt, (float)m);
        Cplx bs = bscale(are, aim, dt);
        Cplx bb = {p.ssm_b[((g * 64 + pp) * 16 + h2) * 2], p.ssm_b[((g * 64 + pp) * 16 + h2) * 2 + 1]};
        Cplx cc = {p.ssm_c[((g * 16 + h) * 64 + pp) * 2], p.ssm_c[((g * 16 + h) * 64 + pp) * 2 + 1]};
        Cplx x = cmul(cmul(am, bs), bb);
        acc += cc.re * x.re - cc.im * x.im;
      }
      if (m == 0 && h == h2) acc += p.ssm_d[g * 16 + h];
      bf16_t v = f2bf(acc);
      for (int t = m; t < 16; ++t) {
        int j = t - m;
        p.Bt2[((size_t)g * 256 + t * 16 + h) * A2LD + j * 16 + h2] = v;
      }
      if (m == 0) {
        for (int t = 0; t < 16; ++t)
          for (int j = t + 1; j < 16; ++j) p.Bt2[((size_t)g * 256 + t * 16 + h) * A2LD + j * 16 + h2] = 0;
      }
    }
    tot = (size_t)32 * 256 * 64;
    for (size_t i = gt; i < tot; i += GT) {
      int g = (int)(i / 16384), rem = (int)(i % 16384), th = rem >> 6, pp = rem & 63, t = th >> 4, h = th & 15;
      float dt = __expf(p.log_dt[g]);
      float are = p.a_re[g * 64 + pp], aim = p.a_im[g * 64 + pp];
      Cplx am = apow(are, aim, dt, (float)(t + 1));
      Cplx cc = {p.ssm_c[((g * 16 + h) * 64 + pp) * 2], p.ssm_c[((g * 16 + h) * 64 + pp) * 2 + 1]};
      p.Bt2[((size_t)g * 256 + th) * A2LD + 256 + pp] = f2bf(cc.re * am.re - cc.im * am.im);
      p.Bt2[((size_t)g * 256 + th) * A2LD + 320 + pp] = f2bf(-(cc.re * am.im + cc.im * am.re));
    }
    tot = (size_t)32 * 64 * 256;
    for (size_t i = gt; i < tot; i += GT) {
      int g = (int)(i / 16384), rem = (int)(i % 16384), pp = rem >> 8, jh = rem & 255, j = jh >> 4, h2 = jh & 15;
      float dt = __expf(p.log_dt[g]);
      float are = p.a_re[g * 64 + pp], aim = p.a_im[g * 64 + pp];
      Cplx am = apow(are, aim, dt, (float)(15 - j));
      Cplx bs = bscale(are, aim, dt);
      Cplx bb = {p.ssm_b[((g * 64 + pp) * 16 + h2) * 2], p.ssm_b[((g * 64 + pp) * 16 + h2) * 2 + 1]};
      Cplx x = cmul(cmul(am, bs), bb);
      p.Emat[((size_t)g * 128 + pp) * 256 + jh] = f2bf(x.re);
      p.Emat[((size_t)g * 128 + 64 + pp) * 256 + jh] = f2bf(x.im);
    }
  }
}

__device__ void phase_rmsnorm(const float* __restrict__ srcP, const float* __restrict__ srcS, const float* __restrict__ gain,
                              bf16_t* __restrict__ dst) {
  const int lane = threadIdx.x & 63, gw = blockIdx.x * 8 + (threadIdx.x >> 6), GW = gridDim.x * 8;
  float4 g[4];
#pragma unroll
  for (int i = 0; i < 4; ++i) g[i] = *(const float4*)(gain + lane * 4 + 256 * i);
  for (int r = gw; r < NT; r += GW) {
    const float* src = (r < NP) ? srcP + (size_t)r * 1024 : srcS + (size_t)(r - NP) * 1024;
    float4 v[4];
    float ss = 0.f;
#pragma unroll
    for (int i = 0; i < 4; ++i) {
      v[i] = *(const float4*)(src + lane * 4 + 256 * i);
      ss += v[i].x * v[i].x + v[i].y * v[i].y + v[i].z * v[i].z + v[i].w * v[i].w;
    }
    ss = wave_sum(ss);
    float rinv = rsqrtf(ss * (1.f / 1024.f) + EPS);
#pragma unroll
    for (int i = 0; i < 4; ++i) {
      uint2 o = make_uint2(pk2(v[i].x * rinv * g[i].x, v[i].y * rinv * g[i].y), pk2(v[i].z * rinv * g[i].z, v[i].w * rinv * g[i].w));
      *(uint2*)(dst + (size_t)r * 1024 + lane * 4 + 256 * i) = o;
    }
  }
}

__device__ void phase_gemm_z(const Params& p, char* smem) {
  const int ntn = 10, ntm = NT / 256;
  for (int t = blockIdx.x; t < ntm * ntn; t += gridDim.x) {
    int tm = t / ntn, tn = t % ntn;
    float* Z = p.Z;
    gemm_tile<2>(p.XN, 1024, p.WinT, 1024, 1024, tm * 256, tn * 128, smem, [=](int m, int n, float v) {
      if (n < INW) Z[(size_t)m * INW + n] = v;
    });
  }
}

__device__ void phase_post1(const Params& p) {
  const int lane = threadIdx.x & 63, gw = blockIdx.x * 8 + (threadIdx.x >> 6), GW = gridDim.x * 8;
  for (int r = gw; r < NT; r += GW) {
    const float* z = p.Z + (size_t)r * INW;
    const bool isP = r < NP;
    const int rs = r - NP;
    {
      float4 a = *(const float4*)(z + lane * 8), b = *(const float4*)(z + lane * 8 + 4);
      int g = lane >> 1, h0 = (lane & 1) * 8;
      int n = isP ? (r >> 4) : (1024 + (rs >> 2));
      int t = isP ? (r & 15) : (rs & 3);
      *(uint4*)(p.A2 + ((size_t)g * NSUB + n) * A2LD + t * 16 + h0) = make_uint4(pk2(a.x, a.y), pk2(a.z, a.w), pk2(b.x, b.y), pk2(b.z, b.w));
    }
    {
      float2 v[3];
      float ss = 0.f;
#pragma unroll
      for (int i = 0; i < 3; ++i) {
        v[i] = *(const float2*)(z + 512 + lane * 2 + 128 * i);
        ss += v[i].x * v[i].x + v[i].y * v[i].y;
      }
      ss = wave_sum(ss);
      float rinv = rsqrtf(ss * (1.f / 384.f) + EPS);
#pragma unroll
      for (int i = 0; i < 3; ++i) {
        float2 g = *(const float2*)(p.norm_q_lora + lane * 2 + 128 * i);
        *(unsigned*)(p.CQN + (size_t)r * 384 + lane * 2 + 128 * i) = pk2(v[i].x * rinv * g.x, v[i].y * rinv * g.y);
      }
    }
    {
      float4 v = *(const float4*)(z + 896 + lane * 4);
      float ss = wave_sum(v.x * v.x + v.y * v.y + v.z * v.z + v.w * v.w);
      float rinv = rsqrtf(ss * (1.f / 256.f) + EPS);
      float4 g = *(const float4*)(p.norm_kv_lora + lane * 4);
      float4 o = make_float4(v.x * rinv * g.x, v.y * rinv * g.y, v.z * rinv * g.z, v.w * rinv * g.w);
      float* dst = isP ? p.out + O_LATP + (size_t)r * 256 : p.out + O_LATS + (size_t)rs * 256;
      *(float4*)(dst + lane * 4) = o;
      *(uint2*)(p.CKV + (size_t)r * 256 + lane * 4) = make_uint2(pk2(o.x, o.y), pk2(o.z, o.w));
    }
    {
      float v = (lane < 32) ? z[1152 + lane] : 0.f;
      float ss = wave_sum(v * v);
      float rinv = rsqrtf(ss * (1.f / 32.f) + EPS);
      float gn = (lane < 32) ? p.g_kr[lane] : 0.f;
      float xv = v * rinv * gn;
      float other = __shfl_xor(xv, 16);
      int i = lane & 15;
      float pos = isP ? (float)(r & 4095) : (float)(8192 + (rs & 3));
      float inv = exp2f(-(float)i * (13.287712379549449f / 16.f));
      float sn, cs;
      sincos_rev(pos * inv, sn, cs);
      float o = (lane & 16) ? (xv * cs + other * sn) : (xv * cs - other * sn);
      if (lane < 32) {
        float* dst = isP ? p.out + O_KRP + (size_t)r * 32 : p.out + O_KRS + (size_t)rs * 32;
        dst[lane] = o;
        bf16_t ob = f2bf(o);
        if (isP) {
          int b = r >> 12, t = r & 4095;
#pragma unroll
          for (int h = 0; h < 8; ++h) p.Kcat[((size_t)(b * 8 + h) * 4096 + t) * 96 + 64 + lane] = ob;
        } else {
          int seq = rs >> 2, t = rs & 3;
#pragma unroll
          for (int h = 0; h < 8; ++h) p.KcatS[((size_t)(seq * 8 + h) * 4 + t) * 96 + 64 + lane] = ob;
        }
      }
    }
  }
}

__device__ void phase_gemm4(const Params& p, char* smem) {
  const int nq = 66 * 6, nk = 66 * 4, nv = 2 * 128, ns = 32 * 9;
  const int total = nq + nk + nv + ns;
  for (int t = blockIdx.x; t < total; t += gridDim.x) {
    if (t < nq) {
      int tm = t / 6, tn = t % 6;
      float* C = p.Qraw;
      gemm_tile<2>(p.CQN, 384, p.WuqT, 384, 384, tm * 256, tn * 128, smem, [=](int m, int n, float v) { C[(size_t)m * 768 + n] = v; });
    } else if (t < nq + nk) {
      int u = t - nq, tm = u / 4, tn = u % 4;
      float* C = p.KNraw;
      gemm_tile<2>(p.CKV, 256, p.WukT, 256, 256, tm * 256, tn * 128, smem, [=](int m, int n, float v) { C[(size_t)m * 512 + n] = v; });
    } else if (t < nq + nk + nv) {
      int u = t - nq - nk, tm = u / 128, tn = u % 128;
      bf16_t* C = p.VT;
      gemm_tile<2>(p.WuvT, 256, p.CKV, 256, 256, tm * 256, tn * 128, smem, [=](int m, int n, float v) { C[(size_t)m * NP + n] = f2bf(v); });
    } else {
      int u = t - nq - nk - nv, g = u / 9, tm = u % 9;
      float* C = p.S + (size_t)g * NSUB * 128;
      gemm_tile<1>(p.A2 + (size_t)g * NSUB * A2LD, A2LD, p.Emat + (size_t)g * 128 * 256, 256, 256, tm * 128, 0, smem,
                   [=](int m, int n, float v) { C[(size_t)m * 128 + n] = v; });
    }
  }
}

__device__ void phase_post2(const Params& p) {
  const int lane = threadIdx.x & 63, gw = blockIdx.x * 8 + (threadIdx.x >> 6), GW = gridDim.x * 8;
  const float gqn = p.g_qn[lane], gkn = p.g_kn[lane];
  const float gqr = p.g_qr[lane & 31];
  const float inv = exp2f(-(float)(lane & 15) * (13.287712379549449f / 16.f));
  for (int r = gw; r < NT; r += GW) {
    const bool isP = r < NP;
    const int rs = r - NP;
    float pos = isP ? (float)(r & 4095) : (float)(8192 + (rs & 3));
    float sn, cs;
    sincos_rev(pos * inv, sn, cs);
#pragma unroll 1
    for (int h = 0; h < 8; ++h) {
      const float* q = p.Qraw + (size_t)r * 768 + h * 96;
      float v = q[lane];
      float ss = wave_sum(v * v);
      float rinv = rsqrtf(ss * (1.f / 64.f) + EPS);
      p.Qb[((size_t)r * 8 + h) * 96 + lane] = f2bf(v * rinv * gqn * QSCALE);
      float w = (lane < 32) ? q[64 + lane] : 0.f;
      float s2 = wave_sum(w * w);
      float rinv2 = rsqrtf(s2 * (1.f / 32.f) + EPS);
      float xv = w * rinv2 * gqr;
      float other = __shfl_xor(xv, 16);
      float o = (lane & 16) ? (xv * cs + other * sn) : (xv * cs - other * sn);
      if (lane < 32) p.Qb[((size_t)r * 8 + h) * 96 + 64 + lane] = f2bf(o * QSCALE);
      float kv = p.KNraw[(size_t)r * 512 + h * 64 + lane];
      float ks = wave_sum(kv * kv);
      float krinv = rsqrtf(ks * (1.f / 64.f) + EPS);
      bf16_t kb = f2bf(kv * krinv * gkn);
      if (isP) {
        int b = r >> 12, t = r & 4095;
        p.Kcat[((size_t)(b * 8 + h) * 4096 + t) * 96 + lane] = kb;
      } else {
        int seq = rs >> 2, t = rs & 3;
        p.KcatS[((size_t)(seq * 8 + h) * 4 + t) * 96 + lane] = kb;
      }
    }
  }
}

__device__ __forceinline__ float softmax_bound(const Params& p) {
  const int lane = threadIdx.x & 63;
  float a = fabsf(p.g_qn[lane]), b = fabsf(p.g_kn[lane]), c = fabsf(p.g_qr[lane & 31]), d = fabsf(p.g_kr[lane & 31]);
#pragma unroll
  for (int o = 32; o >= 1; o >>= 1) {
    a = fmaxf(a, __shfl_xor(a, o)); b = fmaxf(b, __shfl_xor(b, o));
    c = fmaxf(c, __shfl_xor(c, o)); d = fmaxf(d, __shfl_xor(d, o));
  }
  return QSCALE * (64.f * a * b + 32.f * c * d);
}

#define KLD 104
#define VLD 68
__device__ __forceinline__ void attn_prompt_block(const Params& p, char* smem, int b, int h, int qi, float Mb) {
  bf16_t* Ks = (bf16_t*)smem;
  bf16_t* Vs = Ks + 2 * 64 * KLD;
  const int tid = threadIdx.x, lane = tid & 63, wave = tid >> 6, lr = lane & 31, hh = lane >> 5;
  const int q0 = qi * 256 + wave * 32;
  const bf16_t* Kg = p.Kcat + (size_t)(b * 8 + h) * 4096 * 96;
  const bf16_t* Vg = p.VT + (size_t)(h * 64) * NP + b * 4096;
  bf16x8 qf[6];
  {
    const bf16_t* qp = p.Qb + ((size_t)(b * 4096 + q0 + lr) * 8 + h) * 96 + hh * 8;
#pragma unroll
    for (int s = 0; s < 6; ++s) qf[s] = *(const bf16x8*)(qp + s * 16);
  }
  f32x16 ot[2];
#pragma unroll
  for (int i = 0; i < 2; ++i)
#pragma unroll
    for (int r = 0; r < 16; ++r) ot[i][r] = 0.f;
  float lsum = 0.f;
  const int nkt = 4 * (qi + 1);
  uint4 rk[2];
  uint2 rv[2];
  auto gload = [&](int kt) {
    const int k0 = kt * 64;
#pragma unroll
    for (int i = 0; i < 2; ++i) {
      int c = tid + NTHR * i;
      c = c < 768 ? c : 767;
      int row = c / 12, cc = c % 12;
      rk[i] = *(const uint4*)(Kg + (size_t)(k0 + row) * 96 + cc * 8);
    }
#pragma unroll
    for (int i = 0; i < 2; ++i) {
      int c = tid + NTHR * i, row = c >> 4, cc = c & 15;
      rv[i] = *(const uint2*)(Vg + (size_t)row * NP + k0 + cc * 4);
    }
  };
  auto lstore = [&](int buf) {
#pragma unroll
    for (int i = 0; i < 2; ++i) {
      int c = tid + NTHR * i;
      if (c < 768) { int row = c / 12, cc = c % 12; *(uint4*)(Ks + (buf * 64 + row) * KLD + cc * 8) = rk[i]; }
    }
#pragma unroll
    for (int i = 0; i < 2; ++i) {
      int c = tid + NTHR * i, row = c >> 4, cc = c & 15;
      *(uint2*)(Vs + (buf * 64 + row) * VLD + cc * 4) = rv[i];
    }
  };
  gload(0);
  lstore(0);
  __syncthreads();
  for (int kt = 0; kt < nkt; ++kt) {
    const int buf = kt & 1, k0 = kt * 64;
    if (kt + 1 < nkt) gload(kt + 1);
    if (k0 <= q0 + 31) {
      const bool need_mask = (k0 + 63 > q0);
      bf16x8 pb[2][2];
#pragma unroll
      for (int kt2 = 0; kt2 < 2; ++kt2) {
        f32x16 st;
#pragma unroll
        for (int r = 0; r < 16; ++r) st[r] = 0.f;
#pragma unroll
        for (int s = 0; s < 6; ++s) {
          bf16x8 a = *(const bf16x8*)(Ks + (buf * 64 + kt2 * 32 + lr) * KLD + s * 16 + hh * 8);
          st = mfma32(a, qf[s], st);
        }
        float pv[16];
#pragma unroll
        for (int r = 0; r < 16; ++r) {
          float e = exp2f(st[r] - Mb);
          if (need_mask) {
            int key = k0 + kt2 * 32 + (r & 3) + 8 * (r >> 2) + 4 * hh;
            e = (key <= q0 + lr) ? e : 0.f;
          }
          pv[r] = e;
          lsum += e;
        }
#pragma unroll
        for (int s2 = 0; s2 < 2; ++s2)
          pb[kt2][s2] = mk8(pk2(pv[8 * s2 + 0], pv[8 * s2 + 1]), pk2(pv[8 * s2 + 2], pv[8 * s2 + 3]),
                            pk2(pv[8 * s2 + 4], pv[8 * s2 + 5]), pk2(pv[8 * s2 + 6], pv[8 * s2 + 7]));
      }
#pragma unroll
      for (int dt = 0; dt < 2; ++dt)
#pragma unroll
        for (int kt2 = 0; kt2 < 2; ++kt2)
#pragma unroll
          for (int s2 = 0; s2 < 2; ++s2) {
            const bf16_t* vp = Vs + (buf * 64 + dt * 32 + lr) * VLD + kt2 * 32 + 16 * s2 + 4 * hh;
            uint2 lo = *(const uint2*)vp, hi = *(const uint2*)(vp + 8);
            bf16x8 a = mk8(lo.x, lo.y, hi.x, hi.y);
            ot[dt] = mfma32(a, pb[kt2][s2], ot[dt]);
          }
    }
    if (kt + 1 < nkt) lstore(buf ^ 1);
    __syncthreads();
  }
  lsum += __shfl_xor(lsum, 32);
  const float linv = 1.f / lsum;
  bf16_t* op = p.OATT + (size_t)(b * 4096 + q0 + lr) * 512 + h * 64;
#pragma unroll
  for (int dt = 0; dt < 2; ++dt)
#pragma unroll
    for (int rg = 0; rg < 4; ++rg) {
      int d = dt * 32 + 8 * rg + 4 * hh;
      *(uint2*)(op + d) = make_uint2(pk2(ot[dt][4 * rg] * linv, ot[dt][4 * rg + 1] * linv), pk2(ot[dt][4 * rg + 2] * linv, ot[dt][4 * rg + 3] * linv));
    }
}

#define LLD 264
#define KRLD 40
#define PLD 72
__device__ __forceinline__ void attn_decode_unit(const Params& p, char* smem, int seq, int half, float Mb) {
  bf16_t* latS = (bf16_t*)smem;
  bf16_t* krS = latS + 64 * LLD;
  bf16_t* Psh = krS + 64 * KRLD;
  const int tid = threadIdx.x, lane = tid & 63, wave = tid >> 6, lr = lane & 31, hh = lane >> 5;
  const int hd = wave;
  bf16x8 qnf[2][2], qrf[2];
  {
    const bf16_t* qp = p.Qb + ((size_t)(NP + seq * 4 + (lr & 3)) * 8 + hd) * 96;
    const bool valid = lr < 4;
#pragma unroll
    for (int dt = 0; dt < 2; ++dt)
#pragma unroll
      for (int s2 = 0; s2 < 2; ++s2) {
        unsigned w[4];
#pragma unroll
        for (int jj = 0; jj < 4; ++jj) {
          float v[2];
#pragma unroll
          for (int e = 0; e < 2; ++e) {
            int j = jj * 2 + e;
            int d = 32 * dt + 16 * s2 + 8 * (j >> 2) + 4 * hh + (j & 3);
            v[e] = valid ? bf2f(qp[d]) * p.g_kn[d] : 0.f;
          }
          w[jj] = pk2(v[0], v[1]);
        }
        qnf[dt][s2] = mk8(w[0], w[1], w[2], w[3]);
      }
#pragma unroll
    for (int s = 0; s < 2; ++s) {
      uint4 u = *(const uint4*)(qp + 64 + 16 * s + 8 * hh);
      if (!valid) u = make_uint4(0, 0, 0, 0);
      qrf[s] = __builtin_bit_cast(bf16x8, u);
    }
  }
  f32x16 oacc;
#pragma unroll
  for (int r = 0; r < 16; ++r) oacc[r] = 0.f;
  float lsum[4] = {0.f, 0.f, 0.f, 0.f};
  const int ntile = 64 + half;
  float4 rl[8];
  float4 rkr;
  auto gload = [&](int i) {
    int page = p.page_table[seq * 64 + half * 32 + (i >> 1)];
    const float* lp = p.cache_lat + ((size_t)page * 128 + (i & 1) * 64) * 256;
    const float* kp = p.cache_kr + ((size_t)page * 128 + (i & 1) * 64) * 32;
#pragma unroll
    for (int j = 0; j < 8; ++j) rl[j] = ((const float4*)lp)[tid + NTHR * j];
    rkr = ((const float4*)kp)[tid];
  };
  auto lstore = [&]() {
#pragma unroll
    for (int j = 0; j < 8; ++j) {
      int f = tid + NTHR * j, row = f >> 6, c4 = f & 63;
      *(uint2*)(latS + row * LLD + c4 * 4) = make_uint2(pk2(rl[j].x, rl[j].y), pk2(rl[j].z, rl[j].w));
    }
    int row = tid >> 3, c4 = tid & 7;
    *(uint2*)(krS + row * KRLD + c4 * 4) = make_uint2(pk2(rkr.x, rkr.y), pk2(rkr.z, rkr.w));
  };
  auto lstore_new = [&]() {
#pragma unroll
    for (int j = 0; j < 8; ++j) {
      int f = tid + NTHR * j, row = f >> 6, c4 = f & 63;
      uint2 v = make_uint2(0, 0);
      if (row < 4) v = *(const uint2*)(p.CKV + (size_t)(NP + seq * 4 + row) * 256 + c4 * 4);
      *(uint2*)(latS + row * LLD + c4 * 4) = v;
    }
    int row = tid >> 3, c4 = tid & 7;
    uint2 v = make_uint2(0, 0);
    if (row < 4) v = *(const uint2*)(p.KcatS + ((size_t)(seq * 8) * 4 + row) * 96 + 64 + c4 * 4);
    *(uint2*)(krS + row * KRLD + c4 * 4) = v;
  };
  gload(0);
  for (int i = 0; i < ntile; ++i) {
    const bool isnew = (i == 64);
    if (isnew) lstore_new(); else lstore();
    __syncthreads();
    if (i + 1 < 64) gload(i + 1);
#pragma unroll 1
    for (int kt2 = 0; kt2 < 2; ++kt2) {
      float ss = 0.f;
      f32x16 s1, s2;
#pragma unroll
      for (int r = 0; r < 16; ++r) { s1[r] = 0.f; s2[r] = 0.f; }
#pragma unroll
      for (int dt = 0; dt < 2; ++dt) {
        f32x16 acc;
#pragma unroll
        for (int r = 0; r < 16; ++r) acc[r] = 0.f;
        int wofs = (hd * 64 + dt * 32 + lr) * 256 + hh * 8;
        asm volatile("" : "+v"(wofs));
        const bf16_t* wp = p.WukT + wofs;
#pragma unroll
        for (int ks = 0; ks < 16; ++ks) {
          bf16x8 wfr = *(const bf16x8*)(wp + ks * 16);
          bf16x8 bfr = *(const bf16x8*)(latS + (kt2 * 32 + lr) * LLD + ks * 16 + hh * 8);
          acc = mfma32(wfr, bfr, acc);
        }
#pragma unroll
        for (int r = 0; r < 16; ++r) ss += acc[r] * acc[r];
#pragma unroll
        for (int sp = 0; sp < 2; ++sp) {
          bf16x8 bk = mk8(pk2(acc[8 * sp + 0], acc[8 * sp + 1]), pk2(acc[8 * sp + 2], acc[8 * sp + 3]),
                          pk2(acc[8 * sp + 4], acc[8 * sp + 5]), pk2(acc[8 * sp + 6], acc[8 * sp + 7]));
          s1 = mfma32(qnf[dt][sp], bk, s1);
        }
      }
      ss += __shfl_xor(ss, 32);
      const float rinv = rsqrtf(ss * (1.f / 64.f) + EPS);
#pragma unroll
      for (int s = 0; s < 2; ++s) {
        bf16x8 bk = *(const bf16x8*)(krS + (kt2 * 32 + lr) * KRLD + s * 16 + hh * 8);
        s2 = mfma32(qrf[s], bk, s2);
      }
      if (hh == 0) {
        const int kk = kt2 * 32 + lr;
#pragma unroll
        for (int t = 0; t < 4; ++t) {
          float sc = s1[t] * rinv + s2[t];
          float e = exp2f(sc - Mb);
          if (isnew) e = (kk < 4 && kk <= t) ? e : 0.f;
          lsum[t] += e;
          Psh[(hd * 4 + t) * PLD + kk] = f2bf(e);
        }
      }
    }
    __syncthreads();
    {
      const int n0 = wave * 32;
#pragma unroll
      for (int ks = 0; ks < 4; ++ks) {
        bf16x8 a = *(const bf16x8*)(Psh + lr * PLD + ks * 16 + hh * 8);
        const int key0 = ks * 16 + 8 * hh, c0 = n0 + 16 * ((lane >> 4) & 1);
        const int q = (lane & 15) >> 2, pp = lane & 3;
        const bf16_t* ap = latS + (key0 + q) * LLD + c0 + 4 * pp;
        s16x4 lo = __builtin_amdgcn_ds_read_tr16_b64_v4i16((__attribute__((address_space(3))) s16x4*)(ap));
        s16x4 hi = __builtin_amdgcn_ds_read_tr16_b64_v4i16((__attribute__((address_space(3))) s16x4*)(ap + 4 * LLD));
        bf16x8 bfr;
        bfr[0] = lo[0]; bfr[1] = lo[1]; bfr[2] = lo[2]; bfr[3] = lo[3];
        bfr[4] = hi[0]; bfr[5] = hi[1]; bfr[6] = hi[2]; bfr[7] = hi[3];
        oacc = mfma32(a, bfr, oacc);
      }
    }
    __syncthreads();
  }
  float* Op = p.Opart + ((size_t)(seq * 2 + half) * 32) * 256;
#pragma unroll
  for (int r = 0; r < 16; ++r) {
    int m = (r & 3) + 8 * (r >> 2) + 4 * hh;
    Op[(size_t)m * 256 + wave * 32 + lr] = oacc[r];
  }
#pragma unroll
  for (int t = 0; t < 4; ++t) {
    float v = (hh == 0) ? lsum[t] : 0.f;
    v = wave_sum(v);
    if (lane == 0) p.Lpart[(seq * 2 + half) * 32 + hd * 4 + t] = v;
  }
}

__device__ __forceinline__ void ssm_scan_prompt(const Params& p, int job) {
  const int lane = threadIdx.x & 63;
  const int b = job >> 5, g = job & 31;
  const float dt = __expf(p.log_dt[g]);
  const Cplx a16 = apow(p.a_re[g * 64 + lane], p.a_im[g * 64 + lane], dt, 16.f);
  Cplx H = {0.f, 0.f};
  const float* S = p.S + ((size_t)g * NSUB + b * 256) * 128;
  bf16_t* A2 = p.A2 + ((size_t)g * NSUB + b * 256) * A2LD + 256;
  for (int n0 = 0; n0 < 256; n0 += 16) {
    float sr[16], si[16];
#pragma unroll
    for (int k = 0; k < 16; ++k) { sr[k] = S[(size_t)(n0 + k) * 128 + lane]; si[k] = S[(size_t)(n0 + k) * 128 + 64 + lane]; }
#pragma unroll
    for (int k = 0; k < 16; ++k) {
      A2[(size_t)(n0 + k) * A2LD + lane] = f2bf(H.re);
      A2[(size_t)(n0 + k) * A2LD + 64 + lane] = f2bf(H.im);
      Cplx t = cmul(a16, H);
      H.re = t.re + sr[k]; H.im = t.im + si[k];
    }
  }
  float* o = p.out + O_SSMP + ((size_t)(b * 32 + g) * 64 + lane) * 2;
  o[0] = H.re; o[1] = H.im;
}
__device__ __forceinline__ void ssm_sample(const Params& p, int job) {
  const int lane = threadIdx.x & 63;
  const int seq = job >> 5, g = job & 31;
  const float dt = __expf(p.log_dt[g]);
  const float are = p.a_re[g * 64 + lane], aim = p.a_im[g * 64 + lane];
  const Cplx ab = apow(are, aim, dt, 1.f);
  const Cplx bs = bscale(are, aim, dt);
  const float* st = p.state_ssm + ((size_t)(seq * 32 + g) * 64 + lane) * 2;
  Cplx H = {st[0], st[1]};
  bf16_t* A2 = p.A2 + ((size_t)g * NSUB + 1024 + seq) * A2LD + 256;
  A2[lane] = f2bf(H.re);
  A2[64 + lane] = f2bf(H.im);
  Cplx bb[16];
#pragma unroll
  for (int h = 0; h < 16; ++h) {
    Cplx braw = {p.ssm_b[((g * 64 + lane) * 16 + h) * 2], p.ssm_b[((g * 64 + lane) * 16 + h) * 2 + 1]};
    bb[h] = cmul(bs, braw);
  }
#pragma unroll
  for (int t = 0; t < 4; ++t) {
    const float* u = p.Z + (size_t)(NP + seq * 4 + t) * INW + g * 16;
    Cplx bu = {0.f, 0.f};
#pragma unroll
    for (int h = 0; h < 16; ++h) { float uv = u[h]; bu.re += uv * bb[h].re; bu.im += uv * bb[h].im; }
    Cplx tt = cmul(ab, H);
    H.re = tt.re + bu.re; H.im = tt.im + bu.im;
  }
  float* o = p.out + O_SSMS + ((size_t)(seq * 32 + g) * 64 + lane) * 2;
  o[0] = H.re; o[1] = H.im;
}

__device__ void phase_attn(const Params& p, char* smem) {
  const int wave = threadIdx.x >> 6;
  const int gw = blockIdx.x * 8 + wave, GW = gridDim.x * 8;
  for (int j = gw; j < 128; j += GW) ssm_scan_prompt(p, j);
  for (int j = gw; j < 4096; j += GW) ssm_sample(p, j);
  const float Mb = softmax_bound(p);
  __syncthreads();
  for (int it = blockIdx.x; it < 256; it += gridDim.x) {
    int bh = it >> 3, j = it & 7;
    attn_prompt_block(p, smem, bh >> 3, bh & 7, j, Mb);
    attn_prompt_block(p, smem, bh >> 3, bh & 7, 15 - j, Mb);
  }
  for (int it = blockIdx.x; it < 256; it += gridDim.x) attn_decode_unit(p, smem, it >> 1, it & 1, Mb);
}

__device__ void phase_ssm_y(const Params& p, char* smem) {
  const int ntile = 32 * 9 * 2;
  for (int t = blockIdx.x; t < ntile; t += gridDim.x) {
    int g = t / 18, rem = t % 18, tm = rem >> 1, tn = rem & 1;
    bf16_t* G = p.G;
    gemm_tile<1>(p.A2 + (size_t)g * NSUB * A2LD, A2LD, p.Bt2 + (size_t)g * 256 * A2LD, A2LD, 384, tm * 128, tn * 128, smem,
                 [=](int m, int n, float v) {
                   int tt = n >> 4, h = n & 15;
                   int token;
                   if (m < 1024) token = m * 16 + tt;
                   else { if (tt >= 4) return; token = NP + (m - 1024) * 4 + tt; }
                   G[(size_t)token * 512 + g * 16 + h] = f2bf(gelu_tanh(v));
                 });
  }
  const int lane = threadIdx.x & 63, gw = blockIdx.x * 8 + (threadIdx.x >> 6), GW = gridDim.x * 8;
  for (int job = gw; job < 1024; job += GW) {
    int seq = job >> 3, hd = job & 7;
    const float* O0 = p.Opart + ((size_t)(seq * 2) * 32 + hd * 4) * 256;
    const float* O1 = O0 + 32 * 256;
    float acc[4] = {0.f, 0.f, 0.f, 0.f};
    for (int c = 0; c < 256; ++c) {
      float w = p.w_uv[(size_t)c * 512 + hd * 64 + lane];
#pragma unroll
      for (int t = 0; t < 4; ++t) acc[t] += (O0[t * 256 + c] + O1[t * 256 + c]) * w;
    }
#pragma unroll
    for (int t = 0; t < 4; ++t) {
      float l = p.Lpart[(seq * 2) * 32 + hd * 4 + t] + p.Lpart[(seq * 2 + 1) * 32 + hd * 4 + t];
      p.OATT[(size_t)(NP + seq * 4 + t) * 512 + hd * 64 + lane] = f2bf(acc[t] / l);
    }
  }
}

__device__ void phase_gemm_gl(const Params& p, char* smem) {
  for (int t = blockIdx.x; t < 66 * 8; t += gridDim.x) {
    int tm = t / 8, tn = t % 8;
    float* C = p.GL;
    gemm_tile<2>(p.G, 512, p.WgluT, 512, 512, tm * 256, tn * 128, smem, [=](int m, int n, float v) { C[(size_t)m * 1024 + n] = v; });
  }
}
__device__ void phase_cat(const Params& p) {
  const size_t gt = (size_t)blockIdx.x * NTHR + threadIdx.x, GT = (size_t)gridDim.x * NTHR;
  const size_t tot = (size_t)NT * 128;
  for (size_t i = gt; i < tot; i += GT) {
    size_t token = i >> 7;
    int c = (int)(i & 127) * 4;
    float4 a = *(const float4*)(p.GL + token * 1024 + c), b = *(const float4*)(p.GL + token * 1024 + 512 + c);
    float r0 = a.x / (1.f + __expf(-b.x)), r1 = a.y / (1.f + __expf(-b.y)), r2 = a.z / (1.f + __expf(-b.z)), r3 = a.w / (1.f + __expf(-b.w));
    *(uint2*)(p.CAT + token * 1024 + c) = make_uint2(pk2(r0, r1), pk2(r2, r3));
    *(uint2*)(p.CAT + token * 1024 + 512 + c) = *(const uint2*)(p.OATT + token * 512 + c);
  }
}
__device__ void phase_gemm_out(const Params& p, char* smem) {
  for (int t = blockIdx.x; t < 66 * 8; t += gridDim.x) {
    int tm = t / 8, tn = t % 8;
    float* C = p.X1;
    const float *xp = p.x_prompt, *xs = p.x_sample;
    gemm_tile<2>(p.CAT, 1024, p.WoutT, 1024, 1024, tm * 256, tn * 128, smem, [=](int m, int n, float v) {
      float x = (m < NP) ? xp[(size_t)m * 1024 + n] : xs[(size_t)(m - NP) * 1024 + n];
      C[(size_t)m * 1024 + n] = x + v;
    });
  }
}
__device__ void phase_gemm_pq(const Params& p, char* smem) {
  for (int t = blockIdx.x; t < 66 * 16; t += gridDim.x) {
    int tm = t / 16, tn = t % 16;
    bf16_t* C = p.PQ;
    gemm_tile<2>(p.XN, 1024, p.WpqT, 1024, 1024, tm * 256, tn * 128, smem, [=](int m, int n, float v) { C[(size_t)m * 2048 + n] = f2bf(v); });
  }
}
__device__ void phase_gemm_sc(const Params& p, char* smem) {
  const int ntm = NT * 8 / 256;
  for (int t = blockIdx.x; t < ntm * 2; t += gridDim.x) {
    int c = t & 1, tm = t >> 1;
    float* C = p.SC + c * 128;
    gemm_tile<2>(p.PQ + c * 128, 256, p.PK + c * 128 * 128, 128, 128, tm * 256, 0, smem, [=](int m, int n, float v) { C[(size_t)m * 256 + n] = v; });
  }
}
__device__ __forceinline__ void ins16(float (&L)[16], float x) {
#pragma unroll
  for (int j = 15; j >= 1; --j) L[j] = __builtin_amdgcn_fmed3f(L[j - 1], L[j], x);
  L[0] = fmaxf(L[0], x);
}
__device__ void phase_topk(const Params& p, char* smem) {
  unsigned* sidx = (unsigned*)smem;
  const int tid = threadIdx.x;
  const int nrow = NT * 8;
  for (int m = blockIdx.x * NTHR + tid; m < nrow; m += gridDim.x * NTHR) {
    float L1[16], L2[16], T[16];
#pragma unroll
    for (int j = 0; j < 16; ++j) { L1[j] = -3.0e38f; L2[j] = -3.0e38f; T[j] = -3.0e38f; }
    const float4* s1 = (const float4*)(p.SC + (size_t)m * 256);
    const float4* s2 = s1 + 32;
#pragma unroll 2
    for (int k4 = 0; k4 < 32; ++k4) {
      float4 a = s1[k4], b = s2[k4];
      float av[4] = {a.x, a.y, a.z, a.w}, bv[4] = {b.x, b.y, b.z, b.w};
#pragma unroll
      for (int e = 0; e < 4; ++e) {
        unsigned k = k4 * 4 + e;
        ins16(L1, __uint_as_float((__float_as_uint(av[e]) & ~127u) | k));
        ins16(L2, __uint_as_float((__float_as_uint(bv[e]) & ~127u) | k));
      }
    }
#pragma unroll
    for (int j = 0; j < 16; ++j) {
      sidx[j * NTHR + tid] = __float_as_uint(L1[j]) & 127u;
      sidx[(16 + j) * NTHR + tid] = __float_as_uint(L2[j]) & 127u;
    }
#pragma unroll
    for (int i = 0; i < 16; ++i)
#pragma unroll
      for (int j = 0; j < 16; ++j)
        if ((i + 1) * (j + 1) <= 16) {
          float a = __uint_as_float(__float_as_uint(L1[i]) & ~127u), b = __uint_as_float(__float_as_uint(L2[j]) & ~127u);
          float s = a + b;
          ins16(T, __uint_as_float((__float_as_uint(s) & ~255u) | (unsigned)(i * 16 + j)));
        }
    float mx = __uint_as_float(__float_as_uint(T[0]) & ~255u);
    float e[16], sum = 0.f;
    int id[16];
#pragma unroll
    for (int k = 0; k < 16; ++k) {
      unsigned bits = __float_as_uint(T[k]);
      float v = __uint_as_float(bits & ~255u);
      e[k] = __expf(v - mx);
      sum += e[k];
      unsigned ij = bits & 255u;
      unsigned e1 = sidx[(ij >> 4) * NTHR + tid], e2 = sidx[(16 + (ij & 15)) * NTHR + tid];
      id[k] = (int)(e1 * 128 + e2);
    }
    float inv = 1.f / sum;
#pragma unroll
    for (int k4 = 0; k4 < 4; ++k4) {
      *(int4*)(p.IDX + (size_t)m * 16 + k4 * 4) = make_int4(id[k4 * 4], id[k4 * 4 + 1], id[k4 * 4 + 2], id[k4 * 4 + 3]);
      *(float4*)(p.GW + (size_t)m * 16 + k4 * 4) = make_float4(e[k4 * 4] * inv, e[k4 * 4 + 1] * inv, e[k4 * 4 + 2] * inv, e[k4 * 4 + 3] * inv);
    }
  }
}
__device__ void phase_gather(const Params& p) {
  const int lane = threadIdx.x & 63, gw = blockIdx.x * 8 + (threadIdx.x >> 6), GW = gridDim.x * 8;
  for (int r = gw; r < NT; r += GW) {
    uint4 x0 = *(const uint4*)(p.XN + (size_t)r * 1024 + lane * 8);
    uint4 x1 = *(const uint4*)(p.XN + (size_t)r * 1024 + 512 + lane * 8);
    float acc[16];
#pragma unroll
    for (int i = 0; i < 16; ++i) acc[i] = 0.f;
    const int* idx = p.IDX + (size_t)r * 128;
    const float* gwt = p.GW + (size_t)r * 128;
#pragma unroll 4
    for (int k = 0; k < 128; ++k) {
      const int e = __builtin_amdgcn_readfirstlane(idx[k]);
      const float gk = gwt[k];
      const bf16_t* up = p.Utab + (size_t)e * 1024;
      const bf16_t* vp = p.Vtab + (size_t)e * 1024;
      uint4 u0 = *(const uint4*)(up + lane * 8), u1 = *(const uint4*)(up + 512 + lane * 8);
      uint4 v0 = *(const uint4*)(vp + lane * 8), v1 = *(const uint4*)(vp + 512 + lane * 8);
      float d = 0.f;
      d = __builtin_amdgcn_fdot2_f32_bf16(__builtin_bit_cast(bf2, u0.x), __builtin_bit_cast(bf2, x0.x), d, false);
      d = __builtin_amdgcn_fdot2_f32_bf16(__builtin_bit_cast(bf2, u0.y), __builtin_bit_cast(bf2, x0.y), d, false);
      d = __builtin_amdgcn_fdot2_f32_bf16(__builtin_bit_cast(bf2, u0.z), __builtin_bit_cast(bf2, x0.z), d, false);
      d = __builtin_amdgcn_fdot2_f32_bf16(__builtin_bit_cast(bf2, u0.w), __builtin_bit_cast(bf2, x0.w), d, false);
      d = __builtin_amdgcn_fdot2_f32_bf16(__builtin_bit_cast(bf2, u1.x), __builtin_bit_cast(bf2, x1.x), d, false);
      d = __builtin_amdgcn_fdot2_f32_bf16(__builtin_bit_cast(bf2, u1.y), __builtin_bit_cast(bf2, x1.y), d, false);
      d = __builtin_amdgcn_fdot2_f32_bf16(__builtin_bit_cast(bf2, u1.z), __builtin_bit_cast(bf2, x1.z), d, false);
      d = __builtin_amdgcn_fdot2_f32_bf16(__builtin_bit_cast(bf2, u1.w), __builtin_bit_cast(bf2, x1.w), d, false);
      d = wave_sum(d);
      const float w = gk * gelu_tanh(d);
      acc[0] += w * bflo(v0.x); acc[1] += w * bfhi(v0.x); acc[2] += w * bflo(v0.y); acc[3] += w * bfhi(v0.y);
      acc[4] += w * bflo(v0.z); acc[5] += w * bfhi(v0.z); acc[6] += w * bflo(v0.w); acc[7] += w * bfhi(v0.w);
      acc[8] += w * bflo(v1.x); acc[9] += w * bfhi(v1.x); acc[10] += w * bflo(v1.y); acc[11] += w * bfhi(v1.y);
      acc[12] += w * bflo(v1.z); acc[13] += w * bfhi(v1.z); acc[14] += w * bflo(v1.w); acc[15] += w * bfhi(v1.w);
    }
    const float* x1p = p.X1 + (size_t)r * 1024;
    float* yo = (r < NP) ? p.out + O_YP + (size_t)r * 1024 : p.out + O_YS + (size_t)(r - NP) * 1024;
#pragma unroll
    for (int hlf = 0; hlf < 2; ++hlf)
#pragma unroll
      for (int q = 0; q < 2; ++q) {
        int off = hlf * 512 + lane * 8 + q * 4;
        float4 xv = *(const float4*)(x1p + off);
        *(float4*)(yo + off) = make_float4(xv.x + acc[hlf * 8 + q * 4], xv.y + acc[hlf * 8 + q * 4 + 1], xv.z + acc[hlf * 8 + q * 4 + 2], xv.w + acc[hlf * 8 + q * 4 + 3]);
      }
  }
}

extern __shared__ __attribute__((aligned(16))) char dyn_smem[];
template <int PH>
__global__ void __launch_bounds__(NTHR, 2) k_phase(Params p) {
  char* smem = dyn_smem;
  if constexpr (PH == 0) phase0(p);
  if constexpr (PH == 1) phase_rmsnorm(p.x_prompt, p.x_sample, p.norm_mix, p.XN);
  if constexpr (PH == 2) phase_gemm_z(p, smem);
  if constexpr (PH == 3) phase_post1(p);
  if constexpr (PH == 4) phase_gemm4(p, smem);
  if constexpr (PH == 5) phase_post2(p);
  if constexpr (PH == 6) phase_attn(p, smem);
  if constexpr (PH == 7) phase_ssm_y(p, smem);
  if constexpr (PH == 8) phase_gemm_gl(p, smem);
  if constexpr (PH == 9) phase_cat(p);
  if constexpr (PH == 10) phase_gemm_out(p, smem);
  if constexpr (PH == 11) phase_rmsnorm(p.X1, p.X1 + (size_t)NP * 1024, p.norm_ffn, p.XN);
  if constexpr (PH == 12) phase_gemm_pq(p, smem);
  if constexpr (PH == 13) phase_gemm_sc(p, smem);
  if constexpr (PH == 14) phase_topk(p, smem);
  if constexpr (PH == 15) phase_gather(p);
}

#define LDS_BYTES 110592

template <int PH>
static void launch_phase(const Params& p, hipStream_t stream) {
  static bool attr = false;
  if (!attr) { hipFuncSetAttribute((const void*)k_phase<PH>, hipFuncAttributeMaxDynamicSharedMemorySize, LDS_BYTES); attr = true; }
  hipLaunchKernelGGL(k_phase<PH>, dim3(256), dim3(NTHR), LDS_BYTES, stream, p);
}

extern "C" void kernel_launch(void* const* d_in, const int* in_sizes, int n_in, void* d_out, int out_size, void* d_ws, size_t ws_size,
                              hipStream_t stream) {
  Params p{};
  p.x_prompt = (const float*)d_in[0]; p.x_sample = (const float*)d_in[1]; p.cache_lat = (const float*)d_in[2];
  p.cache_kr = (const float*)d_in[3]; p.state_ssm = (const float*)d_in[4]; p.page_table = (const int*)d_in[5];
  p.norm_mix = (const float*)d_in[6]; p.w_in = (const float*)d_in[7]; p.norm_q_lora = (const float*)d_in[8];
  p.w_uq = (const float*)d_in[9]; p.norm_kv_lora = (const float*)d_in[10]; p.w_uk = (const float*)d_in[11];
  p.w_uv = (const float*)d_in[12]; p.g_qn = (const float*)d_in[13]; p.g_qr = (const float*)d_in[14];
  p.g_kn = (const float*)d_in[15]; p.g_kr = (const float*)d_in[16]; p.a_re = (const float*)d_in[17];
  p.a_im = (const float*)d_in[18]; p.log_dt = (const float*)d_in[19]; p.ssm_b = (const float*)d_in[20];
  p.ssm_c = (const float*)d_in[21]; p.ssm_d = (const float*)d_in[22]; p.w_glu = (const float*)d_in[23];
  p.w_out = (const float*)d_in[24]; p.norm_ffn = (const float*)d_in[25]; p.peer_wq = (const float*)d_in[26];
  p.peer_keys = (const float*)d_in[27]; p.peer_u = (const float*)d_in[28]; p.peer_v = (const float*)d_in[29];
  p.out = (float*)d_out;
  char* w = (char*)d_ws;
  size_t off = 0;
  auto take = [&](size_t bytes) { char* r = w + off; off += (bytes + 255) & ~(size_t)255; return r; };
  p.bar = (unsigned*)take(16384);
  p.WinT = (bf16_t*)take((size_t)1280 * 1024 * 2);
  p.WuqT = (bf16_t*)take((size_t)768 * 384 * 2);
  p.WukT = (bf16_t*)take((size_t)512 * 256 * 2);
  p.WuvT = (bf16_t*)take((size_t)512 * 256 * 2);
  p.WgluT = (bf16_t*)take((size_t)1024 * 512 * 2);
  p.WoutT = (bf16_t*)take((size_t)1024 * 1024 * 2);
  p.WpqT = (bf16_t*)take((size_t)2048 * 1024 * 2);
  p.PK = (bf16_t*)take((size_t)2 * 128 * 128 * 2);
  p.Utab = (bf16_t*)take((size_t)16384 * 1024 * 2);
  p.Vtab = (bf16_t*)take((size_t)16384 * 1024 * 2);
  p.Bt2 = (bf16_t*)take((size_t)32 * 256 * A2LD * 2);
  p.Emat = (bf16_t*)take((size_t)32 * 128 * 256 * 2);
  p.XN = (bf16_t*)take((size_t)NT * 1024 * 2);
  p.A2 = (bf16_t*)take((size_t)32 * NSUB * A2LD * 2);
  p.CQN = (bf16_t*)take((size_t)NT * 384 * 2);
  p.CKV = (bf16_t*)take((size_t)NT * 256 * 2);
  p.Kcat = (bf16_t*)take((size_t)32 * 4096 * 96 * 2);
  p.KcatS = (bf16_t*)take((size_t)128 * 8 * 4 * 96 * 2);
  p.Qb = (bf16_t*)take((size_t)NT * 8 * 96 * 2);
  p.VT = (bf16_t*)take((size_t)512 * NP * 2);
  p.OATT = (bf16_t*)take((size_t)NT * 512 * 2);
  p.G = (bf16_t*)take((size_t)NT * 512 * 2);
  p.CAT = (bf16_t*)take((size_t)NT * 1024 * 2);
  p.PQ = (bf16_t*)take((size_t)NT * 2048 * 2);
  p.Z = (float*)take((size_t)NT * INW * 4);
  p.Qraw = (float*)take((size_t)NT * 768 * 4);
  p.KNraw = (float*)take((size_t)NT * 512 * 4);
  p.S = (float*)take((size_t)32 * NSUB * 128 * 4);
  p.GL = (float*)take((size_t)NT * 1024 * 4);
  p.X1 = (float*)take((size_t)NT * 1024 * 4);
  p.SC = (float*)take((size_t)NT * 8 * 256 * 4);
  p.GW = (float*)take((size_t)NT * 128 * 4);
  p.Opart = (float*)take((size_t)128 * 2 * 32 * 256 * 4);
  p.Lpart = (float*)take((size_t)128 * 2 * 32 * 4);
  p.IDX = (int*)take((size_t)NT * 128 * 4);
  if (off > ws_size) { fprintf(stderr, "workspace too small: need %zu have %zu\n", off, ws_size); return; }
  launch_phase<0>(p, stream);
  launch_phase<1>(p, stream);
  launch_phase<2>(p, stream);
  launch_phase<3>(p, stream);
  launch_phase<4>(p, stream);
  launch_phase<5>(p, stream);
  launch_phase<6>(p, stream);
  launch_phase<7>(p, stream);
  launch_phase<8>(p, stream);
  launch_phase<9>(p, stream);
  launch_phase<10>(p, stream);
  launch_phase<11>(p, stream);
  launch_phase<12>(p, stream);
  launch_phase<13>(p, stream);
  launch_phase<14>(p, stream);
  launch_phase<15>(p, stream);
}
```

```cpp
#include <hip/hip_runtime.h>
#include <stdint.h>
#include <stdio.h>

typedef __attribute__((ext_vector_type(8))) short bf16x8;
typedef __attribute__((ext_vector_type(4))) short s16x4;
typedef __attribute__((ext_vector_type(16))) float f32x16;
typedef __attribute__((ext_vector_type(2))) __bf16 bf2;
typedef __attribute__((ext_vector_type(2))) float f2v;
typedef unsigned short bf16_t;

#define NTHR 512
#define D_MODEL 1024
#define NP 16384
#define NS 512
#define NT 16896
#define INW 1184
#define NSUB 1152
#define A2LD 384
#define EPS 1e-6f
#define QSCALE 0.14724466f

#define O_YP 0
#define O_YS 16777216
#define O_LATP 17301504
#define O_KRP 21495808
#define O_SSMP 22020096
#define O_LATS 22036480
#define O_KRS 22167552
#define O_SSMS 22183936

struct Params {
  const float *x_prompt, *x_sample, *cache_lat, *cache_kr, *state_ssm;
  const int* page_table;
  const float *norm_mix, *w_in, *norm_q_lora, *w_uq, *norm_kv_lora, *w_uk, *w_uv, *g_qn, *g_qr, *g_kn, *g_kr;
  const float *a_re, *a_im, *log_dt, *ssm_b, *ssm_c, *ssm_d, *w_glu, *w_out, *norm_ffn, *peer_wq, *peer_keys, *peer_u, *peer_v;
  float* out;
  unsigned* bar;
  bf16_t *WinT, *WuqT, *WukT, *WuvT, *WgluT, *WoutT, *WpqT, *PK, *Utab, *Vtab, *Bt2, *Emat;
  bf16_t *XN, *A2, *CQN, *CKV, *Kcat, *KcatS, *Qb, *VT, *OATT, *G, *CAT, *PQ;
  float *Z, *Qraw, *KNraw, *S, *GL, *X1, *SC, *GW, *Opart, *Lpart;
  int* IDX;
};


#define XB_TMO      128
#define XB_XCNT(j)  (256  + 64 * (j))
#define XB_XSUB(j)  (1280 + 64 * (j))
#define XB_XGEN(j)  (2304 + 64 * (j))
#define XB_TOP      3328
#define XB_TOPGEN   3392
#define XCD_BAR_WORDS 3456
#define XB_SPIN_CAP (1u << 18)
#define LAS __attribute__((address_space(3)))

__device__ __forceinline__ unsigned xb_ld(unsigned* p)              { return __hip_atomic_load(p, __ATOMIC_RELAXED, __HIP_MEMORY_SCOPE_AGENT); }
__device__ __forceinline__ unsigned xb_add(unsigned* p, unsigned v) { return __hip_atomic_fetch_add(p, v, __ATOMIC_RELAXED, __HIP_MEMORY_SCOPE_AGENT); }
__device__ __forceinline__ unsigned xb_xcc_id() { return (unsigned)__builtin_amdgcn_s_getreg((3 << 11) | 20) & 0xFu; }
#define XB_SPIN(cond, bar) do { unsigned _sp = 0; while (cond) { __builtin_amdgcn_s_sleep(1); \
    if ((++_sp & 255u) == 0u) { if (xb_ld(&(bar)[XB_TMO])) break; if (_sp > XB_SPIN_CAP) { atomicAdd(&(bar)[XB_TMO], 1u); break; } } } } while (0)

struct XcdBarrier {
    unsigned* bar; unsigned x;
    volatile LAS unsigned* st;
};

__device__ __forceinline__ XcdBarrier xcd_barrier_post(unsigned* bar, volatile LAS unsigned* st) {
    XcdBarrier b; b.bar = bar; b.x = xb_xcc_id(); b.st = st;
    if (threadIdx.x == 0) (void)xb_add(&bar[XB_XCNT(b.x)], 1u);
    return b;
}
__device__ __forceinline__ void xcd_barrier_complete(unsigned* bar, unsigned x, unsigned& nloc, unsigned& nx) {
    const unsigned G = gridDim.x * gridDim.y * gridDim.z;
    unsigned sum, cnt, mine, sp = 0u;
    for (;;) {
        sum = 0u; cnt = 0u; mine = 0u;
#pragma unroll
        for (unsigned j = 0; j < 16; ++j) { const unsigned c = xb_ld(&bar[XB_XCNT(j)]); sum += c; cnt += (c > 0u) ? 1u : 0u; mine = (j == x) ? c : mine; }
        if (sum == G) break;
        __builtin_amdgcn_s_sleep(1);
        if ((++sp & 255u) == 0u) { if (xb_ld(&bar[XB_TMO])) break; if (sp > XB_SPIN_CAP) { atomicAdd(&bar[XB_TMO], 1u); break; } }
    }
    nloc = mine > 0u ? mine : 1u; nx = cnt > 0u ? cnt : 1u;
}

__device__ __forceinline__ void xcd_barrier(const XcdBarrier& b) {
    asm volatile("s_waitcnt vmcnt(0)" ::: "memory");
    __syncthreads();
    if (threadIdx.x == 0) {
        unsigned* bar = b.bar;
        __builtin_amdgcn_s_waitcnt(0);
        unsigned nloc = b.st[0], nx = b.st[1];
        if (nloc == 0u) { xcd_barrier_complete(bar, b.x, nloc, nx); b.st[0] = nloc; b.st[1] = nx; }
        const unsigned old = xb_add(&bar[XB_XSUB(b.x)], 1u);
        const unsigned gen = old / nloc;
        if (old + 1u == (gen + 1u) * nloc) {
            __builtin_amdgcn_fence(__ATOMIC_RELEASE, "agent");
            asm volatile("s_waitcnt vmcnt(0)" ::: "memory");
            const unsigned og = xb_add(&bar[XB_TOP], 1u);
            const unsigned tg = og / nx;
            if (og + 1u == (tg + 1u) * nx) xb_add(&bar[XB_TOPGEN], 1u);
            else XB_SPIN(xb_ld(&bar[XB_TOPGEN]) == tg, bar);
            __builtin_amdgcn_fence(__ATOMIC_ACQUIRE, "agent");
            xb_add(&bar[XB_XGEN(b.x)], 1u);
            asm volatile("s_waitcnt vmcnt(0)" ::: "memory");
        } else {
            XB_SPIN(xb_ld(&bar[XB_XGEN(b.x)]) == gen, bar);
            __builtin_amdgcn_fence(__ATOMIC_ACQUIRE, "agent");
            asm volatile("s_waitcnt vmcnt(0)" ::: "memory");
        }
    }
    __syncthreads();
}

__device__ __forceinline__ unsigned pk2(float a, float b) {
  f2v v = {a, b};
  bf2 r = __builtin_convertvector(v, bf2);
  return __builtin_bit_cast(unsigned, r);
}
__device__ __forceinline__ bf16_t f2bf(float a) { return (bf16_t)(pk2(a, 0.f) & 0xffffu); }
__device__ __forceinline__ float bf2f(bf16_t x) { return __uint_as_float(((unsigned)x) << 16); }
__device__ __forceinline__ float bflo(unsigned x) { return __uint_as_float(x << 16); }
__device__ __forceinline__ float bfhi(unsigned x) { return __uint_as_float(x & 0xffff0000u); }
__device__ __forceinline__ float wave_sum(float v) {
  v += __shfl_xor(v, 32); v += __shfl_xor(v, 16); v += __shfl_xor(v, 8);
  v += __shfl_xor(v, 4);  v += __shfl_xor(v, 2);  v += __shfl_xor(v, 1);
  return v;
}
__device__ __forceinline__ float gelu_tanh(float x) {
  float u = 0.7978845608028654f * (x + 0.044715f * x * x * x);
  float e = __expf(2.f * u);
  float t = 1.f - 2.f / (1.f + e);
  return 0.5f * x * (1.f + t);
}
__device__ __forceinline__ void sincos_rev(float ang, float& s, float& c) {
  float rev = ang * 0.15915494309189535f;
  rev = rev - floorf(rev);
  s = __builtin_amdgcn_sinf(rev);
  c = __builtin_amdgcn_cosf(rev);
}
__device__ __forceinline__ f32x16 mfma32(bf16x8 a, bf16x8 b, f32x16 c) {
  return __builtin_amdgcn_mfma_f32_32x32x16_bf16(a, b, c, 0, 0, 0);
}
__device__ __forceinline__ bf16x8 mk8(unsigned a, unsigned b, unsigned c, unsigned d) {
  uint4 u = make_uint4(a, b, c, d);
  return __builtin_bit_cast(bf16x8, u);
}

#define GLD 72
template <int MT, class Epi>
__device__ __forceinline__ void gemm_tile(const bf16_t* __restrict__ A, int lda, const bf16_t* __restrict__ Bt, int ldb,
                                          int K, int m0, int n0, char* smem, Epi epi) {
  constexpr int BM = 128 * MT;
  bf16_t* As = (bf16_t*)smem;
  bf16_t* Bs = As + 2 * BM * GLD;
  const int tid = threadIdx.x, lane = tid & 63, wave = tid >> 6;
  const int wm = wave >> 1, wn = wave & 1, lr = lane & 31, hh = lane >> 5;
  uint4 ra[2 * MT], rb[2];
  f32x16 acc[MT][2];
#pragma unroll
  for (int i = 0; i < MT; ++i)
#pragma unroll
    for (int j = 0; j < 2; ++j)
#pragma unroll
      for (int r = 0; r < 16; ++r) acc[i][j][r] = 0.f;
  const int nk = K / 64;
  auto gload = [&](int k0) {
#pragma unroll
    for (int i = 0; i < 2 * MT; ++i) {
      int c = tid + NTHR * i, row = c >> 3, cc = c & 7;
      ra[i] = *(const uint4*)(A + (size_t)(m0 + row) * lda + k0 + cc * 8);
    }
#pragma unroll
    for (int i = 0; i < 2; ++i) {
      int c = tid + NTHR * i, row = c >> 3, cc = c & 7;
      rb[i] = *(const uint4*)(Bt + (size_t)(n0 + row) * ldb + k0 + cc * 8);
    }
  };
  auto lstore = [&](int buf) {
#pragma unroll
    for (int i = 0; i < 2 * MT; ++i) {
      int c = tid + NTHR * i, row = c >> 3, cc = c & 7;
      *(uint4*)(As + (buf * BM + row) * GLD + cc * 8) = ra[i];
    }
#pragma unroll
    for (int i = 0; i < 2; ++i) {
      int c = tid + NTHR * i, row = c >> 3, cc = c & 7;
      *(uint4*)(Bs + (buf * 128 + row) * GLD + cc * 8) = rb[i];
    }
  };
  gload(0);
  lstore(0);
  __syncthreads();
  for (int kt = 0; kt < nk; ++kt) {
    const int buf = kt & 1;
    if (kt + 1 < nk) gload((kt + 1) * 64);
#pragma unroll
    for (int ks = 0; ks < 4; ++ks) {
      bf16x8 a[MT], b[2];
#pragma unroll
      for (int i = 0; i < MT; ++i) a[i] = *(const bf16x8*)(As + (buf * BM + wm * 32 * MT + i * 32 + lr) * GLD + ks * 16 + hh * 8);
#pragma unroll
      for (int j = 0; j < 2; ++j) b[j] = *(const bf16x8*)(Bs + (buf * 128 + wn * 64 + j * 32 + lr) * GLD + ks * 16 + hh * 8);
#pragma unroll
      for (int i = 0; i < MT; ++i)
#pragma unroll
        for (int j = 0; j < 2; ++j) acc[i][j] = mfma32(a[i], b[j], acc[i][j]);
    }
    if (kt + 1 < nk) lstore(buf ^ 1);
    __syncthreads();
  }
#pragma unroll
  for (int i = 0; i < MT; ++i)
#pragma unroll
    for (int j = 0; j < 2; ++j)
#pragma unroll
      for (int r = 0; r < 16; ++r) {
        int m = m0 + wm * 32 * MT + i * 32 + (r & 3) + 8 * (r >> 2) + 4 * hh;
        int n = n0 + wn * 64 + j * 32 + lr;
        epi(m, n, acc[i][j][r]);
      }
}

struct Cplx { float re, im; };
__device__ __forceinline__ Cplx cmul(Cplx a, Cplx b) { return {a.re * b.re - a.im * b.im, a.re * b.im + a.im * b.re}; }
__device__ __forceinline__ Cplx apow(float are, float aim, float dt, float m) {
  float mag = __expf(m * dt * are);
  float s, c;
  sincos_rev(m * dt * aim, s, c);
  return {mag * c, mag * s};
}
__device__ __forceinline__ Cplx bscale(float are, float aim, float dt) {
  Cplx ab = apow(are, aim, dt, 1.f);
  float nr = ab.re - 1.f, ni = ab.im;
  float den = are * are + aim * aim;
  return {(nr * are + ni * aim) / den, (ni * are - nr * aim) / den};
}

__device__ __forceinline__ void tr_cvt(const float* __restrict__ W, bf16_t* __restrict__ Wt, int K, int N, int Npad, size_t gt, size_t GT) {
  size_t tot = (size_t)K * Npad;
  for (size_t i = gt; i < tot; i += GT) {
    int n = (int)(i / K), k = (int)(i % K);
    Wt[i] = (n < N) ? f2bf(W[(size_t)k * N + n]) : (bf16_t)0;
  }
}
__device__ __forceinline__ void cvt_flat(const float* __restrict__ W, bf16_t* __restrict__ Wb, size_t n4, size_t gt, size_t GT) {
  for (size_t i = gt; i < n4; i += GT) {
    float4 v = ((const float4*)W)[i];
    ((uint2*)Wb)[i] = make_uint2(pk2(v.x, v.y), pk2(v.z, v.w));
  }
}
__device__ void phase0(const Params& p) {
  const size_t gt = (size_t)blockIdx.x * NTHR + threadIdx.x, GT = (size_t)gridDim.x * NTHR;
  tr_cvt(p.w_in, p.WinT, 1024, INW, 1280, gt, GT);
  tr_cvt(p.w_uq, p.WuqT, 384, 768, 768, gt, GT);
  tr_cvt(p.w_uk, p.WukT, 256, 512, 512, gt, GT);
  tr_cvt(p.w_uv, p.WuvT, 256, 512, 512, gt, GT);
  tr_cvt(p.w_glu, p.WgluT, 512, 1024, 1024, gt, GT);
  tr_cvt(p.w_out, p.WoutT, 1024, 1024, 1024, gt, GT);
  tr_cvt(p.peer_wq, p.WpqT, 1024, 2048, 2048, gt, GT);
  cvt_flat(p.peer_keys, p.PK, 2 * 128 * 128 / 4, gt, GT);
  cvt_flat(p.peer_u, p.Utab, (size_t)16384 * 1024 / 4, gt, GT);
  cvt_flat(p.peer_v, p.Vtab, (size_t)16384 * 1024 / 4, gt, GT);
  {
    size_t tot = (size_t)32 * 128 * 256 / 8;
    for (size_t i = gt; i < tot; i += GT) {
      int g = (int)(i / (128 * 32)), rem = (int)(i % (128 * 32)), n = rem / 32, c8 = rem % 32;
      *(uint4*)(p.A2 + ((size_t)g * NSUB + 1024 + n) * A2LD + c8 * 8) = make_uint4(0, 0, 0, 0);
    }
  }
  {
    size_t tot = (size_t)32 * 16 * 256;
    for (size_t i = gt; i < tot; i += GT) {
      int g = (int)(i / 4096), rem = (int)(i % 4096), m = rem >> 8, h = (rem >> 4) & 15, h2 = rem & 15;
      float dt = __expf(p.log_dt[g]);
      float acc = 0.f;
      for (int pp = 0; pp < 64; ++pp) {
        float are = p.a_re[g * 64 + pp], aim = p.a_im[g * 64 + pp];
        Cplx am = apow(are, aim, dt, (float)m);
        Cplx bs = bscale(are, aim, dt);
        Cplx bb = {p.ssm_b[((g * 64 + pp) * 16 + h2) * 2], p.ssm_b[((g * 64 + pp) * 16 + h2) * 2 + 1]};
        Cplx cc = {p.ssm_c[((g * 16 + h) * 64 + pp) * 2], p.ssm_c[((g * 16 + h) * 64 + pp) * 2 + 1]};
        Cplx x = cmul(cmul(am, bs), bb);
        acc += cc.re * x.re - cc.im * x.im;
      }
      if (m == 0 && h == h2) acc += p.ssm_d[g * 16 + h];
      bf16_t v = f2bf(acc);
      for (int t = m; t < 16; ++t) {
        int j = t - m;
        p.Bt2[((size_t)g * 256 + t * 16 + h) * A2LD + j * 16 + h2] = v;
      }
      if (m == 0) {
        for (int t = 0; t < 16; ++t)
          for (int j = t + 1; j < 16; ++j) p.Bt2[((size_t)g * 256 + t * 16 + h) * A2LD + j * 16 + h2] = 0;
      }
    }
    tot = (size_t)32 * 256 * 64;
    for (size_t i = gt; i < tot; i += GT) {
      int g = (int)(i / 16384), rem = (int)(i % 16384), th = rem >> 6, pp = rem & 63, t = th >> 4, h = th & 15;
      float dt = __expf(p.log_dt[g]);
      float are = p.a_re[g * 64 + pp], aim = p.a_im[g * 64 + pp];
      Cplx am = apow(are, aim, dt, (float)(t + 1));
      Cplx cc = {p.ssm_c[((g * 16 + h) * 64 + pp) * 2], p.ssm_c[((g * 16 + h) * 64 + pp) * 2 + 1]};
      p.Bt2[((size_t)g * 256 + th) * A2LD + 256 + pp] = f2bf(cc.re * am.re - cc.im * am.im);
      p.Bt2[((size_t)g * 256 + th) * A2LD + 320 + pp] = f2bf(-(cc.re * am.im + cc.im * am.re));
    }
    tot = (size_t)32 * 64 * 256;
    for (size_t i = gt; i < tot; i += GT) {
      int g = (int)(i / 16384), rem = (int)(i % 16384), pp = rem >> 8, jh = rem & 255, j = jh >> 4, h2 = jh & 15;
      float dt = __expf(p.log_dt[g]);
      float are = p.a_re[g * 64 + pp], aim = p.a_im[g * 64 + pp];
      Cplx am = apow(are, aim, dt, (float)(15 - j));
      Cplx bs = bscale(are, aim, dt);
      Cplx bb = {p.ssm_b[((g * 64 + pp) * 16 + h2) * 2], p.ssm_b[((g * 64 + pp) * 16 + h2) * 2 + 1]};
      Cplx x = cmul(cmul(am, bs), bb);
      p.Emat[((size_t)g * 128 + pp) * 256 + jh] = f2bf(x.re);
      p.Emat[((size_t)g * 128 + 64 + pp) * 256 + jh] = f2bf(x.im);
    }
  }
}

__device__ void phase_rmsnorm(const float* __restrict__ srcP, const float* __restrict__ srcS, const float* __restrict__ gain,
                              bf16_t* __restrict__ dst) {
  const int lane = threadIdx.x & 63, gw = blockIdx.x * 8 + (threadIdx.x >> 6), GW = gridDim.x * 8;
  float4 g[4];
#pragma unroll
  for (int i = 0; i < 4; ++i) g[i] = *(const float4*)(gain + lane * 4 + 256 * i);
  for (int r = gw; r < NT; r += GW) {
    const float* src = (r < NP) ? srcP + (size_t)r * 1024 : srcS + (size_t)(r - NP) * 1024;
    float4 v[4];
    float ss = 0.f;
#pragma unroll
    for (int i = 0; i < 4; ++i) {
      v[i] = *(const float4*)(src + lane * 4 + 256 * i);
      ss += v[i].x * v[i].x + v[i].y * v[i].y + v[i].z * v[i].z + v[i].w * v[i].w;
    }
    ss = wave_sum(ss);
    float rinv = rsqrtf(ss * (1.f / 1024.f) + EPS);
#pragma unroll
    for (int i = 0; i < 4; ++i) {
      uint2 o = make_uint2(pk2(v[i].x * rinv * g[i].x, v[i].y * rinv * g[i].y), pk2(v[i].z * rinv * g[i].z, v[i].w * rinv * g[i].w));
      *(uint2*)(dst + (size_t)r * 1024 + lane * 4 + 256 * i) = o;
    }
  }
}

__device__ void phase_gemm_z(const Params& p, char* smem) {
  const int ntn = 10, ntm = NT / 256;
  for (int t = blockIdx.x; t < ntm * ntn; t += gridDim.x) {
    int tm = t / ntn, tn = t % ntn;
    float* Z = p.Z;
    gemm_tile<2>(p.XN, 1024, p.WinT, 1024, 1024, tm * 256, tn * 128, smem, [=](int m, int n, float v) {
      if (n < INW) Z[(size_t)m * INW + n] = v;
    });
  }
}

__device__ void phase_post1(const Params& p) {
  const int lane = threadIdx.x & 63, gw = blockIdx.x * 8 + (threadIdx.x >> 6), GW = gridDim.x * 8;
  for (int r = gw; r < NT; r += GW) {
    const float* z = p.Z + (size_t)r * INW;
    const bool isP = r < NP;
    const int rs = r - NP;
    {
      float4 a = *(const float4*)(z + lane * 8), b = *(const float4*)(z + lane * 8 + 4);
      int g = lane >> 1, h0 = (lane & 1) * 8;
      int n = isP ? (r >> 4) : (1024 + (rs >> 2));
      int t = isP ? (r & 15) : (rs & 3);
      *(uint4*)(p.A2 + ((size_t)g * NSUB + n) * A2LD + t * 16 + h0) = make_uint4(pk2(a.x, a.y), pk2(a.z, a.w), pk2(b.x, b.y), pk2(b.z, b.w));
    }
    {
      float2 v[3];
      float ss = 0.f;
#pragma unroll
      for (int i = 0; i < 3; ++i) {
        v[i] = *(const float2*)(z + 512 + lane * 2 + 128 * i);
        ss += v[i].x * v[i].x + v[i].y * v[i].y;
      }
      ss = wave_sum(ss);
      float rinv = rsqrtf(ss * (1.f / 384.f) + EPS);
#pragma unroll
      for (int i = 0; i < 3; ++i) {
        float2 g = *(const float2*)(p.norm_q_lora + lane * 2 + 128 * i);
        *(unsigned*)(p.CQN + (size_t)r * 384 + lane * 2 + 128 * i) = pk2(v[i].x * rinv * g.x, v[i].y * rinv * g.y);
      }
    }
    {
      float4 v = *(const float4*)(z + 896 + lane * 4);
      float ss = wave_sum(v.x * v.x + v.y * v.y + v.z * v.z + v.w * v.w);
      float rinv = rsqrtf(ss * (1.f / 256.f) + EPS);
      float4 g = *(const float4*)(p.norm_kv_lora + lane * 4);
      float4 o = make_float4(v.x * rinv * g.x, v.y * rinv * g.y, v.z * rinv * g.z, v.w * rinv * g.w);
      float* dst = isP ? p.out + O_LATP + (size_t)r * 256 : p.out + O_LATS + (size_t)rs * 256;
      *(float4*)(dst + lane * 4) = o;
      *(uint2*)(p.CKV + (size_t)r * 256 + lane * 4) = make_uint2(pk2(o.x, o.y), pk2(o.z, o.w));
    }
    {
      float v = (lane < 32) ? z[1152 + lane] : 0.f;
      float ss = wave_sum(v * v);
      float rinv = rsqrtf(ss * (1.f / 32.f) + EPS);
      float gn = (lane < 32) ? p.g_kr[lane] : 0.f;
      float xv = v * rinv * gn;
      float other = __shfl_xor(xv, 16);
      int i = lane & 15;
      float pos = isP ? (float)(r & 4095) : (float)(8192 + (rs & 3));
      float inv = exp2f(-(float)i * (13.287712379549449f / 16.f));
      float sn, cs;
      sincos_rev(pos * inv, sn, cs);
      float o = (lane & 16) ? (xv * cs + other * sn) : (xv * cs - other * sn);
      if (lane < 32) {
        float* dst = isP ? p.out + O_KRP + (size_t)r * 32 : p.out + O_KRS + (size_t)rs * 32;
        dst[lane] = o;
        bf16_t ob = f2bf(o);
        if (isP) {
          int b = r >> 12, t = r & 4095;
#pragma unroll
          for (int h = 0; h < 8; ++h) p.Kcat[((size_t)(b * 8 + h) * 4096 + t) * 96 + 64 + lane] = ob;
        } else {
          int seq = rs >> 2, t = rs & 3;
#pragma unroll
          for (int h = 0; h < 8; ++h) p.KcatS[((size_t)(seq * 8 + h) * 4 + t) * 96 + 64 + lane] = ob;
        }
      }
    }
  }
}

__device__ void phase_gemm4(const Params& p, char* smem) {
  const int nq = 66 * 6, nk = 66 * 4, nv = 2 * 128, ns = 32 * 9;
  const int total = nq + nk + nv + ns;
  for (int t = blockIdx.x; t < total; t += gridDim.x) {
    if (t < nq) {
      int tm = t / 6, tn = t % 6;
      float* C = p.Qraw;
      gemm_tile<2>(p.CQN, 384, p.WuqT, 384, 384, tm * 256, tn * 128, smem, [=](int m, int n, float v) { C[(size_t)m * 768 + n] = v; });
    } else if (t < nq + nk) {
      int u = t - nq, tm = u / 4, tn = u % 4;
      float* C = p.KNraw;
      gemm_tile<2>(p.CKV, 256, p.WukT, 256, 256, tm * 256, tn * 128, smem, [=](int m, int n, float v) { C[(size_t)m * 512 + n] = v; });
    } else if (t < nq + nk + nv) {
      int u = t - nq - nk, tm = u / 128, tn = u % 128;
      bf16_t* C = p.VT;
      gemm_tile<2>(p.WuvT, 256, p.CKV, 256, 256, tm * 256, tn * 128, smem, [=](int m, int n, float v) { C[(size_t)m * NP + n] = f2bf(v); });
    } else {
      int u = t - nq - nk - nv, g = u / 9, tm = u % 9;
      float* C = p.S + (size_t)g * NSUB * 128;
      gemm_tile<1>(p.A2 + (size_t)g * NSUB * A2LD, A2LD, p.Emat + (size_t)g * 128 * 256, 256, 256, tm * 128, 0, smem,
                   [=](int m, int n, float v) { C[(size_t)m * 128 + n] = v; });
    }
  }
}

__device__ void phase_post2(const Params& p) {
  const int lane = threadIdx.x & 63, gw = blockIdx.x * 8 + (threadIdx.x >> 6), GW = gridDim.x * 8;
  const float gqn = p.g_qn[lane], gkn = p.g_kn[lane];
  const float gqr = p.g_qr[lane & 31];
  const float inv = exp2f(-(float)(lane & 15) * (13.287712379549449f / 16.f));
  for (int r = gw; r < NT; r += GW) {
    const bool isP = r < NP;
    const int rs = r - NP;
    float pos = isP ? (float)(r & 4095) : (float)(8192 + (rs & 3));
    float sn, cs;
    sincos_rev(pos * inv, sn, cs);
#pragma unroll 1
    for (int h = 0; h < 8; ++h) {
      const float* q = p.Qraw + (size_t)r * 768 + h * 96;
      float v = q[lane];
      float ss = wave_sum(v * v);
      float rinv = rsqrtf(ss * (1.f / 64.f) + EPS);
      p.Qb[((size_t)r * 8 + h) * 96 + lane] = f2bf(v * rinv * gqn * QSCALE);
      float w = (lane < 32) ? q[64 + lane] : 0.f;
      float s2 = wave_sum(w * w);
      float rinv2 = rsqrtf(s2 * (1.f / 32.f) + EPS);
      float xv = w * rinv2 * gqr;
      float other = __shfl_xor(xv, 16);
      float o = (lane & 16) ? (xv * cs + other * sn) : (xv * cs - other * sn);
      if (lane < 32) p.Qb[((size_t)r * 8 + h) * 96 + 64 + lane] = f2bf(o * QSCALE);
      float kv = p.KNraw[(size_t)r * 512 + h * 64 + lane];
      float ks = wave_sum(kv * kv);
      float krinv = rsqrtf(ks * (1.f / 64.f) + EPS);
      bf16_t kb = f2bf(kv * krinv * gkn);
      if (isP) {
        int b = r >> 12, t = r & 4095;
        p.Kcat[((size_t)(b * 8 + h) * 4096 + t) * 96 + lane] = kb;
      } else {
        int seq = rs >> 2, t = rs & 3;
        p.KcatS[((size_t)(seq * 8 + h) * 4 + t) * 96 + lane] = kb;
      }
    }
  }
}

__device__ __forceinline__ float softmax_bound(const Params& p) {
  const int lane = threadIdx.x & 63;
  float a = fabsf(p.g_qn[lane]), b = fabsf(p.g_kn[lane]), c = fabsf(p.g_qr[lane & 31]), d = fabsf(p.g_kr[lane & 31]);
#pragma unroll
  for (int o = 32; o >= 1; o >>= 1) {
    a = fmaxf(a, __shfl_xor(a, o)); b = fmaxf(b, __shfl_xor(b, o));
    c = fmaxf(c, __shfl_xor(c, o)); d = fmaxf(d, __shfl_xor(d, o));
  }
  return QSCALE * (64.f * a * b + 32.f * c * d);
}

#define KLD 104
#define VLD 68
__device__ __forceinline__ void attn_prompt_block(const Params& p, char* smem, int b, int h, int qi, float Mb) {
  bf16_t* Ks = (bf16_t*)smem;
  bf16_t* Vs = Ks + 2 * 64 * KLD;
  const int tid = threadIdx.x, lane = tid & 63, wave = tid >> 6, lr = lane & 31, hh = lane >> 5;
  const int q0 = qi * 256 + wave * 32;
  const bf16_t* Kg = p.Kcat + (size_t)(b * 8 + h) * 4096 * 96;
  const bf16_t* Vg = p.VT + (size_t)(h * 64) * NP + b * 4096;
  bf16x8 qf[6];
  {
    const bf16_t* qp = p.Qb + ((size_t)(b * 4096 + q0 + lr) * 8 + h) * 96 + hh * 8;
#pragma unroll
    for (int s = 0; s < 6; ++s) qf[s] = *(const bf16x8*)(qp + s * 16);
  }
  f32x16 ot[2];
#pragma unroll
  for (int i = 0; i < 2; ++i)
#pragma unroll
    for (int r = 0; r < 16; ++r) ot[i][r] = 0.f;
  float lsum = 0.f;
  const int nkt = 4 * (qi + 1);
  uint4 rk[2];
  uint2 rv[2];
  auto gload = [&](int kt) {
    const int k0 = kt * 64;
#pragma unroll
    for (int i = 0; i < 2; ++i) {
      int c = tid + NTHR * i;
      c = c < 768 ? c : 767;
      int row = c / 12, cc = c % 12;
      rk[i] = *(const uint4*)(Kg + (size_t)(k0 + row) * 96 + cc * 8);
    }
#pragma unroll
    for (int i = 0; i < 2; ++i) {
      int c = tid + NTHR * i, row = c >> 4, cc = c & 15;
      rv[i] = *(const uint2*)(Vg + (size_t)row * NP + k0 + cc * 4);
    }
  };
  auto lstore = [&](int buf) {
#pragma unroll
    for (int i = 0; i < 2; ++i) {
      int c = tid + NTHR * i;
      if (c < 768) { int row = c / 12, cc = c % 12; *(uint4*)(Ks + (buf * 64 + row) * KLD + cc * 8) = rk[i]; }
    }
#pragma unroll
    for (int i = 0; i < 2; ++i) {
      int c = tid + NTHR * i, row = c >> 4, cc = c & 15;
      *(uint2*)(Vs + (buf * 64 + row) * VLD + cc * 4) = rv[i];
    }
  };
  gload(0);
  lstore(0);
  __syncthreads();
  for (int kt = 0; kt < nkt; ++kt) {
    const int buf = kt & 1, k0 = kt * 64;
    if (kt + 1 < nkt) gload(kt + 1);
    if (k0 <= q0 + 31) {
      const bool need_mask = (k0 + 63 > q0);
      bf16x8 pb[2][2];
#pragma unroll
      for (int kt2 = 0; kt2 < 2; ++kt2) {
        f32x16 st;
#pragma unroll
        for (int r = 0; r < 16; ++r) st[r] = 0.f;
#pragma unroll
        for (int s = 0; s < 6; ++s) {
          bf16x8 a = *(const bf16x8*)(Ks + (buf * 64 + kt2 * 32 + lr) * KLD + s * 16 + hh * 8);
          st = mfma32(a, qf[s], st);
        }
        float pv[16];
#pragma unroll
        for (int r = 0; r < 16; ++r) {
          float e = exp2f(st[r] - Mb);
          if (need_mask) {
            int key = k0 + kt2 * 32 + (r & 3) + 8 * (r >> 2) + 4 * hh;
            e = (key <= q0 + lr) ? e : 0.f;
          }
          pv[r] = e;
          lsum += e;
        }
#pragma unroll
        for (int s2 = 0; s2 < 2; ++s2)
          pb[kt2][s2] = mk8(pk2(pv[8 * s2 + 0], pv[8 * s2 + 1]), pk2(pv[8 * s2 + 2], pv[8 * s2 + 3]),
                            pk2(pv[8 * s2 + 4], pv[8 * s2 + 5]), pk2(pv[8 * s2 + 6], pv[8 * s2 + 7]));
      }
#pragma unroll
      for (int dt = 0; dt < 2; ++dt)
#pragma unroll
        for (int kt2 = 0; kt2 < 2; ++kt2)
#pragma unroll
          for (int s2 = 0; s2 < 2; ++s2) {
            const bf16_t* vp = Vs + (buf * 64 + dt * 32 + lr) * VLD + kt2 * 32 + 16 * s2 + 4 * hh;
            uint2 lo = *(const uint2*)vp, hi = *(const uint2*)(vp + 8);
            bf16x8 a = mk8(lo.x, lo.y, hi.x, hi.y);
            ot[dt] = mfma32(a, pb[kt2][s2], ot[dt]);
          }
    }
    if (kt + 1 < nkt) lstore(buf ^ 1);
    __syncthreads();
  }
  lsum += __shfl_xor(lsum, 32);
  const float linv = 1.f / lsum;
  bf16_t* op = p.OATT + (size_t)(b * 4096 + q0 + lr) * 512 + h * 64;
#pragma unroll
  for (int dt = 0; dt < 2; ++dt)
#pragma unroll
    for (int rg = 0; rg < 4; ++rg) {
      int d = dt * 32 + 8 * rg + 4 * hh;
      *(uint2*)(op + d) = make_uint2(pk2(ot[dt][4 * rg] * linv, ot[dt][4 * rg + 1] * linv), pk2(ot[dt][4 * rg + 2] * linv, ot[dt][4 * rg + 3] * linv));
    }
}

#define LLD 264
#define KRLD 40
#define PLD 72
__device__ __forceinline__ void attn_decode_unit(const Params& p, char* smem, int seq, int half, float Mb) {
  bf16_t* latS = (bf16_t*)smem;
  bf16_t* krS = latS + 64 * LLD;
  bf16_t* Psh = krS + 64 * KRLD;
  const int tid = threadIdx.x, lane = tid & 63, wave = tid >> 6, lr = lane & 31, hh = lane >> 5;
  const int hd = wave;
  bf16x8 qnf[2][2], qrf[2];
  {
    const bf16_t* qp = p.Qb + ((size_t)(NP + seq * 4 + (lr & 3)) * 8 + hd) * 96;
    const bool valid = lr < 4;
#pragma unroll
    for (int dt = 0; dt < 2; ++dt)
#pragma unroll
      for (int s2 = 0; s2 < 2; ++s2) {
        unsigned w[4];
#pragma unroll
        for (int jj = 0; jj < 4; ++jj) {
          float v[2];
#pragma unroll
          for (int e = 0; e < 2; ++e) {
            int j = jj * 2 + e;
            int d = 32 * dt + 16 * s2 + 8 * (j >> 2) + 4 * hh + (j & 3);
            v[e] = valid ? bf2f(qp[d]) * p.g_kn[d] : 0.f;
          }
          w[jj] = pk2(v[0], v[1]);
        }
        qnf[dt][s2] = mk8(w[0], w[1], w[2], w[3]);
      }
#pragma unroll
    for (int s = 0; s < 2; ++s) {
      uint4 u = *(const uint4*)(qp + 64 + 16 * s + 8 * hh);
      if (!valid) u = make_uint4(0, 0, 0, 0);
      qrf[s] = __builtin_bit_cast(bf16x8, u);
    }
  }
  f32x16 oacc;
#pragma unroll
  for (int r = 0; r < 16; ++r) oacc[r] = 0.f;
  float lsum[4] = {0.f, 0.f, 0.f, 0.f};
  const int ntile = 64 + half;
  float4 rl[8];
  float4 rkr;
  auto gload = [&](int i) {
    int page = p.page_table[seq * 64 + half * 32 + (i >> 1)];
    const float* lp = p.cache_lat + ((size_t)page * 128 + (i & 1) * 64) * 256;
    const float* kp = p.cache_kr + ((size_t)page * 128 + (i & 1) * 64) * 32;
#pragma unroll
    for (int j = 0; j < 8; ++j) rl[j] = ((const float4*)lp)[tid + NTHR * j];
    rkr = ((const float4*)kp)[tid];
  };
  auto lstore = [&]() {
#pragma unroll
    for (int j = 0; j < 8; ++j) {
      int f = tid + NTHR * j, row = f >> 6, c4 = f & 63;
      *(uint2*)(latS + row * LLD + c4 * 4) = make_uint2(pk2(rl[j].x, rl[j].y), pk2(rl[j].z, rl[j].w));
    }
    int row = tid >> 3, c4 = tid & 7;
    *(uint2*)(krS + row * KRLD + c4 * 4) = make_uint2(pk2(rkr.x, rkr.y), pk2(rkr.z, rkr.w));
  };
  auto lstore_new = [&]() {
#pragma unroll
    for (int j = 0; j < 8; ++j) {
      int f = tid + NTHR * j, row = f >> 6, c4 = f & 63;
      uint2 v = make_uint2(0, 0);
      if (row < 4) v = *(const uint2*)(p.CKV + (size_t)(NP + seq * 4 + row) * 256 + c4 * 4);
      *(uint2*)(latS + row * LLD + c4 * 4) = v;
    }
    int row = tid >> 3, c4 = tid & 7;
    uint2 v = make_uint2(0, 0);
    if (row < 4) v = *(const uint2*)(p.KcatS + ((size_t)(seq * 8) * 4 + row) * 96 + 64 + c4 * 4);
    *(uint2*)(krS + row * KRLD + c4 * 4) = v;
  };
  gload(0);
  for (int i = 0; i < ntile; ++i) {
    const bool isnew = (i == 64);
    if (isnew) lstore_new(); else lstore();
    __syncthreads();
    if (i + 1 < 64) gload(i + 1);
#pragma unroll 1
    for (int kt2 = 0; kt2 < 2; ++kt2) {
      float ss = 0.f;
      f32x16 s1, s2;
#pragma unroll
      for (int r = 0; r < 16; ++r) { s1[r] = 0.f; s2[r] = 0.f; }
#pragma unroll
      for (int dt = 0; dt < 2; ++dt) {
        f32x16 acc;
#pragma unroll
        for (int r = 0; r < 16; ++r) acc[r] = 0.f;
        int wofs = (hd * 64 + dt * 32 + lr) * 256 + hh * 8;
        asm volatile("" : "+v"(wofs));
        const bf16_t* wp = p.WukT + wofs;
#pragma unroll
        for (int ks = 0; ks < 16; ++ks) {
          bf16x8 wfr = *(const bf16x8*)(wp + ks * 16);
          bf16x8 bfr = *(const bf16x8*)(latS + (kt2 * 32 + lr) * LLD + ks * 16 + hh * 8);
          acc = mfma32(wfr, bfr, acc);
        }
#pragma unroll
        for (int r = 0; r < 16; ++r) ss += acc[r] * acc[r];
#pragma unroll
        for (int sp = 0; sp < 2; ++sp) {
          bf16x8 bk = mk8(pk2(acc[8 * sp + 0], acc[8 * sp + 1]), pk2(acc[8 * sp + 2], acc[8 * sp + 3]),
                          pk2(acc[8 * sp + 4], acc[8 * sp + 5]), pk2(acc[8 * sp + 6], acc[8 * sp + 7]));
          s1 = mfma32(qnf[dt][sp], bk, s1);
        }
      }
      ss += __shfl_xor(ss, 32);
      const float rinv = rsqrtf(ss * (1.f / 64.f) + EPS);
#pragma unroll
      for (int s = 0; s < 2; ++s) {
        bf16x8 bk = *(const bf16x8*)(krS + (kt2 * 32 + lr) * KRLD + s * 16 + hh * 8);
        s2 = mfma32(qrf[s], bk, s2);
      }
      if (hh == 0) {
        const int kk = kt2 * 32 + lr;
#pragma unroll
        for (int t = 0; t < 4; ++t) {
          float sc = s1[t] * rinv + s2[t];
          float e = exp2f(sc - Mb);
          if (isnew) e = (kk < 4 && kk <= t) ? e : 0.f;
          lsum[t] += e;
          Psh[(hd * 4 + t) * PLD + kk] = f2bf(e);
        }
      }
    }
    __syncthreads();
    {
      const int n0 = wave * 32;
#pragma unroll
      for (int ks = 0; ks < 4; ++ks) {
        bf16x8 a = *(const bf16x8*)(Psh + lr * PLD + ks * 16 + hh * 8);
        const int key0 = ks * 16 + 8 * hh, c0 = n0 + 16 * ((lane >> 4) & 1);
        const int q = (lane & 15) >> 2, pp = lane & 3;
        const bf16_t* ap = latS + (key0 + q) * LLD + c0 + 4 * pp;
        s16x4 lo = __builtin_amdgcn_ds_read_tr16_b64_v4i16((__attribute__((address_space(3))) s16x4*)(ap));
        s16x4 hi = __builtin_amdgcn_ds_read_tr16_b64_v4i16((__attribute__((address_space(3))) s16x4*)(ap + 4 * LLD));
        bf16x8 bfr;
        bfr[0] = lo[0]; bfr[1] = lo[1]; bfr[2] = lo[2]; bfr[3] = lo[3];
        bfr[4] = hi[0]; bfr[5] = hi[1]; bfr[6] = hi[2]; bfr[7] = hi[3];
        oacc = mfma32(a, bfr, oacc);
      }
    }
    __syncthreads();
  }
  float* Op = p.Opart + ((size_t)(seq * 2 + half) * 32) * 256;
#pragma unroll
  for (int r = 0; r < 16; ++r) {
    int m = (r & 3) + 8 * (r >> 2) + 4 * hh;
    Op[(size_t)m * 256 + wave * 32 + lr] = oacc[r];
  }
#pragma unroll
  for (int t = 0; t < 4; ++t) {
    float v = (hh == 0) ? lsum[t] : 0.f;
    v = wave_sum(v);
    if (lane == 0) p.Lpart[(seq * 2 + half) * 32 + hd * 4 + t] = v;
  }
}

__device__ __forceinline__ void ssm_scan_prompt(const Params& p, int job) {
  const int lane = threadIdx.x & 63;
  const int b = job >> 5, g = job & 31;
  const float dt = __expf(p.log_dt[g]);
  const Cplx a16 = apow(p.a_re[g * 64 + lane], p.a_im[g * 64 + lane], dt, 16.f);
  Cplx H = {0.f, 0.f};
  const float* S = p.S + ((size_t)g * NSUB + b * 256) * 128;
  bf16_t* A2 = p.A2 + ((size_t)g * NSUB + b * 256) * A2LD + 256;
  for (int n0 = 0; n0 < 256; n0 += 16) {
    float sr[16], si[16];
#pragma unroll
    for (int k = 0; k < 16; ++k) { sr[k] = S[(size_t)(n0 + k) * 128 + lane]; si[k] = S[(size_t)(n0 + k) * 128 + 64 + lane]; }
#pragma unroll
    for (int k = 0; k < 16; ++k) {
      A2[(size_t)(n0 + k) * A2LD + lane] = f2bf(H.re);
      A2[(size_t)(n0 + k) * A2LD + 64 + lane] = f2bf(H.im);
      Cplx t = cmul(a16, H);
      H.re = t.re + sr[k]; H.im = t.im + si[k];
    }
  }
  float* o = p.out + O_SSMP + ((size_t)(b * 32 + g) * 64 + lane) * 2;
  o[0] = H.re; o[1] = H.im;
}
__device__ __forceinline__ void ssm_sample(const Params& p, int job) {
  const int lane = threadIdx.x & 63;
  const int seq = job >> 5, g = job & 31;
  const float dt = __expf(p.log_dt[g]);
  const float are = p.a_re[g * 64 + lane], aim = p.a_im[g * 64 + lane];
  const Cplx ab = apow(are, aim, dt, 1.f);
  const Cplx bs = bscale(are, aim, dt);
  const float* st = p.state_ssm + ((size_t)(seq * 32 + g) * 64 + lane) * 2;
  Cplx H = {st[0], st[1]};
  bf16_t* A2 = p.A2 + ((size_t)g * NSUB + 1024 + seq) * A2LD + 256;
  A2[lane] = f2bf(H.re);
  A2[64 + lane] = f2bf(H.im);
  Cplx bb[16];
#pragma unroll
  for (int h = 0; h < 16; ++h) {
    Cplx braw = {p.ssm_b[((g * 64 + lane) * 16 + h) * 2], p.ssm_b[((g * 64 + lane) * 16 + h) * 2 + 1]};
    bb[h] = cmul(bs, braw);
  }
#pragma unroll
  for (int t = 0; t < 4; ++t) {
    const float* u = p.Z + (size_t)(NP + seq * 4 + t) * INW + g * 16;
    Cplx bu = {0.f, 0.f};
#pragma unroll
    for (int h = 0; h < 16; ++h) { float uv = u[h]; bu.re += uv * bb[h].re; bu.im += uv * bb[h].im; }
    Cplx tt = cmul(ab, H);
    H.re = tt.re + bu.re; H.im = tt.im + bu.im;
  }
  float* o = p.out + O_SSMS + ((size_t)(seq * 32 + g) * 64 + lane) * 2;
  o[0] = H.re; o[1] = H.im;
}

__device__ void phase_attn(const Params& p, char* smem) {
  const int wave = threadIdx.x >> 6;
  const int gw = blockIdx.x * 8 + wave, GW = gridDim.x * 8;
  for (int j = gw; j < 128; j += GW) ssm_scan_prompt(p, j);
  for (int j = gw; j < 4096; j += GW) ssm_sample(p, j);
  const float Mb = softmax_bound(p);
  __syncthreads();
  for (int it = blockIdx.x; it < 256; it += gridDim.x) {
    int bh = it >> 3, j = it & 7;
    attn_prompt_block(p, smem, bh >> 3, bh & 7, j, Mb);
    attn_prompt_block(p, smem, bh >> 3, bh & 7, 15 - j, Mb);
  }
  for (int it = blockIdx.x; it < 256; it += gridDim.x) attn_decode_unit(p, smem, it >> 1, it & 1, Mb);
}

__device__ void phase_ssm_y(const Params& p, char* smem) {
  const int ntile = 32 * 9 * 2;
  for (int t = blockIdx.x; t < ntile; t += gridDim.x) {
    int g = t / 18, rem = t % 18, tm = rem >> 1, tn = rem & 1;
    bf16_t* G = p.G;
    gemm_tile<1>(p.A2 + (size_t)g * NSUB * A2LD, A2LD, p.Bt2 + (size_t)g * 256 * A2LD, A2LD, 384, tm * 128, tn * 128, smem,
                 [=](int m, int n, float v) {
                   int tt = n >> 4, h = n & 15;
                   int token;
                   if (m < 1024) token = m * 16 + tt;
                   else { if (tt >= 4) return; token = NP + (m - 1024) * 4 + tt; }
                   G[(size_t)token * 512 + g * 16 + h] = f2bf(gelu_tanh(v));
                 });
  }
  const int lane = threadIdx.x & 63, gw = blockIdx.x * 8 + (threadIdx.x >> 6), GW = gridDim.x * 8;
  for (int job = gw; job < 1024; job += GW) {
    int seq = job >> 3, hd = job & 7;
    const float* O0 = p.Opart + ((size_t)(seq * 2) * 32 + hd * 4) * 256;
    const float* O1 = O0 + 32 * 256;
    float acc[4] = {0.f, 0.f, 0.f, 0.f};
    for (int c = 0; c < 256; ++c) {
      float w = p.w_uv[(size_t)c * 512 + hd * 64 + lane];
#pragma unroll
      for (int t = 0; t < 4; ++t) acc[t] += (O0[t * 256 + c] + O1[t * 256 + c]) * w;
    }
#pragma unroll
    for (int t = 0; t < 4; ++t) {
      float l = p.Lpart[(seq * 2) * 32 + hd * 4 + t] + p.Lpart[(seq * 2 + 1) * 32 + hd * 4 + t];
      p.OATT[(size_t)(NP + seq * 4 + t) * 512 + hd * 64 + lane] = f2bf(acc[t] / l);
    }
  }
}

__device__ void phase_gemm_gl(const Params& p, char* smem) {
  for (int t = blockIdx.x; t < 66 * 8; t += gridDim.x) {
    int tm = t / 8, tn = t % 8;
    float* C = p.GL;
    gemm_tile<2>(p.G, 512, p.WgluT, 512, 512, tm * 256, tn * 128, smem, [=](int m, int n, float v) { C[(size_t)m * 1024 + n] = v; });
  }
}
__device__ void phase_cat(const Params& p) {
  const size_t gt = (size_t)blockIdx.x * NTHR + threadIdx.x, GT = (size_t)gridDim.x * NTHR;
  const size_t tot = (size_t)NT * 128;
  for (size_t i = gt; i < tot; i += GT) {
    size_t token = i >> 7;
    int c = (int)(i & 127) * 4;
    float4 a = *(const float4*)(p.GL + token * 1024 + c), b = *(const float4*)(p.GL + token * 1024 + 512 + c);
    float r0 = a.x / (1.f + __expf(-b.x)), r1 = a.y / (1.f + __expf(-b.y)), r2 = a.z / (1.f + __expf(-b.z)), r3 = a.w / (1.f + __expf(-b.w));
    *(uint2*)(p.CAT + token * 1024 + c) = make_uint2(pk2(r0, r1), pk2(r2, r3));
    *(uint2*)(p.CAT + token * 1024 + 512 + c) = *(const uint2*)(p.OATT + token * 512 + c);
  }
}
__device__ void phase_gemm_out(const Params& p, char* smem) {
  for (int t = blockIdx.x; t < 66 * 8; t += gridDim.x) {
    int tm = t / 8, tn = t % 8;
    float* C = p.X1;
    const float *xp = p.x_prompt, *xs = p.x_sample;
    gemm_tile<2>(p.CAT, 1024, p.WoutT, 1024, 1024, tm * 256, tn * 128, smem, [=](int m, int n, float v) {
      float x = (m < NP) ? xp[(size_t)m * 1024 + n] : xs[(size_t)(m - NP) * 1024 + n];
      C[(size_t)m * 1024 + n] = x + v;
    });
  }
}
__device__ void phase_gemm_pq(const Params& p, char* smem) {
  for (int t = blockIdx.x; t < 66 * 16; t += gridDim.x) {
    int tm = t / 16, tn = t % 16;
    bf16_t* C = p.PQ;
    gemm_tile<2>(p.XN, 1024, p.WpqT, 1024, 1024, tm * 256, tn * 128, smem, [=](int m, int n, float v) { C[(size_t)m * 2048 + n] = f2bf(v); });
  }
}
__device__ void phase_gemm_sc(const Params& p, char* smem) {
  const int ntm = NT * 8 / 256;
  for (int t = blockIdx.x; t < ntm * 2; t += gridDim.x) {
    int c = t & 1, tm = t >> 1;
    float* C = p.SC + c * 128;
    gemm_tile<2>(p.PQ + c * 128, 256, p.PK + c * 128 * 128, 128, 128, tm * 256, 0, smem, [=](int m, int n, float v) { C[(size_t)m * 256 + n] = v; });
  }
}
__device__ __forceinline__ void ins16(float (&L)[16], float x) {
#pragma unroll
  for (int j = 15; j >= 1; --j) L[j] = __builtin_amdgcn_fmed3f(L[j - 1], L[j], x);
  L[0] = fmaxf(L[0], x);
}
__device__ void phase_topk(const Params& p, char* smem) {
  unsigned* sidx = (unsigned*)smem;
  const int tid = threadIdx.x;
  const int nrow = NT * 8;
  for (int m = blockIdx.x * NTHR + tid; m < nrow; m += gridDim.x * NTHR) {
    float L1[16], L2[16], T[16];
#pragma unroll
    for (int j = 0; j < 16; ++j) { L1[j] = -3.0e38f; L2[j] = -3.0e38f; T[j] = -3.0e38f; }
    const float4* s1 = (const float4*)(p.SC + (size_t)m * 256);
    const float4* s2 = s1 + 32;
#pragma unroll 2
    for (int k4 = 0; k4 < 32; ++k4) {
      float4 a = s1[k4], b = s2[k4];
      float av[4] = {a.x, a.y, a.z, a.w}, bv[4] = {b.x, b.y, b.z, b.w};
#pragma unroll
      for (int e = 0; e < 4; ++e) {
        unsigned k = k4 * 4 + e;
        ins16(L1, __uint_as_float((__float_as_uint(av[e]) & ~127u) | k));
        ins16(L2, __uint_as_float((__float_as_uint(bv[e]) & ~127u) | k));
      }
    }
#pragma unroll
    for (int j = 0; j < 16; ++j) {
      sidx[j * NTHR + tid] = __float_as_uint(L1[j]) & 127u;
      sidx[(16 + j) * NTHR + tid] = __float_as_uint(L2[j]) & 127u;
    }
#pragma unroll
    for (int i = 0; i < 16; ++i)
#pragma unroll
      for (int j = 0; j < 16; ++j)
        if ((i + 1) * (j + 1) <= 16) {
          float a = __uint_as_float(__float_as_uint(L1[i]) & ~127u), b = __uint_as_float(__float_as_uint(L2[j]) & ~127u);
          float s = a + b;
          ins16(T, __uint_as_float((__float_as_uint(s) & ~255u) | (unsigned)(i * 16 + j)));
        }
    float mx = __uint_as_float(__float_as_uint(T[0]) & ~255u);
    float e[16], sum = 0.f;
    int id[16];
#pragma unroll
    for (int k = 0; k < 16; ++k) {
      unsigned bits = __float_as_uint(T[k]);
      float v = __uint_as_float(bits & ~255u);
      e[k] = __expf(v - mx);
      sum += e[k];
      unsigned ij = bits & 255u;
      unsigned e1 = sidx[(ij >> 4) * NTHR + tid], e2 = sidx[(16 + (ij & 15)) * NTHR + tid];
      id[k] = (int)(e1 * 128 + e2);
    }
    float inv = 1.f / sum;
#pragma unroll
    for (int k4 = 0; k4 < 4; ++k4) {
      *(int4*)(p.IDX + (size_t)m * 16 + k4 * 4) = make_int4(id[k4 * 4], id[k4 * 4 + 1], id[k4 * 4 + 2], id[k4 * 4 + 3]);
      *(float4*)(p.GW + (size_t)m * 16 + k4 * 4) = make_float4(e[k4 * 4] * inv, e[k4 * 4 + 1] * inv, e[k4 * 4 + 2] * inv, e[k4 * 4 + 3] * inv);
    }
  }
}
__device__ void phase_gather(const Params& p) {
  const int lane = threadIdx.x & 63, gw = blockIdx.x * 8 + (threadIdx.x >> 6), GW = gridDim.x * 8;
  for (int r = gw; r < NT; r += GW) {
    uint4 x0 = *(const uint4*)(p.XN + (size_t)r * 1024 + lane * 8);
    uint4 x1 = *(const uint4*)(p.XN + (size_t)r * 1024 + 512 + lane * 8);
    float acc[16];
#pragma unroll
    for (int i = 0; i < 16; ++i) acc[i] = 0.f;
    const int* idx = p.IDX + (size_t)r * 128;
    const float* gwt = p.GW + (size_t)r * 128;
#pragma unroll 4
    for (int k = 0; k < 128; ++k) {
      const int e = __builtin_amdgcn_readfirstlane(idx[k]);
      const float gk = gwt[k];
      const bf16_t* up = p.Utab + (size_t)e * 1024;
      const bf16_t* vp = p.Vtab + (size_t)e * 1024;
      uint4 u0 = *(const uint4*)(up + lane * 8), u1 = *(const uint4*)(up + 512 + lane * 8);
      uint4 v0 = *(const uint4*)(vp + lane * 8), v1 = *(const uint4*)(vp + 512 + lane * 8);
      float d = 0.f;
      d = __builtin_amdgcn_fdot2_f32_bf16(__builtin_bit_cast(bf2, u0.x), __builtin_bit_cast(bf2, x0.x), d, false);
      d = __builtin_amdgcn_fdot2_f32_bf16(__builtin_bit_cast(bf2, u0.y), __builtin_bit_cast(bf2, x0.y), d, false);
      d = __builtin_amdgcn_fdot2_f32_bf16(__builtin_bit_cast(bf2, u0.z), __builtin_bit_cast(bf2, x0.z), d, false);
      d = __builtin_amdgcn_fdot2_f32_bf16(__builtin_bit_cast(bf2, u0.w), __builtin_bit_cast(bf2, x0.w), d, false);
      d = __builtin_amdgcn_fdot2_f32_bf16(__builtin_bit_cast(bf2, u1.x), __builtin_bit_cast(bf2, x1.x), d, false);
      d = __builtin_amdgcn_fdot2_f32_bf16(__builtin_bit_cast(bf2, u1.y), __builtin_bit_cast(bf2, x1.y), d, false);
      d = __builtin_amdgcn_fdot2_f32_bf16(__builtin_bit_cast(bf2, u1.z), __builtin_bit_cast(bf2, x1.z), d, false);
      d = __builtin_amdgcn_fdot2_f32_bf16(__builtin_bit_cast(bf2, u1.w), __builtin_bit_cast(bf2, x1.w), d, false);
      d = wave_sum(d);
      const float w = gk * gelu_tanh(d);
      acc[0] += w * bflo(v0.x); acc[1] += w * bfhi(v0.x); acc[2] += w * bflo(v0.y); acc[3] += w * bfhi(v0.y);
      acc[4] += w * bflo(v0.z); acc[5] += w * bfhi(v0.z); acc[6] += w * bflo(v0.w); acc[7] += w * bfhi(v0.w);
      acc[8] += w * bflo(v1.x); acc[9] += w * bfhi(v1.x); acc[10] += w * bflo(v1.y); acc[11] += w * bfhi(v1.y);
      acc[12] += w * bflo(v1.z); acc[13] += w * bfhi(v1.z); acc[14] += w * bflo(v1.w); acc[15] += w * bfhi(v1.w);
    }
    const float* x1p = p.X1 + (size_t)r * 1024;
    float* yo = (r < NP) ? p.out + O_YP + (size_t)r * 1024 : p.out + O_YS + (size_t)(r - NP) * 1024;
#pragma unroll
    for (int hlf = 0; hlf < 2; ++hlf)
#pragma unroll
      for (int q = 0; q < 2; ++q) {
        int off = hlf * 512 + lane * 8 + q * 4;
        float4 xv = *(const float4*)(x1p + off);
        *(float4*)(yo + off) = make_float4(xv.x + acc[hlf * 8 + q * 4], xv.y + acc[hlf * 8 + q * 4 + 1], xv.z + acc[hlf * 8 + q * 4 + 2], xv.w + acc[hlf * 8 + q * 4 + 3]);
      }
  }
}

extern __shared__ __attribute__((aligned(16))) char dyn_smem[];
#define LDS_BYTES 110592
__global__ void __launch_bounds__(NTHR, 2) k_mega(Params p) {
  char* smem = dyn_smem;
  uint4* xbw = (uint4*)(dyn_smem + LDS_BYTES);
  if (threadIdx.x == 0) *xbw = make_uint4(0u, 0u, 0u, 0u);
  __syncthreads();
  XcdBarrier bar = xcd_barrier_post(p.bar, (volatile LAS unsigned*)xbw);
  phase0(p);
  phase_rmsnorm(p.x_prompt, p.x_sample, p.norm_mix, p.XN);
  xcd_barrier(bar);
  phase_gemm_z(p, smem);
  xcd_barrier(bar);
  phase_post1(p);
  xcd_barrier(bar);
  phase_gemm4(p, smem);
  xcd_barrier(bar);
  phase_post2(p);
  xcd_barrier(bar);
  phase_attn(p, smem);
  xcd_barrier(bar);
  phase_ssm_y(p, smem);
  xcd_barrier(bar);
  phase_gemm_gl(p, smem);
  xcd_barrier(bar);
  phase_cat(p);
  xcd_barrier(bar);
  phase_gemm_out(p, smem);
  xcd_barrier(bar);
  phase_rmsnorm(p.X1, p.X1 + (size_t)NP * 1024, p.norm_ffn, p.XN);
  xcd_barrier(bar);
  phase_gemm_pq(p, smem);
  xcd_barrier(bar);
  phase_gemm_sc(p, smem);
  xcd_barrier(bar);
  phase_topk(p, smem);
  xcd_barrier(bar);
  phase_gather(p);
}

extern "C" void kernel_launch(void* const* d_in, const int* in_sizes, int n_in, void* d_out, int out_size, void* d_ws, size_t ws_size,
                              hipStream_t stream) {
  Params p{};
  p.x_prompt = (const float*)d_in[0]; p.x_sample = (const float*)d_in[1]; p.cache_lat = (const float*)d_in[2];
  p.cache_kr = (const float*)d_in[3]; p.state_ssm = (const float*)d_in[4]; p.page_table = (const int*)d_in[5];
  p.norm_mix = (const float*)d_in[6]; p.w_in = (const float*)d_in[7]; p.norm_q_lora = (const float*)d_in[8];
  p.w_uq = (const float*)d_in[9]; p.norm_kv_lora = (const float*)d_in[10]; p.w_uk = (const float*)d_in[11];
  p.w_uv = (const float*)d_in[12]; p.g_qn = (const float*)d_in[13]; p.g_qr = (const float*)d_in[14];
  p.g_kn = (const float*)d_in[15]; p.g_kr = (const float*)d_in[16]; p.a_re = (const float*)d_in[17];
  p.a_im = (const float*)d_in[18]; p.log_dt = (const float*)d_in[19]; p.ssm_b = (const float*)d_in[20];
  p.ssm_c = (const float*)d_in[21]; p.ssm_d = (const float*)d_in[22]; p.w_glu = (const float*)d_in[23];
  p.w_out = (const float*)d_in[24]; p.norm_ffn = (const float*)d_in[25]; p.peer_wq = (const float*)d_in[26];
  p.peer_keys = (const float*)d_in[27]; p.peer_u = (const float*)d_in[28]; p.peer_v = (const float*)d_in[29];
  p.out = (float*)d_out;
  char* w = (char*)d_ws;
  size_t off = 0;
  auto take = [&](size_t bytes) { char* r = w + off; off += (bytes + 255) & ~(size_t)255; return r; };
  p.bar = (unsigned*)take(16384);
  p.WinT = (bf16_t*)take((size_t)1280 * 1024 * 2);
  p.WuqT = (bf16_t*)take((size_t)768 * 384 * 2);
  p.WukT = (bf16_t*)take((size_t)512 * 256 * 2);
  p.WuvT = (bf16_t*)take((size_t)512 * 256 * 2);
  p.WgluT = (bf16_t*)take((size_t)1024 * 512 * 2);
  p.WoutT = (bf16_t*)take((size_t)1024 * 1024 * 2);
  p.WpqT = (bf16_t*)take((size_t)2048 * 1024 * 2);
  p.PK = (bf16_t*)take((size_t)2 * 128 * 128 * 2);
  p.Utab = (bf16_t*)take((size_t)16384 * 1024 * 2);
  p.Vtab = (bf16_t*)take((size_t)16384 * 1024 * 2);
  p.Bt2 = (bf16_t*)take((size_t)32 * 256 * A2LD * 2);
  p.Emat = (bf16_t*)take((size_t)32 * 128 * 256 * 2);
  p.XN = (bf16_t*)take((size_t)NT * 1024 * 2);
  p.A2 = (bf16_t*)take((size_t)32 * NSUB * A2LD * 2);
  p.CQN = (bf16_t*)take((size_t)NT * 384 * 2);
  p.CKV = (bf16_t*)take((size_t)NT * 256 * 2);
  p.Kcat = (bf16_t*)take((size_t)32 * 4096 * 96 * 2);
  p.KcatS = (bf16_t*)take((size_t)128 * 8 * 4 * 96 * 2);
  p.Qb = (bf16_t*)take((size_t)NT * 8 * 96 * 2);
  p.VT = (bf16_t*)take((size_t)512 * NP * 2);
  p.OATT = (bf16_t*)take((size_t)NT * 512 * 2);
  p.G = (bf16_t*)take((size_t)NT * 512 * 2);
  p.CAT = (bf16_t*)take((size_t)NT * 1024 * 2);
  p.PQ = (bf16_t*)take((size_t)NT * 2048 * 2);
  p.Z = (float*)take((size_t)NT * INW * 4);
  p.Qraw = (float*)take((size_t)NT * 768 * 4);
  p.KNraw = (float*)take((size_t)NT * 512 * 4);
  p.S = (float*)take((size_t)32 * NSUB * 128 * 4);
  p.GL = (float*)take((size_t)NT * 1024 * 4);
  p.X1 = (float*)take((size_t)NT * 1024 * 4);
  p.SC = (float*)take((size_t)NT * 8 * 256 * 4);
  p.GW = (float*)take((size_t)NT * 128 * 4);
  p.Opart = (float*)take((size_t)128 * 2 * 32 * 256 * 4);
  p.Lpart = (float*)take((size_t)128 * 2 * 32 * 4);
  p.IDX = (int*)take((size_t)NT * 128 * 4);
  if (off > ws_size) { fprintf(stderr, "workspace too small: need %zu have %zu\n", off, ws_size); return; }
  static int grid = 0;
  if (!grid) {
    int dev = 0, cus = 0, per_cu = 0;
    (void)hipGetDevice(&dev);
    (void)hipDeviceGetAttribute(&cus, hipDeviceAttributeMultiprocessorCount, dev);
    (void)hipFuncSetAttribute((const void*)k_mega, hipFuncAttributeMaxDynamicSharedMemorySize, LDS_BYTES + 16);
    (void)hipOccupancyMaxActiveBlocksPerMultiprocessor(&per_cu, k_mega, NTHR, LDS_BYTES + 16);
    if (per_cu < 1) { fprintf(stderr, "k_mega does not fit a CU\n"); return; }
    grid = cus;
  }
  (void)hipMemsetAsync(p.bar, 0, XCD_BAR_WORDS * sizeof(unsigned), stream);
  hipLaunchKernelGGL(k_mega, dim3(grid), dim3(NTHR), LDS_BYTES + 16, stream, p);
}
```

```cpp
#include <hip/hip_runtime.h>
#include <stdint.h>
#include <stdio.h>

typedef __attribute__((ext_vector_type(8))) short bf16x8;
typedef __attribute__((ext_vector_type(4))) short s16x4;
typedef __attribute__((ext_vector_type(16))) float f32x16;
typedef __attribute__((ext_vector_type(2))) __bf16 bf2;
typedef __attribute__((ext_vector_type(2))) float f2v;
typedef unsigned short bf16_t;

#define NTHR 512
#define D_MODEL 1024
#define NP 16384
#define NS 512
#define NT 16896
#define INW 1184
#define NSUB 1152
#define A2LD 384
#define EPS 1e-6f
#define QSCALE 0.14724466f

#define O_YP 0
#define O_YS 16777216
#define O_LATP 17301504
#define O_KRP 21495808
#define O_SSMP 22020096
#define O_LATS 22036480
#define O_KRS 22167552
#define O_SSMS 22183936

struct Params {
  const float *x_prompt, *x_sample, *cache_lat, *cache_kr, *state_ssm;
  const int* page_table;
  const float *norm_mix, *w_in, *norm_q_lora, *w_uq, *norm_kv_lora, *w_uk, *w_uv, *g_qn, *g_qr, *g_kn, *g_kr;
  const float *a_re, *a_im, *log_dt, *ssm_b, *ssm_c, *ssm_d, *w_glu, *w_out, *norm_ffn, *peer_wq, *peer_keys, *peer_u, *peer_v;
  float* out;
  unsigned* bar;
  bf16_t *WinT, *WuqT, *WukT, *WuvT, *WgluT, *WoutT, *WpqT, *PK, *Bt2, *Emat;
  bf16_t *XN, *A2, *CQN, *CKV, *Kcat, *KcatS, *Qb, *VT, *OATT, *G, *CAT, *PQ;
  float *Z, *Qraw, *KNraw, *S, *GL, *X1, *GW, *Opart, *Lpart;
  int* IDX;
  unsigned char *U8, *V8, *X8;
  int *USC, *XSC;
  float* VSCF;
};


#define XB_TMO      128
#define XB_XCNT(j)  (256  + 64 * (j))
#define XB_XSUB(j)  (1280 + 64 * (j))
#define XB_XGEN(j)  (2304 + 64 * (j))
#define XB_TOP      3328
#define XB_TOPGEN   3392
#define XCD_BAR_WORDS 3456
#define XB_SPIN_CAP (1u << 18)
#define LAS __attribute__((address_space(3)))

__device__ __forceinline__ unsigned xb_ld(unsigned* p)              { return __hip_atomic_load(p, __ATOMIC_RELAXED, __HIP_MEMORY_SCOPE_AGENT); }
__device__ __forceinline__ unsigned xb_add(unsigned* p, unsigned v) { return __hip_atomic_fetch_add(p, v, __ATOMIC_RELAXED, __HIP_MEMORY_SCOPE_AGENT); }
__device__ __forceinline__ unsigned xb_xcc_id() { return (unsigned)__builtin_amdgcn_s_getreg((3 << 11) | 20) & 0xFu; }
#define XB_SPIN(cond, bar) do { unsigned _sp = 0; while (cond) { __builtin_amdgcn_s_sleep(1); \
    if ((++_sp & 255u) == 0u) { if (xb_ld(&(bar)[XB_TMO])) break; if (_sp > XB_SPIN_CAP) { atomicAdd(&(bar)[XB_TMO], 1u); break; } } } } while (0)

struct XcdBarrier {
    unsigned* bar; unsigned x;
    volatile LAS unsigned* st;
};

__device__ __forceinline__ XcdBarrier xcd_barrier_post(unsigned* bar, volatile LAS unsigned* st) {
    XcdBarrier b; b.bar = bar; b.x = xb_xcc_id(); b.st = st;
    if (threadIdx.x == 0) (void)xb_add(&bar[XB_XCNT(b.x)], 1u);
    return b;
}
__device__ __forceinline__ void xcd_barrier_complete(unsigned* bar, unsigned x, unsigned& nloc, unsigned& nx) {
    const unsigned G = gridDim.x * gridDim.y * gridDim.z;
    unsigned sum, cnt, mine, sp = 0u;
    for (;;) {
        sum = 0u; cnt = 0u; mine = 0u;
#pragma unroll
        for (unsigned j = 0; j < 16; ++j) { const unsigned c = xb_ld(&bar[XB_XCNT(j)]); sum += c; cnt += (c > 0u) ? 1u : 0u; mine = (j == x) ? c : mine; }
        if (sum == G) break;
        __builtin_amdgcn_s_sleep(1);
        if ((++sp & 255u) == 0u) { if (xb_ld(&bar[XB_TMO])) break; if (sp > XB_SPIN_CAP) { atomicAdd(&bar[XB_TMO], 1u); break; } }
    }
    nloc = mine > 0u ? mine : 1u; nx = cnt > 0u ? cnt : 1u;
}

__device__ __forceinline__ void xcd_barrier(const XcdBarrier& b) {
    asm volatile("s_waitcnt vmcnt(0)" ::: "memory");
    __syncthreads();
    if (threadIdx.x == 0) {
        unsigned* bar = b.bar;
        __builtin_amdgcn_s_waitcnt(0);
        unsigned nloc = b.st[0], nx = b.st[1];
        if (nloc == 0u) { xcd_barrier_complete(bar, b.x, nloc, nx); b.st[0] = nloc; b.st[1] = nx; }
        const unsigned old = xb_add(&bar[XB_XSUB(b.x)], 1u);
        const unsigned gen = old / nloc;
        if (old + 1u == (gen + 1u) * nloc) {
            __builtin_amdgcn_fence(__ATOMIC_RELEASE, "agent");
            asm volatile("s_waitcnt vmcnt(0)" ::: "memory");
            const unsigned og = xb_add(&bar[XB_TOP], 1u);
            const unsigned tg = og / nx;
            if (og + 1u == (tg + 1u) * nx) xb_add(&bar[XB_TOPGEN], 1u);
            else XB_SPIN(xb_ld(&bar[XB_TOPGEN]) == tg, bar);
            __builtin_amdgcn_fence(__ATOMIC_ACQUIRE, "agent");
            xb_add(&bar[XB_XGEN(b.x)], 1u);
            asm volatile("s_waitcnt vmcnt(0)" ::: "memory");
        } else {
            XB_SPIN(xb_ld(&bar[XB_XGEN(b.x)]) == gen, bar);
            __builtin_amdgcn_fence(__ATOMIC_ACQUIRE, "agent");
            asm volatile("s_waitcnt vmcnt(0)" ::: "memory");
        }
    }
    __syncthreads();
}

__device__ __forceinline__ unsigned pk2(float a, float b) {
  f2v v = {a, b};
  bf2 r = __builtin_convertvector(v, bf2);
  return __builtin_bit_cast(unsigned, r);
}
__device__ __forceinline__ bf16_t f2bf(float a) { return (bf16_t)(pk2(a, 0.f) & 0xffffu); }
__device__ __forceinline__ float bf2f(bf16_t x) { return __uint_as_float(((unsigned)x) << 16); }
__device__ __forceinline__ float bflo(unsigned x) { return __uint_as_float(x << 16); }
__device__ __forceinline__ float bfhi(unsigned x) { return __uint_as_float(x & 0xffff0000u); }
__device__ __forceinline__ float wave_sum(float v) {
  v += __shfl_xor(v, 32); v += __shfl_xor(v, 16); v += __shfl_xor(v, 8);
  v += __shfl_xor(v, 4);  v += __shfl_xor(v, 2);  v += __shfl_xor(v, 1);
  return v;
}
__device__ __forceinline__ float gelu_tanh(float x) {
  float u = 0.7978845608028654f * (x + 0.044715f * x * x * x);
  float e = __expf(2.f * u);
  float t = 1.f - 2.f / (1.f + e);
  return 0.5f * x * (1.f + t);
}
__device__ __forceinline__ void sincos_rev(float ang, float& s, float& c) {
  float rev = ang * 0.15915494309189535f;
  rev = rev - floorf(rev);
  s = __builtin_amdgcn_sinf(rev);
  c = __builtin_amdgcn_cosf(rev);
}
__device__ __forceinline__ f32x16 mfma32(bf16x8 a, bf16x8 b, f32x16 c) {
  return __builtin_amdgcn_mfma_f32_32x32x16_bf16(a, b, c, 0, 0, 0);
}
__device__ __forceinline__ bf16x8 mk8(unsigned a, unsigned b, unsigned c, unsigned d) {
  uint4 u = make_uint4(a, b, c, d);
  return __builtin_bit_cast(bf16x8, u);
}

#define GLD 72
template <int MT, class Epi>
__device__ __forceinline__ void gemm_tile(const bf16_t* __restrict__ A, int lda, const bf16_t* __restrict__ Bt, int ldb,
                                          int K, int m0, int n0, char* smem, Epi epi) {
  constexpr int BM = 128 * MT;
  bf16_t* As = (bf16_t*)smem;
  bf16_t* Bs = As + 2 * BM * GLD;
  const int tid = threadIdx.x, lane = tid & 63, wave = tid >> 6;
  const int wm = wave >> 1, wn = wave & 1, lr = lane & 31, hh = lane >> 5;
  uint4 ra[2 * MT], rb[2];
  f32x16 acc[MT][2];
#pragma unroll
  for (int i = 0; i < MT; ++i)
#pragma unroll
    for (int j = 0; j < 2; ++j)
#pragma unroll
      for (int r = 0; r < 16; ++r) acc[i][j][r] = 0.f;
  const int nk = K / 64;
  auto gload = [&](int k0) {
#pragma unroll
    for (int i = 0; i < 2 * MT; ++i) {
      int c = tid + NTHR * i, row = c >> 3, cc = c & 7;
      ra[i] = *(const uint4*)(A + (size_t)(m0 + row) * lda + k0 + cc * 8);
    }
#pragma unroll
    for (int i = 0; i < 2; ++i) {
      int c = tid + NTHR * i, row = c >> 3, cc = c & 7;
      rb[i] = *(const uint4*)(Bt + (size_t)(n0 + row) * ldb + k0 + cc * 8);
    }
  };
  auto lstore = [&](int buf) {
#pragma unroll
    for (int i = 0; i < 2 * MT; ++i) {
      int c = tid + NTHR * i, row = c >> 3, cc = c & 7;
      *(uint4*)(As + (buf * BM + row) * GLD + cc * 8) = ra[i];
    }
#pragma unroll
    for (int i = 0; i < 2; ++i) {
      int c = tid + NTHR * i, row = c >> 3, cc = c & 7;
      *(uint4*)(Bs + (buf * 128 + row) * GLD + cc * 8) = rb[i];
    }
  };
  gload(0);
  lstore(0);
  __syncthreads();
  for (int kt = 0; kt < nk; ++kt) {
    const int buf = kt & 1;
    if (kt + 1 < nk) gload((kt + 1) * 64);
#pragma unroll
    for (int ks = 0; ks < 4; ++ks) {
      bf16x8 a[MT], b[2];
#pragma unroll
      for (int i = 0; i < MT; ++i) a[i] = *(const bf16x8*)(As + (buf * BM + wm * 32 * MT + i * 32 + lr) * GLD + ks * 16 + hh * 8);
#pragma unroll
      for (int j = 0; j < 2; ++j) b[j] = *(const bf16x8*)(Bs + (buf * 128 + wn * 64 + j * 32 + lr) * GLD + ks * 16 + hh * 8);
#pragma unroll
      for (int i = 0; i < MT; ++i)
#pragma unroll
        for (int j = 0; j < 2; ++j) acc[i][j] = mfma32(a[i], b[j], acc[i][j]);
    }
    if (kt + 1 < nk) lstore(buf ^ 1);
    __syncthreads();
  }
#pragma unroll
  for (int i = 0; i < MT; ++i)
#pragma unroll
    for (int j = 0; j < 2; ++j)
#pragma unroll
      for (int r = 0; r < 16; ++r) {
        int m = m0 + wm * 32 * MT + i * 32 + (r & 3) + 8 * (r >> 2) + 4 * hh;
        int n = n0 + wn * 64 + j * 32 + lr;
        epi(m, n, acc[i][j][r]);
      }
}

struct Cplx { float re, im; };
__device__ __forceinline__ Cplx cmul(Cplx a, Cplx b) { return {a.re * b.re - a.im * b.im, a.re * b.im + a.im * b.re}; }
__device__ __forceinline__ Cplx apow(float are, float aim, float dt, float m) {
  float mag = __expf(m * dt * are);
  float s, c;
  sincos_rev(m * dt * aim, s, c);
  return {mag * c, mag * s};
}
__device__ __forceinline__ Cplx bscale(float are, float aim, float dt) {
  Cplx ab = apow(are, aim, dt, 1.f);
  float nr = ab.re - 1.f, ni = ab.im;
  float den = are * are + aim * aim;
  return {(nr * are + ni * aim) / den, (ni * are - nr * aim) / den};
}

__device__ __forceinline__ void tr_cvt(const float* __restrict__ W, bf16_t* __restrict__ Wt, int K, int N, int Npad, size_t gt, size_t GT) {
  size_t tot = (size_t)K * Npad;
  for (size_t i = gt; i < tot; i += GT) {
    int n = (int)(i / K), k = (int)(i % K);
    Wt[i] = (n < N) ? f2bf(W[(size_t)k * N + n]) : (bf16_t)0;
  }
}
__device__ __forceinline__ void cvt_flat(const float* __restrict__ W, bf16_t* __restrict__ Wb, size_t n4, size_t gt, size_t GT) {
  for (size_t i = gt; i < n4; i += GT) {
    float4 v = ((const float4*)W)[i];
    ((uint2*)Wb)[i] = make_uint2(pk2(v.x, v.y), pk2(v.z, v.w));
  }
}
__device__ void phase0(const Params& p) {
  const size_t gt = (size_t)blockIdx.x * NTHR + threadIdx.x, GT = (size_t)gridDim.x * NTHR;
  tr_cvt(p.w_in, p.WinT, 1024, INW, 1280, gt, GT);
  tr_cvt(p.w_uq, p.WuqT, 384, 768, 768, gt, GT);
  tr_cvt(p.w_uk, p.WukT, 256, 512, 512, gt, GT);
  tr_cvt(p.w_uv, p.WuvT, 256, 512, 512, gt, GT);
  tr_cvt(p.w_glu, p.WgluT, 512, 1024, 1024, gt, GT);
  tr_cvt(p.w_out, p.WoutT, 1024, 1024, 1024, gt, GT);
  tr_cvt(p.peer_wq, p.WpqT, 1024, 2048, 2048, gt, GT);
  cvt_flat(p.peer_keys, p.PK, 2 * 128 * 128 / 4, gt, GT);
  {
    const int lane = threadIdx.x & 63, gw = blockIdx.x * 8 + (threadIdx.x >> 6), GWv = gridDim.x * 8;
    for (int row = gw; row < 2 * 16384; row += GWv) {
      const bool isU = row < 16384;
      const int e = isU ? row : row - 16384;
      const float* src = (isU ? p.peer_u : p.peer_v) + (size_t)e * 1024 + lane * 16;
      float4 v[4];
      float am = 0.f;
#pragma unroll
      for (int i = 0; i < 4; ++i) {
        v[i] = ((const float4*)src)[i];
        am = fmaxf(am, fmaxf(fmaxf(fabsf(v[i].x), fabsf(v[i].y)), fmaxf(fabsf(v[i].z), fabsf(v[i].w))));
      }
#pragma unroll
      for (int o = 32; o >= 1; o >>= 1) am = fmaxf(am, __shfl_xor(am, o));
      int E = (int)((__float_as_uint(am) >> 23) & 0xffu) - 127;
      E = E < -60 ? -60 : E;
      const int k = 7 - E;
      const float sc = __uint_as_float((unsigned)(k + 127) << 23);
      unsigned w[4];
#pragma unroll
      for (int i = 0; i < 4; ++i) {
        int pk = 0;
        pk = __builtin_amdgcn_cvt_pk_fp8_f32(v[i].x * sc, v[i].y * sc, pk, false);
        pk = __builtin_amdgcn_cvt_pk_fp8_f32(v[i].z * sc, v[i].w * sc, pk, true);
        w[i] = (unsigned)pk;
      }
      unsigned char* dst = (isU ? p.U8 : p.V8) + (size_t)e * 1024 + lane * 16;
      *(uint4*)dst = make_uint4(w[0], w[1], w[2], w[3]);
      if (lane == 0) {
        if (isU) p.USC[e] = 127 - k;
        else p.VSCF[e] = __uint_as_float((unsigned)(127 - k) << 23);
      }
    }
  }
  {
    size_t tot = (size_t)32 * 128 * 256 / 8;
    for (size_t i = gt; i < tot; i += GT) {
      int g = (int)(i / (128 * 32)), rem = (int)(i % (128 * 32)), n = rem / 32, c8 = rem % 32;
      *(uint4*)(p.A2 + ((size_t)g * NSUB + 1024 + n) * A2LD + c8 * 8) = make_uint4(0, 0, 0, 0);
    }
  }
  {
    size_t tot = (size_t)32 * 16 * 256;
    for (size_t i = gt; i < tot; i += GT) {
      int g = (int)(i / 4096), rem = (int)(i % 4096), m = rem >> 8, h = (rem >> 4) & 15, h2 = rem & 15;
      float dt = __expf(p.log_dt[g]);
      float acc = 0.f;
      for (int pp = 0; pp < 64; ++pp) {
        float are = p.a_re[g * 64 + pp], aim = p.a_im[g * 64 + pp];
        Cplx am = apow(are, aim, dt, (float)m);
        Cplx bs = bscale(are, aim, dt);
        Cplx bb = {p.ssm_b[((g * 64 + pp) * 16 + h2) * 2], p.ssm_b[((g * 64 + pp) * 16 + h2) * 2 + 1]};
        Cplx cc = {p.ssm_c[((g * 16 + h) * 64 + pp) * 2], p.ssm_c[((g * 16 + h) * 64 + pp) * 2 + 1]};
        Cplx x = cmul(cmul(am, bs), bb);
        acc += cc.re * x.re - cc.im * x.im;
      }
      if (m == 0 && h == h2) acc += p.ssm_d[g * 16 + h];
      bf16_t v = f2bf(acc);
      for (int t = m; t < 16; ++t) {
        int j = t - m;
        p.Bt2[((size_t)g * 256 + t * 16 + h) * A2LD + j * 16 + h2] = v;
      }
      if (m == 0) {
        for (int t = 0; t < 16; ++t)
          for (int j = t + 1; j < 16; ++j) p.Bt2[((size_t)g * 256 + t * 16 + h) * A2LD + j * 16 + h2] = 0;
      }
    }
    tot = (size_t)32 * 256 * 64;
    for (size_t i = gt; i < tot; i += GT) {
      int g = (int)(i / 16384), rem = (int)(i % 16384), th = rem >> 6, pp = rem & 63, t = th >> 4, h = th & 15;
      float dt = __expf(p.log_dt[g]);
      float are = p.a_re[g * 64 + pp], aim = p.a_im[g * 64 + pp];
      Cplx am = apow(are, aim, dt, (float)(t + 1));
      Cplx cc = {p.ssm_c[((g * 16 + h) * 64 + pp) * 2], p.ssm_c[((g * 16 + h) * 64 + pp) * 2 + 1]};
      p.Bt2[((size_t)g * 256 + th) * A2LD + 256 + pp] = f2bf(cc.re * am.re - cc.im * am.im);
      p.Bt2[((size_t)g * 256 + th) * A2LD + 320 + pp] = f2bf(-(cc.re * am.im + cc.im * am.re));
    }
    tot = (size_t)32 * 64 * 256;
    for (size_t i = gt; i < tot; i += GT) {
      int g = (int)(i / 16384), rem = (int)(i % 16384), pp = rem >> 8, jh = rem & 255, j = jh >> 4, h2 = jh & 15;
      float dt = __expf(p.log_dt[g]);
      float are = p.a_re[g * 64 + pp], aim = p.a_im[g * 64 + pp];
      Cplx am = apow(are, aim, dt, (float)(15 - j));
      Cplx bs = bscale(are, aim, dt);
      Cplx bb = {p.ssm_b[((g * 64 + pp) * 16 + h2) * 2], p.ssm_b[((g * 64 + pp) * 16 + h2) * 2 + 1]};
      Cplx x = cmul(cmul(am, bs), bb);
      p.Emat[((size_t)g * 128 + pp) * 256 + jh] = f2bf(x.re);
      p.Emat[((size_t)g * 128 + 64 + pp) * 256 + jh] = f2bf(x.im);
    }
  }
}

template <bool FP8OUT>
__device__ void phase_rmsnorm(const float* __restrict__ srcP, const float* __restrict__ srcS, const float* __restrict__ gain,
                              bf16_t* __restrict__ dst, unsigned char* __restrict__ dst8, int* __restrict__ xsc) {
  const int lane = threadIdx.x & 63, gw = blockIdx.x * 8 + (threadIdx.x >> 6), GW = gridDim.x * 8;
  float4 g[4];
#pragma unroll
  for (int i = 0; i < 4; ++i) g[i] = *(const float4*)(gain + lane * 4 + 256 * i);
  for (int r = gw; r < NT; r += GW) {
    const float* src = (r < NP) ? srcP + (size_t)r * 1024 : srcS + (size_t)(r - NP) * 1024;
    float4 v[4];
    float ss = 0.f;
#pragma unroll
    for (int i = 0; i < 4; ++i) {
      v[i] = *(const float4*)(src + lane * 4 + 256 * i);
      ss += v[i].x * v[i].x + v[i].y * v[i].y + v[i].z * v[i].z + v[i].w * v[i].w;
    }
    ss = wave_sum(ss);
    float rinv = rsqrtf(ss * (1.f / 1024.f) + EPS);
#pragma unroll
    for (int i = 0; i < 4; ++i) {
      uint2 o = make_uint2(pk2(v[i].x * rinv * g[i].x, v[i].y * rinv * g[i].y), pk2(v[i].z * rinv * g[i].z, v[i].w * rinv * g[i].w));
      *(uint2*)(dst + (size_t)r * 1024 + lane * 4 + 256 * i) = o;
    }
    if constexpr (FP8OUT) {
      float am = 0.f;
#pragma unroll
      for (int i = 0; i < 4; ++i) {
        v[i].x *= rinv * g[i].x; v[i].y *= rinv * g[i].y; v[i].z *= rinv * g[i].z; v[i].w *= rinv * g[i].w;
        am = fmaxf(am, fmaxf(fmaxf(fabsf(v[i].x), fabsf(v[i].y)), fmaxf(fabsf(v[i].z), fabsf(v[i].w))));
      }
#pragma unroll
      for (int o = 32; o >= 1; o >>= 1) am = fmaxf(am, __shfl_xor(am, o));
      int E = (int)((__float_as_uint(am) >> 23) & 0xffu) - 127;
      E = E < -60 ? -60 : E;
      const int k = 7 - E;
      const float sc = __uint_as_float((unsigned)(k + 127) << 23);
#pragma unroll
      for (int i = 0; i < 4; ++i) {
        int pk = 0;
        pk = __builtin_amdgcn_cvt_pk_fp8_f32(v[i].x * sc, v[i].y * sc, pk, false);
        pk = __builtin_amdgcn_cvt_pk_fp8_f32(v[i].z * sc, v[i].w * sc, pk, true);
        *(unsigned*)(dst8 + (size_t)r * 1024 + lane * 4 + 256 * i) = (unsigned)pk;
      }
      if (lane == 0) xsc[r] = 127 - k;
    }
  }
}

__device__ void phase_gemm_z(const Params& p, char* smem) {
  const int ntn = 10, ntm = NT / 256;
  for (int t = blockIdx.x; t < ntm * ntn; t += gridDim.x) {
    int tm = t / ntn, tn = t % ntn;
    float* Z = p.Z;
    gemm_tile<2>(p.XN, 1024, p.WinT, 1024, 1024, tm * 256, tn * 128, smem, [=](int m, int n, float v) {
      if (n < INW) Z[(size_t)m * INW + n] = v;
    });
  }
}

__device__ void phase_post1(const Params& p) {
  const int lane = threadIdx.x & 63, gw = blockIdx.x * 8 + (threadIdx.x >> 6), GW = gridDim.x * 8;
  for (int r = gw; r < NT; r += GW) {
    const float* z = p.Z + (size_t)r * INW;
    const bool isP = r < NP;
    const int rs = r - NP;
    {
      float4 a = *(const float4*)(z + lane * 8), b = *(const float4*)(z + lane * 8 + 4);
      int g = lane >> 1, h0 = (lane & 1) * 8;
      int n = isP ? (r >> 4) : (1024 + (rs >> 2));
      int t = isP ? (r & 15) : (rs & 3);
      *(uint4*)(p.A2 + ((size_t)g * NSUB + n) * A2LD + t * 16 + h0) = make_uint4(pk2(a.x, a.y), pk2(a.z, a.w), pk2(b.x, b.y), pk2(b.z, b.w));
    }
    {
      float2 v[3];
      float ss = 0.f;
#pragma unroll
      for (int i = 0; i < 3; ++i) {
        v[i] = *(const float2*)(z + 512 + lane * 2 + 128 * i);
        ss += v[i].x * v[i].x + v[i].y * v[i].y;
      }
      ss = wave_sum(ss);
      float rinv = rsqrtf(ss * (1.f / 384.f) + EPS);
#pragma unroll
      for (int i = 0; i < 3; ++i) {
        float2 g = *(const float2*)(p.norm_q_lora + lane * 2 + 128 * i);
        *(unsigned*)(p.CQN + (size_t)r * 384 + lane * 2 + 128 * i) = pk2(v[i].x * rinv * g.x, v[i].y * rinv * g.y);
      }
    }
    {
      float4 v = *(const float4*)(z + 896 + lane * 4);
      float ss = wave_sum(v.x * v.x + v.y * v.y + v.z * v.z + v.w * v.w);
      float rinv = rsqrtf(ss * (1.f / 256.f) + EPS);
      float4 g = *(const float4*)(p.norm_kv_lora + lane * 4);
      float4 o = make_float4(v.x * rinv * g.x, v.y * rinv * g.y, v.z * rinv * g.z, v.w * rinv * g.w);
      float* dst = isP ? p.out + O_LATP + (size_t)r * 256 : p.out + O_LATS + (size_t)rs * 256;
      *(float4*)(dst + lane * 4) = o;
      *(uint2*)(p.CKV + (size_t)r * 256 + lane * 4) = make_uint2(pk2(o.x, o.y), pk2(o.z, o.w));
    }
    {
      float v = (lane < 32) ? z[1152 + lane] : 0.f;
      float ss = wave_sum(v * v);
      float rinv = rsqrtf(ss * (1.f / 32.f) + EPS);
      float gn = (lane < 32) ? p.g_kr[lane] : 0.f;
      float xv = v * rinv * gn;
      float other = __shfl_xor(xv, 16);
      int i = lane & 15;
      float pos = isP ? (float)(r & 4095) : (float)(8192 + (rs & 3));
      float inv = exp2f(-(float)i * (13.287712379549449f / 16.f));
      float sn, cs;
      sincos_rev(pos * inv, sn, cs);
      float o = (lane & 16) ? (xv * cs + other * sn) : (xv * cs - other * sn);
      if (lane < 32) {
        float* dst = isP ? p.out + O_KRP + (size_t)r * 32 : p.out + O_KRS + (size_t)rs * 32;
        dst[lane] = o;
        bf16_t ob = f2bf(o);
        if (isP) {
          int b = r >> 12, t = r & 4095;
#pragma unroll
          for (int h = 0; h < 8; ++h) p.Kcat[((size_t)(b * 8 + h) * 4096 + t) * 96 + 64 + lane] = ob;
        } else {
          int seq = rs >> 2, t = rs & 3;
#pragma unroll
          for (int h = 0; h < 8; ++h) p.KcatS[((size_t)(seq * 8 + h) * 4 + t) * 96 + 64 + lane] = ob;
        }
      }
    }
  }
}

__device__ void phase_gemm4(const Params& p, char* smem) {
  const int nq = 66 * 6, nk = 66 * 4, nv = 2 * 128, ns = 32 * 9;
  const int total = nq + nk + nv + ns;
  for (int t = blockIdx.x; t < total; t += gridDim.x) {
    if (t < nq) {
      int tm = t / 6, tn = t % 6;
      float* C = p.Qraw;
      gemm_tile<2>(p.CQN, 384, p.WuqT, 384, 384, tm * 256, tn * 128, smem, [=](int m, int n, float v) { C[(size_t)m * 768 + n] = v; });
    } else if (t < nq + nk) {
      int u = t - nq, tm = u / 4, tn = u % 4;
      float* C = p.KNraw;
      gemm_tile<2>(p.CKV, 256, p.WukT, 256, 256, tm * 256, tn * 128, smem, [=](int m, int n, float v) { C[(size_t)m * 512 + n] = v; });
    } else if (t < nq + nk + nv) {
      int u = t - nq - nk, tm = u / 128, tn = u % 128;
      bf16_t* C = p.VT;
      gemm_tile<2>(p.WuvT, 256, p.CKV, 256, 256, tm * 256, tn * 128, smem, [=](int m, int n, float v) { C[(size_t)m * NP + n] = f2bf(v); });
    } else {
      int u = t - nq - nk - nv, g = u / 9, tm = u % 9;
      float* C = p.S + (size_t)g * NSUB * 128;
      gemm_tile<1>(p.A2 + (size_t)g * NSUB * A2LD, A2LD, p.Emat + (size_t)g * 128 * 256, 256, 256, tm * 128, 0, smem,
                   [=](int m, int n, float v) { C[(size_t)m * 128 + n] = v; });
    }
  }
}

__device__ void phase_post2(const Params& p) {
  const int lane = threadIdx.x & 63, gw = blockIdx.x * 8 + (threadIdx.x >> 6), GW = gridDim.x * 8;
  const float gqn = p.g_qn[lane], gkn = p.g_kn[lane];
  const float gqr = p.g_qr[lane & 31];
  const float inv = exp2f(-(float)(lane & 15) * (13.287712379549449f / 16.f));
  for (int r = gw; r < NT; r += GW) {
    const bool isP = r < NP;
    const int rs = r - NP;
    float pos = isP ? (float)(r & 4095) : (float)(8192 + (rs & 3));
    float sn, cs;
    sincos_rev(pos * inv, sn, cs);
#pragma unroll 1
    for (int h = 0; h < 8; ++h) {
      const float* q = p.Qraw + (size_t)r * 768 + h * 96;
      float v = q[lane];
      float ss = wave_sum(v * v);
      float rinv = rsqrtf(ss * (1.f / 64.f) + EPS);
      p.Qb[((size_t)r * 8 + h) * 96 + lane] = f2bf(v * rinv * gqn * QSCALE);
      float w = (lane < 32) ? q[64 + lane] : 0.f;
      float s2 = wave_sum(w * w);
      float rinv2 = rsqrtf(s2 * (1.f / 32.f) + EPS);
      float xv = w * rinv2 * gqr;
      float other = __shfl_xor(xv, 16);
      float o = (lane & 16) ? (xv * cs + other * sn) : (xv * cs - other * sn);
      if (lane < 32) p.Qb[((size_t)r * 8 + h) * 96 + 64 + lane] = f2bf(o * QSCALE);
      float kv = p.KNraw[(size_t)r * 512 + h * 64 + lane];
      float ks = wave_sum(kv * kv);
      float krinv = rsqrtf(ks * (1.f / 64.f) + EPS);
      bf16_t kb = f2bf(kv * krinv * gkn);
      if (isP) {
        int b = r >> 12, t = r & 4095;
        p.Kcat[((size_t)(b * 8 + h) * 4096 + t) * 96 + lane] = kb;
      } else {
        int seq = rs >> 2, t = rs & 3;
        p.KcatS[((size_t)(seq * 8 + h) * 4 + t) * 96 + lane] = kb;
      }
    }
  }
}

__device__ __forceinline__ float softmax_bound(const Params& p) {
  const int lane = threadIdx.x & 63;
  float a = fabsf(p.g_qn[lane]), b = fabsf(p.g_kn[lane]), c = fabsf(p.g_qr[lane & 31]), d = fabsf(p.g_kr[lane & 31]);
#pragma unroll
  for (int o = 32; o >= 1; o >>= 1) {
    a = fmaxf(a, __shfl_xor(a, o)); b = fmaxf(b, __shfl_xor(b, o));
    c = fmaxf(c, __shfl_xor(c, o)); d = fmaxf(d, __shfl_xor(d, o));
  }
  return QSCALE * (64.f * a * b + 32.f * c * d);
}

#define KLD 104
#define VLD 68
__device__ __forceinline__ void attn_prompt_block(const Params& p, char* smem, int b, int h, int qi, float Mb) {
  bf16_t* Ks = (bf16_t*)smem;
  bf16_t* Vs = Ks + 2 * 64 * KLD;
  const int tid = threadIdx.x, lane = tid & 63, wave = tid >> 6, lr = lane & 31, hh = lane >> 5;
  const int q0 = qi * 256 + wave * 32;
  const bf16_t* Kg = p.Kcat + (size_t)(b * 8 + h) * 4096 * 96;
  const bf16_t* Vg = p.VT + (size_t)(h * 64) * NP + b * 4096;
  bf16x8 qf[6];
  {
    const bf16_t* qp = p.Qb + ((size_t)(b * 4096 + q0 + lr) * 8 + h) * 96 + hh * 8;
#pragma unroll
    for (int s = 0; s < 6; ++s) qf[s] = *(const bf16x8*)(qp + s * 16);
  }
  f32x16 ot[2];
#pragma unroll
  for (int i = 0; i < 2; ++i)
#pragma unroll
    for (int r = 0; r < 16; ++r) ot[i][r] = 0.f;
  float lsum = 0.f;
  const int nkt = 4 * (qi + 1);
  uint4 rk[2];
  uint2 rv[2];
  auto gload = [&](int kt) {
    const int k0 = kt * 64;
#pragma unroll
    for (int i = 0; i < 2; ++i) {
      int c = tid + NTHR * i;
      c = c < 768 ? c : 767;
      int row = c / 12, cc = c % 12;
      rk[i] = *(const uint4*)(Kg + (size_t)(k0 + row) * 96 + cc * 8);
    }
#pragma unroll
    for (int i = 0; i < 2; ++i) {
      int c = tid + NTHR * i, row = c >> 4, cc = c & 15;
      rv[i] = *(const uint2*)(Vg + (size_t)row * NP + k0 + cc * 4);
    }
  };
  auto lstore = [&](int buf) {
#pragma unroll
    for (int i = 0; i < 2; ++i) {
      int c = tid + NTHR * i;
      if (c < 768) { int row = c / 12, cc = c % 12; *(uint4*)(Ks + (buf * 64 + row) * KLD + cc * 8) = rk[i]; }
    }
#pragma unroll
    for (int i = 0; i < 2; ++i) {
      int c = tid + NTHR * i, row = c >> 4, cc = c & 15;
      *(uint2*)(Vs + (buf * 64 + row) * VLD + cc * 4) = rv[i];
    }
  };
  gload(0);
  lstore(0);
  __syncthreads();
  for (int kt = 0; kt < nkt; ++kt) {
    const int buf = kt & 1, k0 = kt * 64;
    if (kt + 1 < nkt) gload(kt + 1);
    if (k0 <= q0 + 31) {
      const bool need_mask = (k0 + 63 > q0);
      bf16x8 pb[2][2];
#pragma unroll
      for (int kt2 = 0; kt2 < 2; ++kt2) {
        f32x16 st;
#pragma unroll
        for (int r = 0; r < 16; ++r) st[r] = 0.f;
#pragma unroll
        for (int s = 0; s < 6; ++s) {
          bf16x8 a = *(const bf16x8*)(Ks + (buf * 64 + kt2 * 32 + lr) * KLD + s * 16 + hh * 8);
          st = mfma32(a, qf[s], st);
        }
        float pv[16];
#pragma unroll
        for (int r = 0; r < 16; ++r) {
          float e = exp2f(st[r] - Mb);
          if (need_mask) {
            int key = k0 + kt2 * 32 + (r & 3) + 8 * (r >> 2) + 4 * hh;
            e = (key <= q0 + lr) ? e : 0.f;
          }
          pv[r] = e;
          lsum += e;
        }
#pragma unroll
        for (int s2 = 0; s2 < 2; ++s2)
          pb[kt2][s2] = mk8(pk2(pv[8 * s2 + 0], pv[8 * s2 + 1]), pk2(pv[8 * s2 + 2], pv[8 * s2 + 3]),
                            pk2(pv[8 * s2 + 4], pv[8 * s2 + 5]), pk2(pv[8 * s2 + 6], pv[8 * s2 + 7]));
      }
#pragma unroll
      for (int dt = 0; dt < 2; ++dt)
#pragma unroll
        for (int kt2 = 0; kt2 < 2; ++kt2)
#pragma unroll
          for (int s2 = 0; s2 < 2; ++s2) {
            const bf16_t* vp = Vs + (buf * 64 + dt * 32 + lr) * VLD + kt2 * 32 + 16 * s2 + 4 * hh;
            uint2 lo = *(const uint2*)vp, hi = *(const uint2*)(vp + 8);
            bf16x8 a = mk8(lo.x, lo.y, hi.x, hi.y);
            ot[dt] = mfma32(a, pb[kt2][s2], ot[dt]);
          }
    }
    if (kt + 1 < nkt) lstore(buf ^ 1);
    __syncthreads();
  }
  lsum += __shfl_xor(lsum, 32);
  const float linv = 1.f / lsum;
  bf16_t* op = p.OATT + (size_t)(b * 4096 + q0 + lr) * 512 + h * 64;
#pragma unroll
  for (int dt = 0; dt < 2; ++dt)
#pragma unroll
    for (int rg = 0; rg < 4; ++rg) {
      int d = dt * 32 + 8 * rg + 4 * hh;
      *(uint2*)(op + d) = make_uint2(pk2(ot[dt][4 * rg] * linv, ot[dt][4 * rg + 1] * linv), pk2(ot[dt][4 * rg + 2] * linv, ot[dt][4 * rg + 3] * linv));
    }
}

#define LLD 264
#define KRLD 40
#define PLD 72
__device__ __forceinline__ void attn_decode_unit(const Params& p, char* smem, int seq, int half, float Mb) {
  bf16_t* latS = (bf16_t*)smem;
  bf16_t* krS = latS + 64 * LLD;
  bf16_t* Psh = krS + 64 * KRLD;
  const int tid = threadIdx.x, lane = tid & 63, wave = tid >> 6, lr = lane & 31, hh = lane >> 5;
  const int hd = wave;
  bf16x8 qnf[2][2], qrf[2];
  {
    const bf16_t* qp = p.Qb + ((size_t)(NP + seq * 4 + (lr & 3)) * 8 + hd) * 96;
    const bool valid = lr < 4;
#pragma unroll
    for (int dt = 0; dt < 2; ++dt)
#pragma unroll
      for (int s2 = 0; s2 < 2; ++s2) {
        unsigned w[4];
#pragma unroll
        for (int jj = 0; jj < 4; ++jj) {
          float v[2];
#pragma unroll
          for (int e = 0; e < 2; ++e) {
            int j = jj * 2 + e;
            int d = 32 * dt + 16 * s2 + 8 * (j >> 2) + 4 * hh + (j & 3);
            v[e] = valid ? bf2f(qp[d]) * p.g_kn[d] : 0.f;
          }
          w[jj] = pk2(v[0], v[1]);
        }
        qnf[dt][s2] = mk8(w[0], w[1], w[2], w[3]);
      }
#pragma unroll
    for (int s = 0; s < 2; ++s) {
      uint4 u = *(const uint4*)(qp + 64 + 16 * s + 8 * hh);
      if (!valid) u = make_uint4(0, 0, 0, 0);
      qrf[s] = __builtin_bit_cast(bf16x8, u);
    }
  }
  f32x16 oacc;
#pragma unroll
  for (int r = 0; r < 16; ++r) oacc[r] = 0.f;
  float lsum[4] = {0.f, 0.f, 0.f, 0.f};
  const int ntile = 64 + half;
  float4 rl[8];
  float4 rkr;
  auto gload = [&](int i) {
    int page = p.page_table[seq * 64 + half * 32 + (i >> 1)];
    const float* lp = p.cache_lat + ((size_t)page * 128 + (i & 1) * 64) * 256;
    const float* kp = p.cache_kr + ((size_t)page * 128 + (i & 1) * 64) * 32;
#pragma unroll
    for (int j = 0; j < 8; ++j) rl[j] = ((const float4*)lp)[tid + NTHR * j];
    rkr = ((const float4*)kp)[tid];
  };
  auto lstore = [&]() {
#pragma unroll
    for (int j = 0; j < 8; ++j) {
      int f = tid + NTHR * j, row = f >> 6, c4 = f & 63;
      *(uint2*)(latS + row * LLD + c4 * 4) = make_uint2(pk2(rl[j].x, rl[j].y), pk2(rl[j].z, rl[j].w));
    }
    int row = tid >> 3, c4 = tid & 7;
    *(uint2*)(krS + row * KRLD + c4 * 4) = make_uint2(pk2(rkr.x, rkr.y), pk2(rkr.z, rkr.w));
  };
  auto lstore_new = [&]() {
#pragma unroll
    for (int j = 0; j < 8; ++j) {
      int f = tid + NTHR * j, row = f >> 6, c4 = f & 63;
      uint2 v = make_uint2(0, 0);
      if (row < 4) v = *(const uint2*)(p.CKV + (size_t)(NP + seq * 4 + row) * 256 + c4 * 4);
      *(uint2*)(latS + row * LLD + c4 * 4) = v;
    }
    int row = tid >> 3, c4 = tid & 7;
    uint2 v = make_uint2(0, 0);
    if (row < 4) v = *(const uint2*)(p.KcatS + ((size_t)(seq * 8) * 4 + row) * 96 + 64 + c4 * 4);
    *(uint2*)(krS + row * KRLD + c4 * 4) = v;
  };
  gload(0);
  for (int i = 0; i < ntile; ++i) {
    const bool isnew = (i == 64);
    if (isnew) lstore_new(); else lstore();
    __syncthreads();
    if (i + 1 < 64) gload(i + 1);
#pragma unroll 1
    for (int kt2 = 0; kt2 < 2; ++kt2) {
      float ss = 0.f;
      f32x16 s1, s2;
#pragma unroll
      for (int r = 0; r < 16; ++r) { s1[r] = 0.f; s2[r] = 0.f; }
#pragma unroll
      for (int dt = 0; dt < 2; ++dt) {
        f32x16 acc;
#pragma unroll
        for (int r = 0; r < 16; ++r) acc[r] = 0.f;
        int wofs = (hd * 64 + dt * 32 + lr) * 256 + hh * 8;
        asm volatile("" : "+v"(wofs));
        const bf16_t* wp = p.WukT + wofs;
#pragma unroll
        for (int ks = 0; ks < 16; ++ks) {
          bf16x8 wfr = *(const bf16x8*)(wp + ks * 16);
          bf16x8 bfr = *(const bf16x8*)(latS + (kt2 * 32 + lr) * LLD + ks * 16 + hh * 8);
          acc = mfma32(wfr, bfr, acc);
        }
#pragma unroll
        for (int r = 0; r < 16; ++r) ss += acc[r] * acc[r];
#pragma unroll
        for (int sp = 0; sp < 2; ++sp) {
          bf16x8 bk = mk8(pk2(acc[8 * sp + 0], acc[8 * sp + 1]), pk2(acc[8 * sp + 2], acc[8 * sp + 3]),
                          pk2(acc[8 * sp + 4], acc[8 * sp + 5]), pk2(acc[8 * sp + 6], acc[8 * sp + 7]));
          s1 = mfma32(qnf[dt][sp], bk, s1);
        }
      }
      ss += __shfl_xor(ss, 32);
      const float rinv = rsqrtf(ss * (1.f / 64.f) + EPS);
#pragma unroll
      for (int s = 0; s < 2; ++s) {
        bf16x8 bk = *(const bf16x8*)(krS + (kt2 * 32 + lr) * KRLD + s * 16 + hh * 8);
        s2 = mfma32(qrf[s], bk, s2);
      }
      if (hh == 0) {
        const int kk = kt2 * 32 + lr;
#pragma unroll
        for (int t = 0; t < 4; ++t) {
          float sc = s1[t] * rinv + s2[t];
          float e = exp2f(sc - Mb);
          if (isnew) e = (kk < 4 && kk <= t) ? e : 0.f;
          lsum[t] += e;
          Psh[(hd * 4 + t) * PLD + kk] = f2bf(e);
        }
      }
    }
    __syncthreads();
    {
      const int n0 = wave * 32;
#pragma unroll
      for (int ks = 0; ks < 4; ++ks) {
        bf16x8 a = *(const bf16x8*)(Psh + lr * PLD + ks * 16 + hh * 8);
        const int key0 = ks * 16 + 8 * hh, c0 = n0 + 16 * ((lane >> 4) & 1);
        const int q = (lane & 15) >> 2, pp = lane & 3;
        const bf16_t* ap = latS + (key0 + q) * LLD + c0 + 4 * pp;
        s16x4 lo = __builtin_amdgcn_ds_read_tr16_b64_v4i16((__attribute__((address_space(3))) s16x4*)(ap));
        s16x4 hi = __builtin_amdgcn_ds_read_tr16_b64_v4i16((__attribute__((address_space(3))) s16x4*)(ap + 4 * LLD));
        bf16x8 bfr;
        bfr[0] = lo[0]; bfr[1] = lo[1]; bfr[2] = lo[2]; bfr[3] = lo[3];
        bfr[4] = hi[0]; bfr[5] = hi[1]; bfr[6] = hi[2]; bfr[7] = hi[3];
        oacc = mfma32(a, bfr, oacc);
      }
    }
    __syncthreads();
  }
  float* Op = p.Opart + ((size_t)(seq * 2 + half) * 32) * 256;
#pragma unroll
  for (int r = 0; r < 16; ++r) {
    int m = (r & 3) + 8 * (r >> 2) + 4 * hh;
    Op[(size_t)m * 256 + wave * 32 + lr] = oacc[r];
  }
#pragma unroll
  for (int t = 0; t < 4; ++t) {
    float v = (hh == 0) ? lsum[t] : 0.f;
    v = wave_sum(v);
    if (lane == 0) p.Lpart[(seq * 2 + half) * 32 + hd * 4 + t] = v;
  }
}

__device__ __forceinline__ void ssm_scan_prompt(const Params& p, int job) {
  const int lane = threadIdx.x & 63;
  const int b = job >> 5, g = job & 31;
  const float dt = __expf(p.log_dt[g]);
  const Cplx a16 = apow(p.a_re[g * 64 + lane], p.a_im[g * 64 + lane], dt, 16.f);
  Cplx H = {0.f, 0.f};
  const float* S = p.S + ((size_t)g * NSUB + b * 256) * 128;
  bf16_t* A2 = p.A2 + ((size_t)g * NSUB + b * 256) * A2LD + 256;
  for (int n0 = 0; n0 < 256; n0 += 16) {
    float sr[16], si[16];
#pragma unroll
    for (int k = 0; k < 16; ++k) { sr[k] = S[(size_t)(n0 + k) * 128 + lane]; si[k] = S[(size_t)(n0 + k) * 128 + 64 + lane]; }
#pragma unroll
    for (int k = 0; k < 16; ++k) {
      A2[(size_t)(n0 + k) * A2LD + lane] = f2bf(H.re);
      A2[(size_t)(n0 + k) * A2LD + 64 + lane] = f2bf(H.im);
      Cplx t = cmul(a16, H);
      H.re = t.re + sr[k]; H.im = t.im + si[k];
    }
  }
  float* o = p.out + O_SSMP + ((size_t)(b * 32 + g) * 64 + lane) * 2;
  o[0] = H.re; o[1] = H.im;
}
__device__ __forceinline__ void ssm_sample(const Params& p, int job) {
  const int lane = threadIdx.x & 63;
  const int seq = job >> 5, g = job & 31;
  const float dt = __expf(p.log_dt[g]);
  const float are = p.a_re[g * 64 + lane], aim = p.a_im[g * 64 + lane];
  const Cplx ab = apow(are, aim, dt, 1.f);
  const Cplx bs = bscale(are, aim, dt);
  const float* st = p.state_ssm + ((size_t)(seq * 32 + g) * 64 + lane) * 2;
  Cplx H = {st[0], st[1]};
  bf16_t* A2 = p.A2 + ((size_t)g * NSUB + 1024 + seq) * A2LD + 256;
  A2[lane] = f2bf(H.re);
  A2[64 + lane] = f2bf(H.im);
  Cplx bb[16];
#pragma unroll
  for (int h = 0; h < 16; ++h) {
    Cplx braw = {p.ssm_b[((g * 64 + lane) * 16 + h) * 2], p.ssm_b[((g * 64 + lane) * 16 + h) * 2 + 1]};
    bb[h] = cmul(bs, braw);
  }
#pragma unroll
  for (int t = 0; t < 4; ++t) {
    const float* u = p.Z + (size_t)(NP + seq * 4 + t) * INW + g * 16;
    Cplx bu = {0.f, 0.f};
#pragma unroll
    for (int h = 0; h < 16; ++h) { float uv = u[h]; bu.re += uv * bb[h].re; bu.im += uv * bb[h].im; }
    Cplx tt = cmul(ab, H);
    H.re = tt.re + bu.re; H.im = tt.im + bu.im;
  }
  float* o = p.out + O_SSMS + ((size_t)(seq * 32 + g) * 64 + lane) * 2;
  o[0] = H.re; o[1] = H.im;
}

__device__ void phase_attn(const Params& p, char* smem) {
  const int wave = threadIdx.x >> 6;
  const int gw = blockIdx.x * 8 + wave, GW = gridDim.x * 8;
  for (int j = gw; j < 128; j += GW) ssm_scan_prompt(p, j);
  for (int j = gw; j < 4096; j += GW) ssm_sample(p, j);
  const float Mb = softmax_bound(p);
  __syncthreads();
  for (int it = blockIdx.x; it < 256; it += gridDim.x) {
    int bh = it >> 3, j = it & 7;
    attn_prompt_block(p, smem, bh >> 3, bh & 7, j, Mb);
    attn_prompt_block(p, smem, bh >> 3, bh & 7, 15 - j, Mb);
  }
  for (int it = blockIdx.x; it < 256; it += gridDim.x) attn_decode_unit(p, smem, it >> 1, it & 1, Mb);
}

__device__ void phase_ssm_y(const Params& p, char* smem) {
  const int ntile = 32 * 9 * 2;
  for (int t = blockIdx.x; t < ntile; t += gridDim.x) {
    int g = t / 18, rem = t % 18, tm = rem >> 1, tn = rem & 1;
    bf16_t* G = p.G;
    gemm_tile<1>(p.A2 + (size_t)g * NSUB * A2LD, A2LD, p.Bt2 + (size_t)g * 256 * A2LD, A2LD, 384, tm * 128, tn * 128, smem,
                 [=](int m, int n, float v) {
                   int tt = n >> 4, h = n & 15;
                   int token;
                   if (m < 1024) token = m * 16 + tt;
                   else { if (tt >= 4) return; token = NP + (m - 1024) * 4 + tt; }
                   G[(size_t)token * 512 + g * 16 + h] = f2bf(gelu_tanh(v));
                 });
  }
  const int lane = threadIdx.x & 63, gw = blockIdx.x * 8 + (threadIdx.x >> 6), GW = gridDim.x * 8;
  for (int job = gw; job < 1024; job += GW) {
    int seq = job >> 3, hd = job & 7;
    const float* O0 = p.Opart + ((size_t)(seq * 2) * 32 + hd * 4) * 256;
    const float* O1 = O0 + 32 * 256;
    float acc[4] = {0.f, 0.f, 0.f, 0.f};
    for (int c = 0; c < 256; ++c) {
      float w = p.w_uv[(size_t)c * 512 + hd * 64 + lane];
#pragma unroll
      for (int t = 0; t < 4; ++t) acc[t] += (O0[t * 256 + c] + O1[t * 256 + c]) * w;
    }
#pragma unroll
    for (int t = 0; t < 4; ++t) {
      float l = p.Lpart[(seq * 2) * 32 + hd * 4 + t] + p.Lpart[(seq * 2 + 1) * 32 + hd * 4 + t];
      p.OATT[(size_t)(NP + seq * 4 + t) * 512 + hd * 64 + lane] = f2bf(acc[t] / l);
    }
  }
}

__device__ void phase_gemm_gl(const Params& p, char* smem) {
  for (int t = blockIdx.x; t < 66 * 8; t += gridDim.x) {
    int tm = t / 8, tn = t % 8;
    float* C = p.GL;
    gemm_tile<2>(p.G, 512, p.WgluT, 512, 512, tm * 256, tn * 128, smem, [=](int m, int n, float v) { C[(size_t)m * 1024 + n] = v; });
  }
}
__device__ void phase_cat(const Params& p) {
  const size_t gt = (size_t)blockIdx.x * NTHR + threadIdx.x, GT = (size_t)gridDim.x * NTHR;
  const size_t tot = (size_t)NT * 128;
  for (size_t i = gt; i < tot; i += GT) {
    size_t token = i >> 7;
    int c = (int)(i & 127) * 4;
    float4 a = *(const float4*)(p.GL + token * 1024 + c), b = *(const float4*)(p.GL + token * 1024 + 512 + c);
    float r0 = a.x / (1.f + __expf(-b.x)), r1 = a.y / (1.f + __expf(-b.y)), r2 = a.z / (1.f + __expf(-b.z)), r3 = a.w / (1.f + __expf(-b.w));
    *(uint2*)(p.CAT + token * 1024 + c) = make_uint2(pk2(r0, r1), pk2(r2, r3));
    *(uint2*)(p.CAT + token * 1024 + 512 + c) = *(const uint2*)(p.OATT + token * 512 + c);
  }
}
__device__ void phase_gemm_out(const Params& p, char* smem) {
  for (int t = blockIdx.x; t < 66 * 8; t += gridDim.x) {
    int tm = t / 8, tn = t % 8;
    float* C = p.X1;
    const float *xp = p.x_prompt, *xs = p.x_sample;
    gemm_tile<2>(p.CAT, 1024, p.WoutT, 1024, 1024, tm * 256, tn * 128, smem, [=](int m, int n, float v) {
      float x = (m < NP) ? xp[(size_t)m * 1024 + n] : xs[(size_t)(m - NP) * 1024 + n];
      C[(size_t)m * 1024 + n] = x + v;
    });
  }
}
__device__ void phase_gemm_pq(const Params& p, char* smem) {
  for (int t = blockIdx.x; t < 66 * 16; t += gridDim.x) {
    int tm = t / 16, tn = t % 16;
    bf16_t* C = p.PQ;
    gemm_tile<2>(p.XN, 1024, p.WpqT, 1024, 1024, tm * 256, tn * 128, smem, [=](int m, int n, float v) { C[(size_t)m * 2048 + n] = f2bf(v); });
  }
}
__device__ __forceinline__ void ins16(float (&L)[16], float x) {
#pragma unroll
  for (int j = 15; j >= 1; --j) L[j] = __builtin_amdgcn_fmed3f(L[j - 1], L[j], x);
  L[0] = fmaxf(L[0], x);
}
#define PKLD 136
__device__ void phase_sctopk(const Params& p, char* smem) {
  bf16_t* keysS = (bf16_t*)smem;
  unsigned char* sidx = (unsigned char*)(smem + 2 * 128 * PKLD * 2);
  const int tid = threadIdx.x, lane = tid & 63, wave = tid >> 6, lr = lane & 31, hh = lane >> 5;
  for (int c = tid; c < 2 * 128 * 16; c += NTHR) {
    int row = c >> 4, cc = c & 15;
    *(uint4*)(keysS + row * PKLD + cc * 8) = *(const uint4*)(p.PK + row * 128 + cc * 8);
  }
  __syncthreads();
  const int ntask = NT * 8 / 32;
  for (int task = blockIdx.x * 8 + wave; task < ntask; task += gridDim.x * 8) {
    const int m = task * 32 + lr;
    float L[2][16];
#pragma unroll
    for (int c = 0; c < 2; ++c) {
#pragma unroll
      for (int j = 0; j < 16; ++j) L[c][j] = -3.0e38f;
      bf16x8 qf[8];
#pragma unroll
      for (int s2 = 0; s2 < 8; ++s2) qf[s2] = *(const bf16x8*)(p.PQ + (size_t)m * 256 + c * 128 + s2 * 16 + hh * 8);
#pragma unroll 1
      for (int kt = 0; kt < 4; ++kt) {
        f32x16 acc;
#pragma unroll
        for (int r = 0; r < 16; ++r) acc[r] = 0.f;
#pragma unroll
        for (int s2 = 0; s2 < 8; ++s2) {
          bf16x8 a = *(const bf16x8*)(keysS + (c * 128 + kt * 32 + lr) * PKLD + s2 * 16 + hh * 8);
          acc = mfma32(a, qf[s2], acc);
        }
#pragma unroll
        for (int r = 0; r < 16; ++r) {
          unsigned key = kt * 32 + (r & 3) + 8 * (r >> 2) + 4 * hh;
          ins16(L[c], __uint_as_float((__float_as_uint(acc[r]) & ~127u) | key));
        }
      }
      float P[16];
#pragma unroll
      for (int j = 0; j < 16; ++j) P[j] = __shfl_xor(L[c][j], 32);
#pragma unroll
      for (int j = 0; j < 16; ++j) ins16(L[c], P[j]);
    }
#pragma unroll
    for (int j = 0; j < 16; ++j) {
      sidx[j * NTHR + tid] = (unsigned char)(__float_as_uint(L[0][j]) & 127u);
      sidx[(16 + j) * NTHR + tid] = (unsigned char)(__float_as_uint(L[1][j]) & 127u);
    }
    float T[16];
#pragma unroll
    for (int j = 0; j < 16; ++j) T[j] = -3.0e38f;
#pragma unroll
    for (int i = 0; i < 16; ++i)
#pragma unroll
      for (int j = 0; j < 16; ++j)
        if ((i + 1) * (j + 1) <= 16) {
          float a = __uint_as_float(__float_as_uint(L[0][i]) & ~127u), b = __uint_as_float(__float_as_uint(L[1][j]) & ~127u);
          float sm = a + b;
          ins16(T, __uint_as_float((__float_as_uint(sm) & ~255u) | (unsigned)(i * 16 + j)));
        }
    float mx = __uint_as_float(__float_as_uint(T[0]) & ~255u);
    float e[16], sum = 0.f;
    int id[16];
#pragma unroll
    for (int k = 0; k < 16; ++k) {
      unsigned bits = __float_as_uint(T[k]);
      float v = __uint_as_float(bits & ~255u);
      e[k] = __expf(v - mx);
      sum += e[k];
      unsigned ij = bits & 255u;
      unsigned e1 = sidx[(ij >> 4) * NTHR + tid], e2 = sidx[(16 + (ij & 15)) * NTHR + tid];
      id[k] = (int)(e1 * 128 + e2);
    }
    float inv = 1.f / sum;
    if (hh == 0) {
#pragma unroll
      for (int k4 = 0; k4 < 4; ++k4) {
        *(int4*)(p.IDX + (size_t)m * 16 + k4 * 4) = make_int4(id[k4 * 4], id[k4 * 4 + 1], id[k4 * 4 + 2], id[k4 * 4 + 3]);
        *(float4*)(p.GW + (size_t)m * 16 + k4 * 4) = make_float4(e[k4 * 4] * inv, e[k4 * 4 + 1] * inv, e[k4 * 4 + 2] * inv, e[k4 * 4 + 3] * inv);
      }
    }
  }
}
typedef __attribute__((ext_vector_type(8))) int i32x8;
typedef __attribute__((ext_vector_type(4))) float f32x4;
__device__ void phase_gather(const Params& p, char* smem) {
  float* wsh = (float*)smem;
  const int lane = threadIdx.x & 63, wave = threadIdx.x >> 6, gw = blockIdx.x * 8 + wave, GW = gridDim.x * 8;
  const int lrow = lane & 15, kb = lane >> 4;
  float* wmine = wsh + wave * 128;
  for (int r = gw; r < NT; r += GW) {
    i32x8 xb[8];
    const unsigned char* xp = p.X8 + (size_t)r * 1024 + kb * 32;
#pragma unroll
    for (int ks = 0; ks < 8; ++ks) {
      uint4 a = *(const uint4*)(xp + ks * 128), b = *(const uint4*)(xp + ks * 128 + 16);
      xb[ks][0] = a.x; xb[ks][1] = a.y; xb[ks][2] = a.z; xb[ks][3] = a.w;
      xb[ks][4] = b.x; xb[ks][5] = b.y; xb[ks][6] = b.z; xb[ks][7] = b.w;
    }
    const int xs = p.XSC[r];
    const int* idx = p.IDX + (size_t)r * 128;
    const float* gwt = p.GW + (size_t)r * 128;
#pragma unroll 2
    for (int mt = 0; mt < 8; ++mt) {
      const int e = idx[mt * 16 + lrow];
      const int sa = p.USC[e];
      const unsigned char* up = p.U8 + (size_t)e * 1024 + kb * 32;
      f32x4 acc = {0.f, 0.f, 0.f, 0.f};
#pragma unroll
      for (int ks = 0; ks < 8; ++ks) {
        uint4 a = *(const uint4*)(up + ks * 128), b = *(const uint4*)(up + ks * 128 + 16);
        i32x8 av;
        av[0] = a.x; av[1] = a.y; av[2] = a.z; av[3] = a.w; av[4] = b.x; av[5] = b.y; av[6] = b.z; av[7] = b.w;
        acc = __builtin_amdgcn_mfma_scale_f32_16x16x128_f8f6f4(av, xb[ks], acc, 0, 0, 0, sa, 0, xs);
      }
      if (lrow == 0) {
        float4 g4 = *(const float4*)(gwt + mt * 16 + 4 * kb);
        *(float4*)(wmine + mt * 16 + 4 * kb) = make_float4(g4.x * gelu_tanh(acc[0]), g4.y * gelu_tanh(acc[1]), g4.z * gelu_tanh(acc[2]), g4.w * gelu_tanh(acc[3]));
      }
    }
    float o[16];
#pragma unroll
    for (int i = 0; i < 16; ++i) o[i] = 0.f;
#pragma unroll 8
    for (int k = 0; k < 128; ++k) {
      const int e = __builtin_amdgcn_readfirstlane(idx[k]);
      const float w = wmine[k] * p.VSCF[e];
      uint4 v = *(const uint4*)(p.V8 + (size_t)e * 1024 + lane * 16);
      f2v t;
      t = __builtin_amdgcn_cvt_pk_f32_fp8((int)v.x, false); o[0] += w * t[0]; o[1] += w * t[1];
      t = __builtin_amdgcn_cvt_pk_f32_fp8((int)v.x, true);  o[2] += w * t[0]; o[3] += w * t[1];
      t = __builtin_amdgcn_cvt_pk_f32_fp8((int)v.y, false); o[4] += w * t[0]; o[5] += w * t[1];
      t = __builtin_amdgcn_cvt_pk_f32_fp8((int)v.y, true);  o[6] += w * t[0]; o[7] += w * t[1];
      t = __builtin_amdgcn_cvt_pk_f32_fp8((int)v.z, false); o[8] += w * t[0]; o[9] += w * t[1];
      t = __builtin_amdgcn_cvt_pk_f32_fp8((int)v.z, true);  o[10] += w * t[0]; o[11] += w * t[1];
      t = __builtin_amdgcn_cvt_pk_f32_fp8((int)v.w, false); o[12] += w * t[0]; o[13] += w * t[1];
      t = __builtin_amdgcn_cvt_pk_f32_fp8((int)v.w, true);  o[14] += w * t[0]; o[15] += w * t[1];
    }
    const float* x1p = p.X1 + (size_t)r * 1024 + lane * 16;
    float* yo = ((r < NP) ? p.out + O_YP + (size_t)r * 1024 : p.out + O_YS + (size_t)(r - NP) * 1024) + lane * 16;
#pragma unroll
    for (int q = 0; q < 4; ++q) {
      float4 xv = *(const float4*)(x1p + q * 4);
      *(float4*)(yo + q * 4) = make_float4(xv.x + o[q * 4], xv.y + o[q * 4 + 1], xv.z + o[q * 4 + 2], xv.w + o[q * 4 + 3]);
    }
  }
}

extern __shared__ __attribute__((aligned(16))) char dyn_smem[];
#define LDS_BYTES 110592
__global__ void __launch_bounds__(NTHR, 2) k_mega(Params p) {
  char* smem = dyn_smem;
  uint4* xbw = (uint4*)(dyn_smem + LDS_BYTES);
  if (threadIdx.x == 0) *xbw = make_uint4(0u, 0u, 0u, 0u);
  __syncthreads();
  XcdBarrier bar = xcd_barrier_post(p.bar, (volatile LAS unsigned*)xbw);
  phase0(p);
  phase_rmsnorm<false>(p.x_prompt, p.x_sample, p.norm_mix, p.XN, nullptr, nullptr);
  xcd_barrier(bar);
  phase_gemm_z(p, smem);
  xcd_barrier(bar);
  phase_post1(p);
  xcd_barrier(bar);
  phase_gemm4(p, smem);
  xcd_barrier(bar);
  phase_post2(p);
  xcd_barrier(bar);
  phase_attn(p, smem);
  xcd_barrier(bar);
  phase_ssm_y(p, smem);
  xcd_barrier(bar);
  phase_gemm_gl(p, smem);
  xcd_barrier(bar);
  phase_cat(p);
  xcd_barrier(bar);
  phase_gemm_out(p, smem);
  xcd_barrier(bar);
  phase_rmsnorm<true>(p.X1, p.X1 + (size_t)NP * 1024, p.norm_ffn, p.XN, p.X8, p.XSC);
  xcd_barrier(bar);
  phase_gemm_pq(p, smem);
  xcd_barrier(bar);
  phase_sctopk(p, smem);
  xcd_barrier(bar);
  phase_gather(p, smem);
}

extern "C" void kernel_launch(void* const* d_in, const int* in_sizes, int n_in, void* d_out, int out_size, void* d_ws, size_t ws_size,
                              hipStream_t stream) {
  Params p{};
  p.x_prompt = (const float*)d_in[0]; p.x_sample = (const float*)d_in[1]; p.cache_lat = (const float*)d_in[2];
  p.cache_kr = (const float*)d_in[3]; p.state_ssm = (const float*)d_in[4]; p.page_table = (const int*)d_in[5];
  p.norm_mix = (const float*)d_in[6]; p.w_in = (const float*)d_in[7]; p.norm_q_lora = (const float*)d_in[8];
  p.w_uq = (const float*)d_in[9]; p.norm_kv_lora = (const float*)d_in[10]; p.w_uk = (const float*)d_in[11];
  p.w_uv = (const float*)d_in[12]; p.g_qn = (const float*)d_in[13]; p.g_qr = (const float*)d_in[14];
  p.g_kn = (const float*)d_in[15]; p.g_kr = (const float*)d_in[16]; p.a_re = (const float*)d_in[17];
  p.a_im = (const float*)d_in[18]; p.log_dt = (const float*)d_in[19]; p.ssm_b = (const float*)d_in[20];
  p.ssm_c = (const float*)d_in[21]; p.ssm_d = (const float*)d_in[22]; p.w_glu = (const float*)d_in[23];
  p.w_out = (const float*)d_in[24]; p.norm_ffn = (const float*)d_in[25]; p.peer_wq = (const float*)d_in[26];
  p.peer_keys = (const float*)d_in[27]; p.peer_u = (const float*)d_in[28]; p.peer_v = (const float*)d_in[29];
  p.out = (float*)d_out;
  char* w = (char*)d_ws;
  size_t off = 0;
  auto take = [&](size_t bytes) { char* r = w + off; off += (bytes + 255) & ~(size_t)255; return r; };
  p.bar = (unsigned*)take(16384);
  p.WinT = (bf16_t*)take((size_t)1280 * 1024 * 2);
  p.WuqT = (bf16_t*)take((size_t)768 * 384 * 2);
  p.WukT = (bf16_t*)take((size_t)512 * 256 * 2);
  p.WuvT = (bf16_t*)take((size_t)512 * 256 * 2);
  p.WgluT = (bf16_t*)take((size_t)1024 * 512 * 2);
  p.WoutT = (bf16_t*)take((size_t)1024 * 1024 * 2);
  p.WpqT = (bf16_t*)take((size_t)2048 * 1024 * 2);
  p.PK = (bf16_t*)take((size_t)2 * 128 * 128 * 2);
  p.U8 = (unsigned char*)take((size_t)16384 * 1024);
  p.V8 = (unsigned char*)take((size_t)16384 * 1024);
  p.X8 = (unsigned char*)take((size_t)NT * 1024);
  p.USC = (int*)take(16384 * 4);
  p.XSC = (int*)take(NT * 4);
  p.VSCF = (float*)take(16384 * 4);
  p.Bt2 = (bf16_t*)take((size_t)32 * 256 * A2LD * 2);
  p.Emat = (bf16_t*)take((size_t)32 * 128 * 256 * 2);
  p.XN = (bf16_t*)take((size_t)NT * 1024 * 2);
  p.A2 = (bf16_t*)take((size_t)32 * NSUB * A2LD * 2);
  p.CQN = (bf16_t*)take((size_t)NT * 384 * 2);
  p.CKV = (bf16_t*)take((size_t)NT * 256 * 2);
  p.Kcat = (bf16_t*)take((size_t)32 * 4096 * 96 * 2);
  p.KcatS = (bf16_t*)take((size_t)128 * 8 * 4 * 96 * 2);
  p.Qb = (bf16_t*)take((size_t)NT * 8 * 96 * 2);
  p.VT = (bf16_t*)take((size_t)512 * NP * 2);
  p.OATT = (bf16_t*)take((size_t)NT * 512 * 2);
  p.G = (bf16_t*)take((size_t)NT * 512 * 2);
  p.CAT = (bf16_t*)take((size_t)NT * 1024 * 2);
  p.PQ = (bf16_t*)take((size_t)NT * 2048 * 2);
  p.Z = (float*)take((size_t)NT * INW * 4);
  p.Qraw = (float*)take((size_t)NT * 768 * 4);
  p.KNraw = (float*)take((size_t)NT * 512 * 4);
  p.S = (float*)take((size_t)32 * NSUB * 128 * 4);
  p.GL = (float*)take((size_t)NT * 1024 * 4);
  p.X1 = (float*)take((size_t)NT * 1024 * 4);
  p.GW = (float*)take((size_t)NT * 128 * 4);
  p.Opart = (float*)take((size_t)128 * 2 * 32 * 256 * 4);
  p.Lpart = (float*)take((size_t)128 * 2 * 32 * 4);
  p.IDX = (int*)take((size_t)NT * 128 * 4);
  if (off > ws_size) { fprintf(stderr, "workspace too small: need %zu have %zu\n", off, ws_size); return; }
  static int grid = 0;
  if (!grid) {
    int dev = 0, cus = 0, per_cu = 0;
    (void)hipGetDevice(&dev);
    (void)hipDeviceGetAttribute(&cus, hipDeviceAttributeMultiprocessorCount, dev);
    (void)hipFuncSetAttribute((const void*)k_mega, hipFuncAttributeMaxDynamicSharedMemorySize, LDS_BYTES + 16);
    (void)hipOccupancyMaxActiveBlocksPerMultiprocessor(&per_cu, k_mega, NTHR, LDS_BYTES + 16);
    if (per_cu < 1) { fprintf(stderr, "k_mega does not fit a CU\n"); return; }
    grid = cus;
  }
  (void)hipMemsetAsync(p.bar, 0, XCD_BAR_WORDS * sizeof(unsigned), stream);
  hipLaunchKernelGGL(k_mega, dim3(grid), dim3(NTHR), LDS_BYTES + 16, stream, p);
}
```

```cpp
#include <hip/hip_runtime.h>
#include <stdint.h>
#include <stdio.h>

typedef __attribute__((ext_vector_type(8))) short bf16x8;
typedef __attribute__((ext_vector_type(4))) short s16x4;
typedef __attribute__((ext_vector_type(16))) float f32x16;
typedef __attribute__((ext_vector_type(2))) __bf16 bf2;
typedef __attribute__((ext_vector_type(2))) float f2v;
typedef unsigned short bf16_t;

#define NTHR 512
#define D_MODEL 1024
#define NP 16384
#define NS 512
#define NT 16896
#define INW 1184
#define NSUB 1152
#define A2LD 384
#define EPS 1e-6f
#define QSCALE 0.14724466f

#define O_YP 0
#define O_YS 16777216
#define O_LATP 17301504
#define O_KRP 21495808
#define O_SSMP 22020096
#define O_LATS 22036480
#define O_KRS 22167552
#define O_SSMS 22183936

struct Params {
  const float *x_prompt, *x_sample, *cache_lat, *cache_kr, *state_ssm;
  const int* page_table;
  const float *norm_mix, *w_in, *norm_q_lora, *w_uq, *norm_kv_lora, *w_uk, *w_uv, *g_qn, *g_qr, *g_kn, *g_kr;
  const float *a_re, *a_im, *log_dt, *ssm_b, *ssm_c, *ssm_d, *w_glu, *w_out, *norm_ffn, *peer_wq, *peer_keys, *peer_u, *peer_v;
  float* out;
  unsigned* bar;
  bf16_t *WinT, *WuqT, *WukT, *WuvT, *WgluT, *WoutT, *WpqT, *PK, *Bt2, *Emat;
  bf16_t *XN, *A2, *CQN, *CKV, *Kcat, *KcatS, *Qb, *VT, *OATT, *G, *CAT, *PQ;
  float *Z, *Qraw, *KNraw, *S, *GL, *X1, *GW, *Opart, *Lpart;
  int* IDX;
  unsigned char *U8, *V8, *X8, *W8T;
  int* KW;
  int *USC, *XSC;
  float* VSCF;
};


#define XB_TMO      128
#define XB_XCNT(j)  (256  + 64 * (j))
#define XB_XSUB(j)  (1280 + 64 * (j))
#define XB_XGEN(j)  (2304 + 64 * (j))
#define XB_TOP      3328
#define XB_TOPGEN   3392
#define XCD_BAR_WORDS 3456
#define XB_SPIN_CAP (1u << 18)
#define LAS __attribute__((address_space(3)))

__device__ __forceinline__ unsigned xb_ld(unsigned* p)              { return __hip_atomic_load(p, __ATOMIC_RELAXED, __HIP_MEMORY_SCOPE_AGENT); }
__device__ __forceinline__ unsigned xb_add(unsigned* p, unsigned v) { return __hip_atomic_fetch_add(p, v, __ATOMIC_RELAXED, __HIP_MEMORY_SCOPE_AGENT); }
__device__ __forceinline__ unsigned xb_xcc_id() { return (unsigned)__builtin_amdgcn_s_getreg((3 << 11) | 20) & 0xFu; }
#define XB_SPIN(cond, bar) do { unsigned _sp = 0; while (cond) { __builtin_amdgcn_s_sleep(1); \
    if ((++_sp & 255u) == 0u) { if (xb_ld(&(bar)[XB_TMO])) break; if (_sp > XB_SPIN_CAP) { atomicAdd(&(bar)[XB_TMO], 1u); break; } } } } while (0)

struct XcdBarrier {
    unsigned* bar; unsigned x;
    volatile LAS unsigned* st;
};

__device__ __forceinline__ XcdBarrier xcd_barrier_post(unsigned* bar, volatile LAS unsigned* st) {
    XcdBarrier b; b.bar = bar; b.x = xb_xcc_id(); b.st = st;
    if (threadIdx.x == 0) (void)xb_add(&bar[XB_XCNT(b.x)], 1u);
    return b;
}
__device__ __forceinline__ void xcd_barrier_complete(unsigned* bar, unsigned x, unsigned& nloc, unsigned& nx) {
    const unsigned G = gridDim.x * gridDim.y * gridDim.z;
    unsigned sum, cnt, mine, sp = 0u;
    for (;;) {
        sum = 0u; cnt = 0u; mine = 0u;
#pragma unroll
        for (unsigned j = 0; j < 16; ++j) { const unsigned c = xb_ld(&bar[XB_XCNT(j)]); sum += c; cnt += (c > 0u) ? 1u : 0u; mine = (j == x) ? c : mine; }
        if (sum == G) break;
        __builtin_amdgcn_s_sleep(1);
        if ((++sp & 255u) == 0u) { if (xb_ld(&bar[XB_TMO])) break; if (sp > XB_SPIN_CAP) { atomicAdd(&bar[XB_TMO], 1u); break; } }
    }
    nloc = mine > 0u ? mine : 1u; nx = cnt > 0u ? cnt : 1u;
}

__device__ __forceinline__ void xcd_barrier(const XcdBarrier& b) {
    asm volatile("s_waitcnt vmcnt(0)" ::: "memory");
    __syncthreads();
    if (threadIdx.x == 0) {
        unsigned* bar = b.bar;
        __builtin_amdgcn_s_waitcnt(0);
        unsigned nloc = b.st[0], nx = b.st[1];
        if (nloc == 0u) { xcd_barrier_complete(bar, b.x, nloc, nx); b.st[0] = nloc; b.st[1] = nx; }
        const unsigned old = xb_add(&bar[XB_XSUB(b.x)], 1u);
        const unsigned gen = old / nloc;
        if (old + 1u == (gen + 1u) * nloc) {
            __builtin_amdgcn_fence(__ATOMIC_RELEASE, "agent");
            asm volatile("s_waitcnt vmcnt(0)" ::: "memory");
            const unsigned og = xb_add(&bar[XB_TOP], 1u);
            const unsigned tg = og / nx;
            if (og + 1u == (tg + 1u) * nx) xb_add(&bar[XB_TOPGEN], 1u);
            else XB_SPIN(xb_ld(&bar[XB_TOPGEN]) == tg, bar);
            __builtin_amdgcn_fence(__ATOMIC_ACQUIRE, "agent");
            xb_add(&bar[XB_XGEN(b.x)], 1u);
            asm volatile("s_waitcnt vmcnt(0)" ::: "memory");
        } else {
            XB_SPIN(xb_ld(&bar[XB_XGEN(b.x)]) == gen, bar);
            __builtin_amdgcn_fence(__ATOMIC_ACQUIRE, "agent");
            asm volatile("s_waitcnt vmcnt(0)" ::: "memory");
        }
    }
    __syncthreads();
}

__device__ __forceinline__ int tidx() { int t = threadIdx.x; asm volatile("" : "+v"(t)); return t; }
__device__ __forceinline__ unsigned pk2(float a, float b) {
  f2v v = {a, b};
  bf2 r = __builtin_convertvector(v, bf2);
  return __builtin_bit_cast(unsigned, r);
}
__device__ __forceinline__ bf16_t f2bf(float a) { return (bf16_t)(pk2(a, 0.f) & 0xffffu); }
__device__ __forceinline__ float bf2f(bf16_t x) { return __uint_as_float(((unsigned)x) << 16); }
__device__ __forceinline__ float bflo(unsigned x) { return __uint_as_float(x << 16); }
__device__ __forceinline__ float bfhi(unsigned x) { return __uint_as_float(x & 0xffff0000u); }
__device__ __forceinline__ float wave_sum(float v) {
  v += __shfl_xor(v, 32); v += __shfl_xor(v, 16); v += __shfl_xor(v, 8);
  v += __shfl_xor(v, 4);  v += __shfl_xor(v, 2);  v += __shfl_xor(v, 1);
  return v;
}
__device__ __forceinline__ float gelu_tanh(float x) {
  float u = 0.7978845608028654f * (x + 0.044715f * x * x * x);
  float e = __expf(2.f * u);
  float t = 1.f - 2.f / (1.f + e);
  return 0.5f * x * (1.f + t);
}
__device__ __forceinline__ void sincos_rev(float ang, float& s, float& c) {
  float rev = ang * 0.15915494309189535f;
  rev = rev - floorf(rev);
  s = __builtin_amdgcn_sinf(rev);
  c = __builtin_amdgcn_cosf(rev);
}
__device__ __forceinline__ f32x16 mfma32(bf16x8 a, bf16x8 b, f32x16 c) {
  return __builtin_amdgcn_mfma_f32_32x32x16_bf16(a, b, c, 0, 0, 0);
}
__device__ __forceinline__ bf16x8 mk8(unsigned a, unsigned b, unsigned c, unsigned d) {
  uint4 u = make_uint4(a, b, c, d);
  return __builtin_bit_cast(bf16x8, u);
}

#define GLD 72
template <int MT, class Epi>
__device__ __forceinline__ void gemm_tile(const bf16_t* __restrict__ A, int lda, const bf16_t* __restrict__ Bt, int ldb,
                                          int K, int m0, int n0, char* smem, Epi epi) {
  constexpr int BM = 128 * MT;
  bf16_t* As = (bf16_t*)smem;
  bf16_t* Bs = As + 2 * BM * GLD;
  const int tid = tidx(), lane = tid & 63, wave = tid >> 6;
  const int wm = wave >> 1, wn = wave & 1, lr = lane & 31, hh = lane >> 5;
  uint4 ra[2 * MT], rb[2];
  f32x16 acc[MT][2];
#pragma unroll
  for (int i = 0; i < MT; ++i)
#pragma unroll
    for (int j = 0; j < 2; ++j)
#pragma unroll
      for (int r = 0; r < 16; ++r) acc[i][j][r] = 0.f;
  const int nk = K / 64;
  auto gload = [&](int k0) {
#pragma unroll
    for (int i = 0; i < 2 * MT; ++i) {
      int c = tid + NTHR * i, row = c >> 3, cc = c & 7;
      ra[i] = *(const uint4*)(A + (size_t)(m0 + row) * lda + k0 + cc * 8);
    }
#pragma unroll
    for (int i = 0; i < 2; ++i) {
      int c = tid + NTHR * i, row = c >> 3, cc = c & 7;
      rb[i] = *(const uint4*)(Bt + (size_t)(n0 + row) * ldb + k0 + cc * 8);
    }
  };
  auto lstore = [&](int buf) {
#pragma unroll
    for (int i = 0; i < 2 * MT; ++i) {
      int c = tid + NTHR * i, row = c >> 3, cc = c & 7;
      *(uint4*)(As + (buf * BM + row) * GLD + cc * 8) = ra[i];
    }
#pragma unroll
    for (int i = 0; i < 2; ++i) {
      int c = tid + NTHR * i, row = c >> 3, cc = c & 7;
      *(uint4*)(Bs + (buf * 128 + row) * GLD + cc * 8) = rb[i];
    }
  };
  gload(0);
  lstore(0);
  __syncthreads();
  for (int kt = 0; kt < nk; ++kt) {
    const int buf = kt & 1;
    if (kt + 1 < nk) gload((kt + 1) * 64);
#pragma unroll
    for (int ks = 0; ks < 4; ++ks) {
      bf16x8 a[MT], b[2];
#pragma unroll
      for (int i = 0; i < MT; ++i) a[i] = *(const bf16x8*)(As + (buf * BM + wm * 32 * MT + i * 32 + lr) * GLD + ks * 16 + hh * 8);
#pragma unroll
      for (int j = 0; j < 2; ++j) b[j] = *(const bf16x8*)(Bs + (buf * 128 + wn * 64 + j * 32 + lr) * GLD + ks * 16 + hh * 8);
#pragma unroll
      for (int i = 0; i < MT; ++i)
#pragma unroll
        for (int j = 0; j < 2; ++j) acc[i][j] = mfma32(a[i], b[j], acc[i][j]);
    }
    if (kt + 1 < nk) lstore(buf ^ 1);
    __syncthreads();
  }
#pragma unroll
  for (int i = 0; i < MT; ++i)
#pragma unroll
    for (int j = 0; j < 2; ++j)
#pragma unroll
      for (int r = 0; r < 16; ++r) {
        int m = m0 + wm * 32 * MT + i * 32 + (r & 3) + 8 * (r >> 2) + 4 * hh;
        int n = n0 + wn * 64 + j * 32 + lr;
        epi(m, n, acc[i][j][r]);
      }
}

struct Cplx { float re, im; };
__device__ __forceinline__ Cplx cmul(Cplx a, Cplx b) { return {a.re * b.re - a.im * b.im, a.re * b.im + a.im * b.re}; }
__device__ __forceinline__ Cplx apow(float are, float aim, float dt, float m) {
  float mag = __expf(m * dt * are);
  float s, c;
  sincos_rev(m * dt * aim, s, c);
  return {mag * c, mag * s};
}
__device__ __forceinline__ Cplx bscale(float are, float aim, float dt) {
  Cplx ab = apow(are, aim, dt, 1.f);
  float nr = ab.re - 1.f, ni = ab.im;
  float den = are * are + aim * aim;
  return {(nr * are + ni * aim) / den, (ni * are - nr * aim) / den};
}

__device__ __forceinline__ void tr_cvt(const float* __restrict__ W, bf16_t* __restrict__ Wt, int K, int N, int Npad, size_t gt, size_t GT) {
  size_t tot = (size_t)K * Npad;
  for (size_t i = gt; i < tot; i += GT) {
    int n = (int)(i / K), k = (int)(i % K);
    Wt[i] = (n < N) ? f2bf(W[(size_t)k * N + n]) : (bf16_t)0;
  }
}
__device__ __forceinline__ void cvt_flat(const float* __restrict__ W, bf16_t* __restrict__ Wb, size_t n4, size_t gt, size_t GT) {
  for (size_t i = gt; i < n4; i += GT) {
    float4 v = ((const float4*)W)[i];
    ((uint2*)Wb)[i] = make_uint2(pk2(v.x, v.y), pk2(v.z, v.w));
  }
}
__device__ void phase0(const Params& p, char* smem) {
  if (blockIdx.x < 8) {
    float* red = (float*)smem;
    const int h = blockIdx.x, tid = tidx(), d = tid & 63, c0 = (tid >> 6) * 32;
    float v[32];
    float am = 0.f;
#pragma unroll
    for (int i = 0; i < 32; ++i) { v[i] = p.w_uk[(size_t)(c0 + i) * 512 + h * 64 + d]; am = fmaxf(am, fabsf(v[i])); }
#pragma unroll
    for (int o = 32; o >= 1; o >>= 1) am = fmaxf(am, __shfl_xor(am, o));
    if ((tid & 63) == 0) red[tid >> 6] = am;
    __syncthreads();
    am = red[0];
#pragma unroll
    for (int i = 1; i < 8; ++i) am = fmaxf(am, red[i]);
    int E = (int)((__float_as_uint(am) >> 23) & 0xffu) - 127;
    E = E < -60 ? -60 : E;
    const int k = 7 - E;
    const float sc = __uint_as_float((unsigned)(k + 127) << 23);
    unsigned w[8];
#pragma unroll
    for (int i = 0; i < 8; ++i) {
      int pk = 0;
      pk = __builtin_amdgcn_cvt_pk_fp8_f32(v[4 * i] * sc, v[4 * i + 1] * sc, pk, false);
      pk = __builtin_amdgcn_cvt_pk_fp8_f32(v[4 * i + 2] * sc, v[4 * i + 3] * sc, pk, true);
      w[i] = (unsigned)pk;
    }
    unsigned char* dst = p.W8T + (size_t)(h * 64 + d) * 256 + c0;
    *(uint4*)dst = make_uint4(w[0], w[1], w[2], w[3]);
    *(uint4*)(dst + 16) = make_uint4(w[4], w[5], w[6], w[7]);
    if (tid == 0) p.KW[h] = k;
    __syncthreads();
  }
  const size_t gt = (size_t)blockIdx.x * NTHR + tidx(), GT = (size_t)gridDim.x * NTHR;
  tr_cvt(p.w_in, p.WinT, 1024, INW, 1280, gt, GT);
  tr_cvt(p.w_uq, p.WuqT, 384, 768, 768, gt, GT);
  tr_cvt(p.w_uk, p.WukT, 256, 512, 512, gt, GT);
  tr_cvt(p.w_uv, p.WuvT, 256, 512, 512, gt, GT);
  tr_cvt(p.w_glu, p.WgluT, 512, 1024, 1024, gt, GT);
  tr_cvt(p.w_out, p.WoutT, 1024, 1024, 1024, gt, GT);
  tr_cvt(p.peer_wq, p.WpqT, 1024, 2048, 2048, gt, GT);
  cvt_flat(p.peer_keys, p.PK, 2 * 128 * 128 / 4, gt, GT);
  {
    const int lane = tidx() & 63, gw = blockIdx.x * 8 + (tidx() >> 6), GWv = gridDim.x * 8;
    for (int row = gw; row < 2 * 16384; row += GWv) {
      const bool isU = row < 16384;
      const int e = isU ? row : row - 16384;
      const float* src = (isU ? p.peer_u : p.peer_v) + (size_t)e * 1024 + lane * 16;
      float4 v[4];
      float am = 0.f;
#pragma unroll
      for (int i = 0; i < 4; ++i) {
        v[i] = ((const float4*)src)[i];
        am = fmaxf(am, fmaxf(fmaxf(fabsf(v[i].x), fabsf(v[i].y)), fmaxf(fabsf(v[i].z), fabsf(v[i].w))));
      }
#pragma unroll
      for (int o = 32; o >= 1; o >>= 1) am = fmaxf(am, __shfl_xor(am, o));
      int E = (int)((__float_as_uint(am) >> 23) & 0xffu) - 127;
      E = E < -60 ? -60 : E;
      const int k = 7 - E;
      const float sc = __uint_as_float((unsigned)(k + 127) << 23);
      unsigned w[4];
#pragma unroll
      for (int i = 0; i < 4; ++i) {
        int pk = 0;
        pk = __builtin_amdgcn_cvt_pk_fp8_f32(v[i].x * sc, v[i].y * sc, pk, false);
        pk = __builtin_amdgcn_cvt_pk_fp8_f32(v[i].z * sc, v[i].w * sc, pk, true);
        w[i] = (unsigned)pk;
      }
      unsigned char* dst = (isU ? p.U8 : p.V8) + (size_t)e * 1024 + lane * 16;
      *(uint4*)dst = make_uint4(w[0], w[1], w[2], w[3]);
      if (lane == 0) {
        if (isU) p.USC[e] = 127 - k;
        else p.VSCF[e] = __uint_as_float((unsigned)(127 - k) << 23);
      }
    }
  }
  {
    size_t tot = (size_t)32 * 128 * 256 / 8;
    for (size_t i = gt; i < tot; i += GT) {
      int g = (int)(i / (128 * 32)), rem = (int)(i % (128 * 32)), n = rem / 32, c8 = rem % 32;
      *(uint4*)(p.A2 + ((size_t)g * NSUB + 1024 + n) * A2LD + c8 * 8) = make_uint4(0, 0, 0, 0);
    }
  }
  {
    size_t tot = (size_t)32 * 16 * 256;
    for (size_t i = gt; i < tot; i += GT) {
      int g = (int)(i / 4096), rem = (int)(i % 4096), m = rem >> 8, h = (rem >> 4) & 15, h2 = rem & 15;
      float dt = __expf(p.log_dt[g]);
      float acc = 0.f;
      for (int pp = 0; pp < 64; ++pp) {
        float are = p.a_re[g * 64 + pp], aim = p.a_im[g * 64 + pp];
        Cplx am = apow(are, aim, dt, (float)m);
        Cplx bs = bscale(are, aim, dt);
        Cplx bb = {p.ssm_b[((g * 64 + pp) * 16 + h2) * 2], p.ssm_b[((g * 64 + pp) * 16 + h2) * 2 + 1]};
        Cplx cc = {p.ssm_c[((g * 16 + h) * 64 + pp) * 2], p.ssm_c[((g * 16 + h) * 64 + pp) * 2 + 1]};
        Cplx x = cmul(cmul(am, bs), bb);
        acc += cc.re * x.re - cc.im * x.im;
      }
      if (m == 0 && h == h2) acc += p.ssm_d[g * 16 + h];
      bf16_t v = f2bf(acc);
      for (int t = m; t < 16; ++t) {
        int j = t - m;
        p.Bt2[((size_t)g * 256 + t * 16 + h) * A2LD + j * 16 + h2] = v;
      }
      if (m == 0) {
        for (int t = 0; t < 16; ++t)
          for (int j = t + 1; j < 16; ++j) p.Bt2[((size_t)g * 256 + t * 16 + h) * A2LD + j * 16 + h2] = 0;
      }
    }
    tot = (size_t)32 * 256 * 64;
    for (size_t i = gt; i < tot; i += GT) {
      int g = (int)(i / 16384), rem = (int)(i % 16384), th = rem >> 6, pp = rem & 63, t = th >> 4, h = th & 15;
      float dt = __expf(p.log_dt[g]);
      float are = p.a_re[g * 64 + pp], aim = p.a_im[g * 64 + pp];
      Cplx am = apow(are, aim, dt, (float)(t + 1));
      Cplx cc = {p.ssm_c[((g * 16 + h) * 64 + pp) * 2], p.ssm_c[((g * 16 + h) * 64 + pp) * 2 + 1]};
      p.Bt2[((size_t)g * 256 + th) * A2LD + 256 + pp] = f2bf(cc.re * am.re - cc.im * am.im);
      p.Bt2[((size_t)g * 256 + th) * A2LD + 320 + pp] = f2bf(-(cc.re * am.im + cc.im * am.re));
    }
    tot = (size_t)32 * 64 * 256;
    for (size_t i = gt; i < tot; i += GT) {
      int g = (int)(i / 16384), rem = (int)(i % 16384), pp = rem >> 8, jh = rem & 255, j = jh >> 4, h2 = jh & 15;
      float dt = __expf(p.log_dt[g]);
      float are = p.a_re[g * 64 + pp], aim = p.a_im[g * 64 + pp];
      Cplx am = apow(are, aim, dt, (float)(15 - j));
      Cplx bs = bscale(are, aim, dt);
      Cplx bb = {p.ssm_b[((g * 64 + pp) * 16 + h2) * 2], p.ssm_b[((g * 64 + pp) * 16 + h2) * 2 + 1]};
      Cplx x = cmul(cmul(am, bs), bb);
      p.Emat[((size_t)g * 128 + pp) * 256 + jh] = f2bf(x.re);
      p.Emat[((size_t)g * 128 + 64 + pp) * 256 + jh] = f2bf(x.im);
    }
  }
}

template <bool FP8OUT>
__device__ void phase_rmsnorm(const float* __restrict__ srcP, const float* __restrict__ srcS, const float* __restrict__ gain,
                              bf16_t* __restrict__ dst, unsigned char* __restrict__ dst8, int* __restrict__ xsc) {
  const int lane = tidx() & 63, gw = blockIdx.x * 8 + (tidx() >> 6), GW = gridDim.x * 8;
  float4 g[4];
#pragma unroll
  for (int i = 0; i < 4; ++i) g[i] = *(const float4*)(gain + lane * 4 + 256 * i);
  for (int r = gw; r < NT; r += GW) {
    const float* src = (r < NP) ? srcP + (size_t)r * 1024 : srcS + (size_t)(r - NP) * 1024;
    float4 v[4];
    float ss = 0.f;
#pragma unroll
    for (int i = 0; i < 4; ++i) {
      v[i] = *(const float4*)(src + lane * 4 + 256 * i);
      ss += v[i].x * v[i].x + v[i].y * v[i].y + v[i].z * v[i].z + v[i].w * v[i].w;
    }
    ss = wave_sum(ss);
    float rinv = rsqrtf(ss * (1.f / 1024.f) + EPS);
#pragma unroll
    for (int i = 0; i < 4; ++i) {
      uint2 o = make_uint2(pk2(v[i].x * rinv * g[i].x, v[i].y * rinv * g[i].y), pk2(v[i].z * rinv * g[i].z, v[i].w * rinv * g[i].w));
      *(uint2*)(dst + (size_t)r * 1024 + lane * 4 + 256 * i) = o;
    }
    if constexpr (FP8OUT) {
      float am = 0.f;
#pragma unroll
      for (int i = 0; i < 4; ++i) {
        v[i].x *= rinv * g[i].x; v[i].y *= rinv * g[i].y; v[i].z *= rinv * g[i].z; v[i].w *= rinv * g[i].w;
        am = fmaxf(am, fmaxf(fmaxf(fabsf(v[i].x), fabsf(v[i].y)), fmaxf(fabsf(v[i].z), fabsf(v[i].w))));
      }
#pragma unroll
      for (int o = 32; o >= 1; o >>= 1) am = fmaxf(am, __shfl_xor(am, o));
      int E = (int)((__float_as_uint(am) >> 23) & 0xffu) - 127;
      E = E < -60 ? -60 : E;
      const int k = 7 - E;
      const float sc = __uint_as_float((unsigned)(k + 127) << 23);
#pragma unroll
      for (int i = 0; i < 4; ++i) {
        int pk = 0;
        pk = __builtin_amdgcn_cvt_pk_fp8_f32(v[i].x * sc, v[i].y * sc, pk, false);
        pk = __builtin_amdgcn_cvt_pk_fp8_f32(v[i].z * sc, v[i].w * sc, pk, true);
        *(unsigned*)(dst8 + (size_t)r * 1024 + lane * 4 + 256 * i) = (unsigned)pk;
      }
      if (lane == 0) xsc[r] = 127 - k;
    }
  }
}

__device__ void phase_gemm_z(const Params& p, char* smem) {
  const int ntn = 10, ntm = NT / 256;
  for (int t = blockIdx.x; t < ntm * ntn; t += gridDim.x) {
    int tm = t / ntn, tn = t % ntn;
    float* Z = p.Z;
    gemm_tile<2>(p.XN, 1024, p.WinT, 1024, 1024, tm * 256, tn * 128, smem, [=](int m, int n, float v) {
      if (n < INW) Z[(size_t)m * INW + n] = v;
    });
  }
}

__device__ void phase_post1(const Params& p) {
  const int lane = tidx() & 63, gw = blockIdx.x * 8 + (tidx() >> 6), GW = gridDim.x * 8;
  for (int r = gw; r < NT; r += GW) {
    const float* z = p.Z + (size_t)r * INW;
    const bool isP = r < NP;
    const int rs = r - NP;
    {
      float4 a = *(const float4*)(z + lane * 8), b = *(const float4*)(z + lane * 8 + 4);
      int g = lane >> 1, h0 = (lane & 1) * 8;
      int n = isP ? (r >> 4) : (1024 + (rs >> 2));
      int t = isP ? (r & 15) : (rs & 3);
      *(uint4*)(p.A2 + ((size_t)g * NSUB + n) * A2LD + t * 16 + h0) = make_uint4(pk2(a.x, a.y), pk2(a.z, a.w), pk2(b.x, b.y), pk2(b.z, b.w));
    }
    {
      float2 v[3];
      float ss = 0.f;
#pragma unroll
      for (int i = 0; i < 3; ++i) {
        v[i] = *(const float2*)(z + 512 + lane * 2 + 128 * i);
        ss += v[i].x * v[i].x + v[i].y * v[i].y;
      }
      ss = wave_sum(ss);
      float rinv = rsqrtf(ss * (1.f / 384.f) + EPS);
#pragma unroll
      for (int i = 0; i < 3; ++i) {
        float2 g = *(const float2*)(p.norm_q_lora + lane * 2 + 128 * i);
        *(unsigned*)(p.CQN + (size_t)r * 384 + lane * 2 + 128 * i) = pk2(v[i].x * rinv * g.x, v[i].y * rinv * g.y);
      }
    }
    {
      float4 v = *(const float4*)(z + 896 + lane * 4);
      float ss = wave_sum(v.x * v.x + v.y * v.y + v.z * v.z + v.w * v.w);
      float rinv = rsqrtf(ss * (1.f / 256.f) + EPS);
      float4 g = *(const float4*)(p.norm_kv_lora + lane * 4);
      float4 o = make_float4(v.x * rinv * g.x, v.y * rinv * g.y, v.z * rinv * g.z, v.w * rinv * g.w);
      float* dst = isP ? p.out + O_LATP + (size_t)r * 256 : p.out + O_LATS + (size_t)rs * 256;
      *(float4*)(dst + lane * 4) = o;
      *(uint2*)(p.CKV + (size_t)r * 256 + lane * 4) = make_uint2(pk2(o.x, o.y), pk2(o.z, o.w));
    }
    {
      float v = (lane < 32) ? z[1152 + lane] : 0.f;
      float ss = wave_sum(v * v);
      float rinv = rsqrtf(ss * (1.f / 32.f) + EPS);
      float gn = (lane < 32) ? p.g_kr[lane] : 0.f;
      float xv = v * rinv * gn;
      float other = __shfl_xor(xv, 16);
      int i = lane & 15;
      float pos = isP ? (float)(r & 4095) : (float)(8192 + (rs & 3));
      float inv = exp2f(-(float)i * (13.287712379549449f / 16.f));
      float sn, cs;
      sincos_rev(pos * inv, sn, cs);
      float o = (lane & 16) ? (xv * cs + other * sn) : (xv * cs - other * sn);
      if (lane < 32) {
        float* dst = isP ? p.out + O_KRP + (size_t)r * 32 : p.out + O_KRS + (size_t)rs * 32;
        dst[lane] = o;
        bf16_t ob = f2bf(o);
        if (isP) {
          int b = r >> 12, t = r & 4095;
#pragma unroll
          for (int h = 0; h < 8; ++h) p.Kcat[((size_t)(b * 8 + h) * 4096 + t) * 96 + 64 + lane] = ob;
        } else {
          int seq = rs >> 2, t = rs & 3;
#pragma unroll
          for (int h = 0; h < 8; ++h) p.KcatS[((size_t)(seq * 8 + h) * 4 + t) * 96 + 64 + lane] = ob;
        }
      }
    }
  }
}

__device__ void phase_gemm4(const Params& p, char* smem) {
  const int nq = 66 * 6, nk = 66 * 4, nv = 2 * 128, ns = 32 * 9;
  const int total = nq + nk + nv + ns;
  for (int t = blockIdx.x; t < total; t += gridDim.x) {
    if (t < nq) {
      int tm = t / 6, tn = t % 6;
      float* C = p.Qraw;
      gemm_tile<2>(p.CQN, 384, p.WuqT, 384, 384, tm * 256, tn * 128, smem, [=](int m, int n, float v) { C[(size_t)m * 768 + n] = v; });
    } else if (t < nq + nk) {
      int u = t - nq, tm = u / 4, tn = u % 4;
      float* C = p.KNraw;
      gemm_tile<2>(p.CKV, 256, p.WukT, 256, 256, tm * 256, tn * 128, smem, [=](int m, int n, float v) { C[(size_t)m * 512 + n] = v; });
    } else if (t < nq + nk + nv) {
      int u = t - nq - nk, tm = u / 128, tn = u % 128;
      bf16_t* C = p.VT;
      gemm_tile<2>(p.WuvT, 256, p.CKV, 256, 256, tm * 256, tn * 128, smem, [=](int m, int n, float v) { C[(size_t)m * NP + n] = f2bf(v); });
    } else {
      int u = t - nq - nk - nv, g = u / 9, tm = u % 9;
      float* C = p.S + (size_t)g * NSUB * 128;
      gemm_tile<1>(p.A2 + (size_t)g * NSUB * A2LD, A2LD, p.Emat + (size_t)g * 128 * 256, 256, 256, tm * 128, 0, smem,
                   [=](int m, int n, float v) { C[(size_t)m * 128 + n] = v; });
    }
  }
}

__device__ void phase_post2(const Params& p) {
  const int lane = tidx() & 63, gw = blockIdx.x * 8 + (tidx() >> 6), GW = gridDim.x * 8;
  const float gqn = p.g_qn[lane], gkn = p.g_kn[lane];
  const float gqr = p.g_qr[lane & 31];
  const float inv = exp2f(-(float)(lane & 15) * (13.287712379549449f / 16.f));
  for (int r = gw; r < NT; r += GW) {
    const bool isP = r < NP;
    const int rs = r - NP;
    float pos = isP ? (float)(r & 4095) : (float)(8192 + (rs & 3));
    float sn, cs;
    sincos_rev(pos * inv, sn, cs);
#pragma unroll 1
    for (int h = 0; h < 8; ++h) {
      const float* q = p.Qraw + (size_t)r * 768 + h * 96;
      float v = q[lane];
      float ss = wave_sum(v * v);
      float rinv = rsqrtf(ss * (1.f / 64.f) + EPS);
      p.Qb[((size_t)r * 8 + h) * 96 + lane] = f2bf(v * rinv * gqn * QSCALE);
      float w = (lane < 32) ? q[64 + lane] : 0.f;
      float s2 = wave_sum(w * w);
      float rinv2 = rsqrtf(s2 * (1.f / 32.f) + EPS);
      float xv = w * rinv2 * gqr;
      float other = __shfl_xor(xv, 16);
      float o = (lane & 16) ? (xv * cs + other * sn) : (xv * cs - other * sn);
      if (lane < 32) p.Qb[((size_t)r * 8 + h) * 96 + 64 + lane] = f2bf(o * QSCALE);
      float kv = p.KNraw[(size_t)r * 512 + h * 64 + lane];
      float ks = wave_sum(kv * kv);
      float krinv = rsqrtf(ks * (1.f / 64.f) + EPS);
      bf16_t kb = f2bf(kv * krinv * gkn);
      if (isP) {
        int b = r >> 12, t = r & 4095;
        p.Kcat[((size_t)(b * 8 + h) * 4096 + t) * 96 + lane] = kb;
      } else {
        int seq = rs >> 2, t = rs & 3;
        p.KcatS[((size_t)(seq * 8 + h) * 4 + t) * 96 + lane] = kb;
      }
    }
  }
}

__device__ __forceinline__ float softmax_bound(const Params& p) {
  const int lane = tidx() & 63;
  float a = fabsf(p.g_qn[lane]), b = fabsf(p.g_kn[lane]), c = fabsf(p.g_qr[lane & 31]), d = fabsf(p.g_kr[lane & 31]);
#pragma unroll
  for (int o = 32; o >= 1; o >>= 1) {
    a = fmaxf(a, __shfl_xor(a, o)); b = fmaxf(b, __shfl_xor(b, o));
    c = fmaxf(c, __shfl_xor(c, o)); d = fmaxf(d, __shfl_xor(d, o));
  }
  return QSCALE * (64.f * a * b + 32.f * c * d);
}

#define KLD 104
#define VLD 68
__device__ __forceinline__ void attn_prompt_block(const Params& p, char* smem, int b, int h, int qi, float Mb) {
  bf16_t* Ks = (bf16_t*)smem;
  bf16_t* Vs = Ks + 2 * 64 * KLD;
  const int tid = tidx(), lane = tid & 63, wave = tid >> 6, lr = lane & 31, hh = lane >> 5;
  const int q0 = qi * 256 + wave * 32;
  const bf16_t* Kg = p.Kcat + (size_t)(b * 8 + h) * 4096 * 96;
  const bf16_t* Vg = p.VT + (size_t)(h * 64) * NP + b * 4096;
  bf16x8 qf[6];
  {
    const bf16_t* qp = p.Qb + ((size_t)(b * 4096 + q0 + lr) * 8 + h) * 96 + hh * 8;
#pragma unroll
    for (int s = 0; s < 6; ++s) qf[s] = *(const bf16x8*)(qp + s * 16);
  }
  f32x16 ot[2];
#pragma unroll
  for (int i = 0; i < 2; ++i)
#pragma unroll
    for (int r = 0; r < 16; ++r) ot[i][r] = 0.f;
  float lsum = 0.f;
  const int nkt = 4 * (qi + 1);
  uint4 rk[2];
  uint2 rv[2];
  auto gload = [&](int kt) {
    const int k0 = kt * 64;
#pragma unroll
    for (int i = 0; i < 2; ++i) {
      int c = tid + NTHR * i;
      c = c < 768 ? c : 767;
      int row = c / 12, cc = c % 12;
      rk[i] = *(const uint4*)(Kg + (size_t)(k0 + row) * 96 + cc * 8);
    }
#pragma unroll
    for (int i = 0; i < 2; ++i) {
      int c = tid + NTHR * i, row = c >> 4, cc = c & 15;
      rv[i] = *(const uint2*)(Vg + (size_t)row * NP + k0 + cc * 4);
    }
  };
  auto lstore = [&](int buf) {
#pragma unroll
    for (int i = 0; i < 2; ++i) {
      int c = tid + NTHR * i;
      if (c < 768) { int row = c / 12, cc = c % 12; *(uint4*)(Ks + (buf * 64 + row) * KLD + cc * 8) = rk[i]; }
    }
#pragma unroll
    for (int i = 0; i < 2; ++i) {
      int c = tid + NTHR * i, row = c >> 4, cc = c & 15;
      *(uint2*)(Vs + (buf * 64 + row) * VLD + cc * 4) = rv[i];
    }
  };
  gload(0);
  lstore(0);
  __syncthreads();
  for (int kt = 0; kt < nkt; ++kt) {
    const int buf = kt & 1, k0 = kt * 64;
    if (kt + 1 < nkt) gload(kt + 1);
    if (k0 <= q0 + 31) {
      const bool need_mask = (k0 + 63 > q0);
      bf16x8 pb[2][2];
#pragma unroll
      for (int kt2 = 0; kt2 < 2; ++kt2) {
        f32x16 st;
#pragma unroll
        for (int r = 0; r < 16; ++r) st[r] = 0.f;
#pragma unroll
        for (int s = 0; s < 6; ++s) {
          bf16x8 a = *(const bf16x8*)(Ks + (buf * 64 + kt2 * 32 + lr) * KLD + s * 16 + hh * 8);
          st = mfma32(a, qf[s], st);
        }
        float pv[16];
#pragma unroll
        for (int r = 0; r < 16; ++r) {
          float e = exp2f(st[r] - Mb);
          if (need_mask) {
            int key = k0 + kt2 * 32 + (r & 3) + 8 * (r >> 2) + 4 * hh;
            e = (key <= q0 + lr) ? e : 0.f;
          }
          pv[r] = e;
          lsum += e;
        }
#pragma unroll
        for (int s2 = 0; s2 < 2; ++s2)
          pb[kt2][s2] = mk8(pk2(pv[8 * s2 + 0], pv[8 * s2 + 1]), pk2(pv[8 * s2 + 2], pv[8 * s2 + 3]),
                            pk2(pv[8 * s2 + 4], pv[8 * s2 + 5]), pk2(pv[8 * s2 + 6], pv[8 * s2 + 7]));
      }
#pragma unroll
      for (int dt = 0; dt < 2; ++dt)
#pragma unroll
        for (int kt2 = 0; kt2 < 2; ++kt2)
#pragma unroll
          for (int s2 = 0; s2 < 2; ++s2) {
            const bf16_t* vp = Vs + (buf * 64 + dt * 32 + lr) * VLD + kt2 * 32 + 16 * s2 + 4 * hh;
            uint2 lo = *(const uint2*)vp, hi = *(const uint2*)(vp + 8);
            bf16x8 a = mk8(lo.x, lo.y, hi.x, hi.y);
            ot[dt] = mfma32(a, pb[kt2][s2], ot[dt]);
          }
    }
    if (kt + 1 < nkt) lstore(buf ^ 1);
    __syncthreads();
  }
  lsum += __shfl_xor(lsum, 32);
  const float linv = 1.f / lsum;
  bf16_t* op = p.OATT + (size_t)(b * 4096 + q0 + lr) * 512 + h * 64;
#pragma unroll
  for (int dt = 0; dt < 2; ++dt)
#pragma unroll
    for (int rg = 0; rg < 4; ++rg) {
      int d = dt * 32 + 8 * rg + 4 * hh;
      *(uint2*)(op + d) = make_uint2(pk2(ot[dt][4 * rg] * linv, ot[dt][4 * rg + 1] * linv), pk2(ot[dt][4 * rg + 2] * linv, ot[dt][4 * rg + 3] * linv));
    }
}

#define LLD 264
#define L8LD 272
#define KRLD 40
#define PLD 72
#define DEC_TILE_BYTES (64 * LLD * 2 + 64 * L8LD + 64 * KRLD * 2 + 256)
typedef __attribute__((ext_vector_type(8))) int i32x8;
__device__ __forceinline__ f32x16 mfma8(i32x8 a, i32x8 b, f32x16 c) {
  return __builtin_amdgcn_mfma_scale_f32_32x32x64_f8f6f4(a, b, c, 0, 0, 0, 127, 0, 127);
}
__device__ __forceinline__ void attn_decode_unit(const Params& p, char* smem, int seq, int half, float Mb) {
  const int tid = tidx(), lane = tid & 63, wave = tid >> 6, lr = lane & 31, hh = lane >> 5;
  const int hd = wave;
  bf16_t* Psh = (bf16_t*)(smem + 2 * DEC_TILE_BYTES);
  bf16_t* Qs = Psh + 32 * PLD;
  for (int i = tid; i < 8 * 4 * 96; i += NTHR) {
    int h2 = i / 384, rem = i % 384, t = rem / 96, e = rem % 96;
    const bf16_t* qp = p.Qb + ((size_t)(NP + seq * 4 + t) * 8 + h2) * 96;
    bf16_t val;
    if (e < 64) {
      int j = e & 7, hx = (e >> 3) & 1, sp = (e >> 4) & 1, dt = e >> 5;
      int d = 32 * dt + 16 * sp + 8 * (j >> 2) + 4 * hx + (j & 3);
      val = f2bf(bf2f(qp[d]) * p.g_kn[d]);
    } else val = qp[e];
    Qs[i] = val;
  }
  i32x8 wf8[2][4];
#pragma unroll
  for (int mt = 0; mt < 2; ++mt)
#pragma unroll
    for (int ks = 0; ks < 4; ++ks) {
      const unsigned char* wp = p.W8T + (size_t)(hd * 64 + mt * 32 + lr) * 256 + ks * 64 + hh * 32;
      uint4 a = *(const uint4*)wp, b = *(const uint4*)(wp + 16);
      wf8[mt][ks][0] = a.x; wf8[mt][ks][1] = a.y; wf8[mt][ks][2] = a.z; wf8[mt][ks][3] = a.w;
      wf8[mt][ks][4] = b.x; wf8[mt][ks][5] = b.y; wf8[mt][ks][6] = b.z; wf8[mt][ks][7] = b.w;
    }
  const float eps_w = EPS * __uint_as_float((unsigned)(2 * p.KW[hd] + 127) << 23);
  f32x16 oacc;
#pragma unroll
  for (int r = 0; r < 16; ++r) oacc[r] = 0.f;
  float lsum[4] = {0.f, 0.f, 0.f, 0.f};
  float4 rlA[8], rkA;
  auto gload = [&](int i, float4 (&rl)[8], float4& rk) {
    int page = p.page_table[seq * 64 + half * 32 + (i >> 1)];
    const float* lp = p.cache_lat + ((size_t)page * 128 + (i & 1) * 64) * 256;
    const float* kp = p.cache_kr + ((size_t)page * 128 + (i & 1) * 64) * 32;
#pragma unroll
    for (int j = 0; j < 8; ++j) rl[j] = ((const float4*)lp)[tid + NTHR * j];
    rk = ((const float4*)kp)[tid];
  };
  int olane = lane, otid = tid;
  auto lstore = [&](char* tb, const float4 (&rl)[8], const float4& rk) {
    const int lane = olane, tid = otid, wave = otid >> 6;
    bf16_t* latB = (bf16_t*)tb;
    unsigned char* lat8 = (unsigned char*)(tb + 64 * LLD * 2);
    bf16_t* krB = (bf16_t*)(tb + 64 * LLD * 2 + 64 * L8LD);
    float* epsk = (float*)(tb + 64 * LLD * 2 + 64 * L8LD + 64 * KRLD * 2);
#pragma unroll
    for (int j = 0; j < 8; ++j) {
      const int row = wave + 8 * j;
      float4 v = rl[j];
      float am = fmaxf(fmaxf(fabsf(v.x), fabsf(v.y)), fmaxf(fabsf(v.z), fabsf(v.w)));
#pragma unroll
      for (int o = 32; o >= 1; o >>= 1) am = fmaxf(am, __shfl_xor(am, o));
      int E = (int)((__float_as_uint(am) >> 23) & 0xffu) - 127;
      E = E < -60 ? -60 : E;
      const int k = 7 - E;
      const float sc = __uint_as_float((unsigned)(k + 127) << 23);
      int pk = 0;
      pk = __builtin_amdgcn_cvt_pk_fp8_f32(v.x * sc, v.y * sc, pk, false);
      pk = __builtin_amdgcn_cvt_pk_fp8_f32(v.z * sc, v.w * sc, pk, true);
      *(unsigned*)(lat8 + row * L8LD + lane * 4) = (unsigned)pk;
      *(uint2*)(latB + row * LLD + lane * 4) = make_uint2(pk2(v.x, v.y), pk2(v.z, v.w));
      if (lane == 0) epsk[row] = __uint_as_float((unsigned)(2 * k + 127) << 23);
    }
    int row = tid >> 3, c4 = tid & 7;
    *(uint2*)(krB + row * KRLD + c4 * 4) = make_uint2(pk2(rk.x, rk.y), pk2(rk.z, rk.w));
  };
  auto lstore_new = [&](char* tb) {
    const int lane = olane, tid = otid, wave = otid >> 6;
    bf16_t* latB = (bf16_t*)tb;
    unsigned char* lat8 = (unsigned char*)(tb + 64 * LLD * 2);
    bf16_t* krB = (bf16_t*)(tb + 64 * LLD * 2 + 64 * L8LD);
    float* epsk = (float*)(tb + 64 * LLD * 2 + 64 * L8LD + 64 * KRLD * 2);
#pragma unroll
    for (int j = 0; j < 8; ++j) {
      const int row = wave + 8 * j;
      uint2 v = make_uint2(0, 0);
      if (row < 4) v = *(const uint2*)(p.CKV + (size_t)(NP + seq * 4 + row) * 256 + lane * 4);
      float f0 = bflo(v.x), f1 = bfhi(v.x), f2 = bflo(v.y), f3 = bfhi(v.y);
      float am = fmaxf(fmaxf(fabsf(f0), fabsf(f1)), fmaxf(fabsf(f2), fabsf(f3)));
#pragma unroll
      for (int o = 32; o >= 1; o >>= 1) am = fmaxf(am, __shfl_xor(am, o));
      int E = (int)((__float_as_uint(am) >> 23) & 0xffu) - 127;
      E = E < -60 ? -60 : E;
      const int k = 7 - E;
      const float sc = __uint_as_float((unsigned)(k + 127) << 23);
      int pk = 0;
      pk = __builtin_amdgcn_cvt_pk_fp8_f32(f0 * sc, f1 * sc, pk, false);
      pk = __builtin_amdgcn_cvt_pk_fp8_f32(f2 * sc, f3 * sc, pk, true);
      *(unsigned*)(lat8 + row * L8LD + lane * 4) = (unsigned)pk;
      *(uint2*)(latB + row * LLD + lane * 4) = v;
      if (lane == 0) epsk[row] = __uint_as_float((unsigned)(2 * k + 127) << 23);
    }
    int row = tid >> 3, c4 = tid & 7;
    uint2 v = make_uint2(0, 0);
    if (row < 4) v = *(const uint2*)(p.KcatS + ((size_t)(seq * 8) * 4 + row) * 96 + 64 + c4 * 4);
    *(uint2*)(krB + row * KRLD + c4 * 4) = v;
  };
  auto compute = [&](char* tb, bool isnew) {
    const int lane = olane, wave = otid >> 6, lr = olane & 31, hh = olane >> 5, hd = otid >> 6;
    const bf16_t* latB = (const bf16_t*)tb;
    const unsigned char* lat8 = (const unsigned char*)(tb + 64 * LLD * 2);
    const bf16_t* krB = (const bf16_t*)(tb + 64 * LLD * 2 + 64 * L8LD);
    const float* epsk = (const float*)(tb + 64 * LLD * 2 + 64 * L8LD + 64 * KRLD * 2);
#pragma unroll 1
    for (int kt2 = 0; kt2 < 2; ++kt2) {
      float ss = 0.f;
      f32x16 s1;
#pragma unroll
      for (int r = 0; r < 16; ++r) s1[r] = 0.f;
      const unsigned char* bp = lat8 + (kt2 * 32 + lr) * L8LD + hh * 32;
#pragma unroll
      for (int mt = 0; mt < 2; ++mt) {
        f32x16 acc;
#pragma unroll
        for (int r = 0; r < 16; ++r) acc[r] = 0.f;
#pragma unroll
        for (int ks = 0; ks < 4; ++ks) {
          uint4 a = *(const uint4*)(bp + ks * 64), b = *(const uint4*)(bp + ks * 64 + 16);
          i32x8 bv;
          bv[0] = a.x; bv[1] = a.y; bv[2] = a.z; bv[3] = a.w; bv[4] = b.x; bv[5] = b.y; bv[6] = b.z; bv[7] = b.w;
          acc = mfma8(wf8[mt][ks], bv, acc);
        }
#pragma unroll
        for (int r = 0; r < 16; ++r) ss += acc[r] * acc[r];
#pragma unroll
        for (int sp = 0; sp < 2; ++sp) {
          bf16x8 bk = mk8(pk2(acc[8 * sp + 0], acc[8 * sp + 1]), pk2(acc[8 * sp + 2], acc[8 * sp + 3]),
                          pk2(acc[8 * sp + 4], acc[8 * sp + 5]), pk2(acc[8 * sp + 6], acc[8 * sp + 7]));
          uint4 qa = make_uint4(0, 0, 0, 0);
          if (lr < 4) qa = *(const uint4*)(Qs + (hd * 4 + lr) * 96 + ((mt * 2 + sp) * 2 + hh) * 8);
          s1 = mfma32(__builtin_bit_cast(bf16x8, qa), bk, s1);
        }
      }
      ss += __shfl_xor(ss, 32);
      const float rinv = rsqrtf(ss * (1.f / 64.f) + eps_w * epsk[kt2 * 32 + lr]);
      float s1v[4] = {s1[0] * rinv, s1[1] * rinv, s1[2] * rinv, s1[3] * rinv};
      f32x16 s2;
#pragma unroll
      for (int r = 0; r < 16; ++r) s2[r] = 0.f;
#pragma unroll
      for (int s = 0; s < 2; ++s) {
        bf16x8 bk = *(const bf16x8*)(krB + (kt2 * 32 + lr) * KRLD + s * 16 + hh * 8);
        uint4 qa = make_uint4(0, 0, 0, 0);
        if (lr < 4) qa = *(const uint4*)(Qs + (hd * 4 + lr) * 96 + 64 + s * 16 + hh * 8);
        s2 = mfma32(__builtin_bit_cast(bf16x8, qa), bk, s2);
      }
      if (hh == 0) {
        const int kk = kt2 * 32 + lr;
#pragma unroll
        for (int t = 0; t < 4; ++t) {
          float e = __builtin_amdgcn_exp2f(s1v[t] + s2[t] - Mb);
          if (isnew) e = (kk < 4 && kk <= t) ? e : 0.f;
          lsum[t] += e;
          Psh[(hd * 4 + t) * PLD + kk] = f2bf(e);
        }
      }
    }
    __syncthreads();
    {
      const int n0 = wave * 32;
#pragma unroll
      for (int ks = 0; ks < 4; ++ks) {
        bf16x8 a = *(const bf16x8*)(Psh + lr * PLD + ks * 16 + hh * 8);
        const int key0 = ks * 16 + 8 * hh, c0 = n0 + 16 * ((lane >> 4) & 1);
        const int q = (lane & 15) >> 2, pp = lane & 3;
        const bf16_t* ap = latB + (key0 + q) * LLD + c0 + 4 * pp;
        s16x4 lo = __builtin_amdgcn_ds_read_tr16_b64_v4i16((__attribute__((address_space(3))) s16x4*)(ap));
        s16x4 hi = __builtin_amdgcn_ds_read_tr16_b64_v4i16((__attribute__((address_space(3))) s16x4*)(ap + 4 * LLD));
        bf16x8 bfr;
        bfr[0] = lo[0]; bfr[1] = lo[1]; bfr[2] = lo[2]; bfr[3] = lo[3];
        bfr[4] = hi[0]; bfr[5] = hi[1]; bfr[6] = hi[2]; bfr[7] = hi[3];
        oacc = mfma32(a, bfr, oacc);
      }
    }
  };
  gload(0, rlA, rkA);
  const int ntile = 64 + half;
#pragma unroll 1
  for (int i = 0; i < ntile; ++i) {
    char* tb = smem + (i & 1) * DEC_TILE_BYTES;
    asm volatile("" : "+v"(olane), "+v"(otid));
    if (i < 64) lstore(tb, rlA, rkA); else lstore_new(tb);
    if (i + 1 < 64) gload(i + 1, rlA, rkA);
    __syncthreads();
    compute(tb, i == 64);
  }
  float* Op = p.Opart + ((size_t)(seq * 2 + half) * 32) * 256;
#pragma unroll
  for (int r = 0; r < 16; ++r) {
    int m = (r & 3) + 8 * (r >> 2) + 4 * hh;
    Op[(size_t)m * 256 + wave * 32 + lr] = oacc[r];
  }
#pragma unroll
  for (int t = 0; t < 4; ++t) {
    float v = (hh == 0) ? lsum[t] : 0.f;
    v = wave_sum(v);
    if (lane == 0) p.Lpart[(seq * 2 + half) * 32 + hd * 4 + t] = v;
  }
  __syncthreads();
}

__device__ __forceinline__ void ssm_scan_prompt(const Params& p, int job) {
  const int lane = tidx() & 63;
  const int b = job >> 5, g = job & 31;
  const float dt = __expf(p.log_dt[g]);
  const Cplx a16 = apow(p.a_re[g * 64 + lane], p.a_im[g * 64 + lane], dt, 16.f);
  Cplx H = {0.f, 0.f};
  const float* S = p.S + ((size_t)g * NSUB + b * 256) * 128;
  bf16_t* A2 = p.A2 + ((size_t)g * NSUB + b * 256) * A2LD + 256;
  for (int n0 = 0; n0 < 256; n0 += 16) {
    float sr[16], si[16];
#pragma unroll
    for (int k = 0; k < 16; ++k) { sr[k] = S[(size_t)(n0 + k) * 128 + lane]; si[k] = S[(size_t)(n0 + k) * 128 + 64 + lane]; }
#pragma unroll
    for (int k = 0; k < 16; ++k) {
      A2[(size_t)(n0 + k) * A2LD + lane] = f2bf(H.re);
      A2[(size_t)(n0 + k) * A2LD + 64 + lane] = f2bf(H.im);
      Cplx t = cmul(a16, H);
      H.re = t.re + sr[k]; H.im = t.im + si[k];
    }
  }
  float* o = p.out + O_SSMP + ((size_t)(b * 32 + g) * 64 + lane) * 2;
  o[0] = H.re; o[1] = H.im;
}
__device__ __forceinline__ void ssm_sample(const Params& p, int job) {
  const int lane = tidx() & 63;
  const int seq = job >> 5, g = job & 31;
  const float dt = __expf(p.log_dt[g]);
  const float are = p.a_re[g * 64 + lane], aim = p.a_im[g * 64 + lane];
  const Cplx ab = apow(are, aim, dt, 1.f);
  const Cplx bs = bscale(are, aim, dt);
  const float* st = p.state_ssm + ((size_t)(seq * 32 + g) * 64 + lane) * 2;
  Cplx H = {st[0], st[1]};
  bf16_t* A2 = p.A2 + ((size_t)g * NSUB + 1024 + seq) * A2LD + 256;
  A2[lane] = f2bf(H.re);
  A2[64 + lane] = f2bf(H.im);
  Cplx bb[16];
#pragma unroll
  for (int h = 0; h < 16; ++h) {
    Cplx braw = {p.ssm_b[((g * 64 + lane) * 16 + h) * 2], p.ssm_b[((g * 64 + lane) * 16 + h) * 2 + 1]};
    bb[h] = cmul(bs, braw);
  }
#pragma unroll
  for (int t = 0; t < 4; ++t) {
    const float* u = p.Z + (size_t)(NP + seq * 4 + t) * INW + g * 16;
    Cplx bu = {0.f, 0.f};
#pragma unroll
    for (int h = 0; h < 16; ++h) { float uv = u[h]; bu.re += uv * bb[h].re; bu.im += uv * bb[h].im; }
    Cplx tt = cmul(ab, H);
    H.re = tt.re + bu.re; H.im = tt.im + bu.im;
  }
  float* o = p.out + O_SSMS + ((size_t)(seq * 32 + g) * 64 + lane) * 2;
  o[0] = H.re; o[1] = H.im;
}

__device__ void phase_attn(const Params& p, char* smem) {
  const int wave = tidx() >> 6;
  const int gw = blockIdx.x * 8 + wave, GW = gridDim.x * 8;
  for (int j = gw; j < 128; j += GW) ssm_scan_prompt(p, j);
  for (int j = gw; j < 4096; j += GW) ssm_sample(p, j);
  const float Mb = softmax_bound(p);
  __syncthreads();
#ifdef PROBE_PROMPT2
  for (int rep = 0; rep < 2; ++rep)
#endif
  for (int it = blockIdx.x; it < 256; it += gridDim.x) {
    int bh = it >> 3, j = it & 7;
    attn_prompt_block(p, smem, bh >> 3, bh & 7, j, Mb);
    attn_prompt_block(p, smem, bh >> 3, bh & 7, 15 - j, Mb);
  }
  for (int it = blockIdx.x; it < 256; it += gridDim.x) attn_decode_unit(p, smem, it >> 1, it & 1, Mb);
}

__device__ void phase_ssm_y(const Params& p, char* smem) {
  const int ntile = 32 * 9 * 2;
  for (int t = blockIdx.x; t < ntile; t += gridDim.x) {
    int g = t / 18, rem = t % 18, tm = rem >> 1, tn = rem & 1;
    bf16_t* G = p.G;
    gemm_tile<1>(p.A2 + (size_t)g * NSUB * A2LD, A2LD, p.Bt2 + (size_t)g * 256 * A2LD, A2LD, 384, tm * 128, tn * 128, smem,
                 [=](int m, int n, float v) {
                   int tt = n >> 4, h = n & 15;
                   int token;
                   if (m < 1024) token = m * 16 + tt;
                   else { if (tt >= 4) return; token = NP + (m - 1024) * 4 + tt; }
                   G[(size_t)token * 512 + g * 16 + h] = f2bf(gelu_tanh(v));
                 });
  }
  const int lane = tidx() & 63, gw = blockIdx.x * 8 + (tidx() >> 6), GW = gridDim.x * 8;
  for (int job = gw; job < 1024; job += GW) {
    int seq = job >> 3, hd = job & 7;
    const float* O0 = p.Opart + ((size_t)(seq * 2) * 32 + hd * 4) * 256;
    const float* O1 = O0 + 32 * 256;
    float acc[4] = {0.f, 0.f, 0.f, 0.f};
    for (int c = 0; c < 256; ++c) {
      float w = p.w_uv[(size_t)c * 512 + hd * 64 + lane];
#pragma unroll
      for (int t = 0; t < 4; ++t) acc[t] += (O0[t * 256 + c] + O1[t * 256 + c]) * w;
    }
#pragma unroll
    for (int t = 0; t < 4; ++t) {
      float l = p.Lpart[(seq * 2) * 32 + hd * 4 + t] + p.Lpart[(seq * 2 + 1) * 32 + hd * 4 + t];
      p.OATT[(size_t)(NP + seq * 4 + t) * 512 + hd * 64 + lane] = f2bf(acc[t] / l);
    }
  }
}

__device__ void phase_gemm_gl(const Params& p, char* smem) {
  for (int t = blockIdx.x; t < 66 * 8; t += gridDim.x) {
    int tm = t / 8, tn = t % 8;
    float* C = p.GL;
    gemm_tile<2>(p.G, 512, p.WgluT, 512, 512, tm * 256, tn * 128, smem, [=](int m, int n, float v) { C[(size_t)m * 1024 + n] = v; });
  }
}
__device__ void phase_cat(const Params& p) {
  const size_t gt = (size_t)blockIdx.x * NTHR + tidx(), GT = (size_t)gridDim.x * NTHR;
  const size_t tot = (size_t)NT * 128;
  for (size_t i = gt; i < tot; i += GT) {
    size_t token = i >> 7;
    int c = (int)(i & 127) * 4;
    float4 a = *(const float4*)(p.GL + token * 1024 + c), b = *(const float4*)(p.GL + token * 1024 + 512 + c);
    float r0 = a.x / (1.f + __expf(-b.x)), r1 = a.y / (1.f + __expf(-b.y)), r2 = a.z / (1.f + __expf(-b.z)), r3 = a.w / (1.f + __expf(-b.w));
    *(uint2*)(p.CAT + token * 1024 + c) = make_uint2(pk2(r0, r1), pk2(r2, r3));
    *(uint2*)(p.CAT + token * 1024 + 512 + c) = *(const uint2*)(p.OATT + token * 512 + c);
  }
}
__device__ void phase_gemm_out(const Params& p, char* smem) {
  for (int t = blockIdx.x; t < 66 * 8; t += gridDim.x) {
    int tm = t / 8, tn = t % 8;
    float* C = p.X1;
    const float *xp = p.x_prompt, *xs = p.x_sample;
    gemm_tile<2>(p.CAT, 1024, p.WoutT, 1024, 1024, tm * 256, tn * 128, smem, [=](int m, int n, float v) {
      float x = (m < NP) ? xp[(size_t)m * 1024 + n] : xs[(size_t)(m - NP) * 1024 + n];
      C[(size_t)m * 1024 + n] = x + v;
    });
  }
}
__device__ void phase_gemm_pq(const Params& p, char* smem) {
  for (int t = blockIdx.x; t < 66 * 16; t += gridDim.x) {
    int tm = t / 16, tn = t % 16;
    bf16_t* C = p.PQ;
    gemm_tile<2>(p.XN, 1024, p.WpqT, 1024, 1024, tm * 256, tn * 128, smem, [=](int m, int n, float v) { C[(size_t)m * 2048 + n] = f2bf(v); });
  }
}
__device__ __forceinline__ void ins16(float (&L)[16], float x) {
#pragma unroll
  for (int j = 15; j >= 1; --j) L[j] = __builtin_amdgcn_fmed3f(L[j - 1], L[j], x);
  L[0] = fmaxf(L[0], x);
}
#define PKLD 136
__device__ void phase_sctopk(const Params& p, char* smem) {
  bf16_t* keysS = (bf16_t*)smem;
  unsigned char* sidx = (unsigned char*)(smem + 2 * 128 * PKLD * 2);
  const int tid = tidx(), lane = tid & 63, wave = tid >> 6, lr = lane & 31, hh = lane >> 5;
  for (int c = tid; c < 2 * 128 * 16; c += NTHR) {
    int row = c >> 4, cc = c & 15;
    *(uint4*)(keysS + row * PKLD + cc * 8) = *(const uint4*)(p.PK + row * 128 + cc * 8);
  }
  __syncthreads();
  const int ntask = NT * 8 / 32;
  for (int task = blockIdx.x * 8 + wave; task < ntask; task += gridDim.x * 8) {
    const int m = task * 32 + lr;
    float L[2][16];
#pragma unroll
    for (int c = 0; c < 2; ++c) {
#pragma unroll
      for (int j = 0; j < 16; ++j) L[c][j] = -3.0e38f;
      bf16x8 qf[8];
#pragma unroll
      for (int s2 = 0; s2 < 8; ++s2) qf[s2] = *(const bf16x8*)(p.PQ + (size_t)m * 256 + c * 128 + s2 * 16 + hh * 8);
#pragma unroll 1
      for (int kt = 0; kt < 4; ++kt) {
        f32x16 acc;
#pragma unroll
        for (int r = 0; r < 16; ++r) acc[r] = 0.f;
#pragma unroll
        for (int s2 = 0; s2 < 8; ++s2) {
          bf16x8 a = *(const bf16x8*)(keysS + (c * 128 + kt * 32 + lr) * PKLD + s2 * 16 + hh * 8);
          acc = mfma32(a, qf[s2], acc);
        }
#pragma unroll
        for (int r = 0; r < 16; ++r) {
          unsigned key = kt * 32 + (r & 3) + 8 * (r >> 2) + 4 * hh;
          ins16(L[c], __uint_as_float((__float_as_uint(acc[r]) & ~127u) | key));
        }
      }
      float P[16];
#pragma unroll
      for (int j = 0; j < 16; ++j) P[j] = __shfl_xor(L[c][j], 32);
#pragma unroll
      for (int j = 0; j < 16; ++j) ins16(L[c], P[j]);
    }
#pragma unroll
    for (int j = 0; j < 16; ++j) {
      sidx[j * NTHR + tid] = (unsigned char)(__float_as_uint(L[0][j]) & 127u);
      sidx[(16 + j) * NTHR + tid] = (unsigned char)(__float_as_uint(L[1][j]) & 127u);
    }
    float T[16];
#pragma unroll
    for (int j = 0; j < 16; ++j) T[j] = -3.0e38f;
#pragma unroll
    for (int i = 0; i < 16; ++i)
#pragma unroll
      for (int j = 0; j < 16; ++j)
        if ((i + 1) * (j + 1) <= 16) {
          float a = __uint_as_float(__float_as_uint(L[0][i]) & ~127u), b = __uint_as_float(__float_as_uint(L[1][j]) & ~127u);
          float sm = a + b;
          ins16(T, __uint_as_float((__float_as_uint(sm) & ~255u) | (unsigned)(i * 16 + j)));
        }
    float mx = __uint_as_float(__float_as_uint(T[0]) & ~255u);
    float e[16], sum = 0.f;
    int id[16];
#pragma unroll
    for (int k = 0; k < 16; ++k) {
      unsigned bits = __float_as_uint(T[k]);
      float v = __uint_as_float(bits & ~255u);
      e[k] = __expf(v - mx);
      sum += e[k];
      unsigned ij = bits & 255u;
      unsigned e1 = sidx[(ij >> 4) * NTHR + tid], e2 = sidx[(16 + (ij & 15)) * NTHR + tid];
      id[k] = (int)(e1 * 128 + e2);
    }
    float inv = 1.f / sum;
    if (hh == 0) {
#pragma unroll
      for (int k4 = 0; k4 < 4; ++k4) {
        *(int4*)(p.IDX + (size_t)m * 16 + k4 * 4) = make_int4(id[k4 * 4], id[k4 * 4 + 1], id[k4 * 4 + 2], id[k4 * 4 + 3]);
        *(float4*)(p.GW + (size_t)m * 16 + k4 * 4) = make_float4(e[k4 * 4] * inv, e[k4 * 4 + 1] * inv, e[k4 * 4 + 2] * inv, e[k4 * 4 + 3] * inv);
      }
    }
  }
}
typedef __attribute__((ext_vector_type(4))) float f32x4;
__device__ void phase_gather(const Params& p, char* smem) {
  float* wsh = (float*)smem;
  const int lane = tidx() & 63, wave = tidx() >> 6, gw = blockIdx.x * 8 + wave, GW = gridDim.x * 8;
  const int lrow = lane & 15, kb = lane >> 4;
  float* wmine = wsh + wave * 128;
  for (int r = gw; r < NT; r += GW) {
    i32x8 xb[8];
    const unsigned char* xp = p.X8 + (size_t)r * 1024 + kb * 32;
#pragma unroll
    for (int ks = 0; ks < 8; ++ks) {
      uint4 a = *(const uint4*)(xp + ks * 128), b = *(const uint4*)(xp + ks * 128 + 16);
      xb[ks][0] = a.x; xb[ks][1] = a.y; xb[ks][2] = a.z; xb[ks][3] = a.w;
      xb[ks][4] = b.x; xb[ks][5] = b.y; xb[ks][6] = b.z; xb[ks][7] = b.w;
    }
    const int xs = p.XSC[r];
    const int* idx = p.IDX + (size_t)r * 128;
    const float* gwt = p.GW + (size_t)r * 128;
#pragma unroll 2
    for (int mt = 0; mt < 8; ++mt) {
      const int e = idx[mt * 16 + lrow];
      const int sa = p.USC[e];
      const unsigned char* up = p.U8 + (size_t)e * 1024 + kb * 32;
      f32x4 acc = {0.f, 0.f, 0.f, 0.f};
#pragma unroll
      for (int ks = 0; ks < 8; ++ks) {
        uint4 a = *(const uint4*)(up + ks * 128), b = *(const uint4*)(up + ks * 128 + 16);
        i32x8 av;
        av[0] = a.x; av[1] = a.y; av[2] = a.z; av[3] = a.w; av[4] = b.x; av[5] = b.y; av[6] = b.z; av[7] = b.w;
        acc = __builtin_amdgcn_mfma_scale_f32_16x16x128_f8f6f4(av, xb[ks], acc, 0, 0, 0, sa, 0, xs);
      }
      if (lrow == 0) {
        float4 g4 = *(const float4*)(gwt + mt * 16 + 4 * kb);
        *(float4*)(wmine + mt * 16 + 4 * kb) = make_float4(g4.x * gelu_tanh(acc[0]), g4.y * gelu_tanh(acc[1]), g4.z * gelu_tanh(acc[2]), g4.w * gelu_tanh(acc[3]));
      }
    }
    float o[16];
#pragma unroll
    for (int i = 0; i < 16; ++i) o[i] = 0.f;
#pragma unroll 8
    for (int k = 0; k < 128; ++k) {
      const int e = __builtin_amdgcn_readfirstlane(idx[k]);
      const float w = wmine[k] * p.VSCF[e];
      uint4 v = *(const uint4*)(p.V8 + (size_t)e * 1024 + lane * 16);
      f2v t;
      t = __builtin_amdgcn_cvt_pk_f32_fp8((int)v.x, false); o[0] += w * t[0]; o[1] += w * t[1];
      t = __builtin_amdgcn_cvt_pk_f32_fp8((int)v.x, true);  o[2] += w * t[0]; o[3] += w * t[1];
      t = __builtin_amdgcn_cvt_pk_f32_fp8((int)v.y, false); o[4] += w * t[0]; o[5] += w * t[1];
      t = __builtin_amdgcn_cvt_pk_f32_fp8((int)v.y, true);  o[6] += w * t[0]; o[7] += w * t[1];
      t = __builtin_amdgcn_cvt_pk_f32_fp8((int)v.z, false); o[8] += w * t[0]; o[9] += w * t[1];
      t = __builtin_amdgcn_cvt_pk_f32_fp8((int)v.z, true);  o[10] += w * t[0]; o[11] += w * t[1];
      t = __builtin_amdgcn_cvt_pk_f32_fp8((int)v.w, false); o[12] += w * t[0]; o[13] += w * t[1];
      t = __builtin_amdgcn_cvt_pk_f32_fp8((int)v.w, true);  o[14] += w * t[0]; o[15] += w * t[1];
    }
    const float* x1p = p.X1 + (size_t)r * 1024 + lane * 16;
    float* yo = ((r < NP) ? p.out + O_YP + (size_t)r * 1024 : p.out + O_YS + (size_t)(r - NP) * 1024) + lane * 16;
#pragma unroll
    for (int q = 0; q < 4; ++q) {
      float4 xv = *(const float4*)(x1p + q * 4);
      *(float4*)(yo + q * 4) = make_float4(xv.x + o[q * 4], xv.y + o[q * 4 + 1], xv.z + o[q * 4 + 2], xv.w + o[q * 4 + 3]);
    }
  }
}

extern __shared__ __attribute__((aligned(16))) char dyn_smem[];
#define LDS_BYTES 126976
__global__ void __launch_bounds__(NTHR, 2) k_mega(Params p) {
  char* smem = dyn_smem;
  uint4* xbw = (uint4*)(dyn_smem + LDS_BYTES);
  if (threadIdx.x == 0) *xbw = make_uint4(0u, 0u, 0u, 0u);
  __syncthreads();
  XcdBarrier bar = xcd_barrier_post(p.bar, (volatile LAS unsigned*)xbw);
  phase0(p, smem);
  phase_rmsnorm<false>(p.x_prompt, p.x_sample, p.norm_mix, p.XN, nullptr, nullptr);
  xcd_barrier(bar);
  phase_gemm_z(p, smem);
  xcd_barrier(bar);
  phase_post1(p);
  xcd_barrier(bar);
  phase_gemm4(p, smem);
  xcd_barrier(bar);
  phase_post2(p);
  xcd_barrier(bar);
  phase_attn(p, smem);
  xcd_barrier(bar);
  phase_ssm_y(p, smem);
  xcd_barrier(bar);
  phase_gemm_gl(p, smem);
  xcd_barrier(bar);
  phase_cat(p);
  xcd_barrier(bar);
  phase_gemm_out(p, smem);
  xcd_barrier(bar);
  phase_rmsnorm<true>(p.X1, p.X1 + (size_t)NP * 1024, p.norm_ffn, p.XN, p.X8, p.XSC);
  xcd_barrier(bar);
  phase_gemm_pq(p, smem);
  xcd_barrier(bar);
  phase_sctopk(p, smem);
  xcd_barrier(bar);
  phase_gather(p, smem);
}


#ifdef PROBE_MULTI
template <int PH>
__global__ void __launch_bounds__(NTHR, 2) k_phase(Params p) {
  char* smem = dyn_smem;
  if constexpr (PH == 0) { phase0(p, smem); phase_rmsnorm<false>(p.x_prompt, p.x_sample, p.norm_mix, p.XN, nullptr, nullptr); }
  if constexpr (PH == 1) phase_gemm_z(p, smem);
  if constexpr (PH == 2) phase_post1(p);
  if constexpr (PH == 3) phase_gemm4(p, smem);
  if constexpr (PH == 4) phase_post2(p);
  if constexpr (PH == 5) phase_attn(p, smem);
  if constexpr (PH == 6) phase_ssm_y(p, smem);
  if constexpr (PH == 7) phase_gemm_gl(p, smem);
  if constexpr (PH == 8) phase_cat(p);
  if constexpr (PH == 9) phase_gemm_out(p, smem);
  if constexpr (PH == 10) phase_rmsnorm<true>(p.X1, p.X1 + (size_t)NP * 1024, p.norm_ffn, p.XN, p.X8, p.XSC);
  if constexpr (PH == 11) phase_gemm_pq(p, smem);
  if constexpr (PH == 12) phase_sctopk(p, smem);
  if constexpr (PH == 13) phase_gather(p, smem);
}
template <int PH>
static void launch_phase(const Params& p, hipStream_t stream) {
  (void)hipFuncSetAttribute((const void*)k_phase<PH>, hipFuncAttributeMaxDynamicSharedMemorySize, LDS_BYTES + 16);
  const int reps = (PH == PROBE_MULTI) ? 2 : 1;
  for (int i = 0; i < reps; ++i) hipLaunchKernelGGL(k_phase<PH>, dim3(256), dim3(NTHR), LDS_BYTES + 16, stream, p);
}
#endif

extern "C" void kernel_launch(void* const* d_in, const int* in_sizes, int n_in, void* d_out, int out_size, void* d_ws, size_t ws_size,
                              hipStream_t stream) {
  Params p{};
  p.x_prompt = (const float*)d_in[0]; p.x_sample = (const float*)d_in[1]; p.cache_lat = (const float*)d_in[2];
  p.cache_kr = (const float*)d_in[3]; p.state_ssm = (const float*)d_in[4]; p.page_table = (const int*)d_in[5];
  p.norm_mix = (const float*)d_in[6]; p.w_in = (const float*)d_in[7]; p.norm_q_lora = (const float*)d_in[8];
  p.w_uq = (const float*)d_in[9]; p.norm_kv_lora = (const float*)d_in[10]; p.w_uk = (const float*)d_in[11];
  p.w_uv = (const float*)d_in[12]; p.g_qn = (const float*)d_in[13]; p.g_qr = (const float*)d_in[14];
  p.g_kn = (const float*)d_in[15]; p.g_kr = (const float*)d_in[16]; p.a_re = (const float*)d_in[17];
  p.a_im = (const float*)d_in[18]; p.log_dt = (const float*)d_in[19]; p.ssm_b = (const float*)d_in[20];
  p.ssm_c = (const float*)d_in[21]; p.ssm_d = (const float*)d_in[22]; p.w_glu = (const float*)d_in[23];
  p.w_out = (const float*)d_in[24]; p.norm_ffn = (const float*)d_in[25]; p.peer_wq = (const float*)d_in[26];
  p.peer_keys = (const float*)d_in[27]; p.peer_u = (const float*)d_in[28]; p.peer_v = (const float*)d_in[29];
  p.out = (float*)d_out;
  char* w = (char*)d_ws;
  size_t off = 0;
  auto take = [&](size_t bytes) { char* r = w + off; off += (bytes + 255) & ~(size_t)255; return r; };
  p.bar = (unsigned*)take(16384);
  p.WinT = (bf16_t*)take((size_t)1280 * 1024 * 2);
  p.WuqT = (bf16_t*)take((size_t)768 * 384 * 2);
  p.WukT = (bf16_t*)take((size_t)512 * 256 * 2);
  p.WuvT = (bf16_t*)take((size_t)512 * 256 * 2);
  p.WgluT = (bf16_t*)take((size_t)1024 * 512 * 2);
  p.WoutT = (bf16_t*)take((size_t)1024 * 1024 * 2);
  p.WpqT = (bf16_t*)take((size_t)2048 * 1024 * 2);
  p.PK = (bf16_t*)take((size_t)2 * 128 * 128 * 2);
  p.U8 = (unsigned char*)take((size_t)16384 * 1024);
  p.V8 = (unsigned char*)take((size_t)16384 * 1024);
  p.X8 = (unsigned char*)take((size_t)NT * 1024);
  p.USC = (int*)take(16384 * 4);
  p.W8T = (unsigned char*)take(512 * 256);
  p.KW = (int*)take(256);
  p.XSC = (int*)take(NT * 4);
  p.VSCF = (float*)take(16384 * 4);
  p.Bt2 = (bf16_t*)take((size_t)32 * 256 * A2LD * 2);
  p.Emat = (bf16_t*)take((size_t)32 * 128 * 256 * 2);
  p.XN = (bf16_t*)take((size_t)NT * 1024 * 2);
  p.A2 = (bf16_t*)take((size_t)32 * NSUB * A2LD * 2);
  p.CQN = (bf16_t*)take((size_t)NT * 384 * 2);
  p.CKV = (bf16_t*)take((size_t)NT * 256 * 2);
  p.Kcat = (bf16_t*)take((size_t)32 * 4096 * 96 * 2);
  p.KcatS = (bf16_t*)take((size_t)128 * 8 * 4 * 96 * 2);
  p.Qb = (bf16_t*)take((size_t)NT * 8 * 96 * 2);
  p.VT = (bf16_t*)take((size_t)512 * NP * 2);
  p.OATT = (bf16_t*)take((size_t)NT * 512 * 2);
  p.G = (bf16_t*)take((size_t)NT * 512 * 2);
  p.CAT = (bf16_t*)take((size_t)NT * 1024 * 2);
  p.PQ = (bf16_t*)take((size_t)NT * 2048 * 2);
  p.Z = (float*)take((size_t)NT * INW * 4);
  p.Qraw = (float*)take((size_t)NT * 768 * 4);
  p.KNraw = (float*)take((size_t)NT * 512 * 4);
  p.S = (float*)take((size_t)32 * NSUB * 128 * 4);
  p.GL = (float*)take((size_t)NT * 1024 * 4);
  p.X1 = (float*)take((size_t)NT * 1024 * 4);
  p.GW = (float*)take((size_t)NT * 128 * 4);
  p.Opart = (float*)take((size_t)128 * 2 * 32 * 256 * 4);
  p.Lpart = (float*)take((size_t)128 * 2 * 32 * 4);
  p.IDX = (int*)take((size_t)NT * 128 * 4);
  if (off > ws_size) { fprintf(stderr, "workspace too small: need %zu have %zu\n", off, ws_size); return; }
#ifdef PROBE_MULTI
  launch_phase<0>(p, stream); launch_phase<1>(p, stream); launch_phase<2>(p, stream); launch_phase<3>(p, stream);
  launch_phase<4>(p, stream); launch_phase<5>(p, stream); launch_phase<6>(p, stream); launch_phase<7>(p, stream);
  launch_phase<8>(p, stream); launch_phase<9>(p, stream); launch_phase<10>(p, stream); launch_phase<11>(p, stream);
  launch_phase<12>(p, stream); launch_phase<13>(p, stream);
  return;
#endif
  static int grid = 0;
  if (!grid) {
    int dev = 0, cus = 0, per_cu = 0;
    (void)hipGetDevice(&dev);
    (void)hipDeviceGetAttribute(&cus, hipDeviceAttributeMultiprocessorCount, dev);
    (void)hipFuncSetAttribute((const void*)k_mega, hipFuncAttributeMaxDynamicSharedMemorySize, LDS_BYTES + 16);
    (void)hipOccupancyMaxActiveBlocksPerMultiprocessor(&per_cu, k_mega, NTHR, LDS_BYTES + 16);
    if (per_cu < 1) { fprintf(stderr, "k_mega does not fit a CU\n"); return; }
    grid = cus;
  }
  (void)hipMemsetAsync(p.bar, 0, XCD_BAR_WORDS * sizeof(unsigned), stream);
  hipLaunchKernelGGL(k_mega, dim3(grid), dim3(NTHR), LDS_BYTES + 16, stream, p);
}
```

```cpp
#include <hip/hip_runtime.h>
#include <stdint.h>
#include <stdio.h>

typedef __attribute__((ext_vector_type(8))) short bf16x8;
typedef __attribute__((ext_vector_type(4))) short s16x4;
typedef __attribute__((ext_vector_type(16))) float f32x16;
typedef __attribute__((ext_vector_type(2))) __bf16 bf2;
typedef __attribute__((ext_vector_type(2))) float f2v;
typedef unsigned short bf16_t;

#define NTHR 512
#define D_MODEL 1024
#define NP 16384
#define NS 512
#define NT 16896
#define INW 1184
#define NSUB 1152
#define A2LD 384
#define EPS 1e-6f
#define QSCALE 0.14724466f

#define O_YP 0
#define O_YS 16777216
#define O_LATP 17301504
#define O_KRP 21495808
#define O_SSMP 22020096
#define O_LATS 22036480
#define O_KRS 22167552
#define O_SSMS 22183936

struct Params {
  const float *x_prompt, *x_sample, *cache_lat, *cache_kr, *state_ssm;
  const int* page_table;
  const float *norm_mix, *w_in, *norm_q_lora, *w_uq, *norm_kv_lora, *w_uk, *w_uv, *g_qn, *g_qr, *g_kn, *g_kr;
  const float *a_re, *a_im, *log_dt, *ssm_b, *ssm_c, *ssm_d, *w_glu, *w_out, *norm_ffn, *peer_wq, *peer_keys, *peer_u, *peer_v;
  float* out;
  unsigned* bar;
  bf16_t *WinT, *WuqT, *WukT, *WuvT, *WgluT, *WoutT, *WpqT, *PK, *Bt2, *Emat;
  bf16_t *XN, *A2, *CQN, *CKV, *Kcat, *KcatS, *Qb, *VT, *OATT, *G, *CAT, *PQ;
  float *Z, *Qraw, *KNraw, *S, *GL, *X1, *GW, *Opart, *Lpart;
  int* IDX;
  unsigned char *U8, *V8, *X8, *W8T;
  int* KW;
  int *USC, *XSC;
  float* VSCF;
};


#define XB_TMO      128
#define XB_XCNT(j)  (256  + 64 * (j))
#define XB_XSUB(j)  (1280 + 64 * (j))
#define XB_XGEN(j)  (2304 + 64 * (j))
#define XB_TOP      3328
#define XB_TOPGEN   3392
#define XCD_BAR_WORDS 3456
#define XB_SPIN_CAP (1u << 18)
#define LAS __attribute__((address_space(3)))

__device__ __forceinline__ unsigned xb_ld(unsigned* p)              { return __hip_atomic_load(p, __ATOMIC_RELAXED, __HIP_MEMORY_SCOPE_AGENT); }
__device__ __forceinline__ unsigned xb_add(unsigned* p, unsigned v) { return __hip_atomic_fetch_add(p, v, __ATOMIC_RELAXED, __HIP_MEMORY_SCOPE_AGENT); }
__device__ __forceinline__ unsigned xb_xcc_id() { return (unsigned)__builtin_amdgcn_s_getreg((3 << 11) | 20) & 0xFu; }
#define XB_SPIN(cond, bar) do { unsigned _sp = 0; while (cond) { __builtin_amdgcn_s_sleep(1); \
    if ((++_sp & 255u) == 0u) { if (xb_ld(&(bar)[XB_TMO])) break; if (_sp > XB_SPIN_CAP) { atomicAdd(&(bar)[XB_TMO], 1u); break; } } } } while (0)

struct XcdBarrier {
    unsigned* bar; unsigned x;
    volatile LAS unsigned* st;
};

__device__ __forceinline__ XcdBarrier xcd_barrier_post(unsigned* bar, volatile LAS unsigned* st) {
    XcdBarrier b; b.bar = bar; b.x = xb_xcc_id(); b.st = st;
    if (threadIdx.x == 0) (void)xb_add(&bar[XB_XCNT(b.x)], 1u);
    return b;
}
__device__ __forceinline__ void xcd_barrier_complete(unsigned* bar, unsigned x, unsigned& nloc, unsigned& nx) {
    const unsigned G = gridDim.x * gridDim.y * gridDim.z;
    unsigned sum, cnt, mine, sp = 0u;
    for (;;) {
        sum = 0u; cnt = 0u; mine = 0u;
#pragma unroll
        for (unsigned j = 0; j < 16; ++j) { const unsigned c = xb_ld(&bar[XB_XCNT(j)]); sum += c; cnt += (c > 0u) ? 1u : 0u; mine = (j == x) ? c : mine; }
        if (sum == G) break;
        __builtin_amdgcn_s_sleep(1);
        if ((++sp & 255u) == 0u) { if (xb_ld(&bar[XB_TMO])) break; if (sp > XB_SPIN_CAP) { atomicAdd(&bar[XB_TMO], 1u); break; } }
    }
    nloc = mine > 0u ? mine : 1u; nx = cnt > 0u ? cnt : 1u;
}

__device__ __forceinline__ void xcd_barrier(const XcdBarrier& b) {
    asm volatile("s_waitcnt vmcnt(0)" ::: "memory");
    __syncthreads();
    if (threadIdx.x == 0) {
        unsigned* bar = b.bar;
        __builtin_amdgcn_s_waitcnt(0);
        unsigned nloc = b.st[0], nx = b.st[1];
        if (nloc == 0u) { xcd_barrier_complete(bar, b.x, nloc, nx); b.st[0] = nloc; b.st[1] = nx; }
        const unsigned old = xb_add(&bar[XB_XSUB(b.x)], 1u);
        const unsigned gen = old / nloc;
        if (old + 1u == (gen + 1u) * nloc) {
            __builtin_amdgcn_fence(__ATOMIC_RELEASE, "agent");
            asm volatile("s_waitcnt vmcnt(0)" ::: "memory");
            const unsigned og = xb_add(&bar[XB_TOP], 1u);
            const unsigned tg = og / nx;
            if (og + 1u == (tg + 1u) * nx) xb_add(&bar[XB_TOPGEN], 1u);
            else XB_SPIN(xb_ld(&bar[XB_TOPGEN]) == tg, bar);
            __builtin_amdgcn_fence(__ATOMIC_ACQUIRE, "agent");
            xb_add(&bar[XB_XGEN(b.x)], 1u);
            asm volatile("s_waitcnt vmcnt(0)" ::: "memory");
        } else {
            XB_SPIN(xb_ld(&bar[XB_XGEN(b.x)]) == gen, bar);
            __builtin_amdgcn_fence(__ATOMIC_ACQUIRE, "agent");
            asm volatile("s_waitcnt vmcnt(0)" ::: "memory");
        }
    }
    __syncthreads();
}

__device__ __forceinline__ int tidx() { int t = threadIdx.x; asm volatile("" : "+v"(t)); return t; }
__device__ __forceinline__ unsigned pk2(float a, float b) {
  f2v v = {a, b};
  bf2 r = __builtin_convertvector(v, bf2);
  return __builtin_bit_cast(unsigned, r);
}
__device__ __forceinline__ bf16_t f2bf(float a) { return (bf16_t)(pk2(a, 0.f) & 0xffffu); }
__device__ __forceinline__ float bf2f(bf16_t x) { return __uint_as_float(((unsigned)x) << 16); }
__device__ __forceinline__ float bflo(unsigned x) { return __uint_as_float(x << 16); }
__device__ __forceinline__ float bfhi(unsigned x) { return __uint_as_float(x & 0xffff0000u); }
__device__ __forceinline__ float wave_sum(float v) {
  v += __shfl_xor(v, 32); v += __shfl_xor(v, 16); v += __shfl_xor(v, 8);
  v += __shfl_xor(v, 4);  v += __shfl_xor(v, 2);  v += __shfl_xor(v, 1);
  return v;
}
__device__ __forceinline__ float gelu_tanh(float x) {
  float u = 0.7978845608028654f * (x + 0.044715f * x * x * x);
  float e = __expf(2.f * u);
  float t = 1.f - 2.f / (1.f + e);
  return 0.5f * x * (1.f + t);
}
__device__ __forceinline__ void sincos_rev(float ang, float& s, float& c) {
  float rev = ang * 0.15915494309189535f;
  rev = rev - floorf(rev);
  s = __builtin_amdgcn_sinf(rev);
  c = __builtin_amdgcn_cosf(rev);
}
__device__ __forceinline__ f32x16 mfma32(bf16x8 a, bf16x8 b, f32x16 c) {
  return __builtin_amdgcn_mfma_f32_32x32x16_bf16(a, b, c, 0, 0, 0);
}
__device__ __forceinline__ bf16x8 mk8(unsigned a, unsigned b, unsigned c, unsigned d) {
  uint4 u = make_uint4(a, b, c, d);
  return __builtin_bit_cast(bf16x8, u);
}

#define GLD 72
template <int MT, class Epi>
__device__ __forceinline__ void gemm_tile(const bf16_t* __restrict__ A, int lda, const bf16_t* __restrict__ Bt, int ldb,
                                          int K, int m0, int n0, char* smem, Epi epi) {
  constexpr int BM = 128 * MT;
  bf16_t* As = (bf16_t*)smem;
  bf16_t* Bs = As + 2 * BM * GLD;
  const int tid = tidx(), lane = tid & 63, wave = tid >> 6;
  const int wm = wave >> 1, wn = wave & 1, lr = lane & 31, hh = lane >> 5;
  uint4 ra[2 * MT], rb[2];
  f32x16 acc[MT][2];
#pragma unroll
  for (int i = 0; i < MT; ++i)
#pragma unroll
    for (int j = 0; j < 2; ++j)
#pragma unroll
      for (int r = 0; r < 16; ++r) acc[i][j][r] = 0.f;
  const int nk = K / 64;
  auto gload = [&](int k0) {
#pragma unroll
    for (int i = 0; i < 2 * MT; ++i) {
      int c = tid + NTHR * i, row = c >> 3, cc = c & 7;
      ra[i] = *(const uint4*)(A + (size_t)(m0 + row) * lda + k0 + cc * 8);
    }
#pragma unroll
    for (int i = 0; i < 2; ++i) {
      int c = tid + NTHR * i, row = c >> 3, cc = c & 7;
      rb[i] = *(const uint4*)(Bt + (size_t)(n0 + row) * ldb + k0 + cc * 8);
    }
  };
  auto lstore = [&](int buf) {
#pragma unroll
    for (int i = 0; i < 2 * MT; ++i) {
      int c = tid + NTHR * i, row = c >> 3, cc = c & 7;
      *(uint4*)(As + (buf * BM + row) * GLD + cc * 8) = ra[i];
    }
#pragma unroll
    for (int i = 0; i < 2; ++i) {
      int c = tid + NTHR * i, row = c >> 3, cc = c & 7;
      *(uint4*)(Bs + (buf * 128 + row) * GLD + cc * 8) = rb[i];
    }
  };
  gload(0);
  lstore(0);
  __syncthreads();
  for (int kt = 0; kt < nk; ++kt) {
    const int buf = kt & 1;
    if (kt + 1 < nk) gload((kt + 1) * 64);
#pragma unroll
    for (int ks = 0; ks < 4; ++ks) {
      bf16x8 a[MT], b[2];
#pragma unroll
      for (int i = 0; i < MT; ++i) a[i] = *(const bf16x8*)(As + (buf * BM + wm * 32 * MT + i * 32 + lr) * GLD + ks * 16 + hh * 8);
#pragma unroll
      for (int j = 0; j < 2; ++j) b[j] = *(const bf16x8*)(Bs + (buf * 128 + wn * 64 + j * 32 + lr) * GLD + ks * 16 + hh * 8);
#pragma unroll
      for (int i = 0; i < MT; ++i)
#pragma unroll
        for (int j = 0; j < 2; ++j) acc[i][j] = mfma32(a[i], b[j], acc[i][j]);
    }
    if (kt + 1 < nk) lstore(buf ^ 1);
    __syncthreads();
  }
#pragma unroll
  for (int i = 0; i < MT; ++i)
#pragma unroll
    for (int j = 0; j < 2; ++j)
#pragma unroll
      for (int r = 0; r < 16; ++r) {
        int m = m0 + wm * 32 * MT + i * 32 + (r & 3) + 8 * (r >> 2) + 4 * hh;
        int n = n0 + wn * 64 + j * 32 + lr;
        epi(m, n, acc[i][j][r]);
      }
}

struct Cplx { float re, im; };
__device__ __forceinline__ Cplx cmul(Cplx a, Cplx b) { return {a.re * b.re - a.im * b.im, a.re * b.im + a.im * b.re}; }
__device__ __forceinline__ Cplx apow(float are, float aim, float dt, float m) {
  float mag = __expf(m * dt * are);
  float s, c;
  sincos_rev(m * dt * aim, s, c);
  return {mag * c, mag * s};
}
__device__ __forceinline__ Cplx bscale(float are, float aim, float dt) {
  Cplx ab = apow(are, aim, dt, 1.f);
  float nr = ab.re - 1.f, ni = ab.im;
  float den = are * are + aim * aim;
  return {(nr * are + ni * aim) / den, (ni * are - nr * aim) / den};
}

__device__ __forceinline__ void tr_cvt(const float* __restrict__ W, bf16_t* __restrict__ Wt, int K, int N, int Npad, size_t gt, size_t GT) {
  size_t tot = (size_t)K * Npad;
  for (size_t i = gt; i < tot; i += GT) {
    int n = (int)(i / K), k = (int)(i % K);
    Wt[i] = (n < N) ? f2bf(W[(size_t)k * N + n]) : (bf16_t)0;
  }
}
__device__ __forceinline__ void cvt_flat(const float* __restrict__ W, bf16_t* __restrict__ Wb, size_t n4, size_t gt, size_t GT) {
  for (size_t i = gt; i < n4; i += GT) {
    float4 v = ((const float4*)W)[i];
    ((uint2*)Wb)[i] = make_uint2(pk2(v.x, v.y), pk2(v.z, v.w));
  }
}
__device__ void phase0(const Params& p, char* smem) {
  if (blockIdx.x < 8) {
    float* red = (float*)smem;
    const int h = blockIdx.x, tid = tidx(), d = tid & 63, c0 = (tid >> 6) * 32;
    float v[32];
    float am = 0.f;
#pragma unroll
    for (int i = 0; i < 32; ++i) { v[i] = p.w_uk[(size_t)(c0 + i) * 512 + h * 64 + d]; am = fmaxf(am, fabsf(v[i])); }
#pragma unroll
    for (int o = 32; o >= 1; o >>= 1) am = fmaxf(am, __shfl_xor(am, o));
    if ((tid & 63) == 0) red[tid >> 6] = am;
    __syncthreads();
    am = red[0];
#pragma unroll
    for (int i = 1; i < 8; ++i) am = fmaxf(am, red[i]);
    int E = (int)((__float_as_uint(am) >> 23) & 0xffu) - 127;
    E = E < -60 ? -60 : E;
    const int k = 7 - E;
    const float sc = __uint_as_float((unsigned)(k + 127) << 23);
    unsigned w[8];
#pragma unroll
    for (int i = 0; i < 8; ++i) {
      int pk = 0;
      pk = __builtin_amdgcn_cvt_pk_fp8_f32(v[4 * i] * sc, v[4 * i + 1] * sc, pk, false);
      pk = __builtin_amdgcn_cvt_pk_fp8_f32(v[4 * i + 2] * sc, v[4 * i + 3] * sc, pk, true);
      w[i] = (unsigned)pk;
    }
    unsigned char* dst = p.W8T + (size_t)(h * 64 + d) * 256 + c0;
    *(uint4*)dst = make_uint4(w[0], w[1], w[2], w[3]);
    *(uint4*)(dst + 16) = make_uint4(w[4], w[5], w[6], w[7]);
    if (tid == 0) p.KW[h] = k;
    __syncthreads();
  }
  const size_t gt = (size_t)blockIdx.x * NTHR + tidx(), GT = (size_t)gridDim.x * NTHR;
  tr_cvt(p.w_in, p.WinT, 1024, INW, 1280, gt, GT);
  tr_cvt(p.w_uq, p.WuqT, 384, 768, 768, gt, GT);
  tr_cvt(p.w_uk, p.WukT, 256, 512, 512, gt, GT);
  tr_cvt(p.w_uv, p.WuvT, 256, 512, 512, gt, GT);
  tr_cvt(p.w_glu, p.WgluT, 512, 1024, 1024, gt, GT);
  tr_cvt(p.w_out, p.WoutT, 1024, 1024, 1024, gt, GT);
  tr_cvt(p.peer_wq, p.WpqT, 1024, 2048, 2048, gt, GT);
  cvt_flat(p.peer_keys, p.PK, 2 * 128 * 128 / 4, gt, GT);
  {
    const int lane = tidx() & 63, gw = blockIdx.x * 8 + (tidx() >> 6), GWv = gridDim.x * 8;
    for (int row = gw; row < 2 * 16384; row += GWv) {
      const bool isU = row < 16384;
      const int e = isU ? row : row - 16384;
      const float* src = (isU ? p.peer_u : p.peer_v) + (size_t)e * 1024 + lane * 16;
      float4 v[4];
      float am = 0.f;
#pragma unroll
      for (int i = 0; i < 4; ++i) {
        v[i] = ((const float4*)src)[i];
        am = fmaxf(am, fmaxf(fmaxf(fabsf(v[i].x), fabsf(v[i].y)), fmaxf(fabsf(v[i].z), fabsf(v[i].w))));
      }
#pragma unroll
      for (int o = 32; o >= 1; o >>= 1) am = fmaxf(am, __shfl_xor(am, o));
      int E = (int)((__float_as_uint(am) >> 23) & 0xffu) - 127;
      E = E < -60 ? -60 : E;
      const int k = 7 - E;
      const float sc = __uint_as_float((unsigned)(k + 127) << 23);
      unsigned w[4];
#pragma unroll
      for (int i = 0; i < 4; ++i) {
        int pk = 0;
        pk = __builtin_amdgcn_cvt_pk_fp8_f32(v[i].x * sc, v[i].y * sc, pk, false);
        pk = __builtin_amdgcn_cvt_pk_fp8_f32(v[i].z * sc, v[i].w * sc, pk, true);
        w[i] = (unsigned)pk;
      }
      unsigned char* dst = (isU ? p.U8 : p.V8) + (size_t)e * 1024 + lane * 16;
      *(uint4*)dst = make_uint4(w[0], w[1], w[2], w[3]);
      if (lane == 0) {
        if (isU) p.USC[e] = 127 - k;
        else p.VSCF[e] = __uint_as_float((unsigned)(127 - k) << 23);
      }
    }
  }
  {
    size_t tot = (size_t)32 * 128 * 256 / 8;
    for (size_t i = gt; i < tot; i += GT) {
      int g = (int)(i / (128 * 32)), rem = (int)(i % (128 * 32)), n = rem / 32, c8 = rem % 32;
      *(uint4*)(p.A2 + ((size_t)g * NSUB + 1024 + n) * A2LD + c8 * 8) = make_uint4(0, 0, 0, 0);
    }
  }
  {
    size_t tot = (size_t)32 * 16 * 256;
    for (size_t i = gt; i < tot; i += GT) {
      int g = (int)(i / 4096), rem = (int)(i % 4096), m = rem >> 8, h = (rem >> 4) & 15, h2 = rem & 15;
      float dt = __expf(p.log_dt[g]);
      float acc = 0.f;
      for (int pp = 0; pp < 64; ++pp) {
        float are = p.a_re[g * 64 + pp], aim = p.a_im[g * 64 + pp];
        Cplx am = apow(are, aim, dt, (float)m);
        Cplx bs = bscale(are, aim, dt);
        Cplx bb = {p.ssm_b[((g * 64 + pp) * 16 + h2) * 2], p.ssm_b[((g * 64 + pp) * 16 + h2) * 2 + 1]};
        Cplx cc = {p.ssm_c[((g * 16 + h) * 64 + pp) * 2], p.ssm_c[((g * 16 + h) * 64 + pp) * 2 + 1]};
        Cplx x = cmul(cmul(am, bs), bb);
        acc += cc.re * x.re - cc.im * x.im;
      }
      if (m == 0 && h == h2) acc += p.ssm_d[g * 16 + h];
      bf16_t v = f2bf(acc);
      for (int t = m; t < 16; ++t) {
        int j = t - m;
        p.Bt2[((size_t)g * 256 + t * 16 + h) * A2LD + j * 16 + h2] = v;
      }
      if (m == 0) {
        for (int t = 0; t < 16; ++t)
          for (int j = t + 1; j < 16; ++j) p.Bt2[((size_t)g * 256 + t * 16 + h) * A2LD + j * 16 + h2] = 0;
      }
    }
    tot = (size_t)32 * 256 * 64;
    for (size_t i = gt; i < tot; i += GT) {
      int g = (int)(i / 16384), rem = (int)(i % 16384), th = rem >> 6, pp = rem & 63, t = th >> 4, h = th & 15;
      float dt = __expf(p.log_dt[g]);
      float are = p.a_re[g * 64 + pp], aim = p.a_im[g * 64 + pp];
      Cplx am = apow(are, aim, dt, (float)(t + 1));
      Cplx cc = {p.ssm_c[((g * 16 + h) * 64 + pp) * 2], p.ssm_c[((g * 16 + h) * 64 + pp) * 2 + 1]};
      p.Bt2[((size_t)g * 256 + th) * A2LD + 256 + pp] = f2bf(cc.re * am.re - cc.im * am.im);
      p.Bt2[((size_t)g * 256 + th) * A2LD + 320 + pp] = f2bf(-(cc.re * am.im + cc.im * am.re));
    }
    tot = (size_t)32 * 64 * 256;
    for (size_t i = gt; i < tot; i += GT) {
      int g = (int)(i / 16384), rem = (int)(i % 16384), pp = rem >> 8, jh = rem & 255, j = jh >> 4, h2 = jh & 15;
      float dt = __expf(p.log_dt[g]);
      float are = p.a_re[g * 64 + pp], aim = p.a_im[g * 64 + pp];
      Cplx am = apow(are, aim, dt, (float)(15 - j));
      Cplx bs = bscale(are, aim, dt);
      Cplx bb = {p.ssm_b[((g * 64 + pp) * 16 + h2) * 2], p.ssm_b[((g * 64 + pp) * 16 + h2) * 2 + 1]};
      Cplx x = cmul(cmul(am, bs), bb);
      p.Emat[((size_t)g * 128 + pp) * 256 + jh] = f2bf(x.re);
      p.Emat[((size_t)g * 128 + 64 + pp) * 256 + jh] = f2bf(x.im);
    }
  }
}

template <bool FP8OUT>
__device__ void phase_rmsnorm(const float* __restrict__ srcP, const float* __restrict__ srcS, const float* __restrict__ gain,
                              bf16_t* __restrict__ dst, unsigned char* __restrict__ dst8, int* __restrict__ xsc) {
  const int lane = tidx() & 63, gw = blockIdx.x * 8 + (tidx() >> 6), GW = gridDim.x * 8;
  float4 g[4];
#pragma unroll
  for (int i = 0; i < 4; ++i) g[i] = *(const float4*)(gain + lane * 4 + 256 * i);
  for (int r = gw; r < NT; r += GW) {
    const float* src = (r < NP) ? srcP + (size_t)r * 1024 : srcS + (size_t)(r - NP) * 1024;
    float4 v[4];
    float ss = 0.f;
#pragma unroll
    for (int i = 0; i < 4; ++i) {
      v[i] = *(const float4*)(src + lane * 4 + 256 * i);
      ss += v[i].x * v[i].x + v[i].y * v[i].y + v[i].z * v[i].z + v[i].w * v[i].w;
    }
    ss = wave_sum(ss);
    float rinv = rsqrtf(ss * (1.f / 1024.f) + EPS);
#pragma unroll
    for (int i = 0; i < 4; ++i) {
      uint2 o = make_uint2(pk2(v[i].x * rinv * g[i].x, v[i].y * rinv * g[i].y), pk2(v[i].z * rinv * g[i].z, v[i].w * rinv * g[i].w));
      *(uint2*)(dst + (size_t)r * 1024 + lane * 4 + 256 * i) = o;
    }
    if constexpr (FP8OUT) {
      float am = 0.f;
#pragma unroll
      for (int i = 0; i < 4; ++i) {
        v[i].x *= rinv * g[i].x; v[i].y *= rinv * g[i].y; v[i].z *= rinv * g[i].z; v[i].w *= rinv * g[i].w;
        am = fmaxf(am, fmaxf(fmaxf(fabsf(v[i].x), fabsf(v[i].y)), fmaxf(fabsf(v[i].z), fabsf(v[i].w))));
      }
#pragma unroll
      for (int o = 32; o >= 1; o >>= 1) am = fmaxf(am, __shfl_xor(am, o));
      int E = (int)((__float_as_uint(am) >> 23) & 0xffu) - 127;
      E = E < -60 ? -60 : E;
      const int k = 7 - E;
      const float sc = __uint_as_float((unsigned)(k + 127) << 23);
#pragma unroll
      for (int i = 0; i < 4; ++i) {
        int pk = 0;
        pk = __builtin_amdgcn_cvt_pk_fp8_f32(v[i].x * sc, v[i].y * sc, pk, false);
        pk = __builtin_amdgcn_cvt_pk_fp8_f32(v[i].z * sc, v[i].w * sc, pk, true);
        *(unsigned*)(dst8 + (size_t)r * 1024 + lane * 4 + 256 * i) = (unsigned)pk;
      }
      if (lane == 0) xsc[r] = 127 - k;
    }
  }
}

__device__ void phase_gemm_z(const Params& p, char* smem) {
  const int ntn = 10, ntm = NT / 256;
  for (int t = blockIdx.x; t < ntm * ntn; t += gridDim.x) {
    int tm = t / ntn, tn = t % ntn;
    float* Z = p.Z;
    gemm_tile<2>(p.XN, 1024, p.WinT, 1024, 1024, tm * 256, tn * 128, smem, [=](int m, int n, float v) {
      if (n < INW) Z[(size_t)m * INW + n] = v;
    });
  }
}

__device__ void phase_post1(const Params& p) {
  const int lane = tidx() & 63, gw = blockIdx.x * 8 + (tidx() >> 6), GW = gridDim.x * 8;
  for (int r = gw; r < NT; r += GW) {
    const float* z = p.Z + (size_t)r * INW;
    const bool isP = r < NP;
    const int rs = r - NP;
    {
      float4 a = *(const float4*)(z + lane * 8), b = *(const float4*)(z + lane * 8 + 4);
      int g = lane >> 1, h0 = (lane & 1) * 8;
      int n = isP ? (r >> 4) : (1024 + (rs >> 2));
      int t = isP ? (r & 15) : (rs & 3);
      *(uint4*)(p.A2 + ((size_t)g * NSUB + n) * A2LD + t * 16 + h0) = make_uint4(pk2(a.x, a.y), pk2(a.z, a.w), pk2(b.x, b.y), pk2(b.z, b.w));
    }
    {
      float2 v[3];
      float ss = 0.f;
#pragma unroll
      for (int i = 0; i < 3; ++i) {
        v[i] = *(const float2*)(z + 512 + lane * 2 + 128 * i);
        ss += v[i].x * v[i].x + v[i].y * v[i].y;
      }
      ss = wave_sum(ss);
      float rinv = rsqrtf(ss * (1.f / 384.f) + EPS);
#pragma unroll
      for (int i = 0; i < 3; ++i) {
        float2 g = *(const float2*)(p.norm_q_lora + lane * 2 + 128 * i);
        *(unsigned*)(p.CQN + (size_t)r * 384 + lane * 2 + 128 * i) = pk2(v[i].x * rinv * g.x, v[i].y * rinv * g.y);
      }
    }
    {
      float4 v = *(const float4*)(z + 896 + lane * 4);
      float ss = wave_sum(v.x * v.x + v.y * v.y + v.z * v.z + v.w * v.w);
      float rinv = rsqrtf(ss * (1.f / 256.f) + EPS);
      float4 g = *(const float4*)(p.norm_kv_lora + lane * 4);
      float4 o = make_float4(v.x * rinv * g.x, v.y * rinv * g.y, v.z * rinv * g.z, v.w * rinv * g.w);
      float* dst = isP ? p.out + O_LATP + (size_t)r * 256 : p.out + O_LATS + (size_t)rs * 256;
      *(float4*)(dst + lane * 4) = o;
      *(uint2*)(p.CKV + (size_t)r * 256 + lane * 4) = make_uint2(pk2(o.x, o.y), pk2(o.z, o.w));
    }
    {
      float v = (lane < 32) ? z[1152 + lane] : 0.f;
      float ss = wave_sum(v * v);
      float rinv = rsqrtf(ss * (1.f / 32.f) + EPS);
      float gn = (lane < 32) ? p.g_kr[lane] : 0.f;
      float xv = v * rinv * gn;
      float other = __shfl_xor(xv, 16);
      int i = lane & 15;
      float pos = isP ? (float)(r & 4095) : (float)(8192 + (rs & 3));
      float inv = exp2f(-(float)i * (13.287712379549449f / 16.f));
      float sn, cs;
      sincos_rev(pos * inv, sn, cs);
      float o = (lane & 16) ? (xv * cs + other * sn) : (xv * cs - other * sn);
      if (lane < 32) {
        float* dst = isP ? p.out + O_KRP + (size_t)r * 32 : p.out + O_KRS + (size_t)rs * 32;
        dst[lane] = o;
        bf16_t ob = f2bf(o);
        if (isP) {
          int b = r >> 12, t = r & 4095;
#pragma unroll
          for (int h = 0; h < 8; ++h) p.Kcat[((size_t)(b * 8 + h) * 4096 + t) * 96 + 64 + lane] = ob;
        } else {
          int seq = rs >> 2, t = rs & 3;
#pragma unroll
          for (int h = 0; h < 8; ++h) p.KcatS[((size_t)(seq * 8 + h) * 4 + t) * 96 + 64 + lane] = ob;
        }
      }
    }
  }
}

__device__ void phase_gemm4(const Params& p, char* smem) {
  const int nq = 66 * 6, nk = 66 * 4, nv = 2 * 128, ns = 32 * 9;
  const int total = nq + nk + nv + ns;
  for (int t = blockIdx.x; t < total; t += gridDim.x) {
    if (t < nq) {
      int tm = t / 6, tn = t % 6;
      float* C = p.Qraw;
      gemm_tile<2>(p.CQN, 384, p.WuqT, 384, 384, tm * 256, tn * 128, smem, [=](int m, int n, float v) { C[(size_t)m * 768 + n] = v; });
    } else if (t < nq + nk) {
      int u = t - nq, tm = u / 4, tn = u % 4;
      float* C = p.KNraw;
      gemm_tile<2>(p.CKV, 256, p.WukT, 256, 256, tm * 256, tn * 128, smem, [=](int m, int n, float v) { C[(size_t)m * 512 + n] = v; });
    } else if (t < nq + nk + nv) {
      int u = t - nq - nk, tm = u / 128, tn = u % 128;
      bf16_t* C = p.VT;
      gemm_tile<2>(p.WuvT, 256, p.CKV, 256, 256, tm * 256, tn * 128, smem, [=](int m, int n, float v) { C[(size_t)m * NP + n] = f2bf(v); });
    } else {
      int u = t - nq - nk - nv, g = u / 9, tm = u % 9;
      float* C = p.S + (size_t)g * NSUB * 128;
      gemm_tile<1>(p.A2 + (size_t)g * NSUB * A2LD, A2LD, p.Emat + (size_t)g * 128 * 256, 256, 256, tm * 128, 0, smem,
                   [=](int m, int n, float v) { C[(size_t)m * 128 + n] = v; });
    }
  }
}

__device__ void phase_post2(const Params& p) {
  const int lane = tidx() & 63, gw = blockIdx.x * 8 + (tidx() >> 6), GW = gridDim.x * 8;
  const float gqn = p.g_qn[lane], gkn = p.g_kn[lane];
  const float gqr = p.g_qr[lane & 31];
  const float inv = exp2f(-(float)(lane & 15) * (13.287712379549449f / 16.f));
  for (int r = gw; r < NT; r += GW) {
    const bool isP = r < NP;
    const int rs = r - NP;
    float pos = isP ? (float)(r & 4095) : (float)(8192 + (rs & 3));
    float sn, cs;
    sincos_rev(pos * inv, sn, cs);
#pragma unroll 1
    for (int h = 0; h < 8; ++h) {
      const float* q = p.Qraw + (size_t)r * 768 + h * 96;
      float v = q[lane];
      float ss = wave_sum(v * v);
      float rinv = rsqrtf(ss * (1.f / 64.f) + EPS);
      p.Qb[((size_t)r * 8 + h) * 96 + lane] = f2bf(v * rinv * gqn * QSCALE);
      float w = (lane < 32) ? q[64 + lane] : 0.f;
      float s2 = wave_sum(w * w);
      float rinv2 = rsqrtf(s2 * (1.f / 32.f) + EPS);
      float xv = w * rinv2 * gqr;
      float other = __shfl_xor(xv, 16);
      float o = (lane & 16) ? (xv * cs + other * sn) : (xv * cs - other * sn);
      if (lane < 32) p.Qb[((size_t)r * 8 + h) * 96 + 64 + lane] = f2bf(o * QSCALE);
      float kv = p.KNraw[(size_t)r * 512 + h * 64 + lane];
      float ks = wave_sum(kv * kv);
      float krinv = rsqrtf(ks * (1.f / 64.f) + EPS);
      bf16_t kb = f2bf(kv * krinv * gkn);
      if (isP) {
        int b = r >> 12, t = r & 4095;
        p.Kcat[((size_t)(b * 8 + h) * 4096 + t) * 96 + lane] = kb;
      } else {
        int seq = rs >> 2, t = rs & 3;
        p.KcatS[((size_t)(seq * 8 + h) * 4 + t) * 96 + lane] = kb;
      }
    }
  }
}

__device__ __forceinline__ float softmax_bound(const Params& p) {
  const int lane = tidx() & 63;
  float a = fabsf(p.g_qn[lane]), b = fabsf(p.g_kn[lane]), c = fabsf(p.g_qr[lane & 31]), d = fabsf(p.g_kr[lane & 31]);
#pragma unroll
  for (int o = 32; o >= 1; o >>= 1) {
    a = fmaxf(a, __shfl_xor(a, o)); b = fmaxf(b, __shfl_xor(b, o));
    c = fmaxf(c, __shfl_xor(c, o)); d = fmaxf(d, __shfl_xor(d, o));
  }
  return QSCALE * (64.f * a * b + 32.f * c * d);
}

#define KLD 104
#define VLD 68
__device__ __forceinline__ void attn_prompt_block(const Params& p, char* smem, int b, int h, int qi, float Mb) {
  bf16_t* Ks = (bf16_t*)smem;
  bf16_t* Vs = Ks + 2 * 64 * KLD;
  const int tid = tidx(), lane = tid & 63, wave = tid >> 6, lr = lane & 31, hh = lane >> 5;
  const int q0 = qi * 256 + wave * 32;
  const bf16_t* Kg = p.Kcat + (size_t)(b * 8 + h) * 4096 * 96;
  const bf16_t* Vg = p.VT + (size_t)(h * 64) * NP + b * 4096;
  bf16x8 qf[6];
  {
    const bf16_t* qp = p.Qb + ((size_t)(b * 4096 + q0 + lr) * 8 + h) * 96 + hh * 8;
#pragma unroll
    for (int s = 0; s < 6; ++s) qf[s] = *(const bf16x8*)(qp + s * 16);
  }
  f32x16 ot[2];
#pragma unroll
  for (int i = 0; i < 2; ++i)
#pragma unroll
    for (int r = 0; r < 16; ++r) ot[i][r] = 0.f;
  float lsum = 0.f;
  const int nkt = 4 * (qi + 1);
  uint4 rk[2];
  uint2 rv[2];
  auto gload = [&](int kt) {
    const int k0 = kt * 64;
#pragma unroll
    for (int i = 0; i < 2; ++i) {
      int c = tid + NTHR * i;
      c = c < 768 ? c : 767;
      int row = c / 12, cc = c % 12;
      rk[i] = *(const uint4*)(Kg + (size_t)(k0 + row) * 96 + cc * 8);
    }
#pragma unroll
    for (int i = 0; i < 2; ++i) {
      int c = tid + NTHR * i, row = c >> 4, cc = c & 15;
      rv[i] = *(const uint2*)(Vg + (size_t)row * NP + k0 + cc * 4);
    }
  };
  auto lstore = [&](int buf) {
#pragma unroll
    for (int i = 0; i < 2; ++i) {
      int c = tid + NTHR * i;
      if (c < 768) { int row = c / 12, cc = c % 12; *(uint4*)(Ks + (buf * 64 + row) * KLD + cc * 8) = rk[i]; }
    }
#pragma unroll
    for (int i = 0; i < 2; ++i) {
      int c = tid + NTHR * i, row = c >> 4, cc = c & 15;
      *(uint2*)(Vs + (buf * 64 + row) * VLD + cc * 4) = rv[i];
    }
  };
  gload(0);
  lstore(0);
  __syncthreads();
  for (int kt = 0; kt < nkt; ++kt) {
    const int buf = kt & 1, k0 = kt * 64;
    if (kt + 1 < nkt) gload(kt + 1);
    if (k0 <= q0 + 31) {
      const bool need_mask = (k0 + 63 > q0);
      bf16x8 pb[2][2];
#pragma unroll
      for (int kt2 = 0; kt2 < 2; ++kt2) {
        f32x16 st;
#pragma unroll
        for (int r = 0; r < 16; ++r) st[r] = 0.f;
#pragma unroll
        for (int s = 0; s < 6; ++s) {
          bf16x8 a = *(const bf16x8*)(Ks + (buf * 64 + kt2 * 32 + lr) * KLD + s * 16 + hh * 8);
          st = mfma32(a, qf[s], st);
        }
        float pv[16];
#pragma unroll
        for (int r = 0; r < 16; ++r) {
          float e = exp2f(st[r] - Mb);
          if (need_mask) {
            int key = k0 + kt2 * 32 + (r & 3) + 8 * (r >> 2) + 4 * hh;
            e = (key <= q0 + lr) ? e : 0.f;
          }
          pv[r] = e;
          lsum += e;
        }
#pragma unroll
        for (int s2 = 0; s2 < 2; ++s2)
          pb[kt2][s2] = mk8(pk2(pv[8 * s2 + 0], pv[8 * s2 + 1]), pk2(pv[8 * s2 + 2], pv[8 * s2 + 3]),
                            pk2(pv[8 * s2 + 4], pv[8 * s2 + 5]), pk2(pv[8 * s2 + 6], pv[8 * s2 + 7]));
      }
#pragma unroll
      for (int dt = 0; dt < 2; ++dt)
#pragma unroll
        for (int kt2 = 0; kt2 < 2; ++kt2)
#pragma unroll
          for (int s2 = 0; s2 < 2; ++s2) {
            const bf16_t* vp = Vs + (buf * 64 + dt * 32 + lr) * VLD + kt2 * 32 + 16 * s2 + 4 * hh;
            uint2 lo = *(const uint2*)vp, hi = *(const uint2*)(vp + 8);
            bf16x8 a = mk8(lo.x, lo.y, hi.x, hi.y);
            ot[dt] = mfma32(a, pb[kt2][s2], ot[dt]);
          }
    }
    if (kt + 1 < nkt) lstore(buf ^ 1);
    __syncthreads();
  }
  lsum += __shfl_xor(lsum, 32);
  const float linv = 1.f / lsum;
  bf16_t* op = p.OATT + (size_t)(b * 4096 + q0 + lr) * 512 + h * 64;
#pragma unroll
  for (int dt = 0; dt < 2; ++dt)
#pragma unroll
    for (int rg = 0; rg < 4; ++rg) {
      int d = dt * 32 + 8 * rg + 4 * hh;
      *(uint2*)(op + d) = make_uint2(pk2(ot[dt][4 * rg] * linv, ot[dt][4 * rg + 1] * linv), pk2(ot[dt][4 * rg + 2] * linv, ot[dt][4 * rg + 3] * linv));
    }
}

#define LLD 264
#define L8LD 272
#define KRLD 40
#define PLD 72
#define DEC_TILE_BYTES (64 * LLD * 2 + 64 * L8LD + 64 * KRLD * 2 + 256)
typedef __attribute__((ext_vector_type(8))) int i32x8;
__device__ __forceinline__ f32x16 mfma8(i32x8 a, i32x8 b, f32x16 c) {
  return __builtin_amdgcn_mfma_scale_f32_32x32x64_f8f6f4(a, b, c, 0, 0, 0, 127, 0, 127);
}
__device__ __forceinline__ void attn_decode_unit(const Params& p, char* smem, int seq, int half, float Mb) {
  const int tid = tidx(), lane = tid & 63, wave = tid >> 6, lr = lane & 31, hh = lane >> 5;
  const int hd = wave;
  bf16_t* Psh = (bf16_t*)(smem + 2 * DEC_TILE_BYTES);
  bf16_t* Qs = Psh + 32 * PLD;
  for (int i = tid; i < 8 * 4 * 96; i += NTHR) {
    int h2 = i / 384, rem = i % 384, t = rem / 96, e = rem % 96;
    const bf16_t* qp = p.Qb + ((size_t)(NP + seq * 4 + t) * 8 + h2) * 96;
    bf16_t val;
    if (e < 64) {
      int j = e & 7, hx = (e >> 3) & 1, sp = (e >> 4) & 1, dt = e >> 5;
      int d = 32 * dt + 16 * sp + 8 * (j >> 2) + 4 * hx + (j & 3);
      val = f2bf(bf2f(qp[d]) * p.g_kn[d]);
    } else val = qp[e];
    Qs[i] = val;
  }
  i32x8 wf8[2][4];
#pragma unroll
  for (int mt = 0; mt < 2; ++mt)
#pragma unroll
    for (int ks = 0; ks < 4; ++ks) {
      const unsigned char* wp = p.W8T + (size_t)(hd * 64 + mt * 32 + lr) * 256 + ks * 64 + hh * 32;
      uint4 a = *(const uint4*)wp, b = *(const uint4*)(wp + 16);
      wf8[mt][ks][0] = a.x; wf8[mt][ks][1] = a.y; wf8[mt][ks][2] = a.z; wf8[mt][ks][3] = a.w;
      wf8[mt][ks][4] = b.x; wf8[mt][ks][5] = b.y; wf8[mt][ks][6] = b.z; wf8[mt][ks][7] = b.w;
    }
  const float eps_w = EPS * 256.f * __uint_as_float((unsigned)(2 * p.KW[hd] + 127) << 23);
  f32x16 oacc;
#pragma unroll
  for (int r = 0; r < 16; ++r) oacc[r] = 0.f;
  float lsum[4] = {0.f, 0.f, 0.f, 0.f};
  float4 rlA[8], rkA;
  auto gload = [&](int i, float4 (&rl)[8], float4& rk) {
    int page = p.page_table[seq * 64 + half * 32 + (i >> 1)];
    const float* lp = p.cache_lat + ((size_t)page * 128 + (i & 1) * 64) * 256;
    const float* kp = p.cache_kr + ((size_t)page * 128 + (i & 1) * 64) * 32;
#pragma unroll
    for (int j = 0; j < 8; ++j) rl[j] = ((const float4*)lp)[tid + NTHR * j];
    rk = ((const float4*)kp)[tid];
  };
  int olane = lane, otid = tid;
  auto lstore = [&](char* tb, const float4 (&rl)[8], const float4& rk) {
    const int lane = olane, tid = otid, wave = otid >> 6;
    bf16_t* latB = (bf16_t*)tb;
    unsigned char* lat8 = (unsigned char*)(tb + 64 * LLD * 2);
    bf16_t* krB = (bf16_t*)(tb + 64 * LLD * 2 + 64 * L8LD);
#pragma unroll
    for (int j = 0; j < 8; ++j) {
      const int row = wave + 8 * j;
      float4 v = rl[j];
      int pk = 0;
      pk = __builtin_amdgcn_cvt_pk_fp8_f32(__builtin_amdgcn_fmed3f(v.x * 16.f, -448.f, 448.f), __builtin_amdgcn_fmed3f(v.y * 16.f, -448.f, 448.f), pk, false);
      pk = __builtin_amdgcn_cvt_pk_fp8_f32(__builtin_amdgcn_fmed3f(v.z * 16.f, -448.f, 448.f), __builtin_amdgcn_fmed3f(v.w * 16.f, -448.f, 448.f), pk, true);
      *(unsigned*)(lat8 + row * L8LD + lane * 4) = (unsigned)pk;
      *(uint2*)(latB + row * LLD + lane * 4) = make_uint2(pk2(v.x, v.y), pk2(v.z, v.w));
    }
    int row = tid >> 3, c4 = tid & 7;
    *(uint2*)(krB + row * KRLD + c4 * 4) = make_uint2(pk2(rk.x, rk.y), pk2(rk.z, rk.w));
  };
  auto lstore_new = [&](char* tb) {
    const int lane = olane, tid = otid, wave = otid >> 6;
    bf16_t* latB = (bf16_t*)tb;
    unsigned char* lat8 = (unsigned char*)(tb + 64 * LLD * 2);
    bf16_t* krB = (bf16_t*)(tb + 64 * LLD * 2 + 64 * L8LD);
#pragma unroll
    for (int j = 0; j < 8; ++j) {
      const int row = wave + 8 * j;
      uint2 v = make_uint2(0, 0);
      if (row < 4) v = *(const uint2*)(p.CKV + (size_t)(NP + seq * 4 + row) * 256 + lane * 4);
      float f0 = bflo(v.x), f1 = bfhi(v.x), f2 = bflo(v.y), f3 = bfhi(v.y);
      int pk = 0;
      pk = __builtin_amdgcn_cvt_pk_fp8_f32(__builtin_amdgcn_fmed3f(f0 * 16.f, -448.f, 448.f), __builtin_amdgcn_fmed3f(f1 * 16.f, -448.f, 448.f), pk, false);
      pk = __builtin_amdgcn_cvt_pk_fp8_f32(__builtin_amdgcn_fmed3f(f2 * 16.f, -448.f, 448.f), __builtin_amdgcn_fmed3f(f3 * 16.f, -448.f, 448.f), pk, true);
      *(unsigned*)(lat8 + row * L8LD + lane * 4) = (unsigned)pk;
      *(uint2*)(latB + row * LLD + lane * 4) = v;
    }
    int row = tid >> 3, c4 = tid & 7;
    uint2 v = make_uint2(0, 0);
    if (row < 4) v = *(const uint2*)(p.KcatS + ((size_t)(seq * 8) * 4 + row) * 96 + 64 + c4 * 4);
    *(uint2*)(krB + row * KRLD + c4 * 4) = v;
  };
  auto compute = [&](char* tb, bool isnew) {
    const int lane = olane, wave = otid >> 6, lr = olane & 31, hh = olane >> 5, hd = otid >> 6;
    const bf16_t* latB = (const bf16_t*)tb;
    const unsigned char* lat8 = (const unsigned char*)(tb + 64 * LLD * 2);
    const bf16_t* krB = (const bf16_t*)(tb + 64 * LLD * 2 + 64 * L8LD);
#pragma unroll 1
    for (int kt2 = 0; kt2 < 2; ++kt2) {
      float ss = 0.f;
      f32x16 s1;
#pragma unroll
      for (int r = 0; r < 16; ++r) s1[r] = 0.f;
      const unsigned char* bp = lat8 + (kt2 * 32 + lr) * L8LD + hh * 32;
#pragma unroll
      for (int mt = 0; mt < 2; ++mt) {
        f32x16 acc;
#pragma unroll
        for (int r = 0; r < 16; ++r) acc[r] = 0.f;
#pragma unroll
        for (int ks = 0; ks < 4; ++ks) {
          uint4 a = *(const uint4*)(bp + ks * 64), b = *(const uint4*)(bp + ks * 64 + 16);
          i32x8 bv;
          bv[0] = a.x; bv[1] = a.y; bv[2] = a.z; bv[3] = a.w; bv[4] = b.x; bv[5] = b.y; bv[6] = b.z; bv[7] = b.w;
          acc = mfma8(wf8[mt][ks], bv, acc);
        }
#pragma unroll
        for (int r = 0; r < 16; ++r) ss += acc[r] * acc[r];
#pragma unroll
        for (int sp = 0; sp < 2; ++sp) {
          bf16x8 bk = mk8(pk2(acc[8 * sp + 0], acc[8 * sp + 1]), pk2(acc[8 * sp + 2], acc[8 * sp + 3]),
                          pk2(acc[8 * sp + 4], acc[8 * sp + 5]), pk2(acc[8 * sp + 6], acc[8 * sp + 7]));
          uint4 qa = make_uint4(0, 0, 0, 0);
          if (lr < 4) qa = *(const uint4*)(Qs + (hd * 4 + lr) * 96 + ((mt * 2 + sp) * 2 + hh) * 8);
          s1 = mfma32(__builtin_bit_cast(bf16x8, qa), bk, s1);
        }
      }
      ss += __shfl_xor(ss, 32);
      const float rinv = rsqrtf(ss * (1.f / 64.f) + eps_w);
      float s1v[4] = {s1[0] * rinv, s1[1] * rinv, s1[2] * rinv, s1[3] * rinv};
      f32x16 s2;
#pragma unroll
      for (int r = 0; r < 16; ++r) s2[r] = 0.f;
#pragma unroll
      for (int s = 0; s < 2; ++s) {
        bf16x8 bk = *(const bf16x8*)(krB + (kt2 * 32 + lr) * KRLD + s * 16 + hh * 8);
        uint4 qa = make_uint4(0, 0, 0, 0);
        if (lr < 4) qa = *(const uint4*)(Qs + (hd * 4 + lr) * 96 + 64 + s * 16 + hh * 8);
        s2 = mfma32(__builtin_bit_cast(bf16x8, qa), bk, s2);
      }
      if (hh == 0) {
        const int kk = kt2 * 32 + lr;
#pragma unroll
        for (int t = 0; t < 4; ++t) {
          float e = __builtin_amdgcn_exp2f(s1v[t] + s2[t] - Mb);
          if (isnew) e = (kk < 4 && kk <= t) ? e : 0.f;
          lsum[t] += e;
          Psh[(hd * 4 + t) * PLD + kk] = f2bf(e);
        }
      }
    }
    __syncthreads();
    {
      const int n0 = wave * 32;
#pragma unroll
      for (int ks = 0; ks < 4; ++ks) {
        bf16x8 a = *(const bf16x8*)(Psh + lr * PLD + ks * 16 + hh * 8);
        const int key0 = ks * 16 + 8 * hh, c0 = n0 + 16 * ((lane >> 4) & 1);
        const int q = (lane & 15) >> 2, pp = lane & 3;
        const bf16_t* ap = latB + (key0 + q) * LLD + c0 + 4 * pp;
        s16x4 lo = __builtin_amdgcn_ds_read_tr16_b64_v4i16((__attribute__((address_space(3))) s16x4*)(ap));
        s16x4 hi = __builtin_amdgcn_ds_read_tr16_b64_v4i16((__attribute__((address_space(3))) s16x4*)(ap + 4 * LLD));
        bf16x8 bfr;
        bfr[0] = lo[0]; bfr[1] = lo[1]; bfr[2] = lo[2]; bfr[3] = lo[3];
        bfr[4] = hi[0]; bfr[5] = hi[1]; bfr[6] = hi[2]; bfr[7] = hi[3];
        oacc = mfma32(a, bfr, oacc);
      }
    }
  };
  gload(0, rlA, rkA);
  const int ntile = 64 + half;
#pragma unroll 1
  for (int i = 0; i < ntile; ++i) {
    char* tb = smem + (i & 1) * DEC_TILE_BYTES;
    asm volatile("" : "+v"(olane), "+v"(otid));
    if (i < 64) lstore(tb, rlA, rkA); else lstore_new(tb);
    if (i + 1 < 64) gload(i + 1, rlA, rkA);
    __syncthreads();
    compute(tb, i == 64);
  }
  float* Op = p.Opart + ((size_t)(seq * 2 + half) * 32) * 256;
#pragma unroll
  for (int r = 0; r < 16; ++r) {
    int m = (r & 3) + 8 * (r >> 2) + 4 * hh;
    Op[(size_t)m * 256 + wave * 32 + lr] = oacc[r];
  }
#pragma unroll
  for (int t = 0; t < 4; ++t) {
    float v = (hh == 0) ? lsum[t] : 0.f;
    v = wave_sum(v);
    if (lane == 0) p.Lpart[(seq * 2 + half) * 32 + hd * 4 + t] = v;
  }
  __syncthreads();
}

__device__ __forceinline__ void ssm_scan_prompt(const Params& p, int job) {
  const int lane = tidx() & 63;
  const int b = job >> 5, g = job & 31;
  const float dt = __expf(p.log_dt[g]);
  const Cplx a16 = apow(p.a_re[g * 64 + lane], p.a_im[g * 64 + lane], dt, 16.f);
  Cplx H = {0.f, 0.f};
  const float* S = p.S + ((size_t)g * NSUB + b * 256) * 128;
  bf16_t* A2 = p.A2 + ((size_t)g * NSUB + b * 256) * A2LD + 256;
  for (int n0 = 0; n0 < 256; n0 += 16) {
    float sr[16], si[16];
#pragma unroll
    for (int k = 0; k < 16; ++k) { sr[k] = S[(size_t)(n0 + k) * 128 + lane]; si[k] = S[(size_t)(n0 + k) * 128 + 64 + lane]; }
#pragma unroll
    for (int k = 0; k < 16; ++k) {
      A2[(size_t)(n0 + k) * A2LD + lane] = f2bf(H.re);
      A2[(size_t)(n0 + k) * A2LD + 64 + lane] = f2bf(H.im);
      Cplx t = cmul(a16, H);
      H.re = t.re + sr[k]; H.im = t.im + si[k];
    }
  }
  float* o = p.out + O_SSMP + ((size_t)(b * 32 + g) * 64 + lane) * 2;
  o[0] = H.re; o[1] = H.im;
}
__device__ __forceinline__ void ssm_sample(const Params& p, int job) {
  const int lane = tidx() & 63;
  const int seq = job >> 5, g = job & 31;
  const float dt = __expf(p.log_dt[g]);
  const float are = p.a_re[g * 64 + lane], aim = p.a_im[g * 64 + lane];
  const Cplx ab = apow(are, aim, dt, 1.f);
  const Cplx bs = bscale(are, aim, dt);
  const float* st = p.state_ssm + ((size_t)(seq * 32 + g) * 64 + lane) * 2;
  Cplx H = {st[0], st[1]};
  bf16_t* A2 = p.A2 + ((size_t)g * NSUB + 1024 + seq) * A2LD + 256;
  A2[lane] = f2bf(H.re);
  A2[64 + lane] = f2bf(H.im);
  Cplx bb[16];
#pragma unroll
  for (int h = 0; h < 16; ++h) {
    Cplx braw = {p.ssm_b[((g * 64 + lane) * 16 + h) * 2], p.ssm_b[((g * 64 + lane) * 16 + h) * 2 + 1]};
    bb[h] = cmul(bs, braw);
  }
#pragma unroll
  for (int t = 0; t < 4; ++t) {
    const float* u = p.Z + (size_t)(NP + seq * 4 + t) * INW + g * 16;
    Cplx bu = {0.f, 0.f};
#pragma unroll
    for (int h = 0; h < 16; ++h) { float uv = u[h]; bu.re += uv * bb[h].re; bu.im += uv * bb[h].im; }
    Cplx tt = cmul(ab, H);
    H.re = tt.re + bu.re; H.im = tt.im + bu.im;
  }
  float* o = p.out + O_SSMS + ((size_t)(seq * 32 + g) * 64 + lane) * 2;
  o[0] = H.re; o[1] = H.im;
}

__device__ void phase_attn(const Params& p, char* smem) {
  const int wave = tidx() >> 6;
  const int gw = blockIdx.x * 8 + wave, GW = gridDim.x * 8;
  for (int j = gw; j < 128; j += GW) ssm_scan_prompt(p, j);
  for (int j = gw; j < 4096; j += GW) ssm_sample(p, j);
  const float Mb = softmax_bound(p);
  __syncthreads();
#ifdef PROBE_PROMPT2
  for (int rep = 0; rep < 2; ++rep)
#endif
  for (int it = blockIdx.x; it < 256; it += gridDim.x) {
    int bh = it >> 3, j = it & 7;
    attn_prompt_block(p, smem, bh >> 3, bh & 7, j, Mb);
    attn_prompt_block(p, smem, bh >> 3, bh & 7, 15 - j, Mb);
  }
  for (int it = blockIdx.x; it < 256; it += gridDim.x) attn_decode_unit(p, smem, it >> 1, it & 1, Mb);
}

__device__ void phase_ssm_y(const Params& p, char* smem) {
  const int ntile = 32 * 9 * 2;
  for (int t = blockIdx.x; t < ntile; t += gridDim.x) {
    int g = t / 18, rem = t % 18, tm = rem >> 1, tn = rem & 1;
    bf16_t* G = p.G;
    gemm_tile<1>(p.A2 + (size_t)g * NSUB * A2LD, A2LD, p.Bt2 + (size_t)g * 256 * A2LD, A2LD, 384, tm * 128, tn * 128, smem,
                 [=](int m, int n, float v) {
                   int tt = n >> 4, h = n & 15;
                   int token;
                   if (m < 1024) token = m * 16 + tt;
                   else { if (tt >= 4) return; token = NP + (m - 1024) * 4 + tt; }
                   G[(size_t)token * 512 + g * 16 + h] = f2bf(gelu_tanh(v));
                 });
  }
  const int lane = tidx() & 63, gw = blockIdx.x * 8 + (tidx() >> 6), GW = gridDim.x * 8;
  for (int job = gw; job < 1024; job += GW) {
    int seq = job >> 3, hd = job & 7;
    const float* O0 = p.Opart + ((size_t)(seq * 2) * 32 + hd * 4) * 256;
    const float* O1 = O0 + 32 * 256;
    float acc[4] = {0.f, 0.f, 0.f, 0.f};
    for (int c = 0; c < 256; ++c) {
      float w = p.w_uv[(size_t)c * 512 + hd * 64 + lane];
#pragma unroll
      for (int t = 0; t < 4; ++t) acc[t] += (O0[t * 256 + c] + O1[t * 256 + c]) * w;
    }
#pragma unroll
    for (int t = 0; t < 4; ++t) {
      float l = p.Lpart[(seq * 2) * 32 + hd * 4 + t] + p.Lpart[(seq * 2 + 1) * 32 + hd * 4 + t];
      p.OATT[(size_t)(NP + seq * 4 + t) * 512 + hd * 64 + lane] = f2bf(acc[t] / l);
    }
  }
}

__device__ void phase_gemm_gl(const Params& p, char* smem) {
  for (int t = blockIdx.x; t < 66 * 8; t += gridDim.x) {
    int tm = t / 8, tn = t % 8;
    float* C = p.GL;
    gemm_tile<2>(p.G, 512, p.WgluT, 512, 512, tm * 256, tn * 128, smem, [=](int m, int n, float v) { C[(size_t)m * 1024 + n] = v; });
  }
}
__device__ void phase_cat(const Params& p) {
  const size_t gt = (size_t)blockIdx.x * NTHR + tidx(), GT = (size_t)gridDim.x * NTHR;
  const size_t tot = (size_t)NT * 128;
  for (size_t i = gt; i < tot; i += GT) {
    size_t token = i >> 7;
    int c = (int)(i & 127) * 4;
    float4 a = *(const float4*)(p.GL + token * 1024 + c), b = *(const float4*)(p.GL + token * 1024 + 512 + c);
    float r0 = a.x / (1.f + __expf(-b.x)), r1 = a.y / (1.f + __expf(-b.y)), r2 = a.z / (1.f + __expf(-b.z)), r3 = a.w / (1.f + __expf(-b.w));
    *(uint2*)(p.CAT + token * 1024 + c) = make_uint2(pk2(r0, r1), pk2(r2, r3));
    *(uint2*)(p.CAT + token * 1024 + 512 + c) = *(const uint2*)(p.OATT + token * 512 + c);
  }
}
__device__ void phase_gemm_out(const Params& p, char* smem) {
  for (int t = blockIdx.x; t < 66 * 8; t += gridDim.x) {
    int tm = t / 8, tn = t % 8;
    float* C = p.X1;
    const float *xp = p.x_prompt, *xs = p.x_sample;
    gemm_tile<2>(p.CAT, 1024, p.WoutT, 1024, 1024, tm * 256, tn * 128, smem, [=](int m, int n, float v) {
      float x = (m < NP) ? xp[(size_t)m * 1024 + n] : xs[(size_t)(m - NP) * 1024 + n];
      C[(size_t)m * 1024 + n] = x + v;
    });
  }
}
__device__ void phase_gemm_pq(const Params& p, char* smem) {
  for (int t = blockIdx.x; t < 66 * 16; t += gridDim.x) {
    int tm = t / 16, tn = t % 16;
    bf16_t* C = p.PQ;
    gemm_tile<2>(p.XN, 1024, p.WpqT, 1024, 1024, tm * 256, tn * 128, smem, [=](int m, int n, float v) { C[(size_t)m * 2048 + n] = f2bf(v); });
  }
}
__device__ __forceinline__ void ins16(float (&L)[16], float x) {
#pragma unroll
  for (int j = 15; j >= 1; --j) L[j] = __builtin_amdgcn_fmed3f(L[j - 1], L[j], x);
  L[0] = fmaxf(L[0], x);
}
#define PKLD 136
__device__ void phase_sctopk(const Params& p, char* smem) {
  bf16_t* keysS = (bf16_t*)smem;
  unsigned char* sidx = (unsigned char*)(smem + 2 * 128 * PKLD * 2);
  const int tid = tidx(), lane = tid & 63, wave = tid >> 6, lr = lane & 31, hh = lane >> 5;
  for (int c = tid; c < 2 * 128 * 16; c += NTHR) {
    int row = c >> 4, cc = c & 15;
    *(uint4*)(keysS + row * PKLD + cc * 8) = *(const uint4*)(p.PK + row * 128 + cc * 8);
  }
  __syncthreads();
  const int ntask = NT * 8 / 32;
  for (int task = blockIdx.x * 8 + wave; task < ntask; task += gridDim.x * 8) {
    const int m = task * 32 + lr;
    float L[2][16];
#pragma unroll
    for (int c = 0; c < 2; ++c) {
#pragma unroll
      for (int j = 0; j < 16; ++j) L[c][j] = -3.0e38f;
      bf16x8 qf[8];
#pragma unroll
      for (int s2 = 0; s2 < 8; ++s2) qf[s2] = *(const bf16x8*)(p.PQ + (size_t)m * 256 + c * 128 + s2 * 16 + hh * 8);
#pragma unroll 1
      for (int kt = 0; kt < 4; ++kt) {
        f32x16 acc;
#pragma unroll
        for (int r = 0; r < 16; ++r) acc[r] = 0.f;
#pragma unroll
        for (int s2 = 0; s2 < 8; ++s2) {
          bf16x8 a = *(const bf16x8*)(keysS + (c * 128 + kt * 32 + lr) * PKLD + s2 * 16 + hh * 8);
          acc = mfma32(a, qf[s2], acc);
        }
#pragma unroll
        for (int r = 0; r < 16; ++r) {
          unsigned key = kt * 32 + (r & 3) + 8 * (r >> 2) + 4 * hh;
          ins16(L[c], __uint_as_float((__float_as_uint(acc[r]) & ~127u) | key));
        }
      }
      float P[16];
#pragma unroll
      for (int j = 0; j < 16; ++j) P[j] = __shfl_xor(L[c][j], 32);
#pragma unroll
      for (int j = 0; j < 16; ++j) ins16(L[c], P[j]);
    }
#pragma unroll
    for (int j = 0; j < 16; ++j) {
      sidx[j * NTHR + tid] = (unsigned char)(__float_as_uint(L[0][j]) & 127u);
      sidx[(16 + j) * NTHR + tid] = (unsigned char)(__float_as_uint(L[1][j]) & 127u);
    }
    float T[16];
#pragma unroll
    for (int j = 0; j < 16; ++j) T[j] = -3.0e38f;
#pragma unroll
    for (int i = 0; i < 16; ++i)
#pragma unroll
      for (int j = 0; j < 16; ++j)
        if ((i + 1) * (j + 1) <= 16) {
          float a = __uint_as_float(__float_as_uint(L[0][i]) & ~127u), b = __uint_as_float(__float_as_uint(L[1][j]) & ~127u);
          float sm = a + b;
          ins16(T, __uint_as_float((__float_as_uint(sm) & ~255u) | (unsigned)(i * 16 + j)));
        }
    float mx = __uint_as_float(__float_as_uint(T[0]) & ~255u);
    float e[16], sum = 0.f;
    int id[16];
#pragma unroll
    for (int k = 0; k < 16; ++k) {
      unsigned bits = __float_as_uint(T[k]);
      float v = __uint_as_float(bits & ~255u);
      e[k] = __expf(v - mx);
      sum += e[k];
      unsigned ij = bits & 255u;
      unsigned e1 = sidx[(ij >> 4) * NTHR + tid], e2 = sidx[(16 + (ij & 15)) * NTHR + tid];
      id[k] = (int)(e1 * 128 + e2);
    }
    float inv = 1.f / sum;
    if (hh == 0) {
#pragma unroll
      for (int k4 = 0; k4 < 4; ++k4) {
        *(int4*)(p.IDX + (size_t)m * 16 + k4 * 4) = make_int4(id[k4 * 4], id[k4 * 4 + 1], id[k4 * 4 + 2], id[k4 * 4 + 3]);
        *(float4*)(p.GW + (size_t)m * 16 + k4 * 4) = make_float4(e[k4 * 4] * inv, e[k4 * 4 + 1] * inv, e[k4 * 4 + 2] * inv, e[k4 * 4 + 3] * inv);
      }
    }
  }
}
typedef __attribute__((ext_vector_type(4))) float f32x4;
__device__ void phase_gather(const Params& p, char* smem) {
  float* wsh = (float*)smem;
  const int lane = tidx() & 63, wave = tidx() >> 6, gw = blockIdx.x * 8 + wave, GW = gridDim.x * 8;
  const int lrow = lane & 15, kb = lane >> 4;
  float* wmine = wsh + wave * 128;
  for (int r = gw; r < NT; r += GW) {
    i32x8 xb[8];
    const unsigned char* xp = p.X8 + (size_t)r * 1024 + kb * 32;
#pragma unroll
    for (int ks = 0; ks < 8; ++ks) {
      uint4 a = *(const uint4*)(xp + ks * 128), b = *(const uint4*)(xp + ks * 128 + 16);
      xb[ks][0] = a.x; xb[ks][1] = a.y; xb[ks][2] = a.z; xb[ks][3] = a.w;
      xb[ks][4] = b.x; xb[ks][5] = b.y; xb[ks][6] = b.z; xb[ks][7] = b.w;
    }
    const int xs = p.XSC[r];
    const int* idx = p.IDX + (size_t)r * 128;
    const float* gwt = p.GW + (size_t)r * 128;
#pragma unroll 2
    for (int mt = 0; mt < 8; ++mt) {
      const int e = idx[mt * 16 + lrow];
      const int sa = p.USC[e];
      const unsigned char* up = p.U8 + (size_t)e * 1024 + kb * 32;
      f32x4 acc = {0.f, 0.f, 0.f, 0.f};
#pragma unroll
      for (int ks = 0; ks < 8; ++ks) {
        uint4 a = *(const uint4*)(up + ks * 128), b = *(const uint4*)(up + ks * 128 + 16);
        i32x8 av;
        av[0] = a.x; av[1] = a.y; av[2] = a.z; av[3] = a.w; av[4] = b.x; av[5] = b.y; av[6] = b.z; av[7] = b.w;
        acc = __builtin_amdgcn_mfma_scale_f32_16x16x128_f8f6f4(av, xb[ks], acc, 0, 0, 0, sa, 0, xs);
      }
      if (lrow == 0) {
        float4 g4 = *(const float4*)(gwt + mt * 16 + 4 * kb);
        *(float4*)(wmine + mt * 16 + 4 * kb) = make_float4(g4.x * gelu_tanh(acc[0]), g4.y * gelu_tanh(acc[1]), g4.z * gelu_tanh(acc[2]), g4.w * gelu_tanh(acc[3]));
      }
    }
    float o[16];
#pragma unroll
    for (int i = 0; i < 16; ++i) o[i] = 0.f;
#pragma unroll 8
    for (int k = 0; k < 128; ++k) {
      const int e = __builtin_amdgcn_readfirstlane(idx[k]);
      const float w = wmine[k] * p.VSCF[e];
      uint4 v = *(const uint4*)(p.V8 + (size_t)e * 1024 + lane * 16);
      f2v t;
      t = __builtin_amdgcn_cvt_pk_f32_fp8((int)v.x, false); o[0] += w * t[0]; o[1] += w * t[1];
      t = __builtin_amdgcn_cvt_pk_f32_fp8((int)v.x, true);  o[2] += w * t[0]; o[3] += w * t[1];
      t = __builtin_amdgcn_cvt_pk_f32_fp8((int)v.y, false); o[4] += w * t[0]; o[5] += w * t[1];
      t = __builtin_amdgcn_cvt_pk_f32_fp8((int)v.y, true);  o[6] += w * t[0]; o[7] += w * t[1];
      t = __builtin_amdgcn_cvt_pk_f32_fp8((int)v.z, false); o[8] += w * t[0]; o[9] += w * t[1];
      t = __builtin_amdgcn_cvt_pk_f32_fp8((int)v.z, true);  o[10] += w * t[0]; o[11] += w * t[1];
      t = __builtin_amdgcn_cvt_pk_f32_fp8((int)v.w, false); o[12] += w * t[0]; o[13] += w * t[1];
      t = __builtin_amdgcn_cvt_pk_f32_fp8((int)v.w, true);  o[14] += w * t[0]; o[15] += w * t[1];
    }
    const float* x1p = p.X1 + (size_t)r * 1024 + lane * 16;
    float* yo = ((r < NP) ? p.out + O_YP + (size_t)r * 1024 : p.out + O_YS + (size_t)(r - NP) * 1024) + lane * 16;
#pragma unroll
    for (int q = 0; q < 4; ++q) {
      float4 xv = *(const float4*)(x1p + q * 4);
      *(float4*)(yo + q * 4) = make_float4(xv.x + o[q * 4], xv.y + o[q * 4 + 1], xv.z + o[q * 4 + 2], xv.w + o[q * 4 + 3]);
    }
  }
}

extern __shared__ __attribute__((aligned(16))) char dyn_smem[];
#define LDS_BYTES 126976
__global__ void __launch_bounds__(NTHR, 2) k_mega(Params p) {
  char* smem = dyn_smem;
  uint4* xbw = (uint4*)(dyn_smem + LDS_BYTES);
  if (threadIdx.x == 0) *xbw = make_uint4(0u, 0u, 0u, 0u);
  __syncthreads();
  XcdBarrier bar = xcd_barrier_post(p.bar, (volatile LAS unsigned*)xbw);
  phase0(p, smem);
  phase_rmsnorm<false>(p.x_prompt, p.x_sample, p.norm_mix, p.XN, nullptr, nullptr);
  xcd_barrier(bar);
  phase_gemm_z(p, smem);
  xcd_barrier(bar);
  phase_post1(p);
  xcd_barrier(bar);
  phase_gemm4(p, smem);
  xcd_barrier(bar);
  phase_post2(p);
  xcd_barrier(bar);
  phase_attn(p, smem);
  xcd_barrier(bar);
  phase_ssm_y(p, smem);
  xcd_barrier(bar);
  phase_gemm_gl(p, smem);
  xcd_barrier(bar);
  phase_cat(p);
  xcd_barrier(bar);
  phase_gemm_out(p, smem);
  xcd_barrier(bar);
  phase_rmsnorm<true>(p.X1, p.X1 + (size_t)NP * 1024, p.norm_ffn, p.XN, p.X8, p.XSC);
  xcd_barrier(bar);
  phase_gemm_pq(p, smem);
  xcd_barrier(bar);
  phase_sctopk(p, smem);
  xcd_barrier(bar);
  phase_gather(p, smem);
}


#ifdef PROBE_MULTI
template <int PH>
__global__ void __launch_bounds__(NTHR, 2) k_phase(Params p) {
  char* smem = dyn_smem;
  if constexpr (PH == 0) { phase0(p, smem); phase_rmsnorm<false>(p.x_prompt, p.x_sample, p.norm_mix, p.XN, nullptr, nullptr); }
  if constexpr (PH == 1) phase_gemm_z(p, smem);
  if constexpr (PH == 2) phase_post1(p);
  if constexpr (PH == 3) phase_gemm4(p, smem);
  if constexpr (PH == 4) phase_post2(p);
  if constexpr (PH == 5) phase_attn(p, smem);
  if constexpr (PH == 6) phase_ssm_y(p, smem);
  if constexpr (PH == 7) phase_gemm_gl(p, smem);
  if constexpr (PH == 8) phase_cat(p);
  if constexpr (PH == 9) phase_gemm_out(p, smem);
  if constexpr (PH == 10) phase_rmsnorm<true>(p.X1, p.X1 + (size_t)NP * 1024, p.norm_ffn, p.XN, p.X8, p.XSC);
  if constexpr (PH == 11) phase_gemm_pq(p, smem);
  if constexpr (PH == 12) phase_sctopk(p, smem);
  if constexpr (PH == 13) phase_gather(p, smem);
}
template <int PH>
static void launch_phase(const Params& p, hipStream_t stream) {
  (void)hipFuncSetAttribute((const void*)k_phase<PH>, hipFuncAttributeMaxDynamicSharedMemorySize, LDS_BYTES + 16);
  const int reps = (PH == PROBE_MULTI) ? 2 : 1;
  for (int i = 0; i < reps; ++i) hipLaunchKernelGGL(k_phase<PH>, dim3(256), dim3(NTHR), LDS_BYTES + 16, stream, p);
}
#endif

extern "C" void kernel_launch(void* const* d_in, const int* in_sizes, int n_in, void* d_out, int out_size, void* d_ws, size_t ws_size,
                              hipStream_t stream) {
  Params p{};
  p.x_prompt = (const float*)d_in[0]; p.x_sample = (const float*)d_in[1]; p.cache_lat = (const float*)d_in[2];
  p.cache_kr = (const float*)d_in[3]; p.state_ssm = (const float*)d_in[4]; p.page_table = (const int*)d_in[5];
  p.norm_mix = (const float*)d_in[6]; p.w_in = (const float*)d_in[7]; p.norm_q_lora = (const float*)d_in[8];
  p.w_uq = (const float*)d_in[9]; p.norm_kv_lora = (const float*)d_in[10]; p.w_uk = (const float*)d_in[11];
  p.w_uv = (const float*)d_in[12]; p.g_qn = (const float*)d_in[13]; p.g_qr = (const float*)d_in[14];
  p.g_kn = (const float*)d_in[15]; p.g_kr = (const float*)d_in[16]; p.a_re = (const float*)d_in[17];
  p.a_im = (const float*)d_in[18]; p.log_dt = (const float*)d_in[19]; p.ssm_b = (const float*)d_in[20];
  p.ssm_c = (const float*)d_in[21]; p.ssm_d = (const float*)d_in[22]; p.w_glu = (const float*)d_in[23];
  p.w_out = (const float*)d_in[24]; p.norm_ffn = (const float*)d_in[25]; p.peer_wq = (const float*)d_in[26];
  p.peer_keys = (const float*)d_in[27]; p.peer_u = (const float*)d_in[28]; p.peer_v = (const float*)d_in[29];
  p.out = (float*)d_out;
  char* w = (char*)d_ws;
  size_t off = 0;
  auto take = [&](size_t bytes) { char* r = w + off; off += (bytes + 255) & ~(size_t)255; return r; };
  p.bar = (unsigned*)take(16384);
  p.WinT = (bf16_t*)take((size_t)1280 * 1024 * 2);
  p.WuqT = (bf16_t*)take((size_t)768 * 384 * 2);
  p.WukT = (bf16_t*)take((size_t)512 * 256 * 2);
  p.WuvT = (bf16_t*)take((size_t)512 * 256 * 2);
  p.WgluT = (bf16_t*)take((size_t)1024 * 512 * 2);
  p.WoutT = (bf16_t*)take((size_t)1024 * 1024 * 2);
  p.WpqT = (bf16_t*)take((size_t)2048 * 1024 * 2);
  p.PK = (bf16_t*)take((size_t)2 * 128 * 128 * 2);
  p.U8 = (unsigned char*)take((size_t)16384 * 1024);
  p.V8 = (unsigned char*)take((size_t)16384 * 1024);
  p.X8 = (unsigned char*)take((size_t)NT * 1024);
  p.USC = (int*)take(16384 * 4);
  p.W8T = (unsigned char*)take(512 * 256);
  p.KW = (int*)take(256);
  p.XSC = (int*)take(NT * 4);
  p.VSCF = (float*)take(16384 * 4);
  p.Bt2 = (bf16_t*)take((size_t)32 * 256 * A2LD * 2);
  p.Emat = (bf16_t*)take((size_t)32 * 128 * 256 * 2);
  p.XN = (bf16_t*)take((size_t)NT * 1024 * 2);
  p.A2 = (bf16_t*)take((size_t)32 * NSUB * A2LD * 2);
  p.CQN = (bf16_t*)take((size_t)NT * 384 * 2);
  p.CKV = (bf16_t*)take((size_t)NT * 256 * 2);
  p.Kcat = (bf16_t*)take((size_t)32 * 4096 * 96 * 2);
  p.KcatS = (bf16_t*)take((size_t)128 * 8 * 4 * 96 * 2);
  p.Qb = (bf16_t*)take((size_t)NT * 8 * 96 * 2);
  p.VT = (bf16_t*)take((size_t)512 * NP * 2);
  p.OATT = (bf16_t*)take((size_t)NT * 512 * 2);
  p.G = (bf16_t*)take((size_t)NT * 512 * 2);
  p.CAT = (bf16_t*)take((size_t)NT * 1024 * 2);
  p.PQ = (bf16_t*)take((size_t)NT * 2048 * 2);
  p.Z = (float*)take((size_t)NT * INW * 4);
  p.Qraw = (float*)take((size_t)NT * 768 * 4);
  p.KNraw = (float*)take((size_t)NT * 512 * 4);
  p.S = (float*)take((size_t)32 * NSUB * 128 * 4);
  p.GL = (float*)take((size_t)NT * 1024 * 4);
  p.X1 = (float*)take((size_t)NT * 1024 * 4);
  p.GW = (float*)take((size_t)NT * 128 * 4);
  p.Opart = (float*)take((size_t)128 * 2 * 32 * 256 * 4);
  p.Lpart = (float*)take((size_t)128 * 2 * 32 * 4);
  p.IDX = (int*)take((size_t)NT * 128 * 4);
  if (off > ws_size) { fprintf(stderr, "workspace too small: need %zu have %zu\n", off, ws_size); return; }
#ifdef PROBE_MULTI
  launch_phase<0>(p, stream); launch_phase<1>(p, stream); launch_phase<2>(p, stream); launch_phase<3>(p, stream);
  launch_phase<4>(p, stream); launch_phase<5>(p, stream); launch_phase<6>(p, stream); launch_phase<7>(p, stream);
  launch_phase<8>(p, stream); launch_phase<9>(p, stream); launch_phase<10>(p, stream); launch_phase<11>(p, stream);
  launch_phase<12>(p, stream); launch_phase<13>(p, stream);
  return;
#endif
  static int grid = 0;
  if (!grid) {
    int dev = 0, cus = 0, per_cu = 0;
    (void)hipGetDevice(&dev);
    (void)hipDeviceGetAttribute(&cus, hipDeviceAttributeMultiprocessorCount, dev);
    (void)hipFuncSetAttribute((const void*)k_mega, hipFuncAttributeMaxDynamicSharedMemorySize, LDS_BYTES + 16);
    (void)hipOccupancyMaxActiveBlocksPerMultiprocessor(&per_cu, k_mega, NTHR, LDS_BYTES + 16);
    if (per_cu < 1) { fprintf(stderr, "k_mega does not fit a CU\n"); return; }
    grid = cus;
  }
  (void)hipMemsetAsync(p.bar, 0, XCD_BAR_WORDS * sizeof(unsigned), stream);
  hipLaunchKernelGGL(k_mega, dim3(grid), dim3(NTHR), LDS_BYTES + 16, stream, p);
}
```

```cpp
#include <hip/hip_runtime.h>
#include <stdint.h>
#include <stdio.h>
#include <type_traits>

typedef __attribute__((ext_vector_type(8))) short bf16x8;
typedef __attribute__((ext_vector_type(4))) short s16x4;
typedef __attribute__((ext_vector_type(16))) float f32x16;
typedef __attribute__((ext_vector_type(2))) __bf16 bf2;
typedef __attribute__((ext_vector_type(2))) float f2v;
typedef unsigned short bf16_t;

#define NTHR 512
#define D_MODEL 1024
#define NP 16384
#define NS 512
#define NT 16896
#define INW 1184
#define NSUB 1280
#define NSUBV 1152
#define A2LD 384
#define EPS 1e-6f
#define QSCALE 0.14724466f

#define O_YP 0
#define O_YS 16777216
#define O_LATP 17301504
#define O_KRP 21495808
#define O_SSMP 22020096
#define O_LATS 22036480
#define O_KRS 22167552
#define O_SSMS 22183936

constexpr size_t ws_al(size_t b) { return (b + 255) & ~(size_t)255; }
constexpr size_t WSO_bar = 0;
constexpr size_t WSO_WinT = WSO_bar + ws_al(16384);
constexpr size_t WSO_WuqT = WSO_WinT + ws_al((size_t)1280 * 1024 * 2);
constexpr size_t WSO_WukT = WSO_WuqT + ws_al((size_t)768 * 384 * 2);
constexpr size_t WSO_WuvT = WSO_WukT + ws_al((size_t)512 * 256 * 2);
constexpr size_t WSO_WgluT = WSO_WuvT + ws_al((size_t)512 * 256 * 2);
constexpr size_t WSO_WoutT = WSO_WgluT + ws_al((size_t)1024 * 512 * 2);
constexpr size_t WSO_WpqT = WSO_WoutT + ws_al((size_t)1024 * 1024 * 2);
constexpr size_t WSO_PK = WSO_WpqT + ws_al((size_t)2048 * 1024 * 2);
constexpr size_t WSO_U8 = WSO_PK + ws_al((size_t)2 * 128 * 128 * 2);
constexpr size_t WSO_V8 = WSO_U8 + ws_al((size_t)16384 * 1024);
constexpr size_t WSO_X8 = WSO_V8 + ws_al((size_t)16384 * 1024);
constexpr size_t WSO_USC = WSO_X8 + ws_al((size_t)NT * 1024);
constexpr size_t WSO_W8T = WSO_USC + ws_al(16384 * 4);
constexpr size_t WSO_KW = WSO_W8T + ws_al(512 * 256);
constexpr size_t WSO_XSC = WSO_KW + ws_al(256);
constexpr size_t WSO_VSCF = WSO_XSC + ws_al(NT * 4);
constexpr size_t WSO_Bt2 = WSO_VSCF + ws_al(16384 * 4);
constexpr size_t WSO_Emat = WSO_Bt2 + ws_al((size_t)32 * 256 * A2LD * 2);
constexpr size_t WSO_XN = WSO_Emat + ws_al((size_t)32 * 128 * 256 * 2);
constexpr size_t WSO_A2 = WSO_XN + ws_al((size_t)NT * 1024 * 2);
constexpr size_t WSO_CQN = WSO_A2 + ws_al((size_t)32 * NSUB * A2LD * 2);
constexpr size_t WSO_CKV = WSO_CQN + ws_al((size_t)NT * 384 * 2);
constexpr size_t WSO_Kcat = WSO_CKV + ws_al((size_t)NT * 256 * 2);
constexpr size_t WSO_KcatS = WSO_Kcat + ws_al((size_t)32 * 4096 * 96 * 2);
constexpr size_t WSO_Qb = WSO_KcatS + ws_al((size_t)128 * 8 * 4 * 96 * 2);
constexpr size_t WSO_VT = WSO_Qb + ws_al((size_t)NT * 8 * 96 * 2);
constexpr size_t WSO_WgluS = WSO_VT + ws_al((size_t)512 * NP * 2);
constexpr size_t WSO_G = WSO_WgluS + ws_al((size_t)1024 * 512 * 2);
constexpr size_t WSO_CAT = WSO_G + ws_al((size_t)NT * 512 * 2);
constexpr size_t WSO_PQ = WSO_CAT + ws_al((size_t)NT * 1024 * 2);
constexpr size_t WSO_Z = WSO_PQ + ws_al((size_t)NT * 2048 * 2);
constexpr size_t WSO_Qraw = WSO_Z + ws_al((size_t)NT * INW * 4);
constexpr size_t WSO_KNraw = WSO_Qraw + ws_al((size_t)NT * 768 * 4);
constexpr size_t WSO_S = WSO_KNraw + ws_al((size_t)NT * 512 * 4);
constexpr size_t WSO_GL = WSO_S + ws_al((size_t)32 * NSUB * 128 * 4);
constexpr size_t WSO_X1 = WSO_GL + ws_al((size_t)NT * 1024 * 4);
constexpr size_t WSO_GW = WSO_X1 + ws_al((size_t)NT * 1024 * 4);
constexpr size_t WSO_Pd = WSO_GW + ws_al((size_t)NT * 128 * 4);
constexpr size_t WSO_Wt = WSO_Pd + ws_al((size_t)8 * NT * 128 * 4);
constexpr size_t WSO_Opart = WSO_Wt + ws_al((size_t)NT * 128 * 4);
constexpr size_t WSO_Lpart = WSO_Opart + ws_al((size_t)128 * 2 * 32 * 256 * 4);
constexpr size_t WSO_IDX = WSO_Lpart + ws_al((size_t)128 * 2 * 32 * 4);
constexpr size_t WS_TOTAL = WSO_IDX + ws_al((size_t)NT * 128 * 4);
struct Params {
  const float *x_prompt, *x_sample, *cache_lat, *cache_kr, *state_ssm;
  const int* page_table;
  const float *norm_mix, *w_in, *norm_q_lora, *w_uq, *norm_kv_lora, *w_uk, *w_uv, *g_qn, *g_qr, *g_kn, *g_kr;
  const float *a_re, *a_im, *log_dt, *ssm_b, *ssm_c, *ssm_d, *w_glu, *w_out, *norm_ffn, *peer_wq, *peer_keys, *peer_u, *peer_v;
  float* out;
  char* ws;
  __device__ __forceinline__ unsigned* bar() const { return (unsigned*)(ws + WSO_bar); }
  __device__ __forceinline__ bf16_t* WinT() const { return (bf16_t*)(ws + WSO_WinT); }
  __device__ __forceinline__ bf16_t* WuqT() const { return (bf16_t*)(ws + WSO_WuqT); }
  __device__ __forceinline__ bf16_t* WukT() const { return (bf16_t*)(ws + WSO_WukT); }
  __device__ __forceinline__ bf16_t* WuvT() const { return (bf16_t*)(ws + WSO_WuvT); }
  __device__ __forceinline__ bf16_t* WgluT() const { return (bf16_t*)(ws + WSO_WgluT); }
  __device__ __forceinline__ bf16_t* WoutT() const { return (bf16_t*)(ws + WSO_WoutT); }
  __device__ __forceinline__ bf16_t* WpqT() const { return (bf16_t*)(ws + WSO_WpqT); }
  __device__ __forceinline__ bf16_t* PK() const { return (bf16_t*)(ws + WSO_PK); }
  __device__ __forceinline__ unsigned char* U8() const { return (unsigned char*)(ws + WSO_U8); }
  __device__ __forceinline__ unsigned char* V8() const { return (unsigned char*)(ws + WSO_V8); }
  __device__ __forceinline__ unsigned char* X8() const { return (unsigned char*)(ws + WSO_X8); }
  __device__ __forceinline__ int* USC() const { return (int*)(ws + WSO_USC); }
  __device__ __forceinline__ unsigned char* W8T() const { return (unsigned char*)(ws + WSO_W8T); }
  __device__ __forceinline__ int* KW() const { return (int*)(ws + WSO_KW); }
  __device__ __forceinline__ int* XSC() const { return (int*)(ws + WSO_XSC); }
  __device__ __forceinline__ float* VSCF() const { return (float*)(ws + WSO_VSCF); }
  __device__ __forceinline__ bf16_t* Bt2() const { return (bf16_t*)(ws + WSO_Bt2); }
  __device__ __forceinline__ bf16_t* Emat() const { return (bf16_t*)(ws + WSO_Emat); }
  __device__ __forceinline__ bf16_t* XN() const { return (bf16_t*)(ws + WSO_XN); }
  __device__ __forceinline__ bf16_t* A2() const { return (bf16_t*)(ws + WSO_A2); }
  __device__ __forceinline__ bf16_t* CQN() const { return (bf16_t*)(ws + WSO_CQN); }
  __device__ __forceinline__ bf16_t* CKV() const { return (bf16_t*)(ws + WSO_CKV); }
  __device__ __forceinline__ bf16_t* Kcat() const { return (bf16_t*)(ws + WSO_Kcat); }
  __device__ __forceinline__ bf16_t* KcatS() const { return (bf16_t*)(ws + WSO_KcatS); }
  __device__ __forceinline__ bf16_t* Qb() const { return (bf16_t*)(ws + WSO_Qb); }
  __device__ __forceinline__ bf16_t* VT() const { return (bf16_t*)(ws + WSO_VT); }
  __device__ __forceinline__ bf16_t* WgluS() const { return (bf16_t*)(ws + WSO_WgluS); }
  __device__ __forceinline__ bf16_t* G() const { return (bf16_t*)(ws + WSO_G); }
  __device__ __forceinline__ bf16_t* CAT() const { return (bf16_t*)(ws + WSO_CAT); }
  __device__ __forceinline__ bf16_t* PQ() const { return (bf16_t*)(ws + WSO_PQ); }
  __device__ __forceinline__ float* Z() const { return (float*)(ws + WSO_Z); }
  __device__ __forceinline__ float* Qraw() const { return (float*)(ws + WSO_Qraw); }
  __device__ __forceinline__ float* KNraw() const { return (float*)(ws + WSO_KNraw); }
  __device__ __forceinline__ float* S() const { return (float*)(ws + WSO_S); }
  __device__ __forceinline__ float* GL() const { return (float*)(ws + WSO_GL); }
  __device__ __forceinline__ float* X1() const { return (float*)(ws + WSO_X1); }
  __device__ __forceinline__ float* GW() const { return (float*)(ws + WSO_GW); }
  __device__ __forceinline__ float* Pd() const { return (float*)(ws + WSO_Pd); }
  __device__ __forceinline__ float* Wt() const { return (float*)(ws + WSO_Wt); }
  __device__ __forceinline__ float* Opart() const { return (float*)(ws + WSO_Opart); }
  __device__ __forceinline__ float* Lpart() const { return (float*)(ws + WSO_Lpart); }
  __device__ __forceinline__ int* IDX() const { return (int*)(ws + WSO_IDX); }
};


#define XB_TMO      128
#define XB_XCNT(j)  (256  + 64 * (j))
#define XB_XSUB(j)  (1280 + 64 * (j))
#define XB_XGEN(j)  (2304 + 64 * (j))
#define XB_TOP      3328
#define XB_TOPGEN   3392
#define XCD_BAR_WORDS 3456
#define XB_SPIN_CAP (1u << 18)
#define LAS __attribute__((address_space(3)))

__device__ __forceinline__ unsigned xb_ld(unsigned* p)              { return __hip_atomic_load(p, __ATOMIC_RELAXED, __HIP_MEMORY_SCOPE_AGENT); }
__device__ __forceinline__ unsigned xb_add(unsigned* p, unsigned v) { return __hip_atomic_fetch_add(p, v, __ATOMIC_RELAXED, __HIP_MEMORY_SCOPE_AGENT); }
__device__ __forceinline__ unsigned xb_xcc_id() { return (unsigned)__builtin_amdgcn_s_getreg((3 << 11) | 20) & 0xFu; }
#define XB_SPIN(cond, bar) do { unsigned _sp = 0; while (cond) { __builtin_amdgcn_s_sleep(1); \
    if ((++_sp & 255u) == 0u) { if (xb_ld(&(bar)[XB_TMO])) break; if (_sp > XB_SPIN_CAP) { atomicAdd(&(bar)[XB_TMO], 1u); break; } } } } while (0)

struct XcdBarrier {
    unsigned* bar; unsigned x;
    volatile LAS unsigned* st;
};

__device__ __forceinline__ XcdBarrier xcd_barrier_post(unsigned* bar, volatile LAS unsigned* st) {
    XcdBarrier b; b.bar = bar; b.x = xb_xcc_id(); b.st = st;
    if (threadIdx.x == 0) (void)xb_add(&bar[XB_XCNT(b.x)], 1u);
    return b;
}
__device__ __forceinline__ void xcd_barrier_complete(unsigned* bar, unsigned x, unsigned& nloc, unsigned& nx) {
    const unsigned G = gridDim.x * gridDim.y * gridDim.z;
    unsigned sum, cnt, mine, sp = 0u;
    for (;;) {
        sum = 0u; cnt = 0u; mine = 0u;
#pragma unroll
        for (unsigned j = 0; j < 16; ++j) { const unsigned c = xb_ld(&bar[XB_XCNT(j)]); sum += c; cnt += (c > 0u) ? 1u : 0u; mine = (j == x) ? c : mine; }
        if (sum == G) break;
        __builtin_amdgcn_s_sleep(1);
        if ((++sp & 255u) == 0u) { if (xb_ld(&bar[XB_TMO])) break; if (sp > XB_SPIN_CAP) { atomicAdd(&bar[XB_TMO], 1u); break; } }
    }
    nloc = mine > 0u ? mine : 1u; nx = cnt > 0u ? cnt : 1u;
}

__device__ __forceinline__ void xcd_barrier(const XcdBarrier& b) {
    asm volatile("s_waitcnt vmcnt(0)" ::: "memory");
    __syncthreads();
    if (threadIdx.x == 0) {
        unsigned* bar = b.bar;
        __builtin_amdgcn_s_waitcnt(0);
        unsigned nloc = b.st[0], nx = b.st[1];
        if (nloc == 0u) { xcd_barrier_complete(bar, b.x, nloc, nx); b.st[0] = nloc; b.st[1] = nx; }
        const unsigned old = xb_add(&bar[XB_XSUB(b.x)], 1u);
        const unsigned gen = old / nloc;
        if (old + 1u == (gen + 1u) * nloc) {
            __builtin_amdgcn_fence(__ATOMIC_RELEASE, "agent");
            asm volatile("s_waitcnt vmcnt(0)" ::: "memory");
            const unsigned og = xb_add(&bar[XB_TOP], 1u);
            const unsigned tg = og / nx;
            if (og + 1u == (tg + 1u) * nx) xb_add(&bar[XB_TOPGEN], 1u);
            else XB_SPIN(xb_ld(&bar[XB_TOPGEN]) == tg, bar);
            __builtin_amdgcn_fence(__ATOMIC_ACQUIRE, "agent");
            xb_add(&bar[XB_XGEN(b.x)], 1u);
            asm volatile("s_waitcnt vmcnt(0)" ::: "memory");
        } else {
            XB_SPIN(xb_ld(&bar[XB_XGEN(b.x)]) == gen, bar);
            __builtin_amdgcn_fence(__ATOMIC_ACQUIRE, "agent");
            asm volatile("s_waitcnt vmcnt(0)" ::: "memory");
        }
    }
    __syncthreads();
}

__device__ __forceinline__ int tidx() { int t = threadIdx.x; asm volatile("" : "+v"(t)); return t; }
__device__ __forceinline__ unsigned pk2(float a, float b) {
  f2v v = {a, b};
  bf2 r = __builtin_convertvector(v, bf2);
  return __builtin_bit_cast(unsigned, r);
}
__device__ __forceinline__ bf16_t f2bf(float a) { return (bf16_t)(pk2(a, 0.f) & 0xffffu); }
__device__ __forceinline__ float bf2f(bf16_t x) { return __uint_as_float(((unsigned)x) << 16); }
__device__ __forceinline__ float bflo(unsigned x) { return __uint_as_float(x << 16); }
__device__ __forceinline__ float bfhi(unsigned x) { return __uint_as_float(x & 0xffff0000u); }
__device__ __forceinline__ float wave_sum(float v) {
  v += __shfl_xor(v, 32); v += __shfl_xor(v, 16); v += __shfl_xor(v, 8);
  v += __shfl_xor(v, 4);  v += __shfl_xor(v, 2);  v += __shfl_xor(v, 1);
  return v;
}
__device__ __forceinline__ float gelu_tanh(float x) {
  const float k0 = -2.f * 0.7978845608028654f * 1.4426950408889634f, k1 = k0 * 0.044715f;
  float e = __builtin_amdgcn_exp2f(x * (k0 + k1 * x * x));
  return x * __builtin_amdgcn_rcpf(1.f + e);
}
__device__ __forceinline__ void sincos_rev(float ang, float& s, float& c) {
  float rev = ang * 0.15915494309189535f;
  rev = rev - floorf(rev);
  s = __builtin_amdgcn_sinf(rev);
  c = __builtin_amdgcn_cosf(rev);
}
__device__ __forceinline__ f32x16 mfma32(bf16x8 a, bf16x8 b, f32x16 c) {
  return __builtin_amdgcn_mfma_f32_32x32x16_bf16(a, b, c, 0, 0, 0);
}
__device__ __forceinline__ bf16x8 mk8(unsigned a, unsigned b, unsigned c, unsigned d) {
  uint4 u = make_uint4(a, b, c, d);
  return __builtin_bit_cast(bf16x8, u);
}

#define GLD 72
template <int WM, int WN, int TM, int TN, bool PAIR = false, class Epi>
__device__ __forceinline__ void gemm_tile(const bf16_t* __restrict__ A, int lda, const bf16_t* __restrict__ Bt, int ldb,
                                          int K, int m0, int n0, char* smem, Epi epi) {
  static_assert(WM * WN == 8, "8 waves");
  constexpr int BM = 32 * WM * TM, BN = 32 * WN * TN, NA = BM * 8 / NTHR, NB = BN * 8 / NTHR;
  static_assert(NA >= 1 && NB >= 1, "tile too small");
  bf16_t* As = (bf16_t*)smem;
  bf16_t* Bs = As + 2 * BM * GLD;
  const int tid = tidx(), lane = tid & 63, wave = tid >> 6;
  const int wm = wave / WN, wn = wave % WN, lr = lane & 31, hh = lane >> 5;
  f32x16 acc[TM][TN];
#pragma unroll
  for (int i = 0; i < TM; ++i)
#pragma unroll
    for (int j = 0; j < TN; ++j)
#pragma unroll
      for (int r = 0; r < 16; ++r) acc[i][j][r] = 0.f;
  const int nk = K / 64;
  static_assert(NA <= 2 && NB <= 2, "staging registers are scalarised for at most 2+2 chunks per thread");
  uint4 pa0, pa1, pb0, pb1, qa0, qa1, qb0, qb1;
#define GT_LD1(dst, P, ld, r0, i_) do { int c = tid + NTHR * (i_), row = c >> 3, cc = c & 7; dst = *(const uint4*)(P + (size_t)(r0 + row) * ld + k0_ + cc * 8); } while (0)
#define GT_GLOAD(kt_, A0, A1, B0, B1) do { const int k0_ = ((kt_) < nk ? (kt_) : nk - 1) * 64; \
    GT_LD1(A0, A, lda, m0, 0); if constexpr (NA > 1) GT_LD1(A1, A, lda, m0, 1); \
    GT_LD1(B0, Bt, ldb, n0, 0); if constexpr (NB > 1) GT_LD1(B1, Bt, ldb, n0, 1); } while (0)
#define GT_ST1(src, S, bm, i_) do { int c = tid + NTHR * (i_), row = c >> 3, cc = c & 7; *(uint4*)(S + (bm + row) * GLD + cc * 8) = src; } while (0)
#define GT_LSTORE(buf_, A0, A1, B0, B1) do { \
    GT_ST1(A0, As, (buf_) * BM, 0); if constexpr (NA > 1) GT_ST1(A1, As, (buf_) * BM, 1); \
    GT_ST1(B0, Bs, (buf_) * BN, 0); if constexpr (NB > 1) GT_ST1(B1, Bs, (buf_) * BN, 1); } while (0)
#define GT_COMPUTE(buf_) do { \
    _Pragma("unroll") for (int ks = 0; ks < 4; ++ks) { bf16x8 a[TM], b[TN]; \
      _Pragma("unroll") for (int i = 0; i < TM; ++i) a[i] = *(const bf16x8*)(As + ((buf_) * BM + wm * 32 * TM + i * 32 + lr) * GLD + ks * 16 + hh * 8); \
      _Pragma("unroll") for (int j = 0; j < TN; ++j) b[j] = *(const bf16x8*)(Bs + ((buf_) * BN + wn * 32 * TN + j * 32 + lr) * GLD + ks * 16 + hh * 8); \
      _Pragma("unroll") for (int i = 0; i < TM; ++i) _Pragma("unroll") for (int j = 0; j < TN; ++j) acc[i][j] = mfma32(a[i], b[j], acc[i][j]); } } while (0)
  GT_GLOAD(0, pa0, pa1, pb0, pb1);
  GT_GLOAD(1, qa0, qa1, qb0, qb1);
  GT_LSTORE(0, pa0, pa1, pb0, pb1);
  GT_GLOAD(2, pa0, pa1, pb0, pb1);
  __syncthreads();
#pragma unroll 1
  for (int kt = 0; kt < nk; kt += 2) {
    GT_COMPUTE(0);
    GT_LSTORE(1, qa0, qa1, qb0, qb1);
    GT_GLOAD(kt + 3, qa0, qa1, qb0, qb1);
    __syncthreads();
    GT_COMPUTE(1);
    GT_LSTORE(0, pa0, pa1, pb0, pb1);
    GT_GLOAD(kt + 4, pa0, pa1, pb0, pb1);
    __syncthreads();
  }
#undef GT_GLOAD
#undef GT_LSTORE
#undef GT_COMPUTE
#undef GT_LD1
#undef GT_ST1
  if constexpr (PAIR) {
    static_assert(TN == 2, "paired epilogue needs two column tiles per wave");
#pragma unroll
    for (int i = 0; i < TM; ++i)
#pragma unroll
      for (int r = 0; r < 16; ++r) {
        int m = m0 + wm * 32 * TM + i * 32 + (r & 3) + 8 * (r >> 2) + 4 * hh;
        epi(m, wn * 32 + lr, acc[i][0][r], acc[i][1][r]);
      }
  } else {
#pragma unroll
    for (int i = 0; i < TM; ++i)
#pragma unroll
      for (int j = 0; j < TN; ++j)
#pragma unroll
        for (int r = 0; r < 16; ++r) {
          int m = m0 + wm * 32 * TM + i * 32 + (r & 3) + 8 * (r >> 2) + 4 * hh;
          int n = n0 + wn * 32 * TN + j * 32 + lr;
          epi(m, n, acc[i][j][r]);
        }
  }
}

namespace pg8 {
#define PG8_LAS __attribute__((address_space(3)))
typedef unsigned short bf16_t;
typedef short bf16x8 __attribute__((ext_vector_type(8)));
typedef float f32x4 __attribute__((ext_vector_type(4)));
typedef unsigned u32x4 __attribute__((ext_vector_type(4)));
constexpr int BM = 256, BK = 64, HALF = 128, HTB = HALF * BK * 2  , STAGE_BYTES = 8 * HTB, NXCD = 8, WGM = 8;

__host__ __device__ __forceinline__ int lds_byte(int r, int c) { const int st = (r >> 4) * 2 + (c >> 5), rr = r & 15, cc = c & 31, ob = rr * 64 + cc * 2; return st * 1024 + (ob ^ (((ob >> 9) & 1) << 5)); }
__host__ __device__ __forceinline__ void stage_rc(int b, int& R, int& C) { const int st = b / 1024, sb = b % 1024, swz = sb ^ (((sb >> 9) & 1) << 5); R = (st >> 1) * 16 + swz / 64; C = (st & 1) * 32 + (swz % 64) / 2; }
__host__ __device__ __forceinline__ int perm32(int rho) { const int n = rho >> 4, i = rho & 15; return 8 * (i >> 2) + 4 * n + (i & 3); }

struct Unit { int pm, pn; };
struct Gemm { const bf16_t* A; const bf16_t* Bt; int M, N, K; };

struct StaticOrder {
    int nM, nN, nwg, G, c;
    __host__ __device__ void init(int M, int N, int G_, int c_) { nM = M / BM; nN = N / BM; nwg = nM * nN; G = G_; c = c_; }
    __host__ __device__ bool next(int i, Unit& u) const {
        const long L = (long)i * G + c; if (L >= nwg) return false;
        int wgid = (int)L; { const int q = nwg / NXCD, r = nwg % NXCD, xcd = wgid % NXCD, off = wgid / NXCD; wgid = (xcd < r ? xcd * (q + 1) : r * (q + 1) + (xcd - r) * q) + off; }
        const int nig = WGM * nN, gid = wgid / nig, fm = gid * WGM, gsz = (nM - fm) < WGM ? (nM - fm) : WGM;
        u.pm = fm + ((wgid % nig) % gsz); u.pn = (wgid % nig) / gsz; return true;
    }
    __device__ __forceinline__ void a_ready(const Unit&) const {}
    __device__ __forceinline__ void done(const Unit&) const {}
};
__device__ __forceinline__ unsigned cvt_pk_bf16(float lo, float hi) { unsigned r; asm volatile("v_cvt_pk_bf16_f32 %0, %1, %2" : "=v"(r) : "v"(lo), "v"(hi)); return r; }

template <bool PERM_, class F> struct EpiFn {
    static constexpr bool PERM = PERM_, AFTER_DRAIN = false;
    F f;
    __device__ __forceinline__ void operator()(const f32x4 (&acc)[2][2][4][2], const Unit& u, int wr, int wc, int fr, int fq) const {
        const int row0 = u.pm * BM + wr * 64 + fr;
#pragma unroll
        for (int ai = 0; ai < 2; ++ai)
#pragma unroll
            for (int m = 0; m < 4; ++m) {
                const int row = row0 + ai * HALF + m * 16;
#pragma unroll
                for (int bj = 0; bj < 2; ++bj) {
                    if constexpr (PERM_) {
                        f.st8(row, u.pn * BM + wc * 32 + 8 * fq + bj * HALF, acc[ai][bj][m][0], acc[ai][bj][m][1]);
                    } else {
#pragma unroll
                        for (int n = 0; n < 2; ++n) f.st4(row, u.pn * BM + wc * 32 + 4 * fq + bj * HALF + n * 16, acc[ai][bj][m][n]);
                    }
                }
            }
    }
};
template <class Epi, class Sched, bool STAMP = false>
__device__ __forceinline__ void gemm_phase(PG8_LAS unsigned char* lds, const Gemm g, const Sched& S, const Epi& E, unsigned long long* stamps) {
    const int tid = tidx(), wid = __builtin_amdgcn_readfirstlane(tid >> 6), lane = tid & 63, wr = wid >> 2, wc = wid & 3, fr = lane & 15, fq = lane >> 4;
    const int K = g.K, nt = K / BK;
    int ts_lo = 0, ts_hi = 0, nts = 0; const unsigned long long rt_entry = STAMP ? (unsigned long long)wall_clock64() : 0ull;
#define PG8_STAMP() do { if (STAMP && wid == 0 && nts < 64) { const unsigned long long _c = (unsigned long long)clock64(); \
        ts_lo = (lane == nts) ? (int)(unsigned)_c : ts_lo; ts_hi = (lane == nts) ? (int)(unsigned)(_c >> 32) : ts_hi; ++nts; } } while (0)
    PG8_STAMP();
    unsigned voffA[2], voffB[2];
#pragma unroll
    for (int i = 0; i < 2; ++i) { int R, C; stage_rc(tid * 16 + i * 8192, R, C); const int Rb = Epi::PERM ? ((R & ~31) + perm32(R & 31)) : R;
        voffA[i] = (unsigned)(R * K + C) * 2u; voffB[i] = (unsigned)(Rb * K + C) * 2u; }
    const size_t kstep = (size_t)(BK * 2);
    const size_t hstep = (size_t)HALF * K * 2;
    const size_t tstep = 2 * hstep;
    const unsigned ldsw = (unsigned)wid * 1024u;
    const int aoff = lds_byte(wr * 64 + fr, fq * 8), boff = lds_byte(wc * 32 + fr, fq * 8);
#define PG8_SA(b, h) (((b) * 2 + (h)) * HTB)
#define PG8_SB(b, h) ((4 + (b) * 2 + (h)) * HTB)
#define PG8_STAGE(bufoff, gbase, voff) do { _Pragma("unroll") for (int _i = 0; _i < 2; ++_i) \
        __builtin_amdgcn_global_load_lds((const unsigned*)((const char*)(gbase) + (voff)[_i]), (PG8_LAS unsigned*)(lds + (bufoff) + ldsw + _i * 8192), 16, 0, 0); } while (0)
#define PG8_LDA(dst, b, h) do { _Pragma("unroll") for (int m = 0; m < 4; ++m) _Pragma("unroll") for (int k = 0; k < 2; ++k) dst[m][k] = *(const PG8_LAS bf16x8*)(lds + PG8_SA(b, h) + aoff + m * 2048 + k * 1024); } while (0)
#define PG8_LDB(dst, b, h) do { _Pragma("unroll") for (int n = 0; n < 2; ++n) _Pragma("unroll") for (int k = 0; k < 2; ++k) dst[n][k] = *(const PG8_LAS bf16x8*)(lds + PG8_SB(b, h) + boff + n * 2048 + k * 1024); } while (0)
#define PG8_MMA(ai, bj, At, Bt) do { __builtin_amdgcn_s_setprio(1); _Pragma("unroll") for (int m = 0; m < 4; ++m) _Pragma("unroll") for (int n = 0; n < 2; ++n) _Pragma("unroll") for (int k = 0; k < 2; ++k) \
        acc[ai][bj][m][n] = __builtin_amdgcn_mfma_f32_16x16x32_bf16(Bt[n][k], At[m][k], acc[ai][bj][m][n], 0, 0, 0); __builtin_amdgcn_s_setprio(0); } while (0)
#define PG8_WAIT_V(n) asm volatile("s_waitcnt vmcnt(" #n ")" ::: "memory")
#define PG8_WAIT_L(n) asm volatile("s_waitcnt lgkmcnt(" #n ")" ::: "memory")
#define PG8_BAR __builtin_amdgcn_s_barrier()
#define PG8_SCHED __builtin_amdgcn_sched_barrier(0)
    Unit cur, nxt; int ui = 0;
    if (!S.next(0, cur)) return;
    f32x4 acc[2][2][4][2];
#pragma unroll
    for (int a = 0; a < 2; ++a)
#pragma unroll
        for (int b = 0; b < 2; ++b)
#pragma unroll
            for (int m = 0; m < 4; ++m)
#pragma unroll
                for (int n = 0; n < 2; ++n) acc[a][b][m][n] = (f32x4){0.f, 0.f, 0.f, 0.f};
    bf16x8 At[4][2], B0[2][2], B1[2][2];
    const char* cA = (const char*)g.A + (size_t)cur.pm * tstep; const char* cB = (const char*)g.Bt + (size_t)cur.pn * tstep;
    S.a_ready(cur);
    PG8_STAGE(PG8_SB(0, 0), cB, voffB); PG8_STAGE(PG8_SA(0, 0), cA, voffA); PG8_STAGE(PG8_SB(0, 1), cB + hstep, voffB); PG8_STAGE(PG8_SA(0, 1), cA + hstep, voffA);
    if (wr == 1) PG8_BAR;
    PG8_WAIT_V(4); PG8_BAR;
    PG8_STAGE(PG8_SB(1, 0), cB + kstep, voffB); PG8_STAGE(PG8_SA(1, 0), cA + kstep, voffA); PG8_STAGE(PG8_SB(1, 1), cB + hstep + kstep, voffB);
    PG8_WAIT_V(6); PG8_BAR;
    PG8_STAMP();
    for (;;) {
        const bool has_next = S.next(ui + 1, nxt);
        const char* nA = has_next ? (const char*)g.A + (size_t)nxt.pm * tstep : cA; const char* nB = has_next ? (const char*)g.Bt + (size_t)nxt.pn * tstep : cB;
        for (int t = 0; t < nt; t += 2) {
            const bool last = (t == nt - 2);
            const char* a1 = cA + (size_t)(t + 1) * kstep;
            const char* a2 = last ? nA : cA + (size_t)(t + 2) * kstep; const char* b2 = last ? nB : cB + (size_t)(t + 2) * kstep;
            const char* a3 = a2 + kstep; const char* b3 = b2 + kstep;
            if (last && has_next) S.a_ready(nxt);
            PG8_LDB(B0, 0, 0); PG8_SCHED; PG8_LDA(At, 0, 0); PG8_STAGE(PG8_SA(1, 1), a1 + hstep, voffA);
            PG8_WAIT_L(8); PG8_BAR; PG8_WAIT_L(0); PG8_MMA(0, 0, At, B0); PG8_BAR; PG8_SCHED;
            PG8_LDB(B1, 0, 1); PG8_STAGE(PG8_SB(0, 0), b2, voffB);
            PG8_BAR; PG8_WAIT_L(0); PG8_MMA(0, 1, At, B1); PG8_BAR;
            PG8_LDA(At, 0, 1); PG8_STAGE(PG8_SA(0, 0), a2, voffA);
            PG8_BAR; PG8_WAIT_L(0); PG8_MMA(1, 0, At, B0); PG8_BAR; PG8_SCHED;
            PG8_STAGE(PG8_SB(0, 1), b2 + hstep, voffB);
            PG8_WAIT_V(6); PG8_BAR; PG8_MMA(1, 1, At, B1); PG8_BAR;
            PG8_LDB(B0, 1, 0); PG8_SCHED; PG8_LDA(At, 1, 0); PG8_STAGE(PG8_SA(0, 1), a2 + hstep, voffA);
            PG8_WAIT_L(8); PG8_BAR; PG8_WAIT_L(0); PG8_MMA(0, 0, At, B0); PG8_BAR; PG8_SCHED;
            PG8_LDB(B1, 1, 1); PG8_STAGE(PG8_SB(1, 0), b3, voffB);
            PG8_BAR; PG8_WAIT_L(0); PG8_MMA(0, 1, At, B1); PG8_BAR;
            PG8_LDA(At, 1, 1); PG8_STAGE(PG8_SA(1, 0), a3, voffA);
            PG8_BAR; PG8_WAIT_L(0); PG8_MMA(1, 0, At, B0); PG8_BAR; PG8_SCHED;
            PG8_STAGE(PG8_SB(1, 1), b3 + hstep, voffB);
            PG8_WAIT_V(6); PG8_BAR; PG8_MMA(1, 1, At, B1); PG8_BAR;
        }
        PG8_STAMP();
        if constexpr (!Epi::AFTER_DRAIN) { E(acc, cur, wr, wc, fr, fq); S.done(cur); }
        PG8_STAMP();
        if (!has_next) break;
#pragma unroll
        for (int a = 0; a < 2; ++a)
#pragma unroll
            for (int b = 0; b < 2; ++b)
#pragma unroll
                for (int m = 0; m < 4; ++m)
#pragma unroll
                    for (int n = 0; n < 2; ++n) acc[a][b][m][n] = (f32x4){0.f, 0.f, 0.f, 0.f};
        cur = nxt; cA = nA; cB = nB; ++ui;
    }
    PG8_WAIT_V(0);
    if (wr == 0) PG8_BAR;
    PG8_BAR;
    if constexpr (Epi::AFTER_DRAIN) { E.fused(acc, cur, wr, wc, fr, fq, lds, wid, lane); S.done(cur); }
    PG8_STAMP();
    if (STAMP && wid == 0) { stamps[lane] = lane < nts ? (((unsigned long long)(unsigned)ts_hi << 32) | (unsigned)ts_lo) : 0ull;
        if (lane == 62) stamps[62] = rt_entry; if (lane == 63) stamps[63] = (unsigned long long)wall_clock64(); }
#undef PG8_STAMP
#undef PG8_SA
#undef PG8_SB
#undef PG8_STAGE
#undef PG8_LDA
#undef PG8_LDB
#undef PG8_MMA
#undef PG8_WAIT_V
#undef PG8_WAIT_L
#undef PG8_BAR
#undef PG8_SCHED
}
}

struct Cplx { float re, im; };
__device__ __forceinline__ Cplx cmul(Cplx a, Cplx b) { return {a.re * b.re - a.im * b.im, a.re * b.im + a.im * b.re}; }
__device__ __forceinline__ Cplx apow(float are, float aim, float dt, float m) {
  float mag = __expf(m * dt * are);
  float s, c;
  sincos_rev(m * dt * aim, s, c);
  return {mag * c, mag * s};
}
__device__ __forceinline__ Cplx bscale(float are, float aim, float dt) {
  Cplx ab = apow(are, aim, dt, 1.f);
  float nr = ab.re - 1.f, ni = ab.im;
  float den = are * are + aim * aim;
  return {(nr * are + ni * aim) / den, (ni * are - nr * aim) / den};
}

__device__ __forceinline__ void convert_tables(const Params& p, int gw, int GWv) {
  const int lane = tidx() & 63;
  auto ldrow = [&](int row, float4 (&v)[4]) {
    const int rc = row < 2 * 16384 ? row : 2 * 16384 - 1;
    const bool isU = rc < 16384;
    const int e = isU ? rc : rc - 16384;
    const float* src = (isU ? p.peer_u : p.peer_v) + (size_t)e * 1024 + lane * 16;
#pragma unroll
    for (int i = 0; i < 4; ++i) v[i] = ((const float4*)src)[i];
  };
  auto cvrow = [&](int row, const float4 (&v)[4]) {
    const bool isU = row < 16384;
    const int e = isU ? row : row - 16384;
    float am = 0.f;
#pragma unroll
    for (int i = 0; i < 4; ++i) am = fmaxf(am, fmaxf(fmaxf(fabsf(v[i].x), fabsf(v[i].y)), fmaxf(fabsf(v[i].z), fabsf(v[i].w))));
#pragma unroll
    for (int o = 32; o >= 1; o >>= 1) am = fmaxf(am, __shfl_xor(am, o));
    int E = (int)((__float_as_uint(am) >> 23) & 0xffu) - 127;
    E = E < -60 ? -60 : E;
    const int k = 7 - E;
    const float sc = __uint_as_float((unsigned)(k + 127) << 23);
    unsigned w[4];
#pragma unroll
    for (int i = 0; i < 4; ++i) {
      int pk = 0;
      pk = __builtin_amdgcn_cvt_pk_fp8_f32(v[i].x * sc, v[i].y * sc, pk, false);
      pk = __builtin_amdgcn_cvt_pk_fp8_f32(v[i].z * sc, v[i].w * sc, pk, true);
      w[i] = (unsigned)pk;
    }
    unsigned char* dst = (isU ? p.U8() : p.V8()) + ((size_t)(lane >> 3) * 16384 + e) * 128 + (lane & 7) * 16;
    *(uint4*)dst = make_uint4(w[0], w[1], w[2], w[3]);
    if (lane == 0) {
      ((unsigned short*)p.USC())[e * 2 + (isU ? 0 : 1)] = (unsigned short)(127 - k);
    }
  };
  if (gw >= 2 * 16384) return;
  float4 b0[4], b1[4], c[4];
  ldrow(gw, b0);
  ldrow(gw + GWv, b1);
  for (int row = gw; row < 2 * 16384; row += 2 * GWv) {
#pragma unroll
    for (int i = 0; i < 4; ++i) c[i] = b0[i];
    ldrow(row + 2 * GWv, b0);
    cvrow(row, c);
    if (row + GWv < 2 * 16384) {
#pragma unroll
      for (int i = 0; i < 4; ++i) c[i] = b1[i];
      ldrow(row + 3 * GWv, b1);
      cvrow(row + GWv, c);
    }
  }
}

__device__ __forceinline__ void tr_cvt(const float* __restrict__ W, bf16_t* __restrict__ Wt, int K, int N, int Npad, size_t gt, size_t GT) {
  size_t tot = (size_t)K * Npad;
  for (size_t i = gt; i < tot; i += GT) {
    int n = (int)(i / K), k = (int)(i % K);
    Wt[i] = (n < N) ? f2bf(W[(size_t)k * N + n]) : (bf16_t)0;
  }
}
__device__ __forceinline__ void cvt_flat(const float* __restrict__ W, bf16_t* __restrict__ Wb, size_t n4, size_t gt, size_t GT) {
  for (size_t i = gt; i < n4; i += GT) {
    float4 v = ((const float4*)W)[i];
    ((uint2*)Wb)[i] = make_uint2(pk2(v.x, v.y), pk2(v.z, v.w));
  }
}
__device__ __forceinline__ void phase0(const Params& p, char* smem) {
  if (blockIdx.x < 8) {
    float* red = (float*)smem;
    const int h = blockIdx.x, tid = tidx(), d = tid & 63, c0 = (tid >> 6) * 32;
    float v[32];
    float am = 0.f;
#pragma unroll
    for (int i = 0; i < 32; ++i) { v[i] = p.w_uk[(size_t)(c0 + i) * 512 + h * 64 + d]; am = fmaxf(am, fabsf(v[i])); }
#pragma unroll
    for (int o = 32; o >= 1; o >>= 1) am = fmaxf(am, __shfl_xor(am, o));
    if ((tid & 63) == 0) red[tid >> 6] = am;
    __syncthreads();
    am = red[0];
#pragma unroll
    for (int i = 1; i < 8; ++i) am = fmaxf(am, red[i]);
    int E = (int)((__float_as_uint(am) >> 23) & 0xffu) - 127;
    E = E < -60 ? -60 : E;
    const int k = 7 - E;
    const float sc = __uint_as_float((unsigned)(k + 127) << 23);
    unsigned w[8];
#pragma unroll
    for (int i = 0; i < 8; ++i) {
      int pk = 0;
      pk = __builtin_amdgcn_cvt_pk_fp8_f32(v[4 * i] * sc, v[4 * i + 1] * sc, pk, false);
      pk = __builtin_amdgcn_cvt_pk_fp8_f32(v[4 * i + 2] * sc, v[4 * i + 3] * sc, pk, true);
      w[i] = (unsigned)pk;
    }
    unsigned char* dst = p.W8T() + (size_t)(h * 64 + d) * 256 + c0;
    *(uint4*)dst = make_uint4(w[0], w[1], w[2], w[3]);
    *(uint4*)(dst + 16) = make_uint4(w[4], w[5], w[6], w[7]);
    if (tid == 0) p.KW()[h] = k;
    __syncthreads();
  }
  const size_t gt = (size_t)blockIdx.x * NTHR + tidx(), GT = (size_t)gridDim.x * NTHR;
  {
    const int lane = tidx() & 63, wave = tidx() >> 6;
    float* tl = (float*)smem + wave * (64 * 65);
    const int woff = gridDim.x > 8 ? 64 : 0;
    const int gwv = blockIdx.x * 8 + wave - woff, GWv = gridDim.x * 8 - woff;
    for (int t = gwv; t < 1480 && gwv >= 0; t += GWv) {
      const float* W; bf16_t* Wt; int K, N, tk, mode, tt;
      if (t < 320)       { W = p.w_in;    Wt = p.WinT();  K = 1024; N = INW;  tk = 16; mode = 0; tt = t; }
      else if (t < 392)  { W = p.w_uq;    Wt = p.WuqT();  K = 384;  N = 768;  tk = 6;  mode = 0; tt = t - 320; }
      else if (t < 424)  { W = p.w_uk;    Wt = p.WukT();  K = 256;  N = 512;  tk = 4;  mode = 0; tt = t - 392; }
      else if (t < 456)  { W = p.w_uv;    Wt = p.WuvT();  K = 256;  N = 512;  tk = 4;  mode = 0; tt = t - 424; }
      else if (t < 584)  { W = p.w_glu;   Wt = p.WgluT(); K = 512;  N = 1024; tk = 8;  mode = 1; tt = t - 456; }
      else if (t < 712)  { W = p.w_glu;   Wt = p.WgluS(); K = 512;  N = 1024; tk = 8;  mode = 2; tt = t - 584; }
      else if (t < 968)  { W = p.w_out;   Wt = p.WoutT(); K = 1024; N = 1024; tk = 16; mode = 0; tt = t - 712; }
      else               { W = p.peer_wq; Wt = p.WpqT();  K = 1024; N = 2048; tk = 16; mode = 0; tt = t - 968; }
      const int k0 = (tt % tk) * 64, n0 = (tt / tk) * 64;
      const int n = n0 + lane;
      int sn = n;
      if (mode == 1) sn = ((n & 255) >> 7) * 512 + (n >> 8) * 128 + (n & 127);
      if (mode == 2) sn = (((n & 63) >> 5)) * 512 + (n >> 7) * 64 + (((n & 127) >> 6)) * 32 + (n & 31);
      const bool okn = n < N;
      const float* wp = W + (size_t)k0 * N + (okn ? sn : 0);
#pragma unroll
      for (int rb = 0; rb < 64; rb += 16) {
        float v[16];
#pragma unroll
        for (int r = 0; r < 16; ++r) v[r] = wp[(size_t)(rb + r) * N];
#pragma unroll
        for (int r = 0; r < 16; ++r) tl[lane * 65 + rb + r] = okn ? v[r] : 0.f;
      }
      const int kl = (lane & 31) * 2, nh = lane >> 5;
#pragma unroll 8
      for (int i = 0; i < 32; ++i) {
        const int nl = 2 * i + nh;
        *(unsigned*)(Wt + (size_t)(n0 + nl) * K + k0 + kl) = pk2(tl[nl * 65 + kl], tl[nl * 65 + kl + 1]);
      }
    }
  }
  cvt_flat(p.peer_keys, p.PK(), 2 * 128 * 128 / 4, gt, GT);
  {
    size_t tot = (size_t)32 * 128 * 256 / 8;
    for (size_t i = gt; i < tot; i += GT) {
      int g = (int)(i / (128 * 32)), rem = (int)(i % (128 * 32)), n = rem / 32, c8 = rem % 32;
      *(uint4*)(p.A2() + ((size_t)g * NSUB + 1024 + n) * A2LD + c8 * 8) = make_uint4(0, 0, 0, 0);
    }
  }
  {
    size_t tot = (size_t)32 * 16 * 256;
    float* xs = (float*)smem;
    __syncthreads();
    for (size_t base = (size_t)blockIdx.x * NTHR; base < tot; base += GT) {
      const int tid = tidx();
      const int g = (int)(base / 4096), m0 = (int)((base % 4096) >> 8);
      if (tid < 128) {
        const int mm = tid >> 6, pp = tid & 63;
        float dt = __expf(p.log_dt[g]);
        float are = p.a_re[g * 64 + pp], aim = p.a_im[g * 64 + pp];
        Cplx x = cmul(apow(are, aim, dt, (float)(m0 + mm)), bscale(are, aim, dt));
        xs[(mm * 64 + pp) * 2] = x.re; xs[(mm * 64 + pp) * 2 + 1] = x.im;
      }
      __syncthreads();
      const int mm = tid >> 8, m = m0 + mm, h = (tid >> 4) & 15, h2 = tid & 15;
      float acc = 0.f;
#pragma unroll 4
      for (int pp = 0; pp < 64; ++pp) {
        Cplx ab = {xs[(mm * 64 + pp) * 2], xs[(mm * 64 + pp) * 2 + 1]};
        Cplx bb = {p.ssm_b[((g * 64 + pp) * 16 + h2) * 2], p.ssm_b[((g * 64 + pp) * 16 + h2) * 2 + 1]};
        Cplx cc = {p.ssm_c[((g * 16 + h) * 64 + pp) * 2], p.ssm_c[((g * 16 + h) * 64 + pp) * 2 + 1]};
        Cplx x = cmul(ab, bb);
        acc += cc.re * x.re - cc.im * x.im;
      }
      if (m == 0 && h == h2) acc += p.ssm_d[g * 16 + h];
      bf16_t v = f2bf(acc);
      for (int t = m; t < 16; ++t) {
        int j = t - m;
        p.Bt2()[((size_t)g * 256 + t * 16 + h) * A2LD + j * 16 + h2] = v;
      }
      if (m == 0) {
        for (int t = 0; t < 16; ++t)
          for (int j = t + 1; j < 16; ++j) p.Bt2()[((size_t)g * 256 + t * 16 + h) * A2LD + j * 16 + h2] = 0;
      }
      __syncthreads();
    }
    tot = (size_t)32 * 256 * 64;
    for (size_t i = gt; i < tot; i += GT) {
      int g = (int)(i / 16384), rem = (int)(i % 16384), th = rem >> 6, pp = rem & 63, t = th >> 4, h = th & 15;
      float dt = __expf(p.log_dt[g]);
      float are = p.a_re[g * 64 + pp], aim = p.a_im[g * 64 + pp];
      Cplx am = apow(are, aim, dt, (float)(t + 1));
      Cplx cc = {p.ssm_c[((g * 16 + h) * 64 + pp) * 2], p.ssm_c[((g * 16 + h) * 64 + pp) * 2 + 1]};
      p.Bt2()[((size_t)g * 256 + th) * A2LD + 256 + pp] = f2bf(cc.re * am.re - cc.im * am.im);
      p.Bt2()[((size_t)g * 256 + th) * A2LD + 320 + pp] = f2bf(-(cc.re * am.im + cc.im * am.re));
    }
    tot = (size_t)32 * 64 * 256;
    for (size_t i = gt; i < tot; i += GT) {
      int g = (int)(i / 16384), rem = (int)(i % 16384), pp = rem >> 8, jh = rem & 255, j = jh >> 4, h2 = jh & 15;
      float dt = __expf(p.log_dt[g]);
      float are = p.a_re[g * 64 + pp], aim = p.a_im[g * 64 + pp];
      Cplx am = apow(are, aim, dt, (float)(15 - j));
      Cplx bs = bscale(are, aim, dt);
      Cplx bb = {p.ssm_b[((g * 64 + pp) * 16 + h2) * 2], p.ssm_b[((g * 64 + pp) * 16 + h2) * 2 + 1]};
      Cplx x = cmul(cmul(am, bs), bb);
      p.Emat()[((size_t)g * 128 + pp) * 256 + jh] = f2bf(x.re);
      p.Emat()[((size_t)g * 128 + 64 + pp) * 256 + jh] = f2bf(x.im);
    }
  }
}

template <bool FP8OUT, bool SRCBF = false>
__device__ __forceinline__ void phase_rmsnorm(const float* __restrict__ srcP, const float* __restrict__ srcS, const float* __restrict__ gain,
                              bf16_t* __restrict__ dst, unsigned char* __restrict__ dst8, int* __restrict__ xsc) {
  const int lane = tidx() & 63, gw = blockIdx.x * 8 + (tidx() >> 6), GW = gridDim.x * 8;
  float4 g[4];
#pragma unroll
  for (int i = 0; i < 4; ++i) g[i] = *(const float4*)(gain + lane * 4 + 256 * i);
  if (gw >= NT) return;
  float4 nx[4];
  uint2 nxb[4];
#define RN_LOAD(R_) do { const int rr_ = (R_); \
    if constexpr (SRCBF) { const bf16_t* s_ = (rr_ < NP) ? (const bf16_t*)srcP + (size_t)rr_ * 1024 : (const bf16_t*)srcS + (size_t)(rr_ - NP) * 1024; \
      _Pragma("unroll") for (int i = 0; i < 4; ++i) nxb[i] = *(const uint2*)(s_ + lane * 4 + 256 * i); } \
    else { const float* s_ = (rr_ < NP) ? srcP + (size_t)rr_ * 1024 : srcS + (size_t)(rr_ - NP) * 1024; \
      _Pragma("unroll") for (int i = 0; i < 4; ++i) nx[i] = *(const float4*)(s_ + lane * 4 + 256 * i); } } while (0)
  RN_LOAD(gw);
  for (int r = gw; r < NT; r += GW) {
    float4 v[4];
    float ss = 0.f;
#pragma unroll
    for (int i = 0; i < 4; ++i) {
      if constexpr (SRCBF) v[i] = make_float4(bflo(nxb[i].x), bfhi(nxb[i].x), bflo(nxb[i].y), bfhi(nxb[i].y));
      else v[i] = nx[i];
    }
    RN_LOAD(r + GW < NT ? r + GW : r);
#pragma unroll
    for (int i = 0; i < 4; ++i) ss += v[i].x * v[i].x + v[i].y * v[i].y + v[i].z * v[i].z + v[i].w * v[i].w;
    ss = wave_sum(ss);
    float rinv = rsqrtf(ss * (1.f / 1024.f) + EPS);
#pragma unroll
    for (int i = 0; i < 4; ++i) {
      uint2 o = make_uint2(pk2(v[i].x * rinv * g[i].x, v[i].y * rinv * g[i].y), pk2(v[i].z * rinv * g[i].z, v[i].w * rinv * g[i].w));
      *(uint2*)(dst + (size_t)r * 1024 + lane * 4 + 256 * i) = o;
    }
    if constexpr (FP8OUT) {
      float am = 0.f;
#pragma unroll
      for (int i = 0; i < 4; ++i) {
        v[i].x *= rinv * g[i].x; v[i].y *= rinv * g[i].y; v[i].z *= rinv * g[i].z; v[i].w *= rinv * g[i].w;
        am = fmaxf(am, fmaxf(fmaxf(fabsf(v[i].x), fabsf(v[i].y)), fmaxf(fabsf(v[i].z), fabsf(v[i].w))));
      }
#pragma unroll
      for (int o = 32; o >= 1; o >>= 1) am = fmaxf(am, __shfl_xor(am, o));
      int E = (int)((__float_as_uint(am) >> 23) & 0xffu) - 127;
      E = E < -60 ? -60 : E;
      const int k = 7 - E;
      const float sc = __uint_as_float((unsigned)(k + 127) << 23);
#pragma unroll
      for (int i = 0; i < 4; ++i) {
        int pk = 0;
        pk = __builtin_amdgcn_cvt_pk_fp8_f32(v[i].x * sc, v[i].y * sc, pk, false);
        pk = __builtin_amdgcn_cvt_pk_fp8_f32(v[i].z * sc, v[i].w * sc, pk, true);
        *(unsigned*)(dst8 + (size_t)r * 1024 + lane * 4 + 256 * i) = (unsigned)pk;
      }
      if (lane == 0) xsc[r] = 127 - k;
    }
  }
}

struct StZ { bf16_t* Z; __device__ __forceinline__ void st8(int row, int col, pg8::f32x4 a, pg8::f32x4 b) const {
    if (col < INW) *(uint4*)(Z + (unsigned)(row * INW + col)) = make_uint4(pk2(a[0], a[1]), pk2(a[2], a[3]), pk2(b[0], b[1]), pk2(b[2], b[3])); } };
struct StF32 { float* C; int ldc; __device__ __forceinline__ void st4(int row, int col, pg8::f32x4 v) const { *(pg8::f32x4*)(C + (unsigned)(row * ldc + col)) = v; } };
struct StBf16 { bf16_t* C; int ldc; __device__ __forceinline__ void st8(int row, int col, pg8::f32x4 a, pg8::f32x4 b) const {
    *(uint4*)(C + (unsigned)(row * ldc + col)) = make_uint4(pk2(a[0], a[1]), pk2(a[2], a[3]), pk2(b[0], b[1]), pk2(b[2], b[3])); } };
struct StX1 { bf16_t* C; const float* x; __device__ __forceinline__ void st8(int row, int col, pg8::f32x4 a, pg8::f32x4 b) const {
    const unsigned o = (unsigned)(row * 1024 + col); const pg8::f32x4 xa = *(const pg8::f32x4*)(x + o) + a, xb = *(const pg8::f32x4*)(x + o + 4) + b;
    *(uint4*)(C + o) = make_uint4(pk2(xa[0], xa[1]), pk2(xa[2], xa[3]), pk2(xb[0], xb[1]), pk2(xb[2], xb[3])); } };
__device__ __forceinline__ void phase_rmsnorm_x1(const bf16_t* __restrict__ src, const float* __restrict__ gain, bf16_t* __restrict__ dst,
                                                 unsigned char* __restrict__ dst8, int* __restrict__ xsc) {
  const int lane = tidx() & 63, gw = blockIdx.x * 8 + (tidx() >> 6), GW = gridDim.x * 8;
  float g[16];
#pragma unroll
  for (int i = 0; i < 2; ++i) {
    const float4 a = *(const float4*)(gain + lane * 8 + 512 * i), b = *(const float4*)(gain + lane * 8 + 512 * i + 4);
    g[i * 8 + 0] = a.x; g[i * 8 + 1] = a.y; g[i * 8 + 2] = a.z; g[i * 8 + 3] = a.w; g[i * 8 + 4] = b.x; g[i * 8 + 5] = b.y; g[i * 8 + 6] = b.z; g[i * 8 + 7] = b.w;
  }
  if (gw >= NT) return;
  uint4 n0 = *(const uint4*)(src + (size_t)gw * 1024 + lane * 8), n1 = *(const uint4*)(src + (size_t)gw * 1024 + 512 + lane * 8);
  for (int r = gw; r < NT; r += GW) {
    const uint4 c0 = n0, c1 = n1;
    {
      const int rn = r + GW < NT ? r + GW : r;
      n0 = *(const uint4*)(src + (size_t)rn * 1024 + lane * 8); n1 = *(const uint4*)(src + (size_t)rn * 1024 + 512 + lane * 8);
    }
    float v[16] = {bflo(c0.x), bfhi(c0.x), bflo(c0.y), bfhi(c0.y), bflo(c0.z), bfhi(c0.z), bflo(c0.w), bfhi(c0.w),
                   bflo(c1.x), bfhi(c1.x), bflo(c1.y), bfhi(c1.y), bflo(c1.z), bfhi(c1.z), bflo(c1.w), bfhi(c1.w)};
    float ss = 0.f;
#pragma unroll
    for (int k = 0; k < 16; ++k) ss += v[k] * v[k];
    ss = wave_sum(ss);
    const float rinv = rsqrtf(ss * (1.f / 1024.f) + EPS);
    float am = 0.f;
#pragma unroll
    for (int k = 0; k < 16; ++k) { v[k] *= rinv * g[k]; am = fmaxf(am, fabsf(v[k])); }
#pragma unroll
    for (int i = 0; i < 2; ++i)
      *(uint4*)(dst + (size_t)r * 1024 + 512 * i + lane * 8) = make_uint4(pk2(v[i * 8], v[i * 8 + 1]), pk2(v[i * 8 + 2], v[i * 8 + 3]), pk2(v[i * 8 + 4], v[i * 8 + 5]), pk2(v[i * 8 + 6], v[i * 8 + 7]));
#pragma unroll
    for (int o = 32; o >= 1; o >>= 1) am = fmaxf(am, __shfl_xor(am, o));
    int E = (int)((__float_as_uint(am) >> 23) & 0xffu) - 127;
    E = E < -60 ? -60 : E;
    const int k = 7 - E;
    const float sc = __uint_as_float((unsigned)(k + 127) << 23);
#pragma unroll
    for (int i = 0; i < 2; ++i) {
      int p0 = 0, p1 = 0;
      p0 = __builtin_amdgcn_cvt_pk_fp8_f32(v[i * 8] * sc, v[i * 8 + 1] * sc, p0, false);
      p0 = __builtin_amdgcn_cvt_pk_fp8_f32(v[i * 8 + 2] * sc, v[i * 8 + 3] * sc, p0, true);
      p1 = __builtin_amdgcn_cvt_pk_fp8_f32(v[i * 8 + 4] * sc, v[i * 8 + 5] * sc, p1, false);
      p1 = __builtin_amdgcn_cvt_pk_fp8_f32(v[i * 8 + 6] * sc, v[i * 8 + 7] * sc, p1, true);
      *(uint2*)(dst8 + (size_t)r * 1024 + 512 * i + lane * 8) = make_uint2((unsigned)p0, (unsigned)p1);
    }
    if (lane == 0) xsc[r] = 127 - k;
  }
}
template <class Epi>
__device__ __forceinline__ void big_gemm(const bf16_t* A, const bf16_t* Bt, int M, int N, int K, char* smem, const Epi& E) {
  pg8::Gemm g{A, Bt, M, N, K};
  pg8::StaticOrder S;
  S.init(M, N, (int)gridDim.x, (int)blockIdx.x);
  pg8::gemm_phase<Epi, pg8::StaticOrder, false>((PG8_LAS unsigned char*)smem, g, S, E, nullptr);
}
__device__ __forceinline__ void phase_gemm_z(const Params& p, char* smem) {
  bf16_t* Z = (bf16_t*)p.Z();
  for (int t = blockIdx.x; t < 8 * 10; t += gridDim.x) {
    int tm = t / 10, tn = t % 10;
    gemm_tile<2, 4, 1, 1>(p.XN(), 1024, p.WinT(), 1024, 1024, NP + tm * 64, tn * 128, smem, [=](int m, int n, float v) {
      if (n < INW) Z[(size_t)m * INW + n] = f2bf(v);
    });
  }
  big_gemm(p.XN(), p.WinT(), NP, 1280, 1024, smem, pg8::EpiFn<true, StZ>{StZ{Z}});
  if (gridDim.x > 64) {
    if (blockIdx.x >= 64) convert_tables(p, (blockIdx.x - 64) * 8 + (tidx() >> 6), (gridDim.x - 64) * 8);
  } else {
    convert_tables(p, blockIdx.x * 8 + (tidx() >> 6), gridDim.x * 8);
  }
}

__device__ __forceinline__ void phase_post1(const Params& p) {
  const int lane = tidx() & 63, gw = blockIdx.x * 8 + (tidx() >> 6), GW = gridDim.x * 8;
  if (gw >= NT) return;
  typedef unsigned u32x3 __attribute__((ext_vector_type(3)));
  uint4 n_u; uint2 n_kvb; u32x3 n_cb; bf16_t n_krb;
#define P1_LOAD(R_) do { const bf16_t* z_ = (const bf16_t*)p.Z() + (size_t)(R_) * INW; \
    n_u = *(const uint4*)(z_ + lane * 8); \
    n_cb = *(const u32x3*)(z_ + 512 + lane * 6); \
    n_kvb = *(const uint2*)(z_ + 896 + lane * 4); n_krb = z_[1152 + (lane & 31)]; } while (0)
  float gq6[6];
#pragma unroll
  for (int e = 0; e < 6; ++e) gq6[e] = p.norm_q_lora[lane * 6 + e];
  const float4 gkv4 = *(const float4*)(p.norm_kv_lora + lane * 4);
  const float gkr1 = (lane < 32) ? p.g_kr[lane] : 0.f;
  const float ropeinv = exp2f(-(float)(lane & 15) * (13.287712379549449f / 16.f));
  P1_LOAD(gw);
  for (int r = gw; r < NT; r += GW) {
    const bool isP = r < NP;
    const int rs = r - NP;
    const uint4 c_u = n_u;
    const float4 c_kv = make_float4(bflo(n_kvb.x), bfhi(n_kvb.x), bflo(n_kvb.y), bfhi(n_kvb.y));
    const float2 c_c[3] = {make_float2(bflo(n_cb[0]), bfhi(n_cb[0])), make_float2(bflo(n_cb[1]), bfhi(n_cb[1])), make_float2(bflo(n_cb[2]), bfhi(n_cb[2]))};
    const float c_kr = __uint_as_float((unsigned)n_krb << 16);
    P1_LOAD(r + GW < NT ? r + GW : r);
    {
      int g = lane >> 1, h0 = (lane & 1) * 8;
      int n = isP ? (r >> 4) : (1024 + (rs >> 2));
      int t = isP ? (r & 15) : (rs & 3);
      *(uint4*)(p.A2() + ((size_t)g * NSUB + n) * A2LD + t * 16 + h0) = c_u;
    }
    {
      float2 v[3];
      float ss = 0.f;
#pragma unroll
      for (int i = 0; i < 3; ++i) {
        v[i] = c_c[i];
        ss += v[i].x * v[i].x + v[i].y * v[i].y;
      }
      ss = wave_sum(ss);
      float rinv = rsqrtf(ss * (1.f / 384.f) + EPS);
      u32x3 oq;
#pragma unroll
      for (int i = 0; i < 3; ++i) oq[i] = pk2(v[i].x * rinv * gq6[2 * i], v[i].y * rinv * gq6[2 * i + 1]);
      *(u32x3*)(p.CQN() + (size_t)r * 384 + lane * 6) = oq;
    }
    {
      float4 v = c_kv;
      float ss = wave_sum(v.x * v.x + v.y * v.y + v.z * v.z + v.w * v.w);
      float rinv = rsqrtf(ss * (1.f / 256.f) + EPS);
      const float4 g = gkv4;
      float4 o = make_float4(v.x * rinv * g.x, v.y * rinv * g.y, v.z * rinv * g.z, v.w * rinv * g.w);
      float* dst = isP ? p.out + O_LATP + (size_t)r * 256 : p.out + O_LATS + (size_t)rs * 256;
      *(float4*)(dst + lane * 4) = o;
      *(uint2*)(p.CKV() + (size_t)r * 256 + lane * 4) = make_uint2(pk2(o.x, o.y), pk2(o.z, o.w));
    }
    {
      float v = (lane < 32) ? c_kr : 0.f;
      float ss = wave_sum(v * v);
      float rinv = rsqrtf(ss * (1.f / 32.f) + EPS);
      float xv = v * rinv * gkr1;
      float other = __shfl_xor(xv, 16);
      int i = lane & 15;
      float pos = isP ? (float)(r & 4095) : (float)(8192 + (rs & 3));
      float sn, cs;
      sincos_rev(pos * ropeinv, sn, cs);
      float o = (lane & 16) ? (xv * cs + other * sn) : (xv * cs - other * sn);
      if (lane < 32) {
        float* dst = isP ? p.out + O_KRP + (size_t)r * 32 : p.out + O_KRS + (size_t)rs * 32;
        dst[lane] = o;
        bf16_t ob = f2bf(o);
        if (isP) {
          int b = r >> 12, t = r & 4095;
#pragma unroll
          for (int h = 0; h < 8; ++h) p.Kcat()[((size_t)(b * 8 + h) * 4096 + t) * 96 + 64 + lane] = ob;
        } else {
          int seq = rs >> 2, t = rs & 3;
#pragma unroll
          for (int h = 0; h < 8; ++h) p.KcatS()[((size_t)(seq * 8 + h) * 4 + t) * 96 + 64 + lane] = ob;
        }
      }
    }
  }
}

__device__ __forceinline__ void phase_gemm4(const Params& p, char* smem) {
  const int ns = 32 * 9, nq = 8 * 6, nk = 8 * 4;
  int t0 = blockIdx.x, tcnt = (ns + nq + nk - (int)blockIdx.x + (int)gridDim.x - 1) / (int)gridDim.x, tstr = gridDim.x;
  if (gridDim.x == 256) {
    if (blockIdx.x >= 192) { t0 = ((int)blockIdx.x - 192) * 3; tcnt = 3; tstr = 1; }
    else if (blockIdx.x < 176) { t0 = 192 + (int)blockIdx.x; tcnt = 1; tstr = 1; }
    else tcnt = 0;
  }
  for (int ti = 0; ti < tcnt; ++ti) {
    const int t = t0 + ti * tstr;
    if (t < ns) {
      int g = t / 9, tm = t % 9;
      float* C = p.S() + (size_t)g * NSUB * 128;
      gemm_tile<4, 2, 1, 2>(p.A2() + (size_t)g * NSUB * A2LD, A2LD, p.Emat() + (size_t)g * 128 * 256, 256, 256, tm * 128, 0, smem,
                            [=](int m, int n, float v) { C[(size_t)m * 128 + n] = v; });
    } else if (t < ns + nq) {
      int u = t - ns, tm = u / 6, tn = u % 6;
      bf16_t* C = (bf16_t*)p.Qraw();
      gemm_tile<2, 4, 1, 1>(p.CQN(), 384, p.WuqT(), 384, 384, NP + tm * 64, tn * 128, smem, [=](int m, int n, float v) { C[(size_t)m * 768 + n] = f2bf(v); });
    } else {
      int u = t - ns - nq, tm = u / 4, tn = u % 4;
      bf16_t* C = (bf16_t*)p.KNraw();
      gemm_tile<2, 4, 1, 1>(p.CKV(), 256, p.WukT(), 256, 256, NP + tm * 64, tn * 128, smem, [=](int m, int n, float v) { C[(size_t)m * 512 + n] = f2bf(v); });
    }
  }
  big_gemm(p.CQN(), p.WuqT(), NP, 768, 384, smem, pg8::EpiFn<true, StBf16>{StBf16{(bf16_t*)p.Qraw(), 768}});
  big_gemm(p.CKV(), p.WukT(), NP, 512, 256, smem, pg8::EpiFn<true, StBf16>{StBf16{(bf16_t*)p.KNraw(), 512}});
  {
    pg8::Gemm g{p.WuvT(), p.CKV(), 512, NP, 256};
    pg8::StaticOrder S;
    S.init(512, NP, (int)gridDim.x, (int)((blockIdx.x + gridDim.x / 2) % gridDim.x));
    pg8::EpiFn<true, StBf16> E{StBf16{p.VT(), NP}};
    pg8::gemm_phase<pg8::EpiFn<true, StBf16>, pg8::StaticOrder, false>((PG8_LAS unsigned char*)smem, g, S, E, nullptr);
  }
}

__device__ __forceinline__ float sum8(float v) {
  v += __shfl_xor(v, 1); v += __shfl_xor(v, 2); v += __shfl_xor(v, 4);
  return v;
}
__device__ __forceinline__ void ssm_scan_prompt(const Params& p, int job);
__device__ __forceinline__ void ssm_sample(const Params& p, int job);
__device__ __forceinline__ void phase_post2(const Params& p) {
  const int lane = tidx() & 63, gw = blockIdx.x * 8 + (tidx() >> 6), GW = gridDim.x * 8;
  if (gw < 128) { ssm_scan_prompt(p, gw); }
  for (int j = gw; j < 4096; j += GW) ssm_sample(p, j);
  if (gw < 128) return;
  const int h = lane >> 3, a8 = lane & 7;
  float gq[8], gk[8], gr[4], inv[4];
#pragma unroll
  for (int e = 0; e < 8; ++e) { gq[e] = p.g_qn[a8 * 8 + e] * QSCALE; gk[e] = p.g_kn[a8 * 8 + e]; }
#pragma unroll
  for (int e = 0; e < 4; ++e) {
    gr[e] = p.g_qr[a8 * 4 + e] * QSCALE;
    inv[e] = exp2f(-(float)((a8 & 3) * 4 + e) * (13.287712379549449f / 16.f));
  }
  if (gw - 128 >= NT) return;
  uint4 n_x, n_k; uint2 n_w;
#define P2_LOAD(R_) do { const bf16_t* q_ = (const bf16_t*)p.Qraw() + (size_t)(R_) * 768 + h * 96; const bf16_t* kn_ = (const bf16_t*)p.KNraw() + (size_t)(R_) * 512 + h * 64 + a8 * 8; \
    n_x = *(const uint4*)(q_ + a8 * 8); n_w = *(const uint2*)(q_ + 64 + a8 * 4); n_k = *(const uint4*)kn_; } while (0)
  P2_LOAD(gw - 128);
  for (int r = gw - 128; r < NT; r += GW - 128) {
    const bool isP = r < NP;
    const int rs = r - NP;
    const float pos = isP ? (float)(r & 4095) : (float)(8192 + (rs & 3));
    const float4 c_x0 = make_float4(bflo(n_x.x), bfhi(n_x.x), bflo(n_x.y), bfhi(n_x.y)), c_x1 = make_float4(bflo(n_x.z), bfhi(n_x.z), bflo(n_x.w), bfhi(n_x.w));
    const float4 c_w = make_float4(bflo(n_w.x), bfhi(n_w.x), bflo(n_w.y), bfhi(n_w.y));
    const float4 c_k0 = make_float4(bflo(n_k.x), bfhi(n_k.x), bflo(n_k.y), bfhi(n_k.y)), c_k1 = make_float4(bflo(n_k.z), bfhi(n_k.z), bflo(n_k.w), bfhi(n_k.w));
    P2_LOAD(r + GW - 128 < NT ? r + GW - 128 : r);
    float4 x0 = c_x0, x1 = c_x1;
    float ss = sum8(x0.x * x0.x + x0.y * x0.y + x0.z * x0.z + x0.w * x0.w + x1.x * x1.x + x1.y * x1.y + x1.z * x1.z + x1.w * x1.w);
    float ri = rsqrtf(ss * (1.f / 64.f) + EPS);
    bf16_t* qo = p.Qb() + ((size_t)r * 8 + h) * 96;
    *(uint4*)(qo + a8 * 8) = make_uint4(pk2(x0.x * ri * gq[0], x0.y * ri * gq[1]), pk2(x0.z * ri * gq[2], x0.w * ri * gq[3]),
                                         pk2(x1.x * ri * gq[4], x1.y * ri * gq[5]), pk2(x1.z * ri * gq[6], x1.w * ri * gq[7]));
    float4 w = c_w;
    float s2 = sum8(w.x * w.x + w.y * w.y + w.z * w.z + w.w * w.w);
    float r2 = rsqrtf(s2 * (1.f / 32.f) + EPS);
    float xv[4] = {w.x * r2 * gr[0], w.y * r2 * gr[1], w.z * r2 * gr[2], w.w * r2 * gr[3]};
    float ov[4];
#pragma unroll
    for (int e = 0; e < 4; ++e) {
      float other = __shfl_xor(xv[e], 4);
      float sn, cs;
      sincos_rev(pos * inv[e], sn, cs);
      ov[e] = (a8 & 4) ? (xv[e] * cs + other * sn) : (xv[e] * cs - other * sn);
    }
    *(uint2*)(qo + 64 + a8 * 4) = make_uint2(pk2(ov[0], ov[1]), pk2(ov[2], ov[3]));
    float4 k0 = c_k0, k1 = c_k1;
    float ks = sum8(k0.x * k0.x + k0.y * k0.y + k0.z * k0.z + k0.w * k0.w + k1.x * k1.x + k1.y * k1.y + k1.z * k1.z + k1.w * k1.w);
    float kri = rsqrtf(ks * (1.f / 64.f) + EPS);
    bf16_t* ko = isP ? p.Kcat() + ((size_t)((r >> 12) * 8 + h) * 4096 + (r & 4095)) * 96 : p.KcatS() + ((size_t)((rs >> 2) * 8 + h) * 4 + (rs & 3)) * 96;
    *(uint4*)(ko + a8 * 8) = make_uint4(pk2(k0.x * kri * gk[0], k0.y * kri * gk[1]), pk2(k0.z * kri * gk[2], k0.w * kri * gk[3]),
                                         pk2(k1.x * kri * gk[4], k1.y * kri * gk[5]), pk2(k1.z * kri * gk[6], k1.w * kri * gk[7]));
  }
}

__device__ __forceinline__ float softmax_bound(const Params& p) {
  const int lane = tidx() & 63;
  float a = fabsf(p.g_qn[lane]), b = fabsf(p.g_kn[lane]), c = fabsf(p.g_qr[lane & 31]), d = fabsf(p.g_kr[lane & 31]);
#pragma unroll
  for (int o = 32; o >= 1; o >>= 1) {
    a = fmaxf(a, __shfl_xor(a, o)); b = fmaxf(b, __shfl_xor(b, o));
    c = fmaxf(c, __shfl_xor(c, o)); d = fmaxf(d, __shfl_xor(d, o));
  }
  return QSCALE * (64.f * a * b + 32.f * c * d);
}

#define KLD 104
#define VLD 68
__device__ __forceinline__ void attn_prompt_block(const Params& p, char* smem, int b, int h, int qi, float Mb) {
  bf16_t* Ks = (bf16_t*)smem;
  bf16_t* Vs = Ks + 2 * 64 * KLD;
  const int tid = tidx(), lane = tid & 63, wave = tid >> 6, lr = lane & 31, hh = lane >> 5;
  const int q0 = qi * 256 + wave * 32;
  const bf16_t* Kg = p.Kcat() + (size_t)(b * 8 + h) * 4096 * 96;
  const bf16_t* Vg = p.VT() + (size_t)(h * 64) * NP + b * 4096;
  bf16x8 qf[6];
  {
    const bf16_t* qp = p.Qb() + ((size_t)(b * 4096 + q0 + lr) * 8 + h) * 96 + hh * 8;
#pragma unroll
    for (int s = 0; s < 6; ++s) qf[s] = *(const bf16x8*)(qp + s * 16);
  }
  f32x16 ot[2];
#pragma unroll
  for (int i = 0; i < 2; ++i)
#pragma unroll
    for (int r = 0; r < 16; ++r) ot[i][r] = 0.f;
  float lsum = 0.f;
  const int nkt = 4 * (qi + 1);
  uint4 kA0, kA1, kB0, kB1;
  uint2 vA0, vA1, vB0, vB1;
#define PA_GLOAD(kt_, k0r, k1r, v0r, v1r) do { const int k0_ = ((kt_) < nkt ? (kt_) : nkt - 1) * 64; \
    { int c = tid; int row = c / 12, cc = c % 12; k0r = *(const uint4*)(Kg + (size_t)(k0_ + row) * 96 + cc * 8); } \
    { int c = tid + NTHR; c = c < 768 ? c : 767; int row = c / 12, cc = c % 12; k1r = *(const uint4*)(Kg + (size_t)(k0_ + row) * 96 + cc * 8); } \
    { int c = tid, row = c >> 4, cc = c & 15; v0r = *(const uint2*)(Vg + (size_t)row * NP + k0_ + cc * 4); } \
    { int c = tid + NTHR, row = c >> 4, cc = c & 15; v1r = *(const uint2*)(Vg + (size_t)row * NP + k0_ + cc * 4); } } while (0)
#define PA_LSTORE(buf_, k0r, k1r, v0r, v1r) do { \
    { int c = tid; int row = c / 12, cc = c % 12; *(uint4*)(Ks + ((buf_) * 64 + row) * KLD + cc * 8) = k0r; } \
    { int c = tid + NTHR; if (c < 768) { int row = c / 12, cc = c % 12; *(uint4*)(Ks + ((buf_) * 64 + row) * KLD + cc * 8) = k1r; } } \
    { int c = tid, row = c >> 4, cc = c & 15; *(uint2*)(Vs + ((buf_) * 64 + row) * VLD + cc * 4) = v0r; } \
    { int c = tid + NTHR, row = c >> 4, cc = c & 15; *(uint2*)(Vs + ((buf_) * 64 + row) * VLD + cc * 4) = v1r; } } while (0)
  auto compute = [&](int kt, int buf) __attribute__((always_inline)) {
    const int k0 = kt * 64;
    if (k0 <= q0 + 31) {
      const bool need_mask = (k0 + 63 > q0);
      bf16x8 pb[2][2];
#pragma unroll
      for (int kt2 = 0; kt2 < 2; ++kt2) {
        f32x16 st;
#pragma unroll
        for (int r = 0; r < 16; ++r) st[r] = -Mb;
#pragma unroll
        for (int s = 0; s < 6; ++s) {
          bf16x8 a = *(const bf16x8*)(Ks + (buf * 64 + kt2 * 32 + lr) * KLD + s * 16 + hh * 8);
          st = mfma32(a, qf[s], st);
        }
        float pv[16];
#pragma unroll
        for (int r = 0; r < 16; ++r) {
          float e = __builtin_amdgcn_exp2f(st[r]);
          if (need_mask) {
            int key = k0 + kt2 * 32 + (r & 3) + 8 * (r >> 2) + 4 * hh;
            e = (key <= q0 + lr) ? e : 0.f;
          }
          pv[r] = e;
          lsum += e;
        }
#pragma unroll
        for (int s2 = 0; s2 < 2; ++s2)
          pb[kt2][s2] = mk8(pk2(pv[8 * s2 + 0], pv[8 * s2 + 1]), pk2(pv[8 * s2 + 2], pv[8 * s2 + 3]),
                            pk2(pv[8 * s2 + 4], pv[8 * s2 + 5]), pk2(pv[8 * s2 + 6], pv[8 * s2 + 7]));
      }
#pragma unroll
      for (int dt = 0; dt < 2; ++dt)
#pragma unroll
        for (int kt2 = 0; kt2 < 2; ++kt2)
#pragma unroll
          for (int s2 = 0; s2 < 2; ++s2) {
            const bf16_t* vp = Vs + (buf * 64 + dt * 32 + lr) * VLD + kt2 * 32 + 16 * s2 + 4 * hh;
            uint2 lo = *(const uint2*)vp, hi = *(const uint2*)(vp + 8);
            bf16x8 a = mk8(lo.x, lo.y, hi.x, hi.y);
            ot[dt] = mfma32(a, pb[kt2][s2], ot[dt]);
          }
    }
  };
  PA_GLOAD(0, kA0, kA1, vA0, vA1);
  PA_GLOAD(1, kB0, kB1, vB0, vB1);
  PA_LSTORE(0, kA0, kA1, vA0, vA1);
  PA_GLOAD(2, kA0, kA1, vA0, vA1);
  __syncthreads();
#pragma unroll 1
  for (int kt = 0; kt < nkt; kt += 2) {
    compute(kt, 0);
    PA_LSTORE(1, kB0, kB1, vB0, vB1);
    PA_GLOAD(kt + 3, kB0, kB1, vB0, vB1);
    __syncthreads();
    compute(kt + 1, 1);
    PA_LSTORE(0, kA0, kA1, vA0, vA1);
    PA_GLOAD(kt + 4, kA0, kA1, vA0, vA1);
    __syncthreads();
  }
  lsum += __shfl_xor(lsum, 32);
  const float linv = 1.f / lsum;
  bf16_t* op = p.CAT() + (size_t)(b * 4096 + q0 + lr) * 1024 + 512 + h * 64;
#pragma unroll
  for (int dt = 0; dt < 2; ++dt)
#pragma unroll
    for (int rg = 0; rg < 4; ++rg) {
      int d = dt * 32 + 8 * rg + 4 * hh;
      *(uint2*)(op + d) = make_uint2(pk2(ot[dt][4 * rg] * linv, ot[dt][4 * rg + 1] * linv), pk2(ot[dt][4 * rg + 2] * linv, ot[dt][4 * rg + 3] * linv));
    }
}

#define LLD 264
#define L8LD 272
#define KRLD 40
#define PLD 72
#define DEC_TILE_BYTES (64 * LLD * 2 + 64 * L8LD + 64 * KRLD * 2 + 256)
typedef __attribute__((ext_vector_type(8))) int i32x8;
__device__ __forceinline__ f32x16 mfma8(i32x8 a, i32x8 b, f32x16 c) {
  return __builtin_amdgcn_mfma_scale_f32_32x32x64_f8f6f4(a, b, c, 0, 0, 0, 127, 0, 127);
}
__device__ __forceinline__ void attn_decode_unit(const Params& p, char* smem, int seq, int half, float Mb) {
  const int tid = tidx(), lane = tid & 63, wave = tid >> 6, lr = lane & 31, hh = lane >> 5;
  const int hd = wave;
  bf16_t* Psh = (bf16_t*)(smem + 2 * DEC_TILE_BYTES);
  bf16_t* Qs = Psh + 32 * PLD;
  for (int i = tid; i < 8 * 4 * 96; i += NTHR) {
    int h2 = i / 384, rem = i % 384, t = rem / 96, e = rem % 96;
    const bf16_t* qp = p.Qb() + ((size_t)(NP + seq * 4 + t) * 8 + h2) * 96;
    bf16_t val;
    if (e < 64) {
      int j = e & 7, hx = (e >> 3) & 1, sp = (e >> 4) & 1, dt = e >> 5;
      int d = 32 * dt + 16 * sp + 8 * (j >> 2) + 4 * hx + (j & 3);
      val = f2bf(bf2f(qp[d]) * p.g_kn[d]);
    } else val = qp[e];
    Qs[i] = val;
  }
  i32x8 wf8[2][4];
#pragma unroll
  for (int mt = 0; mt < 2; ++mt)
#pragma unroll
    for (int ks = 0; ks < 4; ++ks) {
      const unsigned char* wp = p.W8T() + (size_t)(hd * 64 + mt * 32 + lr) * 256 + ks * 64 + hh * 32;
      uint4 a = *(const uint4*)wp, b = *(const uint4*)(wp + 16);
      wf8[mt][ks][0] = a.x; wf8[mt][ks][1] = a.y; wf8[mt][ks][2] = a.z; wf8[mt][ks][3] = a.w;
      wf8[mt][ks][4] = b.x; wf8[mt][ks][5] = b.y; wf8[mt][ks][6] = b.z; wf8[mt][ks][7] = b.w;
    }
  const float eps_w = EPS * 256.f * __uint_as_float((unsigned)(2 * p.KW()[hd] + 127) << 23);
  f32x16 oacc;
#pragma unroll
  for (int r = 0; r < 16; ++r) oacc[r] = 0.f;
  float lsum[4] = {0.f, 0.f, 0.f, 0.f};
  float4 rlA[8], rkA;
  auto gload = [&](int i, float4 (&rl)[8], float4& rk) {
    int page = p.page_table[seq * 64 + half * 32 + (i >> 1)];
    const float* lp = p.cache_lat + ((size_t)page * 128 + (i & 1) * 64) * 256;
    const float* kp = p.cache_kr + ((size_t)page * 128 + (i & 1) * 64) * 32;
#pragma unroll
    for (int j = 0; j < 8; ++j) rl[j] = ((const float4*)lp)[tid + NTHR * j];
    rk = ((const float4*)kp)[tid];
  };
  int olane = lane, otid = tid;
  auto lstore = [&](char* tb, const float4 (&rl)[8], const float4& rk) {
    const int lane = olane, tid = otid, wave = otid >> 6;
    bf16_t* latB = (bf16_t*)tb;
    unsigned char* lat8 = (unsigned char*)(tb + 64 * LLD * 2);
    bf16_t* krB = (bf16_t*)(tb + 64 * LLD * 2 + 64 * L8LD);
#pragma unroll
    for (int j = 0; j < 8; ++j) {
      const int row = wave + 8 * j;
      float4 v = rl[j];
      int pk = 0;
      pk = __builtin_amdgcn_cvt_pk_fp8_f32(__builtin_amdgcn_fmed3f(v.x * 16.f, -448.f, 448.f), __builtin_amdgcn_fmed3f(v.y * 16.f, -448.f, 448.f), pk, false);
      pk = __builtin_amdgcn_cvt_pk_fp8_f32(__builtin_amdgcn_fmed3f(v.z * 16.f, -448.f, 448.f), __builtin_amdgcn_fmed3f(v.w * 16.f, -448.f, 448.f), pk, true);
      *(unsigned*)(lat8 + row * L8LD + lane * 4) = (unsigned)pk;
      *(uint2*)(latB + row * LLD + lane * 4) = make_uint2(pk2(v.x, v.y), pk2(v.z, v.w));
    }
    int row = tid >> 3, c4 = tid & 7;
    *(uint2*)(krB + row * KRLD + c4 * 4) = make_uint2(pk2(rk.x, rk.y), pk2(rk.z, rk.w));
  };
  auto lstore_new = [&](char* tb) {
    const int lane = olane, tid = otid, wave = otid >> 6;
    bf16_t* latB = (bf16_t*)tb;
    unsigned char* lat8 = (unsigned char*)(tb + 64 * LLD * 2);
    bf16_t* krB = (bf16_t*)(tb + 64 * LLD * 2 + 64 * L8LD);
#pragma unroll
    for (int j = 0; j < 8; ++j) {
      const int row = wave + 8 * j;
      uint2 v = make_uint2(0, 0);
      if (row < 4) v = *(const uint2*)(p.CKV() + (size_t)(NP + seq * 4 + row) * 256 + lane * 4);
      float f0 = bflo(v.x), f1 = bfhi(v.x), f2 = bflo(v.y), f3 = bfhi(v.y);
      int pk = 0;
      pk = __builtin_amdgcn_cvt_pk_fp8_f32(__builtin_amdgcn_fmed3f(f0 * 16.f, -448.f, 448.f), __builtin_amdgcn_fmed3f(f1 * 16.f, -448.f, 448.f), pk, false);
      pk = __builtin_amdgcn_cvt_pk_fp8_f32(__builtin_amdgcn_fmed3f(f2 * 16.f, -448.f, 448.f), __builtin_amdgcn_fmed3f(f3 * 16.f, -448.f, 448.f), pk, true);
      *(unsigned*)(lat8 + row * L8LD + lane * 4) = (unsigned)pk;
      *(uint2*)(latB + row * LLD + lane * 4) = v;
    }
    int row = tid >> 3, c4 = tid & 7;
    uint2 v = make_uint2(0, 0);
    if (row < 4) v = *(const uint2*)(p.KcatS() + ((size_t)(seq * 8) * 4 + row) * 96 + 64 + c4 * 4);
    *(uint2*)(krB + row * KRLD + c4 * 4) = v;
  };
  auto compute = [&](char* tb, bool isnew) {
    const int lane = olane, wave = otid >> 6, lr = olane & 31, hh = olane >> 5, hd = otid >> 6;
    const bf16_t* latB = (const bf16_t*)tb;
    const unsigned char* lat8 = (const unsigned char*)(tb + 64 * LLD * 2);
    const bf16_t* krB = (const bf16_t*)(tb + 64 * LLD * 2 + 64 * L8LD);
#pragma unroll 1
    for (int kt2 = 0; kt2 < 2; ++kt2) {
      float ss = 0.f;
      f32x16 s1;
#pragma unroll
      for (int r = 0; r < 16; ++r) s1[r] = 0.f;
      const unsigned char* bp = lat8 + (kt2 * 32 + lr) * L8LD + hh * 32;
#pragma unroll
      for (int mt = 0; mt < 2; ++mt) {
        f32x16 acc;
#pragma unroll
        for (int r = 0; r < 16; ++r) acc[r] = 0.f;
#pragma unroll
        for (int ks = 0; ks < 4; ++ks) {
          uint4 a = *(const uint4*)(bp + ks * 64), b = *(const uint4*)(bp + ks * 64 + 16);
          i32x8 bv;
          bv[0] = a.x; bv[1] = a.y; bv[2] = a.z; bv[3] = a.w; bv[4] = b.x; bv[5] = b.y; bv[6] = b.z; bv[7] = b.w;
          acc = mfma8(wf8[mt][ks], bv, acc);
        }
#pragma unroll
        for (int r = 0; r < 16; ++r) ss += acc[r] * acc[r];
#pragma unroll
        for (int sp = 0; sp < 2; ++sp) {
          bf16x8 bk = mk8(pk2(acc[8 * sp + 0], acc[8 * sp + 1]), pk2(acc[8 * sp + 2], acc[8 * sp + 3]),
                          pk2(acc[8 * sp + 4], acc[8 * sp + 5]), pk2(acc[8 * sp + 6], acc[8 * sp + 7]));
          uint4 qa = make_uint4(0, 0, 0, 0);
          if (lr < 4) qa = *(const uint4*)(Qs + (hd * 4 + lr) * 96 + ((mt * 2 + sp) * 2 + hh) * 8);
          s1 = mfma32(__builtin_bit_cast(bf16x8, qa), bk, s1);
        }
      }
      ss += __shfl_xor(ss, 32);
      const float rinv = rsqrtf(ss * (1.f / 64.f) + eps_w);
      float s1v[4] = {s1[0] * rinv, s1[1] * rinv, s1[2] * rinv, s1[3] * rinv};
      f32x16 s2;
#pragma unroll
      for (int r = 0; r < 16; ++r) s2[r] = 0.f;
#pragma unroll
      for (int s = 0; s < 2; ++s) {
        bf16x8 bk = *(const bf16x8*)(krB + (kt2 * 32 + lr) * KRLD + s * 16 + hh * 8);
        uint4 qa = make_uint4(0, 0, 0, 0);
        if (lr < 4) qa = *(const uint4*)(Qs + (hd * 4 + lr) * 96 + 64 + s * 16 + hh * 8);
        s2 = mfma32(__builtin_bit_cast(bf16x8, qa), bk, s2);
      }
      if (hh == 0) {
        const int kk = kt2 * 32 + lr;
#pragma unroll
        for (int t = 0; t < 4; ++t) {
          float e = __builtin_amdgcn_exp2f(s1v[t] + s2[t] - Mb);
          if (isnew) e = (kk < 4 && kk <= t) ? e : 0.f;
          lsum[t] += e;
          Psh[(hd * 4 + t) * PLD + kk] = f2bf(e);
        }
      }
    }
    __syncthreads();
    {
      const int n0 = wave * 32;
#pragma unroll
      for (int ks = 0; ks < 4; ++ks) {
        bf16x8 a = *(const bf16x8*)(Psh + lr * PLD + ks * 16 + hh * 8);
        const int key0 = ks * 16 + 8 * hh, c0 = n0 + 16 * ((lane >> 4) & 1);
        const int q = (lane & 15) >> 2, pp = lane & 3;
        const bf16_t* ap = latB + (key0 + q) * LLD + c0 + 4 * pp;
        s16x4 lo = __builtin_amdgcn_ds_read_tr16_b64_v4i16((__attribute__((address_space(3))) s16x4*)(ap));
        s16x4 hi = __builtin_amdgcn_ds_read_tr16_b64_v4i16((__attribute__((address_space(3))) s16x4*)(ap + 4 * LLD));
        bf16x8 bfr;
        bfr[0] = lo[0]; bfr[1] = lo[1]; bfr[2] = lo[2]; bfr[3] = lo[3];
        bfr[4] = hi[0]; bfr[5] = hi[1]; bfr[6] = hi[2]; bfr[7] = hi[3];
        oacc = mfma32(a, bfr, oacc);
      }
    }
  };
  gload(0, rlA, rkA);
  const int ntile = 64 + half;
#pragma unroll 1
  for (int i = 0; i < ntile; ++i) {
    char* tb = smem + (i & 1) * DEC_TILE_BYTES;
    asm volatile("" : "+v"(olane), "+v"(otid));
    if (i < 64) lstore(tb, rlA, rkA); else lstore_new(tb);
    if (i + 1 < 64) gload(i + 1, rlA, rkA);
    __syncthreads();
    compute(tb, i == 64);
  }
  float* Op = p.Opart() + ((size_t)(seq * 2 + half) * 32) * 256;
#pragma unroll
  for (int r = 0; r < 16; ++r) {
    int m = (r & 3) + 8 * (r >> 2) + 4 * hh;
    Op[(size_t)m * 256 + wave * 32 + lr] = oacc[r];
  }
#pragma unroll
  for (int t = 0; t < 4; ++t) {
    float v = (hh == 0) ? lsum[t] : 0.f;
    v = wave_sum(v);
    if (lane == 0) p.Lpart()[(seq * 2 + half) * 32 + hd * 4 + t] = v;
  }
  __syncthreads();
}

typedef unsigned lds_u4 __attribute__((ext_vector_type(4)));
typedef unsigned lds_u2 __attribute__((ext_vector_type(2)));
typedef float lds_f4 __attribute__((ext_vector_type(4)));
__device__ __forceinline__ uint4 ldl_u4(const LAS void* p) { lds_u4 v = *(const LAS lds_u4*)p; return make_uint4(v.x, v.y, v.z, v.w); }
__device__ __forceinline__ float4 ldl_f4(const LAS void* p) { lds_f4 v = *(const LAS lds_f4*)p; return make_float4(v.x, v.y, v.z, v.w); }
__device__ __forceinline__ void stl_u2(LAS void* p, unsigned a, unsigned b) { lds_u2 v = {a, b}; *(LAS lds_u2*)p = v; }
__device__ __forceinline__ void stl_u4(LAS void* p, uint4 a) { lds_u4 v = {a.x, a.y, a.z, a.w}; *(LAS lds_u4*)p = v; }
#define D_STAGE 36864
#define D_TB (3 * D_STAGE)
#define D_LAT8 (32 * LLD * 2)
#define D_KRB (D_LAT8 + 32 * L8LD)
#define D_TBSZ (D_KRB + 32 * KRLD * 2)
#define D_PLD 40
#define D_PSH (D_TB + D_TBSZ)
#define D_QS (D_PSH + 32 * D_PLD * 2)
#define D_END (D_QS + 8 * 4 * 96 * 2)
__device__ __forceinline__ void bar_lds() { asm volatile("s_waitcnt lgkmcnt(0)\n\ts_barrier" ::: "memory"); }
__device__ __forceinline__ void attn_decode_unit_dma(const Params& p, char* smem_generic, int seq, int half, float Mb) {
  LAS char* const smem = (LAS char*)smem_generic;
  const int tid = tidx(), lane = tid & 63, wave = tid >> 6, lr = lane & 31, hh = lane >> 5;
  const int hd = wave;
  LAS bf16_t* Psh = (LAS bf16_t*)(smem + D_PSH);
  LAS bf16_t* Qs = (LAS bf16_t*)(smem + D_QS);
  for (int i = tid; i < 8 * 4 * 96; i += NTHR) {
    int h2 = i / 384, rem = i % 384, t = rem / 96, e = rem % 96;
    const bf16_t* qp = p.Qb() + ((size_t)(NP + seq * 4 + t) * 8 + h2) * 96;
    bf16_t val;
    if (e < 64) {
      int j = e & 7, hx = (e >> 3) & 1, sp = (e >> 4) & 1, dt = e >> 5;
      int d = 32 * dt + 16 * sp + 8 * (j >> 2) + 4 * hx + (j & 3);
      val = f2bf(bf2f(qp[d]) * p.g_kn[d]);
    } else val = qp[e];
    Qs[i] = val;
  }
  i32x8 wf8[2][4];
#pragma unroll
  for (int mt = 0; mt < 2; ++mt)
#pragma unroll
    for (int ks = 0; ks < 4; ++ks) {
      const unsigned char* wp = p.W8T() + (size_t)(hd * 64 + mt * 32 + lr) * 256 + ks * 64 + hh * 32;
      uint4 a = *(const uint4*)wp, b = *(const uint4*)(wp + 16);
      wf8[mt][ks][0] = a.x; wf8[mt][ks][1] = a.y; wf8[mt][ks][2] = a.z; wf8[mt][ks][3] = a.w;
      wf8[mt][ks][4] = b.x; wf8[mt][ks][5] = b.y; wf8[mt][ks][6] = b.z; wf8[mt][ks][7] = b.w;
    }
  const float eps_w = EPS * __uint_as_float((unsigned)(2 * p.KW()[hd] + 127) << 23);
  const int ptv = p.page_table[seq * 64 + half * 32 + lr];
  f32x16 oacc;
#pragma unroll
  for (int r = 0; r < 16; ++r) oacc[r] = 0.f;
  float lsum[4] = {0.f, 0.f, 0.f, 0.f};
  constexpr int ntile = 128;
  asm volatile("s_waitcnt vmcnt(0)" ::: "memory");
  __syncthreads();
#define DD_ISSUE(t_, SLOT) do { \
    const int tt_ = (t_) < ntile ? (t_) : ntile - 1; \
    const int page_ = __builtin_amdgcn_readlane(ptv, tt_ >> 2); \
    const char* g_ = (const char*)(p.cache_lat + ((size_t)page_ * 128 + (tt_ & 3) * 32) * 256) + lane * 16; \
    LAS char* st_ = smem + (SLOT) * D_STAGE; \
    _Pragma("unroll") for (int j = 0; j < 4; ++j) { const int row = wave + 8 * j; \
      __builtin_amdgcn_global_load_lds((const unsigned*)(g_ + row * 1024), (LAS unsigned*)(st_ + row * 1024), 16, 0, 0); } \
    if (wave < 4) {     \
      const char* gk_ = (const char*)(p.cache_kr + ((size_t)page_ * 128 + (tt_ & 3) * 32) * 32) + wave * 1024 + lane * 16; \
      __builtin_amdgcn_global_load_lds((const unsigned*)gk_, (LAS unsigned*)(st_ + 32768 + wave * 1024), 16, 0, 0); } } while (0)
  const LAS bf16_t* latB = (const LAS bf16_t*)(smem + D_TB);
  const LAS unsigned char* lat8 = (const LAS unsigned char*)(smem + D_TB + D_LAT8);
  const LAS bf16_t* krB = (const LAS bf16_t*)(smem + D_TB + D_KRB);
  auto computeB = [&](bool isnew) __attribute__((always_inline)) {
#ifdef PROBE_DECB2
    for (int prep_ = 0; prep_ < 2; ++prep_)
#endif
    {
      f32x16 s2;
#pragma unroll
      for (int r = 0; r < 16; ++r) s2[r] = 0.f;
#pragma unroll
      for (int s = 0; s < 2; ++s) {
        bf16x8 bk = *(const LAS bf16x8*)(krB + lr * KRLD + s * 16 + hh * 8);
        uint4 qa = make_uint4(0, 0, 0, 0);
        if (lr < 4) qa = ldl_u4(Qs + (hd * 4 + lr) * 96 + 64 + s * 16 + hh * 8);
        s2 = mfma32(__builtin_bit_cast(bf16x8, qa), bk, s2);
      }
      const LAS unsigned char* bp = lat8 + lr * L8LD + hh * 32;
      f32x16 acc0, acc1;
#pragma unroll
      for (int r = 0; r < 16; ++r) { acc0[r] = 0.f; acc1[r] = 0.f; }
#pragma unroll
      for (int ks = 0; ks < 4; ++ks) {
        uint4 a = ldl_u4(bp + ks * 64), b = ldl_u4(bp + ks * 64 + 16);
        i32x8 bv;
        bv[0] = a.x; bv[1] = a.y; bv[2] = a.z; bv[3] = a.w; bv[4] = b.x; bv[5] = b.y; bv[6] = b.z; bv[7] = b.w;
        acc0 = mfma8(wf8[0][ks], bv, acc0);
        acc1 = mfma8(wf8[1][ks], bv, acc1);
      }
      uint4 qn[4];
#pragma unroll
      for (int f = 0; f < 4; ++f) {
        qn[f] = make_uint4(0, 0, 0, 0);
        if (lr < 4) qn[f] = ldl_u4(Qs + (hd * 4 + lr) * 96 + (f * 2 + hh) * 8);
      }
      float ss = 0.f;
      f32x16 s1;
#pragma unroll
      for (int r = 0; r < 16; ++r) s1[r] = 0.f;
#pragma unroll
      for (int r = 0; r < 16; ++r) ss += acc0[r] * acc0[r];
#pragma unroll
      for (int sp = 0; sp < 2; ++sp) {
        bf16x8 bk = mk8(pk2(acc0[8 * sp + 0], acc0[8 * sp + 1]), pk2(acc0[8 * sp + 2], acc0[8 * sp + 3]),
                        pk2(acc0[8 * sp + 4], acc0[8 * sp + 5]), pk2(acc0[8 * sp + 6], acc0[8 * sp + 7]));
        s1 = mfma32(__builtin_bit_cast(bf16x8, qn[sp]), bk, s1);
      }
#pragma unroll
      for (int r = 0; r < 16; ++r) ss += acc1[r] * acc1[r];
#pragma unroll
      for (int sp = 0; sp < 2; ++sp) {
        bf16x8 bk = mk8(pk2(acc1[8 * sp + 0], acc1[8 * sp + 1]), pk2(acc1[8 * sp + 2], acc1[8 * sp + 3]),
                        pk2(acc1[8 * sp + 4], acc1[8 * sp + 5]), pk2(acc1[8 * sp + 6], acc1[8 * sp + 7]));
        s1 = mfma32(__builtin_bit_cast(bf16x8, qn[2 + sp]), bk, s1);
      }
      ss += __shfl_xor(ss, 32);
      const float rinv = rsqrtf(ss * (1.f / 64.f) + eps_w);
      if (hh == 0) {
#pragma unroll
        for (int t = 0; t < 4; ++t) {
          float e = __builtin_amdgcn_exp2f(s1[t] * rinv + (s2[t] - Mb));
          if (isnew) e = (lr < 4 && lr <= t) ? e : 0.f;
#ifdef PROBE_DECB2
          if (prep_ == 0)
#endif
          lsum[t] += e;
          Psh[(hd * 4 + t) * D_PLD + lr] = f2bf(e);
        }
      }
    }
  };
  auto computeC = [&]() __attribute__((always_inline)) {
    {
      const int n0 = wave * 32;
      const int key0 = 8 * hh, c0 = n0 + 16 * ((lane >> 4) & 1);
      const int q = (lane & 15) >> 2, pp = lane & 3;
      const LAS bf16_t* ap = latB + (key0 + q) * LLD + c0 + 4 * pp;
      const LAS bf16_t* pa = Psh + lr * D_PLD + hh * 8;
      lds_u2 lo0, hi0, lo1, hi1;
      lds_u4 a0v, a1v;
      static_assert(4 * LLD * 2 == 2112 && 16 * LLD * 2 == 8448, "offsets of the transposed reads");
      asm volatile("ds_read_b128 %4, %7\n\tds_read_b128 %5, %7 offset:32\n\t"
                   "ds_read_b64_tr_b16 %0, %6\n\tds_read_b64_tr_b16 %1, %6 offset:2112\n\t"
                   "ds_read_b64_tr_b16 %2, %6 offset:8448\n\tds_read_b64_tr_b16 %3, %6 offset:10560\n\ts_waitcnt lgkmcnt(0)"
                   : "=&v"(lo0), "=&v"(hi0), "=&v"(lo1), "=&v"(hi1), "=&v"(a0v), "=&v"(a1v)
                   : "v"((unsigned)(__UINTPTR_TYPE__)ap), "v"((unsigned)(__UINTPTR_TYPE__)pa) : "memory");
      oacc = mfma32(__builtin_bit_cast(bf16x8, a0v), mk8(lo0.x, lo0.y, hi0.x, hi0.y), oacc);
      oacc = mfma32(__builtin_bit_cast(bf16x8, a1v), mk8(lo1.x, lo1.y, hi1.x, hi1.y), oacc);
    }
  };
#define DD_STEP(t_, SLOT) do { \
    if (wave < 4) asm volatile("s_waitcnt vmcnt(10)" ::: "memory");     \
    else asm volatile("s_waitcnt vmcnt(8)" ::: "memory"); \
    bar_lds();                                              \
    { const LAS char* st = smem + (SLOT) * D_STAGE; \
      LAS bf16_t* latB = (LAS bf16_t*)(smem + D_TB); \
      LAS unsigned char* lat8 = (LAS unsigned char*)(smem + D_TB + D_LAT8); \
      LAS bf16_t* krB = (LAS bf16_t*)(smem + D_TB + D_KRB); \
      float4 cv_[4], ck_ = make_float4(0.f, 0.f, 0.f, 0.f); \
      _Pragma("unroll") for (int j = 0; j < 4; ++j) cv_[j] = ldl_f4(st + (wave + 8 * j) * 1024 + lane * 16);     \
      if (tid < 256) ck_ = ldl_f4(st + 32768 + tid * 16); \
      _Pragma("unroll") for (int j = 0; j < 4; ++j) { \
        const int row = wave + 8 * j; \
        const float4 v = cv_[j]; \
        int pk = 0; \
        pk = __builtin_amdgcn_cvt_pk_fp8_f32(v.x, v.y, pk, false); \
        pk = __builtin_amdgcn_cvt_pk_fp8_f32(v.z, v.w, pk, true); \
        *(LAS unsigned*)(lat8 + row * L8LD + lane * 4) = (unsigned)pk; \
        stl_u2(latB + row * LLD + lane * 4, pk2(v.x, v.y), pk2(v.z, v.w)); } \
      if (tid < 256) stl_u2(krB + (tid >> 3) * KRLD + (tid & 7) * 4, pk2(ck_.x, ck_.y), pk2(ck_.z, ck_.w)); } \
    bar_lds();                                              \
      \
      \
    if (wave < 4) DD_ISSUE((t_) + 3, SLOT); \
    computeB(false); \
    if (wave >= 4) DD_ISSUE((t_) + 3, SLOT); \
    bar_lds(); \
    computeC(); } while (0)
  DD_ISSUE(0, 0);
  DD_ISSUE(1, 1);
  DD_ISSUE(2, 2);
#pragma unroll 1
  for (int t = 0; t < 126; t += 3) { DD_STEP(t, 0); DD_STEP(t + 1, 1); DD_STEP(t + 2, 2); }
  DD_STEP(126, 0);
  DD_STEP(127, 1);
  asm volatile("s_waitcnt vmcnt(0)" ::: "memory");
  bar_lds();
  if (half) {
    LAS bf16_t* latB = (LAS bf16_t*)(smem + D_TB);
    LAS unsigned char* lat8 = (LAS unsigned char*)(smem + D_TB + D_LAT8);
    LAS bf16_t* krB = (LAS bf16_t*)(smem + D_TB + D_KRB);
#pragma unroll
    for (int j = 0; j < 4; ++j) {
      const int row = wave + 8 * j;
      uint2 v = make_uint2(0, 0);
      if (row < 4) v = *(const uint2*)(p.CKV() + (size_t)(NP + seq * 4 + row) * 256 + lane * 4);
      float f0 = bflo(v.x), f1 = bfhi(v.x), f2 = bflo(v.y), f3 = bfhi(v.y);
      int pk = 0;
      pk = __builtin_amdgcn_cvt_pk_fp8_f32(f0, f1, pk, false);
      pk = __builtin_amdgcn_cvt_pk_fp8_f32(f2, f3, pk, true);
      *(LAS unsigned*)(lat8 + row * L8LD + lane * 4) = (unsigned)pk;
      stl_u2(latB + row * LLD + lane * 4, v.x, v.y);
    }
    if (tid < 256) {
      const int row = tid >> 3, c4 = tid & 7;
      uint2 v = make_uint2(0, 0);
      if (row < 4) v = *(const uint2*)(p.KcatS() + ((size_t)(seq * 8) * 4 + row) * 96 + 64 + c4 * 4);
      stl_u2(krB + row * KRLD + c4 * 4, v.x, v.y);
    }
    __syncthreads();
    computeB(true);
    bar_lds();
    computeC();
  }
  float* Op = p.Opart() + ((size_t)(seq * 2 + half) * 32) * 256;
#pragma unroll
  for (int r = 0; r < 16; ++r) {
    int m = (r & 3) + 8 * (r >> 2) + 4 * hh;
    Op[(size_t)m * 256 + wave * 32 + lr] = oacc[r];
  }
#pragma unroll
  for (int t = 0; t < 4; ++t) {
    float v = (hh == 0) ? lsum[t] : 0.f;
    v = wave_sum(v);
    if (lane == 0) p.Lpart()[(seq * 2 + half) * 32 + hd * 4 + t] = v;
  }
  __syncthreads();
}

__device__ __forceinline__ void ssm_scan_prompt(const Params& p, int job) {
  const int lane = tidx() & 63;
  const int b = job >> 5, g = job & 31;
  const float dt = __expf(p.log_dt[g]);
  const Cplx a16 = apow(p.a_re[g * 64 + lane], p.a_im[g * 64 + lane], dt, 16.f);
  Cplx H = {0.f, 0.f};
  const float* S = p.S() + ((size_t)g * NSUB + b * 256) * 128;
  bf16_t* A2 = p.A2() + ((size_t)g * NSUB + b * 256) * A2LD + 256;
  for (int n0 = 0; n0 < 256; n0 += 32) {
    float sr[32], si[32];
#pragma unroll
    for (int k = 0; k < 32; ++k) { sr[k] = S[(size_t)(n0 + k) * 128 + lane]; si[k] = S[(size_t)(n0 + k) * 128 + 64 + lane]; }
#pragma unroll
    for (int k = 0; k < 32; ++k) {
      A2[(size_t)(n0 + k) * A2LD + lane] = f2bf(H.re);
      A2[(size_t)(n0 + k) * A2LD + 64 + lane] = f2bf(H.im);
      Cplx t = cmul(a16, H);
      H.re = t.re + sr[k]; H.im = t.im + si[k];
    }
  }
  float* o = p.out + O_SSMP + ((size_t)(b * 32 + g) * 64 + lane) * 2;
  o[0] = H.re; o[1] = H.im;
}
__device__ __forceinline__ void ssm_sample(const Params& p, int job) {
  const int lane = tidx() & 63;
  const int seq = job >> 5, g = job & 31;
  const float dt = __expf(p.log_dt[g]);
  const float are = p.a_re[g * 64 + lane], aim = p.a_im[g * 64 + lane];
  const Cplx ab = apow(are, aim, dt, 1.f);
  const Cplx bs = bscale(are, aim, dt);
  const float* st = p.state_ssm + ((size_t)(seq * 32 + g) * 64 + lane) * 2;
  Cplx H = {st[0], st[1]};
  const Cplx H0 = H;
  bf16_t* A2 = p.A2() + ((size_t)g * NSUB + 1024 + seq) * A2LD + 256;
  Cplx bb[16];
#pragma unroll
  for (int h = 0; h < 16; ++h) {
    Cplx braw = {p.ssm_b[((g * 64 + lane) * 16 + h) * 2], p.ssm_b[((g * 64 + lane) * 16 + h) * 2 + 1]};
    bb[h] = cmul(bs, braw);
  }
#pragma unroll
  for (int t = 0; t < 4; ++t) {
    const bf16_t* u = (const bf16_t*)p.Z() + (size_t)(NP + seq * 4 + t) * INW + g * 16;
    const uint4 u0 = *(const uint4*)u, u1 = *(const uint4*)(u + 8);
    const float uf[16] = {bflo(u0.x), bfhi(u0.x), bflo(u0.y), bfhi(u0.y), bflo(u0.z), bfhi(u0.z), bflo(u0.w), bfhi(u0.w),
                          bflo(u1.x), bfhi(u1.x), bflo(u1.y), bfhi(u1.y), bflo(u1.z), bfhi(u1.z), bflo(u1.w), bfhi(u1.w)};
    Cplx bu = {0.f, 0.f};
#pragma unroll
    for (int h = 0; h < 16; ++h) { float uv = uf[h]; bu.re += uv * bb[h].re; bu.im += uv * bb[h].im; }
    Cplx tt = cmul(ab, H);
    H.re = tt.re + bu.re; H.im = tt.im + bu.im;
  }
  A2[lane] = f2bf(H0.re);
  A2[64 + lane] = f2bf(H0.im);
  float* o = p.out + O_SSMS + ((size_t)(seq * 32 + g) * 64 + lane) * 2;
  o[0] = H.re; o[1] = H.im;
}

__device__ __forceinline__ void ssm_y_gemm(const Params& p, char* smem);
__device__ __forceinline__ void phase_attn(const Params& p, char* smem) {
  const int wave = tidx() >> 6;
  const int gw = blockIdx.x * 8 + wave, GW = gridDim.x * 8;
  ssm_y_gemm(p, smem);
  __syncthreads();
  const float Mb = softmax_bound(p);
  __syncthreads();
#ifdef PROBE_PROMPT2
  for (int rep = 0; rep < 2; ++rep)
#endif
  for (int it = blockIdx.x; it < 256; it += gridDim.x) {
    const int xg = it & 7, rr = it >> 3, bh = xg * 4 + (rr >> 3), j = rr & 7;
    attn_prompt_block(p, smem, bh >> 3, bh & 7, j, Mb);
    attn_prompt_block(p, smem, bh >> 3, bh & 7, 15 - j, Mb);
  }
  for (int it = blockIdx.x; it < 256; it += gridDim.x) attn_decode_unit_dma(p, smem, it >> 1, it & 1, Mb);
}

struct SsmOrder {
  int G, c;
  __device__ bool next(int i, pg8::Unit& u) const {
    const int L = i * G + c;
    if (L >= 32 * 5) return false;
    u.pm = L; u.pn = L / 5;
    return true;
  }
  __device__ __forceinline__ void a_ready(const pg8::Unit&) const {}
  __device__ __forceinline__ void done(const pg8::Unit&) const {}
};
struct StSsmY { bf16_t* G; __device__ __forceinline__ void st8(int row, int col, pg8::f32x4 a, pg8::f32x4 b) const {
    const int g = col >> 8, n = col & 255, m = row - g * NSUB, tt = n >> 4, h = n & 15;
    const bool isP = m < 1024;
    const bool ok = isP || (tt < 4 && m < NSUBV);
    const int token = isP ? m * 16 + tt : NP + (m - 1024) * 4 + (tt & 3);
    const uint4 o = make_uint4(pk2(gelu_tanh(a[0]), gelu_tanh(a[1])), pk2(gelu_tanh(a[2]), gelu_tanh(a[3])),
                               pk2(gelu_tanh(b[0]), gelu_tanh(b[1])), pk2(gelu_tanh(b[2]), gelu_tanh(b[3])));
    if (ok) *(uint4*)(G + (unsigned)(token * 512 + g * 16 + h)) = o;
  } };
__device__ __forceinline__ void decode_combine(const Params& p, char* smem) {
  const int lane = tidx() & 63, wave = tidx() >> 6, half = wave >> 2, jw = wave & 3;
  float* osh = (float*)smem + wave * 512;
  float* red = (float*)smem + 8 * 512;
  for (int jb = blockIdx.x * 4; jb < 1024; jb += gridDim.x * 4) {
    const int job = jb + jw, seq = job >> 3, hd = job & 7;
    const float* O0 = p.Opart() + ((size_t)(seq * 2) * 32 + hd * 4) * 256 + half * 128;
    const float* O1 = O0 + 32 * 256;
    float lp[4];
#pragma unroll
    for (int t = 0; t < 4; ++t) lp[t] = p.Lpart()[(seq * 2) * 32 + hd * 4 + t] + p.Lpart()[(seq * 2 + 1) * 32 + hd * 4 + t];
#pragma unroll
    for (int i = 0; i < 4; ++i) {
      float2 a = *(const float2*)(O0 + i * 256 + lane * 2), b = *(const float2*)(O1 + i * 256 + lane * 2);
      *(float2*)(osh + i * 128 + lane * 2) = make_float2(a.x + b.x, a.y + b.y);
    }
    float acc[4] = {0.f, 0.f, 0.f, 0.f};
    const float* wp = p.w_uv + (size_t)(half * 128) * 512 + hd * 64 + lane;
#pragma unroll 1
    for (int c0 = 0; c0 < 128; c0 += 32) {
      float w[32];
#pragma unroll
      for (int c = 0; c < 32; ++c) w[c] = wp[(size_t)(c0 + c) * 512];
#pragma unroll
      for (int c = 0; c < 32; ++c)
#pragma unroll
        for (int t = 0; t < 4; ++t) acc[t] += osh[t * 128 + c0 + c] * w[c];
    }
    if (half == 1) {
#pragma unroll
      for (int t = 0; t < 4; ++t) red[(jw * 4 + t) * 64 + lane] = acc[t];
    }
    __syncthreads();
    if (half == 0) {
#pragma unroll
      for (int t = 0; t < 4; ++t)
        p.CAT()[(size_t)(NP + seq * 4 + t) * 1024 + 512 + hd * 64 + lane] = f2bf((acc[t] + red[(jw * 4 + t) * 64 + lane]) / lp[t]);
    }
    __syncthreads();
  }
}
__device__ __forceinline__ void ssm_y_gemm(const Params& p, char* smem) {
  pg8::Gemm g{p.A2(), p.Bt2(), 32 * NSUB, 32 * 256, 384};
  SsmOrder S{(int)gridDim.x, (int)((blockIdx.x + 160) % gridDim.x)};
  pg8::EpiFn<true, StSsmY> E{StSsmY{p.G()}};
  pg8::gemm_phase<pg8::EpiFn<true, StSsmY>, SsmOrder, false>((PG8_LAS unsigned char*)smem, g, S, E, nullptr);
}

struct EpiGlu {
  static constexpr bool PERM = true, AFTER_DRAIN = false;
  bf16_t* CAT;
  __device__ __forceinline__ void operator()(const pg8::f32x4 (&acc)[2][2][4][2], const pg8::Unit& u, int wr, int wc, int fr, int fq) const {
    const int row0 = u.pm * 256 + wr * 64 + fr, col0 = u.pn * 128 + wc * 32 + 8 * fq;
#pragma unroll
    for (int ai = 0; ai < 2; ++ai)
#pragma unroll
      for (int m = 0; m < 4; ++m) {
        const unsigned rb = (unsigned)((row0 + ai * 128 + m * 16) * 1024 + col0);
        float o[8];
#pragma unroll
        for (int n = 0; n < 2; ++n) {
          const pg8::f32x4 v = acc[ai][0][m][n], g = acc[ai][1][m][n];
#pragma unroll
          for (int q = 0; q < 4; ++q) o[n * 4 + q] = v[q] * __builtin_amdgcn_rcpf(1.f + __builtin_amdgcn_exp2f(-1.4426950408889634f * g[q]));
        }
        *(uint4*)(CAT + rb) = make_uint4(pk2(o[0], o[1]), pk2(o[2], o[3]), pk2(o[4], o[5]), pk2(o[6], o[7]));
      }
  }
};
__device__ __forceinline__ void phase_gemm_gl(const Params& p, char* smem) {
  decode_combine(p, smem);
  bf16_t* C = p.CAT();
  for (int t = blockIdx.x; t < 4 * 8; t += gridDim.x) {
    int tm = t / 8, tn = t % 8;
    gemm_tile<4, 2, 1, 2, true>(p.G(), 512, p.WgluS(), 512, 512, NP + tm * 128, tn * 128, smem, [=](int m, int c, float v, float g) {
      C[(size_t)m * 1024 + tn * 64 + c] = f2bf(v * __builtin_amdgcn_rcpf(1.f + __builtin_amdgcn_exp2f(-1.4426950408889634f * g)));
    });
  }
  pg8::Gemm g{p.G(), p.WgluT(), NP, 1024, 512};
  pg8::StaticOrder S;
  S.init(NP, 1024, (int)gridDim.x, (int)blockIdx.x);
  EpiGlu E{C};
  pg8::gemm_phase<EpiGlu, pg8::StaticOrder, false>((PG8_LAS unsigned char*)smem, g, S, E, nullptr);
}
__device__ __forceinline__ void phase_gemm_out(const Params& p, char* smem) {
  bf16_t* C = (bf16_t*)p.X1();
  const float* xs = p.x_sample;
  for (int t = blockIdx.x; t < 8 * 8; t += gridDim.x) {
    int tm = t / 8, tn = t % 8;
    gemm_tile<2, 4, 1, 1>(p.CAT(), 1024, p.WoutT(), 1024, 1024, NP + tm * 64, tn * 128, smem, [=](int m, int n, float v) {
      C[(size_t)m * 1024 + n] = f2bf(xs[(size_t)(m - NP) * 1024 + n] + v);
    });
  }
  big_gemm(p.CAT(), p.WoutT(), NP, 1024, 1024, smem, pg8::EpiFn<true, StX1>{StX1{C, p.x_prompt}});
}
__device__ __forceinline__ void phase_gemm_pq(const Params& p, char* smem) {
  bf16_t* C = p.PQ();
  for (int t = blockIdx.x; t < 8 * 16; t += gridDim.x) {
    int tm = t / 16, tn = t % 16;
    gemm_tile<2, 4, 1, 1>(p.XN(), 1024, p.WpqT(), 1024, 1024, NP + tm * 64, tn * 128, smem, [=](int m, int n, float v) { C[(size_t)m * 2048 + n] = f2bf(v); });
  }
  big_gemm(p.XN(), p.WpqT(), NP, 2048, 1024, smem, pg8::EpiFn<true, StBf16>{StBf16{C, 2048}});
}
__device__ __forceinline__ void ins16(float (&L)[16], float x) {
#pragma unroll
  for (int j = 15; j >= 1; --j) L[j] = __builtin_amdgcn_fmed3f(L[j - 1], L[j], x);
  L[0] = fmaxf(L[0], x);
}
#define CSD(a, b) do { const float hi_ = fmaxf(a, b), lo_ = fminf(a, b); a = hi_; b = lo_; } while (0)
__device__ __forceinline__ void sort16d(float (&v)[16]) {
  CSD(v[0], v[1]); CSD(v[2], v[3]); CSD(v[4], v[5]); CSD(v[6], v[7]); CSD(v[8], v[9]); CSD(v[10], v[11]); CSD(v[12], v[13]); CSD(v[14], v[15]); CSD(v[0], v[2]);
  CSD(v[1], v[3]); CSD(v[4], v[6]); CSD(v[5], v[7]); CSD(v[8], v[10]); CSD(v[9], v[11]); CSD(v[12], v[14]); CSD(v[13], v[15]); CSD(v[1], v[2]); CSD(v[5], v[6]);
  CSD(v[9], v[10]); CSD(v[13], v[14]); CSD(v[0], v[4]); CSD(v[1], v[5]); CSD(v[2], v[6]); CSD(v[3], v[7]); CSD(v[8], v[12]); CSD(v[9], v[13]); CSD(v[10], v[14]);
  CSD(v[11], v[15]); CSD(v[2], v[4]); CSD(v[3], v[5]); CSD(v[10], v[12]); CSD(v[11], v[13]); CSD(v[1], v[2]); CSD(v[3], v[4]); CSD(v[5], v[6]); CSD(v[9], v[10]);
  CSD(v[11], v[12]); CSD(v[13], v[14]); CSD(v[0], v[8]); CSD(v[1], v[9]); CSD(v[2], v[10]); CSD(v[3], v[11]); CSD(v[4], v[12]); CSD(v[5], v[13]); CSD(v[6], v[14]);
  CSD(v[7], v[15]); CSD(v[4], v[8]); CSD(v[5], v[9]); CSD(v[6], v[10]); CSD(v[7], v[11]); CSD(v[2], v[4]); CSD(v[3], v[5]); CSD(v[6], v[8]); CSD(v[7], v[9]);
  CSD(v[10], v[12]); CSD(v[11], v[13]); CSD(v[1], v[2]); CSD(v[3], v[4]); CSD(v[5], v[6]); CSD(v[7], v[8]); CSD(v[9], v[10]); CSD(v[11], v[12]); CSD(v[13], v[14]);
}
__device__ __forceinline__ void bitonic16d(float (&v)[16]) {
  CSD(v[0], v[8]); CSD(v[1], v[9]); CSD(v[2], v[10]); CSD(v[3], v[11]); CSD(v[4], v[12]); CSD(v[5], v[13]); CSD(v[6], v[14]); CSD(v[7], v[15]); CSD(v[0], v[4]);
  CSD(v[1], v[5]); CSD(v[2], v[6]); CSD(v[3], v[7]); CSD(v[8], v[12]); CSD(v[9], v[13]); CSD(v[10], v[14]); CSD(v[11], v[15]); CSD(v[0], v[2]); CSD(v[1], v[3]);
  CSD(v[4], v[6]); CSD(v[5], v[7]); CSD(v[8], v[10]); CSD(v[9], v[11]); CSD(v[12], v[14]); CSD(v[13], v[15]); CSD(v[0], v[1]); CSD(v[2], v[3]); CSD(v[4], v[5]);
  CSD(v[6], v[7]); CSD(v[8], v[9]); CSD(v[10], v[11]); CSD(v[12], v[13]); CSD(v[14], v[15]);
}
__device__ __forceinline__ void merge16d(float (&L)[16], const float (&R)[16]) {
#pragma unroll
  for (int i = 0; i < 16; ++i) L[i] = fmaxf(L[i], R[15 - i]);
  bitonic16d(L);
}
#define PKLD 136
__device__ __forceinline__ void phase_sctopk(const Params& p, char* smem) {
  bf16_t* keysS = (bf16_t*)smem;
  unsigned char* sidx = (unsigned char*)(smem + 2 * 128 * PKLD * 2);
  const int tid = tidx(), lane = tid & 63, wave = tid >> 6, lr = lane & 31, hh = lane >> 5;
  for (int c = tid; c < 2 * 128 * 16; c += NTHR) {
    int row = c >> 4, cc = c & 15;
    *(uint4*)(keysS + row * PKLD + cc * 8) = *(const uint4*)(p.PK() + row * 128 + cc * 8);
  }
  __syncthreads();
  const int ntask = NT * 8 / 32;
  const int GWv = gridDim.x * 8, gwv = blockIdx.x * 8 + wave;
  const int nfull = ntask / GWv, rem = ntask - nfull * GWv;
  const int rstride = rem > 0 ? (GWv / rem > 0 ? GWv / rem : 1) : 1;
  const bool hasx = rem > 0 && (gwv % rstride) == 0 && (gwv / rstride) < rem;
  const int nround = nfull + (hasx ? 1 : 0);
  for (int rd = 0; rd < nround; ++rd) {
    const int task = rd < nfull ? gwv + rd * GWv : nfull * GWv + gwv / rstride;
    const int m = task * 32 + lr;
    float L[2][16];
#pragma unroll
    for (int c = 0; c < 2; ++c) {
      bf16x8 qf[8];
#pragma unroll
      for (int s2 = 0; s2 < 8; ++s2) qf[s2] = *(const bf16x8*)(p.PQ() + (size_t)m * 256 + c * 128 + s2 * 16 + hh * 8);
      auto tile = [&](int kt, float (&ch)[16]) __attribute__((always_inline)) {
        f32x16 acc;
#pragma unroll
        for (int r = 0; r < 16; ++r) acc[r] = 0.f;
#pragma unroll
        for (int s2 = 0; s2 < 8; ++s2) {
          bf16x8 a = *(const bf16x8*)(keysS + (c * 128 + kt * 32 + lr) * PKLD + s2 * 16 + hh * 8);
          acc = mfma32(a, qf[s2], acc);
        }
#pragma unroll
        for (int r = 0; r < 16; ++r) {
          unsigned key = kt * 32 + (r & 3) + 8 * (r >> 2) + 4 * hh;
          ch[r] = __uint_as_float((__float_as_uint(acc[r]) & ~127u) | key);
        }
        sort16d(ch);
      };
      tile(0, L[c]);
#pragma unroll 1
      for (int kt = 1; kt < 4; ++kt) {
        float ch[16];
        tile(kt, ch);
        merge16d(L[c], ch);
      }
      float P[16];
#pragma unroll
      for (int j = 0; j < 16; ++j) P[j] = __shfl_xor(L[c][j], 32);
      merge16d(L[c], P);
    }
#pragma unroll
    for (int j = 0; j < 16; ++j) {
      sidx[j * NTHR + tid] = (unsigned char)(__float_as_uint(L[0][j]) & 127u);
      sidx[(16 + j) * NTHR + tid] = (unsigned char)(__float_as_uint(L[1][j]) & 127u);
    }
    float av[16], bv[16];
#pragma unroll
    for (int i = 0; i < 16; ++i) {
      av[i] = __uint_as_float(__float_as_uint(L[0][i]) & ~127u);
      bv[i] = __uint_as_float(__float_as_uint(L[1][i]) & ~127u);
    }
#define SC_CAND(i_, j_) __uint_as_float((__float_as_uint(av[i_] + bv[j_]) & ~255u) | (unsigned)(255 - ((i_) * 16 + (j_))))
    float T[16], Bq[16], Cq[16];
#pragma unroll
    for (int j = 0; j < 16; ++j) T[j] = SC_CAND(0, j);
#pragma unroll
    for (int j = 0; j < 8; ++j) { Bq[j] = SC_CAND(1, j); Bq[8 + j] = SC_CAND(15 - j, 0); }
    Cq[0] = SC_CAND(2, 0); Cq[1] = SC_CAND(2, 1); Cq[2] = SC_CAND(2, 2); Cq[3] = SC_CAND(2, 3); Cq[4] = SC_CAND(2, 4);
    Cq[5] = SC_CAND(3, 0); Cq[6] = SC_CAND(3, 1); Cq[7] = SC_CAND(3, 2); Cq[8] = SC_CAND(3, 3);
    Cq[9] = SC_CAND(4, 0); Cq[10] = SC_CAND(4, 1); Cq[11] = SC_CAND(4, 2);
    Cq[12] = SC_CAND(5, 0); Cq[13] = SC_CAND(5, 1); Cq[14] = SC_CAND(6, 0); Cq[15] = SC_CAND(6, 1);
    bitonic16d(Bq);
    merge16d(T, Bq);
    sort16d(Cq);
    merge16d(T, Cq);
    ins16(T, SC_CAND(7, 0));
    ins16(T, SC_CAND(7, 1));
#undef SC_CAND
    float mx = __uint_as_float(__float_as_uint(T[0]) & ~255u);
    float e[16], sum = 0.f;
    int id[16];
#pragma unroll
    for (int k = 0; k < 16; ++k) {
      unsigned bits = __float_as_uint(T[k]);
      float v = __uint_as_float(bits & ~255u);
      e[k] = __expf(v - mx);
      sum += e[k];
      unsigned ij = 255u - (bits & 255u);
      unsigned e1 = sidx[(ij >> 4) * NTHR + tid], e2 = sidx[(16 + (ij & 15)) * NTHR + tid];
      id[k] = (int)(e1 * 128 + e2);
    }
    float inv = 1.f / sum;
    if (hh == 0) {
#pragma unroll
      for (int k4 = 0; k4 < 4; ++k4)
        *(float4*)(p.GW() + (size_t)m * 16 + k4 * 4) = make_float4(e[k4 * 4] * inv, e[k4 * 4 + 1] * inv, e[k4 * 4 + 2] * inv, e[k4 * 4 + 3] * inv);
      unsigned short* ip16 = (unsigned short*)p.IDX() + (size_t)m * 16;
      *(uint4*)(ip16) = make_uint4(id[0] | (id[1] << 16), id[2] | (id[3] << 16), id[4] | (id[5] << 16), id[6] | (id[7] << 16));
      *(uint4*)(ip16 + 8) = make_uint4(id[8] | (id[9] << 16), id[10] | (id[11] << 16), id[12] | (id[13] << 16), id[14] | (id[15] << 16));
    }
  }
}
typedef __attribute__((ext_vector_type(4))) float f32x4;
#define GU_LDIDX(i_, EH0_, EH1_) do { const int r_ = wsl + ((i_) < ntok ? (i_) : ntok - 1) * nw; \
    const unsigned short* ip_ = (const unsigned short*)p.IDX() + (unsigned)(r_ * 128 + (lane >> 3) * 8); \
    EH0_ = *(const uint4*)(ip_); EH1_ = *(const uint4*)(ip_ + 64); } while (0)
#define GU_ID(Q_, k_) ((k_) == 0 ? (int)(Q_.x & 0xffffu) : (k_) == 1 ? (int)(Q_.x >> 16) : (k_) == 2 ? (int)(Q_.y & 0xffffu) : (k_) == 3 ? (int)(Q_.y >> 16) : \
                       (k_) == 4 ? (int)(Q_.z & 0xffffu) : (k_) == 5 ? (int)(Q_.z >> 16) : (k_) == 6 ? (int)(Q_.w & 0xffffu) : (int)(Q_.w >> 16))
#define GU_LDROWS(i_, EH0_, EH1_, RA_, RB_, XA_, XB_, XS_) do { const int r_ = wsl + ((i_) < ntok ? (i_) : ntok - 1) * nw; \
    const unsigned char* xp_ = p.X8() + (unsigned)(r_ * 1024 + j * 128 + kb * 16); \
    XA_ = *(const uint4*)xp_; XB_ = *(const uint4*)(xp_ + 64); XS_ = 127;     \
    _Pragma("unroll") for (int mt = 0; mt < 8; ++mt) { \
      RA_[mt] = *(const uint4*)(p.U8() + (unsigned)((j * 16384 + GU_ID(EH0_, mt)) * 128 + (lane & 7) * 16)); \
      RB_[mt] = *(const uint4*)(p.U8() + (unsigned)((j * 16384 + GU_ID(EH1_, mt)) * 128 + (lane & 7) * 16)); } } while (0)
#define GU_COMPUTE(i_, RA_, RB_, XA_, XB_, XS_) do { const int r_ = wsl + ((i_) < ntok ? (i_) : ntok - 1) * nw; \
    i32x8 xb_; xb_[0] = XA_.x; xb_[1] = XA_.y; xb_[2] = XA_.z; xb_[3] = XA_.w; xb_[4] = XB_.x; xb_[5] = XB_.y; xb_[6] = XB_.z; xb_[7] = XB_.w; \
    bf16_t* pd_ = (bf16_t*)p.Pd() + ((size_t)j * NT + r_) * 128; \
    _Pragma("unroll") for (int mt = 0; mt < 8; ++mt) { \
      stl_u4(ltile + wr0, RA_[mt]); stl_u4(ltile + wr1, RB_[mt]); \
      const uint4 pa_ = ldl_u4(ltile + rd0), pb_ = ldl_u4(ltile + rd1); \
      i32x8 av_; av_[0] = pa_.x; av_[1] = pa_.y; av_[2] = pa_.z; av_[3] = pa_.w; av_[4] = pb_.x; av_[5] = pb_.y; av_[6] = pb_.z; av_[7] = pb_.w; \
      f32x4 acc_ = {0.f, 0.f, 0.f, 0.f}; \
      acc_ = __builtin_amdgcn_mfma_scale_f32_16x16x128_f8f6f4(av_, xb_, acc_, 0, 0, 0, 127, 0, XS_); \
      if (lrow == 0) {   \
        *(LAS float*)(lpd + (kb * 32 + mt) * 4) = acc_[0]; *(LAS float*)(lpd + (kb * 32 + 8 + mt) * 4) = acc_[1]; \
        *(LAS float*)(lpd + (kb * 32 + 16 + mt) * 4) = acc_[2]; *(LAS float*)(lpd + (kb * 32 + 24 + mt) * 4) = acc_[3]; } } \
    if (lane < 32) { const lds_f4 pv_ = *(const LAS lds_f4*)(lpd + lane * 16); *(uint2*)(pd_ + lane * 4) = make_uint2(pk2(pv_.x, pv_.y), pk2(pv_.z, pv_.w)); } } while (0)
__device__ __forceinline__ void phase_gather_u(const Params& p, char* smem) {
  const int lane = tidx() & 63, wave = tidx() >> 6;
  const int j = blockIdx.x & 7, wsl = (blockIdx.x >> 3) * 8 + wave, nw = (gridDim.x >> 3) * 8;
  const int lrow = lane & 15, kb = lane >> 4;
  const int ntok = (NT - wsl + nw - 1) / nw;
  if (ntok <= 0) return;
  LAS char* ltile = (LAS char*)smem + wave * 2048;
  LAS char* lpd = (LAS char*)smem + 16384 + wave * 512;
  const int wrow = lane >> 3, wpc = lane & 7;
  const int wr0 = wrow * 128 + ((wpc ^ ((wrow >> 1) & 7)) << 4), wr1 = (wrow + 8) * 128 + ((wpc ^ (((wrow + 8) >> 1) & 7)) << 4);
  const int rsw = (lrow >> 1) & 7;
  const int rd0 = lrow * 128 + ((kb ^ rsw) << 4), rd1 = lrow * 128 + (((4 + kb) ^ rsw) << 4);
  uint4 e0a, e0b, e1a, e1b; int xs0, xs1;
  uint4 a0[8], b0[8], a1[8], b1[8], xa0, xb0, xa1, xb1;
  GU_LDIDX(0, e0a, e0b);
  GU_LDIDX(1, e1a, e1b);
  asm volatile("" ::: "memory");
  GU_LDROWS(0, e0a, e0b, a0, b0, xa0, xb0, xs0);
  asm volatile("" ::: "memory");
#pragma unroll 1
  for (int i = 0; i < ntok; i += 2) {
    GU_LDIDX(i + 2, e0a, e0b);
    asm volatile("" ::: "memory");
    GU_LDROWS(i + 1, e1a, e1b, a1, b1, xa1, xb1, xs1);
    asm volatile("" ::: "memory");
    GU_COMPUTE(i, a0, b0, xa0, xb0, xs0);
    asm volatile("" ::: "memory");
    GU_LDIDX(i + 3, e1a, e1b);
    asm volatile("" ::: "memory");
    GU_LDROWS(i + 2, e0a, e0b, a0, b0, xa0, xb0, xs0);
    asm volatile("" ::: "memory");
    GU_COMPUTE(i + 1, a1, b1, xa1, xb1, xs1);
    asm volatile("" ::: "memory");
  }
}
__device__ __forceinline__ void phase_gather_w(const Params& p) {
  const unsigned gt = (unsigned)blockIdx.x * NTHR + tidx(), GT = (unsigned)gridDim.x * NTHR;
  const unsigned tot = (unsigned)NT * 16;
  const bf16_t* PdB = (const bf16_t*)p.Pd();
  for (unsigned i0 = gt; i0 < tot; i0 += 2 * GT) {
    const unsigned i1r = i0 + GT;
    const bool has1 = i1r < tot;
    const unsigned i1 = has1 ? i1r : i0;
    uint4 pa[8], pb[8];
#pragma unroll
    for (int jj = 0; jj < 8; ++jj) {
      pa[jj] = ((const uint4*)(PdB + (size_t)jj * NT * 128))[i0];
      pb[jj] = ((const uint4*)(PdB + (size_t)jj * NT * 128))[i1];
    }
    const float4 ga0 = ((const float4*)p.GW())[2 * i0], ga1 = ((const float4*)p.GW())[2 * i0 + 1];
    const float4 gb0 = ((const float4*)p.GW())[2 * i1], gb1 = ((const float4*)p.GW())[2 * i1 + 1];
    const uint4 ea = ((const uint4*)p.IDX())[i0], eb = ((const uint4*)p.IDX())[i1];
    const float xsa = __uint_as_float((unsigned)p.XSC()[i0 >> 4] << 23), xsb = __uint_as_float((unsigned)p.XSC()[i1 >> 4] << 23);
    const int ev[16] = {(int)(ea.x & 0xffffu), (int)(ea.x >> 16), (int)(ea.y & 0xffffu), (int)(ea.y >> 16), (int)(ea.z & 0xffffu), (int)(ea.z >> 16), (int)(ea.w & 0xffffu), (int)(ea.w >> 16),
                        (int)(eb.x & 0xffffu), (int)(eb.x >> 16), (int)(eb.y & 0xffffu), (int)(eb.y >> 16), (int)(eb.z & 0xffffu), (int)(eb.z >> 16), (int)(eb.w & 0xffffu), (int)(eb.w >> 16)};
    const float gv[16] = {ga0.x, ga0.y, ga0.z, ga0.w, ga1.x, ga1.y, ga1.z, ga1.w, gb0.x, gb0.y, gb0.z, gb0.w, gb1.x, gb1.y, gb1.z, gb1.w};
    unsigned scw[16];
#pragma unroll
    for (int q = 0; q < 16; ++q) scw[q] = ((const unsigned*)p.USC())[ev[q]];
    float sv[16];
#pragma unroll
    for (int q = 0; q < 16; ++q) sv[q] = 0.f;
#pragma unroll
    for (int jj = 0; jj < 8; ++jj) {
      sv[0] += bflo(pa[jj].x); sv[1] += bfhi(pa[jj].x); sv[2] += bflo(pa[jj].y); sv[3] += bfhi(pa[jj].y);
      sv[4] += bflo(pa[jj].z); sv[5] += bfhi(pa[jj].z); sv[6] += bflo(pa[jj].w); sv[7] += bfhi(pa[jj].w);
      sv[8] += bflo(pb[jj].x); sv[9] += bfhi(pb[jj].x); sv[10] += bflo(pb[jj].y); sv[11] += bfhi(pb[jj].y);
      sv[12] += bflo(pb[jj].z); sv[13] += bfhi(pb[jj].z); sv[14] += bflo(pb[jj].w); sv[15] += bfhi(pb[jj].w);
    }
    float o[16];
#pragma unroll
    for (int q = 0; q < 16; ++q) {
      const float us = __uint_as_float((scw[q] & 0xffffu) << 23) * (q < 8 ? xsa : xsb);
      o[q] = gv[q] * gelu_tanh(sv[q] * us) * __uint_as_float((scw[q] >> 16) << 23);
    }
    ((uint4*)p.Wt())[i0] = make_uint4(pk2(o[0], o[1]), pk2(o[2], o[3]), pk2(o[4], o[5]), pk2(o[6], o[7]));
    if (has1) ((uint4*)p.Wt())[i1] = make_uint4(pk2(o[8], o[9]), pk2(o[10], o[11]), pk2(o[12], o[13]), pk2(o[14], o[15]));
  }
}
__device__ __forceinline__ void phase_gather_v(const Params& p) {
  const int lane = tidx() & 63, wave = tidx() >> 6;
  const int j = blockIdx.x & 7, wsl = (blockIdx.x >> 3) * 8 + wave, nw = (gridDim.x >> 3) * 8;
  const int sub = lane >> 3, c16 = (lane & 7) * 16;
  const int ntok = (NT - wsl + nw - 1) / nw, nit = ntok * 2;
  auto ldidx = [&](int it, uint4& e) {
    const int itc = it < nit ? it : nit - 1;
    const unsigned base = (unsigned)((wsl + (itc >> 1) * nw) * 128 + sub * 16 + (itc & 1) * 8);
    e = *(const uint4*)((const unsigned short*)p.IDX() + base);
  };
  auto ldrows = [&](int it, const uint4& e, uint4 (&v)[8], uint4& w) {
    const int itc = it < nit ? it : nit - 1;
    const unsigned base = (unsigned)((wsl + (itc >> 1) * nw) * 128 + sub * 16 + (itc & 1) * 8);
    w = *(const uint4*)((const bf16_t*)p.Wt() + base);
    const int ev[8] = {(int)(e.x & 0xffffu), (int)(e.x >> 16), (int)(e.y & 0xffffu), (int)(e.y >> 16),
                       (int)(e.z & 0xffffu), (int)(e.z >> 16), (int)(e.w & 0xffffu), (int)(e.w >> 16)};
#pragma unroll
    for (int k = 0; k < 8; ++k) v[k] = *(const uint4*)(p.V8() + (unsigned)((j * 16384 + ev[k]) * 128 + c16));
  };
  f2v o2[8];
  uint2 xr;
  const int fo = c16 + ((lane >> 5) & 1) * 8 + ((lane >> 4) & 1) * 4;
  auto accum = [&](const uint4 (&vv)[8], const uint4& wq) {
    const float ww[8] = {bflo(wq.x), bfhi(wq.x), bflo(wq.y), bfhi(wq.y), bflo(wq.z), bfhi(wq.z), bflo(wq.w), bfhi(wq.w)};
#pragma unroll
    for (int k = 0; k < 8; ++k) {
      const f2v w = {ww[k], ww[k]};
      const uint4 v = vv[k];
      o2[0] += w * __builtin_amdgcn_cvt_pk_f32_fp8((int)v.x, false); o2[1] += w * __builtin_amdgcn_cvt_pk_f32_fp8((int)v.x, true);
      o2[2] += w * __builtin_amdgcn_cvt_pk_f32_fp8((int)v.y, false); o2[3] += w * __builtin_amdgcn_cvt_pk_f32_fp8((int)v.y, true);
      o2[4] += w * __builtin_amdgcn_cvt_pk_f32_fp8((int)v.z, false); o2[5] += w * __builtin_amdgcn_cvt_pk_f32_fp8((int)v.z, true);
      o2[6] += w * __builtin_amdgcn_cvt_pk_f32_fp8((int)v.w, false); o2[7] += w * __builtin_amdgcn_cvt_pk_f32_fp8((int)v.w, true);
    }
  };
  auto finish = [&](int i) {
    const int r = wsl + i * nw;
    float r8[8], r4[4];
#pragma unroll
    for (int q = 0; q < 8; ++q) {
      auto s = __builtin_amdgcn_permlane32_swap(__float_as_uint(o2[q >> 1][q & 1]), __float_as_uint(o2[(q + 8) >> 1][q & 1]), false, false);
      r8[q] = __uint_as_float(s[0]) + __uint_as_float(s[1]);
    }
#pragma unroll
    for (int q = 0; q < 4; ++q) {
      auto s = __builtin_amdgcn_permlane16_swap(__float_as_uint(r8[q]), __float_as_uint(r8[q + 4]), false, false);
      r4[q] = __uint_as_float(s[0]) + __uint_as_float(s[1]);
    }
#pragma unroll
    for (int q = 0; q < 4; ++q) r4[q] += __uint_as_float(__builtin_amdgcn_update_dpp(0, __float_as_uint(r4[q]), 0x128, 0xf, 0xf, false));
    if ((lane & 8) == 0 && i < ntok) {
      const unsigned off = (unsigned)(r * 1024 + j * 128 + fo);
      float* yo = ((r < NP) ? p.out + O_YP : p.out + O_YS - (size_t)NP * 1024) + off;
      *(float4*)(yo) = make_float4(bflo(xr.x) + r4[0], bfhi(xr.x) + r4[1], bflo(xr.y) + r4[2], bfhi(xr.y) + r4[3]);
    }
  };
  if (ntok <= 0) return;
  uint4 eA, eB, eC;
  uint4 wA, wB, wC;
  uint4 vA[8], vB[8], vC[8];
  ldidx(0, eA);
  ldidx(1, eB);
  ldidx(2, eC);
  asm volatile("" ::: "memory");
  ldrows(0, eA, vA, wA);
  asm volatile("" ::: "memory");
  ldrows(1, eB, vB, wB);
  asm volatile("" :: "v"(vB[7].x) : "memory");
#define GV_STEP(k_, EX, VX, WX, EY, VY, WY) do { \
    ldidx((k_) + 3, EX); \
    asm volatile("" ::: "memory"); \
    ldrows((k_) + 2, EY, VY, WY); \
    asm volatile("" : "+v"(WX.x), "+v"(WX.y), "+v"(WX.z), "+v"(WX.w) :: "memory"); \
    accum(VX, WX); } while (0)
#define GV_TOKEN(i_) do { \
    _Pragma("unroll") for (int q = 0; q < 8; ++q) { o2[q][0] = 0.f; o2[q][1] = 0.f; } \
    xr = *(const uint2*)((const bf16_t*)p.X1() + (unsigned)((wsl + ((i_) < ntok ? (i_) : ntok - 1) * nw) * 1024 + j * 128 + fo)); \
    asm volatile("" ::: "memory"); } while (0)
#pragma unroll 1
  for (int i = 0; i < ntok; i += 3) {
    const int k = 2 * i;
    GV_TOKEN(i);
    GV_STEP(k, eA, vA, wA, eC, vC, wC);
    GV_STEP(k + 1, eB, vB, wB, eA, vA, wA);
    finish(i);
    asm volatile("" ::: "memory");
    GV_TOKEN(i + 1);
    GV_STEP(k + 2, eC, vC, wC, eB, vB, wB);
    GV_STEP(k + 3, eA, vA, wA, eC, vC, wC);
    finish(i + 1);
    asm volatile("" ::: "memory");
    GV_TOKEN(i + 2);
    GV_STEP(k + 4, eB, vB, wB, eA, vA, wA);
    GV_STEP(k + 5, eC, vC, wC, eB, vB, wB);
    finish(i + 2);
    asm volatile("" ::: "memory");
  }
}

extern __shared__ __attribute__((aligned(16))) char dyn_smem[];
#define LDS_BYTES 147456
__global__ void __launch_bounds__(NTHR, 2) k_mega(Params p) {
  char* smem = dyn_smem;
  uint4* xbw = (uint4*)(dyn_smem + LDS_BYTES);
  if (threadIdx.x == 0) *xbw = make_uint4(0u, 0u, 0u, 0u);
  __syncthreads();
  XcdBarrier bar = xcd_barrier_post(p.bar(), (volatile LAS unsigned*)xbw);
  phase0(p, smem);
  phase_rmsnorm<false>(p.x_prompt, p.x_sample, p.norm_mix, p.XN(), nullptr, nullptr);
  xcd_barrier(bar);
  phase_gemm_z(p, smem);
  xcd_barrier(bar);
  phase_post1(p);
  xcd_barrier(bar);
  phase_gemm4(p, smem);
  xcd_barrier(bar);
  phase_post2(p);
  xcd_barrier(bar);
  phase_attn(p, smem);
  xcd_barrier(bar);
  phase_gemm_gl(p, smem);
  xcd_barrier(bar);
  phase_gemm_out(p, smem);
  xcd_barrier(bar);
  phase_rmsnorm_x1((const bf16_t*)p.X1(), p.norm_ffn, p.XN(), p.X8(), p.XSC());
  xcd_barrier(bar);
  phase_gemm_pq(p, smem);
  xcd_barrier(bar);
  phase_sctopk(p, smem);
  xcd_barrier(bar);
  phase_gather_u(p, smem);
  xcd_barrier(bar);
  phase_gather_w(p);
  xcd_barrier(bar);
  phase_gather_v(p);
}


#ifdef PROBE_MULTI
template <int PH>
__global__ void __launch_bounds__(NTHR, 2) k_phase(Params p) {
  char* smem = dyn_smem;
  if constexpr (PH == 0) { phase0(p, smem); phase_rmsnorm<false>(p.x_prompt, p.x_sample, p.norm_mix, p.XN(), nullptr, nullptr); }
  if constexpr (PH == 1) phase_gemm_z(p, smem);
  if constexpr (PH == 2) phase_post1(p);
  if constexpr (PH == 3) phase_gemm4(p, smem);
  if constexpr (PH == 4) phase_post2(p);
  if constexpr (PH == 5) phase_attn(p, smem);
  if constexpr (PH == 7) phase_gemm_gl(p, smem);
  if constexpr (PH == 9) phase_gemm_out(p, smem);
  if constexpr (PH == 10) phase_rmsnorm<true>(p.X1(), p.X1() + (size_t)NP * 1024, p.norm_ffn, p.XN(), p.X8(), p.XSC());
  if constexpr (PH == 11) phase_gemm_pq(p, smem);
  if constexpr (PH == 12) phase_sctopk(p, smem);
  if constexpr (PH == 13) phase_gather_u(p, smem);
  if constexpr (PH == 14) phase_gather_w(p);
  if constexpr (PH == 15) phase_gather_v(p);
}
template <int PH>
static void launch_phase(const Params& p, hipStream_t stream) {
  (void)hipFuncSetAttribute((const void*)k_phase<PH>, hipFuncAttributeMaxDynamicSharedMemorySize, LDS_BYTES + 16);
  const int reps = (PH == PROBE_MULTI) ? 2 : 1;
  for (int i = 0; i < reps; ++i) hipLaunchKernelGGL(k_phase<PH>, dim3(256), dim3(NTHR), LDS_BYTES + 16, stream, p);
}
#endif

extern "C" void kernel_launch(void* const* d_in, const int* in_sizes, int n_in, void* d_out, int out_size, void* d_ws, size_t ws_size,
                              hipStream_t stream) {
  Params p{};
  p.x_prompt = (const float*)d_in[0]; p.x_sample = (const float*)d_in[1]; p.cache_lat = (const float*)d_in[2];
  p.cache_kr = (const float*)d_in[3]; p.state_ssm = (const float*)d_in[4]; p.page_table = (const int*)d_in[5];
  p.norm_mix = (const float*)d_in[6]; p.w_in = (const float*)d_in[7]; p.norm_q_lora = (const float*)d_in[8];
  p.w_uq = (const float*)d_in[9]; p.norm_kv_lora = (const float*)d_in[10]; p.w_uk = (const float*)d_in[11];
  p.w_uv = (const float*)d_in[12]; p.g_qn = (const float*)d_in[13]; p.g_qr = (const float*)d_in[14];
  p.g_kn = (const float*)d_in[15]; p.g_kr = (const float*)d_in[16]; p.a_re = (const float*)d_in[17];
  p.a_im = (const float*)d_in[18]; p.log_dt = (const float*)d_in[19]; p.ssm_b = (const float*)d_in[20];
  p.ssm_c = (const float*)d_in[21]; p.ssm_d = (const float*)d_in[22]; p.w_glu = (const float*)d_in[23];
  p.w_out = (const float*)d_in[24]; p.norm_ffn = (const float*)d_in[25]; p.peer_wq = (const float*)d_in[26];
  p.peer_keys = (const float*)d_in[27]; p.peer_u = (const float*)d_in[28]; p.peer_v = (const float*)d_in[29];
  p.out = (float*)d_out;
  p.ws = (char*)d_ws;
  const size_t off = WS_TOTAL;
  if (off > ws_size) { fprintf(stderr, "workspace too small: need %zu have %zu\n", off, ws_size); return; }
#ifdef PROBE_MULTI
  launch_phase<0>(p, stream); launch_phase<1>(p, stream); launch_phase<2>(p, stream); launch_phase<3>(p, stream);
  launch_phase<4>(p, stream); launch_phase<5>(p, stream); launch_phase<6>(p, stream); launch_phase<7>(p, stream);
  launch_phase<8>(p, stream); launch_phase<9>(p, stream); launch_phase<10>(p, stream); launch_phase<11>(p, stream);
  launch_phase<12>(p, stream); launch_phase<13>(p, stream); launch_phase<14>(p, stream); launch_phase<15>(p, stream);
  return;
#endif
  static int grid = 0;
  if (!grid) {
    int dev = 0, cus = 0, per_cu = 0;
    (void)hipGetDevice(&dev);
    (void)hipDeviceGetAttribute(&cus, hipDeviceAttributeMultiprocessorCount, dev);
    (void)hipFuncSetAttribute((const void*)k_mega, hipFuncAttributeMaxDynamicSharedMemorySize, LDS_BYTES + 16);
    (void)hipOccupancyMaxActiveBlocksPerMultiprocessor(&per_cu, k_mega, NTHR, LDS_BYTES + 16);
    if (per_cu < 1) { fprintf(stderr, "k_mega does not fit a CU\n"); return; }
    grid = cus;
  }
  (void)hipMemsetAsync(p.ws + WSO_bar, 0, XCD_BAR_WORDS * sizeof(unsigned), stream);
  hipLaunchKernelGGL(k_mega, dim3(grid), dim3(NTHR), LDS_BYTES + 16, stream, p);
}
```

```cpp
#include <hip/hip_runtime.h>
#include <stdint.h>
#include <stdio.h>
#include <type_traits>

typedef __attribute__((ext_vector_type(8))) short bf16x8;
typedef __attribute__((ext_vector_type(4))) short s16x4;
typedef __attribute__((ext_vector_type(16))) float f32x16;
typedef __attribute__((ext_vector_type(2))) __bf16 bf2;
typedef __attribute__((ext_vector_type(2))) float f2v;
typedef unsigned short bf16_t;

#define NTHR 512
#define D_MODEL 1024
#define NP 16384
#define NS 512
#define NT 16896
#define INW 1184
#define NSUB 1280
#define NSUBV 1152
#define A2LD 384
#define EPS 1e-6f
#define QSCALE 0.14724466f

#define O_YP 0
#define O_YS 16777216
#define O_LATP 17301504
#define O_KRP 21495808
#define O_SSMP 22020096
#define O_LATS 22036480
#define O_KRS 22167552
#define O_SSMS 22183936

constexpr size_t ws_al(size_t b) { return (b + 255) & ~(size_t)255; }
constexpr size_t WSO_bar = 0;
constexpr size_t WSO_WinT = WSO_bar + ws_al(16384);
constexpr size_t WSO_WuqT = WSO_WinT + ws_al((size_t)1280 * 1024 * 2);
constexpr size_t WSO_WukT = WSO_WuqT + ws_al((size_t)768 * 384 * 2);
constexpr size_t WSO_WuvT = WSO_WukT + ws_al((size_t)512 * 256 * 2);
constexpr size_t WSO_WgluT = WSO_WuvT + ws_al((size_t)512 * 256 * 2);
constexpr size_t WSO_WoutT = WSO_WgluT + ws_al((size_t)1024 * 512 * 2);
constexpr size_t WSO_WpqT = WSO_WoutT + ws_al((size_t)1024 * 1024 * 2);
constexpr size_t WSO_PK = WSO_WpqT + ws_al((size_t)2048 * 1024 * 2);
constexpr size_t WSO_U8 = WSO_PK + ws_al((size_t)2 * 128 * 128 * 2);
constexpr size_t WSO_V8 = WSO_U8 + ws_al((size_t)16384 * 1024);
constexpr size_t WSO_X8 = WSO_V8 + ws_al((size_t)16384 * 1024);
constexpr size_t WSO_USC = WSO_X8 + ws_al((size_t)NT * 1024);
constexpr size_t WSO_W8T = WSO_USC + ws_al(16384 * 4);
constexpr size_t WSO_KW = WSO_W8T + ws_al(512 * 256);
constexpr size_t WSO_XSC = WSO_KW + ws_al(256);
constexpr size_t WSO_VSCF = WSO_XSC + ws_al(NT * 4);
constexpr size_t WSO_Bt2 = WSO_VSCF + ws_al(16384 * 4);
constexpr size_t WSO_Emat = WSO_Bt2 + ws_al((size_t)32 * 256 * A2LD * 2);
constexpr size_t WSO_XN = WSO_Emat + ws_al((size_t)32 * 128 * 256 * 2);
constexpr size_t WSO_A2 = WSO_XN + ws_al((size_t)NT * 1024 * 2);
constexpr size_t WSO_CQN = WSO_A2 + ws_al((size_t)32 * NSUB * A2LD * 2);
constexpr size_t WSO_CKV = WSO_CQN + ws_al((size_t)NT * 384 * 2);
constexpr size_t WSO_Kcat = WSO_CKV + ws_al((size_t)NT * 256 * 2);
constexpr size_t WSO_KcatS = WSO_Kcat + ws_al((size_t)32 * 4096 * 96 * 2);
constexpr size_t WSO_Qb = WSO_KcatS + ws_al((size_t)128 * 8 * 4 * 96 * 2);
constexpr size_t WSO_VT = WSO_Qb + ws_al((size_t)NT * 8 * 96 * 2);
constexpr size_t WSO_WgluS = WSO_VT + ws_al((size_t)512 * NP * 2);
constexpr size_t WSO_G = WSO_WgluS + ws_al((size_t)1024 * 512 * 2);
constexpr size_t WSO_CAT = WSO_G + ws_al((size_t)NT * 512 * 2);
constexpr size_t WSO_PQ = WSO_CAT + ws_al((size_t)NT * 1024 * 2);
constexpr size_t WSO_Z = WSO_PQ + ws_al((size_t)NT * 2048 * 2);
constexpr size_t WSO_Qraw = WSO_Z + ws_al((size_t)NT * INW * 4);
constexpr size_t WSO_KNraw = WSO_Qraw + ws_al((size_t)NT * 768 * 4);
constexpr size_t WSO_S = WSO_KNraw + ws_al((size_t)NT * 512 * 4);
constexpr size_t WSO_GL = WSO_S + ws_al((size_t)32 * NSUB * 128 * 4);
constexpr size_t WSO_X1 = WSO_GL + ws_al((size_t)NT * 1024 * 4);
constexpr size_t WSO_GW = WSO_X1 + ws_al((size_t)NT * 1024 * 4);
constexpr size_t WSO_Pd = WSO_GW + ws_al((size_t)NT * 128 * 4);
constexpr size_t WSO_Wt = WSO_Pd + ws_al((size_t)8 * NT * 128 * 4);
constexpr size_t WSO_Opart = WSO_Wt + ws_al((size_t)NT * 128 * 4);
constexpr size_t WSO_Lpart = WSO_Opart + ws_al((size_t)128 * 2 * 32 * 256 * 4);
constexpr size_t WSO_IDX = WSO_Lpart + ws_al((size_t)128 * 2 * 32 * 4);
constexpr size_t WS_TOTAL = WSO_IDX + ws_al((size_t)NT * 128 * 4);
struct Params {
  const float *x_prompt, *x_sample, *cache_lat, *cache_kr, *state_ssm;
  const int* page_table;
  const float *norm_mix, *w_in, *norm_q_lora, *w_uq, *norm_kv_lora, *w_uk, *w_uv, *g_qn, *g_qr, *g_kn, *g_kr;
  const float *a_re, *a_im, *log_dt, *ssm_b, *ssm_c, *ssm_d, *w_glu, *w_out, *norm_ffn, *peer_wq, *peer_keys, *peer_u, *peer_v;
  float* out;
  char* ws;
  __device__ __forceinline__ unsigned* bar() const { return (unsigned*)(ws + WSO_bar); }
  __device__ __forceinline__ bf16_t* WinT() const { return (bf16_t*)(ws + WSO_WinT); }
  __device__ __forceinline__ bf16_t* WuqT() const { return (bf16_t*)(ws + WSO_WuqT); }
  __device__ __forceinline__ bf16_t* WukT() const { return (bf16_t*)(ws + WSO_WukT); }
  __device__ __forceinline__ bf16_t* WuvT() const { return (bf16_t*)(ws + WSO_WuvT); }
  __device__ __forceinline__ bf16_t* WgluT() const { return (bf16_t*)(ws + WSO_WgluT); }
  __device__ __forceinline__ bf16_t* WoutT() const { return (bf16_t*)(ws + WSO_WoutT); }
  __device__ __forceinline__ bf16_t* WpqT() const { return (bf16_t*)(ws + WSO_WpqT); }
  __device__ __forceinline__ bf16_t* PK() const { return (bf16_t*)(ws + WSO_PK); }
  __device__ __forceinline__ unsigned char* U8() const { return (unsigned char*)(ws + WSO_U8); }
  __device__ __forceinline__ unsigned char* V8() const { return (unsigned char*)(ws + WSO_V8); }
  __device__ __forceinline__ unsigned char* X8() const { return (unsigned char*)(ws + WSO_X8); }
  __device__ __forceinline__ int* USC() const { return (int*)(ws + WSO_USC); }
  __device__ __forceinline__ unsigned char* W8T() const { return (unsigned char*)(ws + WSO_W8T); }
  __device__ __forceinline__ int* KW() const { return (int*)(ws + WSO_KW); }
  __device__ __forceinline__ int* XSC() const { return (int*)(ws + WSO_XSC); }
  __device__ __forceinline__ float* VSCF() const { return (float*)(ws + WSO_VSCF); }
  __device__ __forceinline__ bf16_t* Bt2() const { return (bf16_t*)(ws + WSO_Bt2); }
  __device__ __forceinline__ bf16_t* Emat() const { return (bf16_t*)(ws + WSO_Emat); }
  __device__ __forceinline__ bf16_t* XN() const { return (bf16_t*)(ws + WSO_XN); }
  __device__ __forceinline__ bf16_t* A2() const { return (bf16_t*)(ws + WSO_A2); }
  __device__ __forceinline__ bf16_t* CQN() const { return (bf16_t*)(ws + WSO_CQN); }
  __device__ __forceinline__ bf16_t* CKV() const { return (bf16_t*)(ws + WSO_CKV); }
  __device__ __forceinline__ bf16_t* Kcat() const { return (bf16_t*)(ws + WSO_Kcat); }
  __device__ __forceinline__ bf16_t* KcatS() const { return (bf16_t*)(ws + WSO_KcatS); }
  __device__ __forceinline__ bf16_t* Qb() const { return (bf16_t*)(ws + WSO_Qb); }
  __device__ __forceinline__ bf16_t* VT() const { return (bf16_t*)(ws + WSO_VT); }
  __device__ __forceinline__ bf16_t* WgluS() const { return (bf16_t*)(ws + WSO_WgluS); }
  __device__ __forceinline__ bf16_t* G() const { return (bf16_t*)(ws + WSO_G); }
  __device__ __forceinline__ bf16_t* CAT() const { return (bf16_t*)(ws + WSO_CAT); }
  __device__ __forceinline__ bf16_t* PQ() const { return (bf16_t*)(ws + WSO_PQ); }
  __device__ __forceinline__ float* Z() const { return (float*)(ws + WSO_Z); }
  __device__ __forceinline__ float* Qraw() const { return (float*)(ws + WSO_Qraw); }
  __device__ __forceinline__ float* KNraw() const { return (float*)(ws + WSO_KNraw); }
  __device__ __forceinline__ float* S() const { return (float*)(ws + WSO_S); }
  __device__ __forceinline__ float* GL() const { return (float*)(ws + WSO_GL); }
  __device__ __forceinline__ float* X1() const { return (float*)(ws + WSO_X1); }
  __device__ __forceinline__ float* GW() const { return (float*)(ws + WSO_GW); }
  __device__ __forceinline__ float* Pd() const { return (float*)(ws + WSO_Pd); }
  __device__ __forceinline__ float* Wt() const { return (float*)(ws + WSO_Wt); }
  __device__ __forceinline__ float* Opart() const { return (float*)(ws + WSO_Opart); }
  __device__ __forceinline__ float* Lpart() const { return (float*)(ws + WSO_Lpart); }
  __device__ __forceinline__ int* IDX() const { return (int*)(ws + WSO_IDX); }
};


#define XB_TMO      128
#define XB_XCNT(j)  (256  + 64 * (j))
#define XB_XSUB(j)  (1280 + 64 * (j))
#define XB_XGEN(j)  (2304 + 64 * (j))
#define XB_TOP      3328
#define XB_TOPGEN   3392
#define XCD_BAR_WORDS 3456
#define XB_SPIN_CAP (1u << 18)
#define LAS __attribute__((address_space(3)))

__device__ __forceinline__ unsigned xb_ld(unsigned* p)              { return __hip_atomic_load(p, __ATOMIC_RELAXED, __HIP_MEMORY_SCOPE_AGENT); }
__device__ __forceinline__ unsigned xb_add(unsigned* p, unsigned v) { return __hip_atomic_fetch_add(p, v, __ATOMIC_RELAXED, __HIP_MEMORY_SCOPE_AGENT); }
__device__ __forceinline__ unsigned xb_xcc_id() { return (unsigned)__builtin_amdgcn_s_getreg((3 << 11) | 20) & 0xFu; }
#define XB_SPIN(cond, bar) do { unsigned _sp = 0; while (cond) { __builtin_amdgcn_s_sleep(1); \
    if ((++_sp & 255u) == 0u) { if (xb_ld(&(bar)[XB_TMO])) break; if (_sp > XB_SPIN_CAP) { atomicAdd(&(bar)[XB_TMO], 1u); break; } } } } while (0)

struct XcdBarrier {
    unsigned* bar; unsigned x;
    volatile LAS unsigned* st;
};

__device__ __forceinline__ XcdBarrier xcd_barrier_post(unsigned* bar, volatile LAS unsigned* st) {
    XcdBarrier b; b.bar = bar; b.x = xb_xcc_id(); b.st = st;
    if (threadIdx.x == 0) (void)xb_add(&bar[XB_XCNT(b.x)], 1u);
    return b;
}
__device__ __forceinline__ void xcd_barrier_complete(unsigned* bar, unsigned x, unsigned& nloc, unsigned& nx) {
    const unsigned G = gridDim.x * gridDim.y * gridDim.z;
    unsigned sum, cnt, mine, sp = 0u;
    for (;;) {
        sum = 0u; cnt = 0u; mine = 0u;
#pragma unroll
        for (unsigned j = 0; j < 16; ++j) { const unsigned c = xb_ld(&bar[XB_XCNT(j)]); sum += c; cnt += (c > 0u) ? 1u : 0u; mine = (j == x) ? c : mine; }
        if (sum == G) break;
        __builtin_amdgcn_s_sleep(1);
        if ((++sp & 255u) == 0u) { if (xb_ld(&bar[XB_TMO])) break; if (sp > XB_SPIN_CAP) { atomicAdd(&bar[XB_TMO], 1u); break; } }
    }
    nloc = mine > 0u ? mine : 1u; nx = cnt > 0u ? cnt : 1u;
}

__device__ __forceinline__ void xcd_barrier(const XcdBarrier& b) {
    asm volatile("s_waitcnt vmcnt(0)" ::: "memory");
    __syncthreads();
    if (threadIdx.x == 0) {
        unsigned* bar = b.bar;
        __builtin_amdgcn_s_waitcnt(0);
        unsigned nloc = b.st[0], nx = b.st[1];
        if (nloc == 0u) { xcd_barrier_complete(bar, b.x, nloc, nx); b.st[0] = nloc; b.st[1] = nx; }
        const unsigned old = xb_add(&bar[XB_XSUB(b.x)], 1u);
        const unsigned gen = old / nloc;
        if (old + 1u == (gen + 1u) * nloc) {
            __builtin_amdgcn_fence(__ATOMIC_RELEASE, "agent");
            asm volatile("s_waitcnt vmcnt(0)" ::: "memory");
            const unsigned og = xb_add(&bar[XB_TOP], 1u);
            const unsigned tg = og / nx;
            if (og + 1u == (tg + 1u) * nx) xb_add(&bar[XB_TOPGEN], 1u);
            else XB_SPIN(xb_ld(&bar[XB_TOPGEN]) == tg, bar);
            __builtin_amdgcn_fence(__ATOMIC_ACQUIRE, "agent");
            xb_add(&bar[XB_XGEN(b.x)], 1u);
            asm volatile("s_waitcnt vmcnt(0)" ::: "memory");
        } else {
            XB_SPIN(xb_ld(&bar[XB_XGEN(b.x)]) == gen, bar);
            __builtin_amdgcn_fence(__ATOMIC_ACQUIRE, "agent");
            asm volatile("s_waitcnt vmcnt(0)" ::: "memory");
        }
    }
    __syncthreads();
}

__device__ __forceinline__ int tidx() { int t = threadIdx.x; asm volatile("" : "+v"(t)); return t; }
__device__ __forceinline__ unsigned pk2(float a, float b) {
  f2v v = {a, b};
  bf2 r = __builtin_convertvector(v, bf2);
  return __builtin_bit_cast(unsigned, r);
}
__device__ __forceinline__ bf16_t f2bf(float a) { return (bf16_t)(pk2(a, 0.f) & 0xffffu); }
__device__ __forceinline__ float bf2f(bf16_t x) { return __uint_as_float(((unsigned)x) << 16); }
__device__ __forceinline__ float bflo(unsigned x) { return __uint_as_float(x << 16); }
__device__ __forceinline__ float bfhi(unsigned x) { return __uint_as_float(x & 0xffff0000u); }
__device__ __forceinline__ float wave_sum(float v) {
  v += __shfl_xor(v, 32); v += __shfl_xor(v, 16); v += __shfl_xor(v, 8);
  v += __shfl_xor(v, 4);  v += __shfl_xor(v, 2);  v += __shfl_xor(v, 1);
  return v;
}
__device__ __forceinline__ float gelu_tanh(float x) {
  const float k0 = -2.f * 0.7978845608028654f * 1.4426950408889634f, k1 = k0 * 0.044715f;
  float e = __builtin_amdgcn_exp2f(x * (k0 + k1 * x * x));
  return x * __builtin_amdgcn_rcpf(1.f + e);
}
__device__ __forceinline__ void sincos_rev(float ang, float& s, float& c) {
  float rev = ang * 0.15915494309189535f;
  rev = rev - floorf(rev);
  s = __builtin_amdgcn_sinf(rev);
  c = __builtin_amdgcn_cosf(rev);
}
__device__ __forceinline__ f32x16 mfma32(bf16x8 a, bf16x8 b, f32x16 c) {
  return __builtin_amdgcn_mfma_f32_32x32x16_bf16(a, b, c, 0, 0, 0);
}
__device__ __forceinline__ bf16x8 mk8(unsigned a, unsigned b, unsigned c, unsigned d) {
  uint4 u = make_uint4(a, b, c, d);
  return __builtin_bit_cast(bf16x8, u);
}

#define GLD 72
template <int WM, int WN, int TM, int TN, bool PAIR = false, class Epi>
__device__ __forceinline__ void gemm_tile(const bf16_t* __restrict__ A, int lda, const bf16_t* __restrict__ Bt, int ldb,
                                          int K, int m0, int n0, char* smem, Epi epi) {
  static_assert(WM * WN == 8, "8 waves");
  constexpr int BM = 32 * WM * TM, BN = 32 * WN * TN, NA = BM * 8 / NTHR, NB = BN * 8 / NTHR;
  static_assert(NA >= 1 && NB >= 1, "tile too small");
  bf16_t* As = (bf16_t*)smem;
  bf16_t* Bs = As + 2 * BM * GLD;
  const int tid = tidx(), lane = tid & 63, wave = tid >> 6;
  const int wm = wave / WN, wn = wave % WN, lr = lane & 31, hh = lane >> 5;
  f32x16 acc[TM][TN];
#pragma unroll
  for (int i = 0; i < TM; ++i)
#pragma unroll
    for (int j = 0; j < TN; ++j)
#pragma unroll
      for (int r = 0; r < 16; ++r) acc[i][j][r] = 0.f;
  const int nk = K / 64;
  static_assert(NA <= 2 && NB <= 2, "staging registers are scalarised for at most 2+2 chunks per thread");
  uint4 pa0, pa1, pb0, pb1, qa0, qa1, qb0, qb1;
#define GT_LD1(dst, P, ld, r0, i_) do { int c = tid + NTHR * (i_), row = c >> 3, cc = c & 7; dst = *(const uint4*)(P + (size_t)(r0 + row) * ld + k0_ + cc * 8); } while (0)
#define GT_GLOAD(kt_, A0, A1, B0, B1) do { const int k0_ = ((kt_) < nk ? (kt_) : nk - 1) * 64; \
    GT_LD1(A0, A, lda, m0, 0); if constexpr (NA > 1) GT_LD1(A1, A, lda, m0, 1); \
    GT_LD1(B0, Bt, ldb, n0, 0); if constexpr (NB > 1) GT_LD1(B1, Bt, ldb, n0, 1); } while (0)
#define GT_ST1(src, S, bm, i_) do { int c = tid + NTHR * (i_), row = c >> 3, cc = c & 7; *(uint4*)(S + (bm + row) * GLD + cc * 8) = src; } while (0)
#define GT_LSTORE(buf_, A0, A1, B0, B1) do { \
    GT_ST1(A0, As, (buf_) * BM, 0); if constexpr (NA > 1) GT_ST1(A1, As, (buf_) * BM, 1); \
    GT_ST1(B0, Bs, (buf_) * BN, 0); if constexpr (NB > 1) GT_ST1(B1, Bs, (buf_) * BN, 1); } while (0)
#define GT_COMPUTE(buf_) do { \
    _Pragma("unroll") for (int ks = 0; ks < 4; ++ks) { bf16x8 a[TM], b[TN]; \
      _Pragma("unroll") for (int i = 0; i < TM; ++i) a[i] = *(const bf16x8*)(As + ((buf_) * BM + wm * 32 * TM + i * 32 + lr) * GLD + ks * 16 + hh * 8); \
      _Pragma("unroll") for (int j = 0; j < TN; ++j) b[j] = *(const bf16x8*)(Bs + ((buf_) * BN + wn * 32 * TN + j * 32 + lr) * GLD + ks * 16 + hh * 8); \
      _Pragma("unroll") for (int i = 0; i < TM; ++i) _Pragma("unroll") for (int j = 0; j < TN; ++j) acc[i][j] = mfma32(a[i], b[j], acc[i][j]); } } while (0)
  GT_GLOAD(0, pa0, pa1, pb0, pb1);
  GT_GLOAD(1, qa0, qa1, qb0, qb1);
  GT_LSTORE(0, pa0, pa1, pb0, pb1);
  GT_GLOAD(2, pa0, pa1, pb0, pb1);
  __syncthreads();
#pragma unroll 1
  for (int kt = 0; kt < nk; kt += 2) {
    GT_COMPUTE(0);
    GT_LSTORE(1, qa0, qa1, qb0, qb1);
    GT_GLOAD(kt + 3, qa0, qa1, qb0, qb1);
    __syncthreads();
    GT_COMPUTE(1);
    GT_LSTORE(0, pa0, pa1, pb0, pb1);
    GT_GLOAD(kt + 4, pa0, pa1, pb0, pb1);
    __syncthreads();
  }
#undef GT_GLOAD
#undef GT_LSTORE
#undef GT_COMPUTE
#undef GT_LD1
#undef GT_ST1
  if constexpr (PAIR) {
    static_assert(TN == 2, "paired epilogue needs two column tiles per wave");
#pragma unroll
    for (int i = 0; i < TM; ++i)
#pragma unroll
      for (int r = 0; r < 16; ++r) {
        int m = m0 + wm * 32 * TM + i * 32 + (r & 3) + 8 * (r >> 2) + 4 * hh;
        epi(m, wn * 32 + lr, acc[i][0][r], acc[i][1][r]);
      }
  } else {
#pragma unroll
    for (int i = 0; i < TM; ++i)
#pragma unroll
      for (int j = 0; j < TN; ++j)
#pragma unroll
        for (int r = 0; r < 16; ++r) {
          int m = m0 + wm * 32 * TM + i * 32 + (r & 3) + 8 * (r >> 2) + 4 * hh;
          int n = n0 + wn * 32 * TN + j * 32 + lr;
          epi(m, n, acc[i][j][r]);
        }
  }
}

namespace pg8 {
#define PG8_LAS __attribute__((address_space(3)))
typedef unsigned short bf16_t;
typedef short bf16x8 __attribute__((ext_vector_type(8)));
typedef float f32x4 __attribute__((ext_vector_type(4)));
typedef unsigned u32x4 __attribute__((ext_vector_type(4)));
constexpr int BM = 256, BK = 64, HALF = 128, HTB = HALF * BK * 2  , STAGE_BYTES = 8 * HTB, NXCD = 8, WGM = 8;

__host__ __device__ __forceinline__ int lds_byte(int r, int c) { const int st = (r >> 4) * 2 + (c >> 5), rr = r & 15, cc = c & 31, ob = rr * 64 + cc * 2; return st * 1024 + (ob ^ (((ob >> 9) & 1) << 5)); }
__host__ __device__ __forceinline__ void stage_rc(int b, int& R, int& C) { const int st = b / 1024, sb = b % 1024, swz = sb ^ (((sb >> 9) & 1) << 5); R = (st >> 1) * 16 + swz / 64; C = (st & 1) * 32 + (swz % 64) / 2; }
__host__ __device__ __forceinline__ int perm32(int rho) { const int n = rho >> 4, i = rho & 15; return 8 * (i >> 2) + 4 * n + (i & 3); }

struct Unit { int pm, pn; };
struct Gemm { const bf16_t* A; const bf16_t* Bt; int M, N, K; };

struct StaticOrder {
    int nM, nN, nwg, G, c;
    __host__ __device__ void init(int M, int N, int G_, int c_) { nM = M / BM; nN = N / BM; nwg = nM * nN; G = G_; c = c_; }
    __host__ __device__ bool next(int i, Unit& u) const {
        const long L = (long)i * G + c; if (L >= nwg) return false;
        int wgid = (int)L; { const int q = nwg / NXCD, r = nwg % NXCD, xcd = wgid % NXCD, off = wgid / NXCD; wgid = (xcd < r ? xcd * (q + 1) : r * (q + 1) + (xcd - r) * q) + off; }
        const int nig = WGM * nN, gid = wgid / nig, fm = gid * WGM, gsz = (nM - fm) < WGM ? (nM - fm) : WGM;
        u.pm = fm + ((wgid % nig) % gsz); u.pn = (wgid % nig) / gsz; return true;
    }
    __device__ __forceinline__ void a_ready(const Unit&) const {}
    __device__ __forceinline__ void done(const Unit&) const {}
};
__device__ __forceinline__ unsigned cvt_pk_bf16(float lo, float hi) { unsigned r; asm volatile("v_cvt_pk_bf16_f32 %0, %1, %2" : "=v"(r) : "v"(lo), "v"(hi)); return r; }

template <bool PERM_, class F> struct EpiFn {
    static constexpr bool PERM = PERM_, AFTER_DRAIN = false;
    F f;
    __device__ __forceinline__ void operator()(const f32x4 (&acc)[2][2][4][2], const Unit& u, int wr, int wc, int fr, int fq) const {
        const int row0 = u.pm * BM + wr * 64 + fr;
#pragma unroll
        for (int ai = 0; ai < 2; ++ai)
#pragma unroll
            for (int m = 0; m < 4; ++m) {
                const int row = row0 + ai * HALF + m * 16;
#pragma unroll
                for (int bj = 0; bj < 2; ++bj) {
                    if constexpr (PERM_) {
                        f.st8(row, u.pn * BM + wc * 32 + 8 * fq + bj * HALF, acc[ai][bj][m][0], acc[ai][bj][m][1]);
                    } else {
#pragma unroll
                        for (int n = 0; n < 2; ++n) f.st4(row, u.pn * BM + wc * 32 + 4 * fq + bj * HALF + n * 16, acc[ai][bj][m][n]);
                    }
                }
            }
    }
};
template <class Epi, class Sched, bool STAMP = false>
__device__ __forceinline__ void gemm_phase(PG8_LAS unsigned char* lds, const Gemm g, const Sched& S, const Epi& E, unsigned long long* stamps) {
    const int tid = tidx(), wid = __builtin_amdgcn_readfirstlane(tid >> 6), lane = tid & 63, wr = wid >> 2, wc = wid & 3, fr = lane & 15, fq = lane >> 4;
    const int K = g.K, nt = K / BK;
    int ts_lo = 0, ts_hi = 0, nts = 0; const unsigned long long rt_entry = STAMP ? (unsigned long long)wall_clock64() : 0ull;
#define PG8_STAMP() do { if (STAMP && wid == 0 && nts < 64) { const unsigned long long _c = (unsigned long long)clock64(); \
        ts_lo = (lane == nts) ? (int)(unsigned)_c : ts_lo; ts_hi = (lane == nts) ? (int)(unsigned)(_c >> 32) : ts_hi; ++nts; } } while (0)
    PG8_STAMP();
    unsigned voffA[2], voffB[2];
#pragma unroll
    for (int i = 0; i < 2; ++i) { int R, C; stage_rc(tid * 16 + i * 8192, R, C); const int Rb = Epi::PERM ? ((R & ~31) + perm32(R & 31)) : R;
        voffA[i] = (unsigned)(R * K + C) * 2u; voffB[i] = (unsigned)(Rb * K + C) * 2u; }
    const size_t kstep = (size_t)(BK * 2);
    const size_t hstep = (size_t)HALF * K * 2;
    const size_t tstep = 2 * hstep;
    const unsigned ldsw = (unsigned)wid * 1024u;
    const int aoff = lds_byte(wr * 64 + fr, fq * 8), boff = lds_byte(wc * 32 + fr, fq * 8);
#define PG8_SA(b, h) (((b) * 2 + (h)) * HTB)
#define PG8_SB(b, h) ((4 + (b) * 2 + (h)) * HTB)
#define PG8_STAGE(bufoff, gbase, voff) do { _Pragma("unroll") for (int _i = 0; _i < 2; ++_i) \
        __builtin_amdgcn_global_load_lds((const unsigned*)((const char*)(gbase) + (voff)[_i]), (PG8_LAS unsigned*)(lds + (bufoff) + ldsw + _i * 8192), 16, 0, 0); } while (0)
#define PG8_LDA(dst, b, h) do { _Pragma("unroll") for (int m = 0; m < 4; ++m) _Pragma("unroll") for (int k = 0; k < 2; ++k) dst[m][k] = *(const PG8_LAS bf16x8*)(lds + PG8_SA(b, h) + aoff + m * 2048 + k * 1024); } while (0)
#define PG8_LDB(dst, b, h) do { _Pragma("unroll") for (int n = 0; n < 2; ++n) _Pragma("unroll") for (int k = 0; k < 2; ++k) dst[n][k] = *(const PG8_LAS bf16x8*)(lds + PG8_SB(b, h) + boff + n * 2048 + k * 1024); } while (0)
#define PG8_MMA(ai, bj, At, Bt) do { __builtin_amdgcn_s_setprio(1); _Pragma("unroll") for (int m = 0; m < 4; ++m) _Pragma("unroll") for (int n = 0; n < 2; ++n) _Pragma("unroll") for (int k = 0; k < 2; ++k) \
        acc[ai][bj][m][n] = __builtin_amdgcn_mfma_f32_16x16x32_bf16(Bt[n][k], At[m][k], acc[ai][bj][m][n], 0, 0, 0); __builtin_amdgcn_s_setprio(0); } while (0)
#define PG8_WAIT_V(n) asm volatile("s_waitcnt vmcnt(" #n ")" ::: "memory")
#define PG8_WAIT_L(n) asm volatile("s_waitcnt lgkmcnt(" #n ")" ::: "memory")
#define PG8_BAR __builtin_amdgcn_s_barrier()
#define PG8_SCHED __builtin_amdgcn_sched_barrier(0)
    Unit cur, nxt; int ui = 0;
    if (!S.next(0, cur)) return;
    f32x4 acc[2][2][4][2];
#pragma unroll
    for (int a = 0; a < 2; ++a)
#pragma unroll
        for (int b = 0; b < 2; ++b)
#pragma unroll
            for (int m = 0; m < 4; ++m)
#pragma unroll
                for (int n = 0; n < 2; ++n) acc[a][b][m][n] = (f32x4){0.f, 0.f, 0.f, 0.f};
    bf16x8 At[4][2], B0[2][2], B1[2][2];
    const char* cA = (const char*)g.A + (size_t)cur.pm * tstep; const char* cB = (const char*)g.Bt + (size_t)cur.pn * tstep;
    S.a_ready(cur);
    PG8_STAGE(PG8_SB(0, 0), cB, voffB); PG8_STAGE(PG8_SA(0, 0), cA, voffA); PG8_STAGE(PG8_SB(0, 1), cB + hstep, voffB); PG8_STAGE(PG8_SA(0, 1), cA + hstep, voffA);
    if (wr == 1) PG8_BAR;
    PG8_WAIT_V(4); PG8_BAR;
    PG8_STAGE(PG8_SB(1, 0), cB + kstep, voffB); PG8_STAGE(PG8_SA(1, 0), cA + kstep, voffA); PG8_STAGE(PG8_SB(1, 1), cB + hstep + kstep, voffB);
    PG8_WAIT_V(6); PG8_BAR;
    PG8_STAMP();
    for (;;) {
        const bool has_next = S.next(ui + 1, nxt);
        const char* nA = has_next ? (const char*)g.A + (size_t)nxt.pm * tstep : cA; const char* nB = has_next ? (const char*)g.Bt + (size_t)nxt.pn * tstep : cB;
        for (int t = 0; t < nt; t += 2) {
            const bool last = (t == nt - 2);
            const char* a1 = cA + (size_t)(t + 1) * kstep;
            const char* a2 = last ? nA : cA + (size_t)(t + 2) * kstep; const char* b2 = last ? nB : cB + (size_t)(t + 2) * kstep;
            const char* a3 = a2 + kstep; const char* b3 = b2 + kstep;
            if (last && has_next) S.a_ready(nxt);
            PG8_LDB(B0, 0, 0); PG8_SCHED; PG8_LDA(At, 0, 0); PG8_STAGE(PG8_SA(1, 1), a1 + hstep, voffA);
            PG8_WAIT_L(8); PG8_BAR; PG8_WAIT_L(0); PG8_MMA(0, 0, At, B0); PG8_BAR; PG8_SCHED;
            PG8_LDB(B1, 0, 1); PG8_STAGE(PG8_SB(0, 0), b2, voffB);
            PG8_BAR; PG8_WAIT_L(0); PG8_MMA(0, 1, At, B1); PG8_BAR;
            PG8_LDA(At, 0, 1); PG8_STAGE(PG8_SA(0, 0), a2, voffA);
            PG8_BAR; PG8_WAIT_L(0); PG8_MMA(1, 0, At, B0); PG8_BAR; PG8_SCHED;
            PG8_STAGE(PG8_SB(0, 1), b2 + hstep, voffB);
            PG8_WAIT_V(6); PG8_BAR; PG8_MMA(1, 1, At, B1); PG8_BAR;
            PG8_LDB(B0, 1, 0); PG8_SCHED; PG8_LDA(At, 1, 0); PG8_STAGE(PG8_SA(0, 1), a2 + hstep, voffA);
            PG8_WAIT_L(8); PG8_BAR; PG8_WAIT_L(0); PG8_MMA(0, 0, At, B0); PG8_BAR; PG8_SCHED;
            PG8_LDB(B1, 1, 1); PG8_STAGE(PG8_SB(1, 0), b3, voffB);
            PG8_BAR; PG8_WAIT_L(0); PG8_MMA(0, 1, At, B1); PG8_BAR;
            PG8_LDA(At, 1, 1); PG8_STAGE(PG8_SA(1, 0), a3, voffA);
            PG8_BAR; PG8_WAIT_L(0); PG8_MMA(1, 0, At, B0); PG8_BAR; PG8_SCHED;
            PG8_STAGE(PG8_SB(1, 1), b3 + hstep, voffB);
            PG8_WAIT_V(6); PG8_BAR; PG8_MMA(1, 1, At, B1); PG8_BAR;
        }
        PG8_STAMP();
        if constexpr (!Epi::AFTER_DRAIN) { E(acc, cur, wr, wc, fr, fq); S.done(cur); }
        PG8_STAMP();
        if (!has_next) break;
#pragma unroll
        for (int a = 0; a < 2; ++a)
#pragma unroll
            for (int b = 0; b < 2; ++b)
#pragma unroll
                for (int m = 0; m < 4; ++m)
#pragma unroll
                    for (int n = 0; n < 2; ++n) acc[a][b][m][n] = (f32x4){0.f, 0.f, 0.f, 0.f};
        cur = nxt; cA = nA; cB = nB; ++ui;
    }
    PG8_WAIT_V(0);
    if (wr == 0) PG8_BAR;
    PG8_BAR;
    if constexpr (Epi::AFTER_DRAIN) { E.fused(acc, cur, wr, wc, fr, fq, lds, wid, lane); S.done(cur); }
    PG8_STAMP();
    if (STAMP && wid == 0) { stamps[lane] = lane < nts ? (((unsigned long long)(unsigned)ts_hi << 32) | (unsigned)ts_lo) : 0ull;
        if (lane == 62) stamps[62] = rt_entry; if (lane == 63) stamps[63] = (unsigned long long)wall_clock64(); }
#undef PG8_STAMP
#undef PG8_SA
#undef PG8_SB
#undef PG8_STAGE
#undef PG8_LDA
#undef PG8_LDB
#undef PG8_MMA
#undef PG8_WAIT_V
#undef PG8_WAIT_L
#undef PG8_BAR
#undef PG8_SCHED
}
}

struct Cplx { float re, im; };
__device__ __forceinline__ Cplx cmul(Cplx a, Cplx b) { return {a.re * b.re - a.im * b.im, a.re * b.im + a.im * b.re}; }
__device__ __forceinline__ Cplx apow(float are, float aim, float dt, float m) {
  float mag = __expf(m * dt * are);
  float s, c;
  sincos_rev(m * dt * aim, s, c);
  return {mag * c, mag * s};
}
__device__ __forceinline__ Cplx bscale(float are, float aim, float dt) {
  Cplx ab = apow(are, aim, dt, 1.f);
  float nr = ab.re - 1.f, ni = ab.im;
  float den = are * are + aim * aim;
  return {(nr * are + ni * aim) / den, (ni * are - nr * aim) / den};
}

__device__ __forceinline__ void convert_tables(const Params& p, int gw, int GWv) {
  const int lane = tidx() & 63;
  auto ldrow = [&](int row, float4 (&v)[4]) {
    const int rc = row < 2 * 16384 ? row : 2 * 16384 - 1;
    const bool isU = rc < 16384;
    const int e = isU ? rc : rc - 16384;
    const float* src = (isU ? p.peer_u : p.peer_v) + (size_t)e * 1024 + lane * 16;
#pragma unroll
    for (int i = 0; i < 4; ++i) v[i] = ((const float4*)src)[i];
  };
  auto cvrow = [&](int row, const float4 (&v)[4]) {
    const bool isU = row < 16384;
    const int e = isU ? row : row - 16384;
    float am = 0.f;
#pragma unroll
    for (int i = 0; i < 4; ++i) am = fmaxf(am, fmaxf(fmaxf(fabsf(v[i].x), fabsf(v[i].y)), fmaxf(fabsf(v[i].z), fabsf(v[i].w))));
#pragma unroll
    for (int o = 32; o >= 1; o >>= 1) am = fmaxf(am, __shfl_xor(am, o));
    int E = (int)((__float_as_uint(am) >> 23) & 0xffu) - 127;
    E = E < -60 ? -60 : E;
    const int k = 7 - E;
    const float sc = __uint_as_float((unsigned)(k + 127) << 23);
    unsigned w[4];
#pragma unroll
    for (int i = 0; i < 4; ++i) {
      int pk = 0;
      pk = __builtin_amdgcn_cvt_pk_fp8_f32(v[i].x * sc, v[i].y * sc, pk, false);
      pk = __builtin_amdgcn_cvt_pk_fp8_f32(v[i].z * sc, v[i].w * sc, pk, true);
      w[i] = (unsigned)pk;
    }
    unsigned char* dst = (isU ? p.U8() : p.V8()) + ((size_t)(lane >> 3) * 16384 + e) * 128 + (lane & 7) * 16;
    *(uint4*)dst = make_uint4(w[0], w[1], w[2], w[3]);
    if (lane == 0) {
      ((unsigned short*)p.USC())[e * 2 + (isU ? 0 : 1)] = (unsigned short)(127 - k);
    }
  };
  if (gw >= 2 * 16384) return;
  float4 b0[4], b1[4], c[4];
  ldrow(gw, b0);
  ldrow(gw + GWv, b1);
  for (int row = gw; row < 2 * 16384; row += 2 * GWv) {
#pragma unroll
    for (int i = 0; i < 4; ++i) c[i] = b0[i];
    ldrow(row + 2 * GWv, b0);
    cvrow(row, c);
    if (row + GWv < 2 * 16384) {
#pragma unroll
      for (int i = 0; i < 4; ++i) c[i] = b1[i];
      ldrow(row + 3 * GWv, b1);
      cvrow(row + GWv, c);
    }
  }
}

__device__ __forceinline__ void tr_cvt(const float* __restrict__ W, bf16_t* __restrict__ Wt, int K, int N, int Npad, size_t gt, size_t GT) {
  size_t tot = (size_t)K * Npad;
  for (size_t i = gt; i < tot; i += GT) {
    int n = (int)(i / K), k = (int)(i % K);
    Wt[i] = (n < N) ? f2bf(W[(size_t)k * N + n]) : (bf16_t)0;
  }
}
__device__ __forceinline__ void cvt_flat(const float* __restrict__ W, bf16_t* __restrict__ Wb, size_t n4, size_t gt, size_t GT) {
  for (size_t i = gt; i < n4; i += GT) {
    float4 v = ((const float4*)W)[i];
    ((uint2*)Wb)[i] = make_uint2(pk2(v.x, v.y), pk2(v.z, v.w));
  }
}
__device__ __forceinline__ void phase0(const Params& p, char* smem) {
  if (blockIdx.x < 8) {
    float* red = (float*)smem;
    const int h = blockIdx.x, tid = tidx(), d = tid & 63, c0 = (tid >> 6) * 32;
    float v[32];
    float am = 0.f;
#pragma unroll
    for (int i = 0; i < 32; ++i) { v[i] = p.w_uk[(size_t)(c0 + i) * 512 + h * 64 + d]; am = fmaxf(am, fabsf(v[i])); }
#pragma unroll
    for (int o = 32; o >= 1; o >>= 1) am = fmaxf(am, __shfl_xor(am, o));
    if ((tid & 63) == 0) red[tid >> 6] = am;
    __syncthreads();
    am = red[0];
#pragma unroll
    for (int i = 1; i < 8; ++i) am = fmaxf(am, red[i]);
    int E = (int)((__float_as_uint(am) >> 23) & 0xffu) - 127;
    E = E < -60 ? -60 : E;
    const int k = 7 - E;
    const float sc = __uint_as_float((unsigned)(k + 127) << 23);
    unsigned w[8];
#pragma unroll
    for (int i = 0; i < 8; ++i) {
      int pk = 0;
      pk = __builtin_amdgcn_cvt_pk_fp8_f32(v[4 * i] * sc, v[4 * i + 1] * sc, pk, false);
      pk = __builtin_amdgcn_cvt_pk_fp8_f32(v[4 * i + 2] * sc, v[4 * i + 3] * sc, pk, true);
      w[i] = (unsigned)pk;
    }
    unsigned char* dst = p.W8T() + (size_t)(h * 64 + d) * 256 + c0;
    *(uint4*)dst = make_uint4(w[0], w[1], w[2], w[3]);
    *(uint4*)(dst + 16) = make_uint4(w[4], w[5], w[6], w[7]);
    if (tid == 0) p.KW()[h] = k;
    __syncthreads();
  }
  const size_t gt = (size_t)blockIdx.x * NTHR + tidx(), GT = (size_t)gridDim.x * NTHR;
  {
    const int lane = tidx() & 63, wave = tidx() >> 6;
    float* tl = (float*)smem + wave * (64 * 65);
    const int woff = gridDim.x > 8 ? 64 : 0;
    const int gwv = blockIdx.x * 8 + wave - woff, GWv = gridDim.x * 8 - woff;
    for (int t = gwv; t < 1480 && gwv >= 0; t += GWv) {
      const float* W; bf16_t* Wt; int K, N, tk, mode, tt;
      if (t < 320)       { W = p.w_in;    Wt = p.WinT();  K = 1024; N = INW;  tk = 16; mode = 0; tt = t; }
      else if (t < 392)  { W = p.w_uq;    Wt = p.WuqT();  K = 384;  N = 768;  tk = 6;  mode = 0; tt = t - 320; }
      else if (t < 424)  { W = p.w_uk;    Wt = p.WukT();  K = 256;  N = 512;  tk = 4;  mode = 0; tt = t - 392; }
      else if (t < 456)  { W = p.w_uv;    Wt = p.WuvT();  K = 256;  N = 512;  tk = 4;  mode = 0; tt = t - 424; }
      else if (t < 584)  { W = p.w_glu;   Wt = p.WgluT(); K = 512;  N = 1024; tk = 8;  mode = 1; tt = t - 456; }
      else if (t < 712)  { W = p.w_glu;   Wt = p.WgluS(); K = 512;  N = 1024; tk = 8;  mode = 2; tt = t - 584; }
      else if (t < 968)  { W = p.w_out;   Wt = p.WoutT(); K = 1024; N = 1024; tk = 16; mode = 0; tt = t - 712; }
      else               { W = p.peer_wq; Wt = p.WpqT();  K = 1024; N = 2048; tk = 16; mode = 0; tt = t - 968; }
      const int k0 = (tt % tk) * 64, n0 = (tt / tk) * 64;
      const int n = n0 + lane;
      int sn = n;
      if (mode == 1) sn = ((n & 255) >> 7) * 512 + (n >> 8) * 128 + (n & 127);
      if (mode == 2) sn = (((n & 63) >> 5)) * 512 + (n >> 7) * 64 + (((n & 127) >> 6)) * 32 + (n & 31);
      const bool okn = n < N;
      const float* wp = W + (size_t)k0 * N + (okn ? sn : 0);
#pragma unroll
      for (int rb = 0; rb < 64; rb += 16) {
        float v[16];
#pragma unroll
        for (int r = 0; r < 16; ++r) v[r] = wp[(size_t)(rb + r) * N];
#pragma unroll
        for (int r = 0; r < 16; ++r) tl[lane * 65 + rb + r] = okn ? v[r] : 0.f;
      }
      const int kl = (lane & 31) * 2, nh = lane >> 5;
#pragma unroll 8
      for (int i = 0; i < 32; ++i) {
        const int nl = 2 * i + nh;
        *(unsigned*)(Wt + (size_t)(n0 + nl) * K + k0 + kl) = pk2(tl[nl * 65 + kl], tl[nl * 65 + kl + 1]);
      }
    }
  }
  cvt_flat(p.peer_keys, p.PK(), 2 * 128 * 128 / 4, gt, GT);
  {
    size_t tot = (size_t)32 * 128 * 256 / 8;
    for (size_t i = gt; i < tot; i += GT) {
      int g = (int)(i / (128 * 32)), rem = (int)(i % (128 * 32)), n = rem / 32, c8 = rem % 32;
      *(uint4*)(p.A2() + ((size_t)g * NSUB + 1024 + n) * A2LD + c8 * 8) = make_uint4(0, 0, 0, 0);
    }
  }
  {
    size_t tot = (size_t)32 * 16 * 256;
    float* xs = (float*)smem;
    __syncthreads();
    for (size_t base = (size_t)blockIdx.x * NTHR; base < tot; base += GT) {
      const int tid = tidx();
      const int g = (int)(base / 4096), m0 = (int)((base % 4096) >> 8);
      if (tid < 128) {
        const int mm = tid >> 6, pp = tid & 63;
        float dt = __expf(p.log_dt[g]);
        float are = p.a_re[g * 64 + pp], aim = p.a_im[g * 64 + pp];
        Cplx x = cmul(apow(are, aim, dt, (float)(m0 + mm)), bscale(are, aim, dt));
        xs[(mm * 64 + pp) * 2] = x.re; xs[(mm * 64 + pp) * 2 + 1] = x.im;
      }
      __syncthreads();
      const int mm = tid >> 8, m = m0 + mm, h = (tid >> 4) & 15, h2 = tid & 15;
      float acc = 0.f;
#pragma unroll 4
      for (int pp = 0; pp < 64; ++pp) {
        Cplx ab = {xs[(mm * 64 + pp) * 2], xs[(mm * 64 + pp) * 2 + 1]};
        Cplx bb = {p.ssm_b[((g * 64 + pp) * 16 + h2) * 2], p.ssm_b[((g * 64 + pp) * 16 + h2) * 2 + 1]};
        Cplx cc = {p.ssm_c[((g * 16 + h) * 64 + pp) * 2], p.ssm_c[((g * 16 + h) * 64 + pp) * 2 + 1]};
        Cplx x = cmul(ab, bb);
        acc += cc.re * x.re - cc.im * x.im;
      }
      if (m == 0 && h == h2) acc += p.ssm_d[g * 16 + h];
      bf16_t v = f2bf(acc);
      for (int t = m; t < 16; ++t) {
        int j = t - m;
        p.Bt2()[((size_t)g * 256 + t * 16 + h) * A2LD + j * 16 + h2] = v;
      }
      if (m == 0) {
        for (int t = 0; t < 16; ++t)
          for (int j = t + 1; j < 16; ++j) p.Bt2()[((size_t)g * 256 + t * 16 + h) * A2LD + j * 16 + h2] = 0;
      }
      __syncthreads();
    }
    tot = (size_t)32 * 256 * 64;
    for (size_t i = gt; i < tot; i += GT) {
      int g = (int)(i / 16384), rem = (int)(i % 16384), th = rem >> 6, pp = rem & 63, t = th >> 4, h = th & 15;
      float dt = __expf(p.log_dt[g]);
      float are = p.a_re[g * 64 + pp], aim = p.a_im[g * 64 + pp];
      Cplx am = apow(are, aim, dt, (float)(t + 1));
      Cplx cc = {p.ssm_c[((g * 16 + h) * 64 + pp) * 2], p.ssm_c[((g * 16 + h) * 64 + pp) * 2 + 1]};
      p.Bt2()[((size_t)g * 256 + th) * A2LD + 256 + pp] = f2bf(cc.re * am.re - cc.im * am.im);
      p.Bt2()[((size_t)g * 256 + th) * A2LD + 320 + pp] = f2bf(-(cc.re * am.im + cc.im * am.re));
    }
    tot = (size_t)32 * 64 * 256;
    for (size_t i = gt; i < tot; i += GT) {
      int g = (int)(i / 16384), rem = (int)(i % 16384), pp = rem >> 8, jh = rem & 255, j = jh >> 4, h2 = jh & 15;
      float dt = __expf(p.log_dt[g]);
      float are = p.a_re[g * 64 + pp], aim = p.a_im[g * 64 + pp];
      Cplx am = apow(are, aim, dt, (float)(15 - j));
      Cplx bs = bscale(are, aim, dt);
      Cplx bb = {p.ssm_b[((g * 64 + pp) * 16 + h2) * 2], p.ssm_b[((g * 64 + pp) * 16 + h2) * 2 + 1]};
      Cplx x = cmul(cmul(am, bs), bb);
      p.Emat()[((size_t)g * 128 + pp) * 256 + jh] = f2bf(x.re);
      p.Emat()[((size_t)g * 128 + 64 + pp) * 256 + jh] = f2bf(x.im);
    }
  }
}

template <bool FP8OUT, bool SRCBF = false>
__device__ __forceinline__ void phase_rmsnorm(const float* __restrict__ srcP, const float* __restrict__ srcS, const float* __restrict__ gain,
                              bf16_t* __restrict__ dst, unsigned char* __restrict__ dst8, int* __restrict__ xsc) {
  const int lane = tidx() & 63, gw = blockIdx.x * 8 + (tidx() >> 6), GW = gridDim.x * 8;
  float4 g[4];
#pragma unroll
  for (int i = 0; i < 4; ++i) g[i] = *(const float4*)(gain + lane * 4 + 256 * i);
  if (gw >= NT) return;
  float4 nx[4];
  uint2 nxb[4];
#define RN_LOAD(R_) do { const int rr_ = (R_); \
    if constexpr (SRCBF) { const bf16_t* s_ = (rr_ < NP) ? (const bf16_t*)srcP + (size_t)rr_ * 1024 : (const bf16_t*)srcS + (size_t)(rr_ - NP) * 1024; \
      _Pragma("unroll") for (int i = 0; i < 4; ++i) nxb[i] = *(const uint2*)(s_ + lane * 4 + 256 * i); } \
    else { const float* s_ = (rr_ < NP) ? srcP + (size_t)rr_ * 1024 : srcS + (size_t)(rr_ - NP) * 1024; \
      _Pragma("unroll") for (int i = 0; i < 4; ++i) nx[i] = *(const float4*)(s_ + lane * 4 + 256 * i); } } while (0)
  RN_LOAD(gw);
  for (int r = gw; r < NT; r += GW) {
    float4 v[4];
    float ss = 0.f;
#pragma unroll
    for (int i = 0; i < 4; ++i) {
      if constexpr (SRCBF) v[i] = make_float4(bflo(nxb[i].x), bfhi(nxb[i].x), bflo(nxb[i].y), bfhi(nxb[i].y));
      else v[i] = nx[i];
    }
    RN_LOAD(r + GW < NT ? r + GW : r);
#pragma unroll
    for (int i = 0; i < 4; ++i) ss += v[i].x * v[i].x + v[i].y * v[i].y + v[i].z * v[i].z + v[i].w * v[i].w;
    ss = wave_sum(ss);
    float rinv = rsqrtf(ss * (1.f / 1024.f) + EPS);
#pragma unroll
    for (int i = 0; i < 4; ++i) {
      uint2 o = make_uint2(pk2(v[i].x * rinv * g[i].x, v[i].y * rinv * g[i].y), pk2(v[i].z * rinv * g[i].z, v[i].w * rinv * g[i].w));
      *(uint2*)(dst + (size_t)r * 1024 + lane * 4 + 256 * i) = o;
    }
    if constexpr (FP8OUT) {
      float am = 0.f;
#pragma unroll
      for (int i = 0; i < 4; ++i) {
        v[i].x *= rinv * g[i].x; v[i].y *= rinv * g[i].y; v[i].z *= rinv * g[i].z; v[i].w *= rinv * g[i].w;
        am = fmaxf(am, fmaxf(fmaxf(fabsf(v[i].x), fabsf(v[i].y)), fmaxf(fabsf(v[i].z), fabsf(v[i].w))));
      }
#pragma unroll
      for (int o = 32; o >= 1; o >>= 1) am = fmaxf(am, __shfl_xor(am, o));
      int E = (int)((__float_as_uint(am) >> 23) & 0xffu) - 127;
      E = E < -60 ? -60 : E;
      const int k = 7 - E;
      const float sc = __uint_as_float((unsigned)(k + 127) << 23);
#pragma unroll
      for (int i = 0; i < 4; ++i) {
        int pk = 0;
        pk = __builtin_amdgcn_cvt_pk_fp8_f32(v[i].x * sc, v[i].y * sc, pk, false);
        pk = __builtin_amdgcn_cvt_pk_fp8_f32(v[i].z * sc, v[i].w * sc, pk, true);
        *(unsigned*)(dst8 + (size_t)r * 1024 + lane * 4 + 256 * i) = (unsigned)pk;
      }
      if (lane == 0) xsc[r] = 127 - k;
    }
  }
}

struct StZ { bf16_t* Z; __device__ __forceinline__ void st8(int row, int col, pg8::f32x4 a, pg8::f32x4 b) const {
    if (col < INW) *(uint4*)(Z + (unsigned)(row * INW + col)) = make_uint4(pk2(a[0], a[1]), pk2(a[2], a[3]), pk2(b[0], b[1]), pk2(b[2], b[3])); } };
struct StF32 { float* C; int ldc; __device__ __forceinline__ void st4(int row, int col, pg8::f32x4 v) const { *(pg8::f32x4*)(C + (unsigned)(row * ldc + col)) = v; } };
struct StBf16 { bf16_t* C; int ldc; __device__ __forceinline__ void st8(int row, int col, pg8::f32x4 a, pg8::f32x4 b) const {
    *(uint4*)(C + (unsigned)(row * ldc + col)) = make_uint4(pk2(a[0], a[1]), pk2(a[2], a[3]), pk2(b[0], b[1]), pk2(b[2], b[3])); } };
struct StX1 { bf16_t* C; const float* x; __device__ __forceinline__ void st8(int row, int col, pg8::f32x4 a, pg8::f32x4 b) const {
    const unsigned o = (unsigned)(row * 1024 + col); const pg8::f32x4 xa = *(const pg8::f32x4*)(x + o) + a, xb = *(const pg8::f32x4*)(x + o + 4) + b;
    *(uint4*)(C + o) = make_uint4(pk2(xa[0], xa[1]), pk2(xa[2], xa[3]), pk2(xb[0], xb[1]), pk2(xb[2], xb[3])); } };
__device__ __forceinline__ void phase_rmsnorm_x1(const bf16_t* __restrict__ src, const float* __restrict__ gain, bf16_t* __restrict__ dst,
                                                 unsigned char* __restrict__ dst8, int* __restrict__ xsc) {
  const int lane = tidx() & 63, gw = blockIdx.x * 8 + (tidx() >> 6), GW = gridDim.x * 8;
  float g[16];
#pragma unroll
  for (int i = 0; i < 2; ++i) {
    const float4 a = *(const float4*)(gain + lane * 8 + 512 * i), b = *(const float4*)(gain + lane * 8 + 512 * i + 4);
    g[i * 8 + 0] = a.x; g[i * 8 + 1] = a.y; g[i * 8 + 2] = a.z; g[i * 8 + 3] = a.w; g[i * 8 + 4] = b.x; g[i * 8 + 5] = b.y; g[i * 8 + 6] = b.z; g[i * 8 + 7] = b.w;
  }
  if (gw >= NT) return;
  uint4 n0 = *(const uint4*)(src + (size_t)gw * 1024 + lane * 8), n1 = *(const uint4*)(src + (size_t)gw * 1024 + 512 + lane * 8);
  for (int r = gw; r < NT; r += GW) {
    const uint4 c0 = n0, c1 = n1;
    {
      const int rn = r + GW < NT ? r + GW : r;
      n0 = *(const uint4*)(src + (size_t)rn * 1024 + lane * 8); n1 = *(const uint4*)(src + (size_t)rn * 1024 + 512 + lane * 8);
    }
    float v[16] = {bflo(c0.x), bfhi(c0.x), bflo(c0.y), bfhi(c0.y), bflo(c0.z), bfhi(c0.z), bflo(c0.w), bfhi(c0.w),
                   bflo(c1.x), bfhi(c1.x), bflo(c1.y), bfhi(c1.y), bflo(c1.z), bfhi(c1.z), bflo(c1.w), bfhi(c1.w)};
    float ss = 0.f;
#pragma unroll
    for (int k = 0; k < 16; ++k) ss += v[k] * v[k];
    ss = wave_sum(ss);
    const float rinv = rsqrtf(ss * (1.f / 1024.f) + EPS);
    float am = 0.f;
#pragma unroll
    for (int k = 0; k < 16; ++k) { v[k] *= rinv * g[k]; am = fmaxf(am, fabsf(v[k])); }
#pragma unroll
    for (int i = 0; i < 2; ++i)
      *(uint4*)(dst + (size_t)r * 1024 + 512 * i + lane * 8) = make_uint4(pk2(v[i * 8], v[i * 8 + 1]), pk2(v[i * 8 + 2], v[i * 8 + 3]), pk2(v[i * 8 + 4], v[i * 8 + 5]), pk2(v[i * 8 + 6], v[i * 8 + 7]));
#pragma unroll
    for (int o = 32; o >= 1; o >>= 1) am = fmaxf(am, __shfl_xor(am, o));
    int E = (int)((__float_as_uint(am) >> 23) & 0xffu) - 127;
    E = E < -60 ? -60 : E;
    const int k = 7 - E;
    const float sc = __uint_as_float((unsigned)(k + 127) << 23);
#pragma unroll
    for (int i = 0; i < 2; ++i) {
      int p0 = 0, p1 = 0;
      p0 = __builtin_amdgcn_cvt_pk_fp8_f32(v[i * 8] * sc, v[i * 8 + 1] * sc, p0, false);
      p0 = __builtin_amdgcn_cvt_pk_fp8_f32(v[i * 8 + 2] * sc, v[i * 8 + 3] * sc, p0, true);
      p1 = __builtin_amdgcn_cvt_pk_fp8_f32(v[i * 8 + 4] * sc, v[i * 8 + 5] * sc, p1, false);
      p1 = __builtin_amdgcn_cvt_pk_fp8_f32(v[i * 8 + 6] * sc, v[i * 8 + 7] * sc, p1, true);
      *(uint2*)(dst8 + (size_t)r * 1024 + 512 * i + lane * 8) = make_uint2((unsigned)p0, (unsigned)p1);
    }
    if (lane == 0) xsc[r] = 127 - k;
  }
}
template <class Epi>
__device__ __forceinline__ void big_gemm(const bf16_t* A, const bf16_t* Bt, int M, int N, int K, char* smem, const Epi& E) {
  pg8::Gemm g{A, Bt, M, N, K};
  pg8::StaticOrder S;
  S.init(M, N, (int)gridDim.x, (int)blockIdx.x);
  pg8::gemm_phase<Epi, pg8::StaticOrder, false>((PG8_LAS unsigned char*)smem, g, S, E, nullptr);
}
__device__ __forceinline__ void phase_gemm_z(const Params& p, char* smem) {
  bf16_t* Z = (bf16_t*)p.Z();
  for (int t = blockIdx.x; t < 8 * 10; t += gridDim.x) {
    int tm = t / 10, tn = t % 10;
    gemm_tile<2, 4, 1, 1>(p.XN(), 1024, p.WinT(), 1024, 1024, NP + tm * 64, tn * 128, smem, [=](int m, int n, float v) {
      if (n < INW) Z[(size_t)m * INW + n] = f2bf(v);
    });
  }
  big_gemm(p.XN(), p.WinT(), NP, 1280, 1024, smem, pg8::EpiFn<true, StZ>{StZ{Z}});
  if (gridDim.x > 64) {
    if (blockIdx.x >= 64) convert_tables(p, (blockIdx.x - 64) * 8 + (tidx() >> 6), (gridDim.x - 64) * 8);
  } else {
    convert_tables(p, blockIdx.x * 8 + (tidx() >> 6), gridDim.x * 8);
  }
}

__device__ __forceinline__ void phase_post1(const Params& p) {
  const int lane = tidx() & 63, gw = blockIdx.x * 8 + (tidx() >> 6), GW = gridDim.x * 8;
  if (gw >= NT) return;
  typedef unsigned u32x3 __attribute__((ext_vector_type(3)));
  uint4 n_u; uint2 n_kvb; u32x3 n_cb; bf16_t n_krb;
#define P1_LOAD(R_) do { const bf16_t* z_ = (const bf16_t*)p.Z() + (size_t)(R_) * INW; \
    n_u = *(const uint4*)(z_ + lane * 8); \
    n_cb = *(const u32x3*)(z_ + 512 + lane * 6); \
    n_kvb = *(const uint2*)(z_ + 896 + lane * 4); n_krb = z_[1152 + (lane & 31)]; } while (0)
  float gq6[6];
#pragma unroll
  for (int e = 0; e < 6; ++e) gq6[e] = p.norm_q_lora[lane * 6 + e];
  const float4 gkv4 = *(const float4*)(p.norm_kv_lora + lane * 4);
  const float gkr1 = (lane < 32) ? p.g_kr[lane] : 0.f;
  const float ropeinv = exp2f(-(float)(lane & 15) * (13.287712379549449f / 16.f));
  P1_LOAD(gw);
  for (int r = gw; r < NT; r += GW) {
    const bool isP = r < NP;
    const int rs = r - NP;
    const uint4 c_u = n_u;
    const float4 c_kv = make_float4(bflo(n_kvb.x), bfhi(n_kvb.x), bflo(n_kvb.y), bfhi(n_kvb.y));
    const float2 c_c[3] = {make_float2(bflo(n_cb[0]), bfhi(n_cb[0])), make_float2(bflo(n_cb[1]), bfhi(n_cb[1])), make_float2(bflo(n_cb[2]), bfhi(n_cb[2]))};
    const float c_kr = __uint_as_float((unsigned)n_krb << 16);
    P1_LOAD(r + GW < NT ? r + GW : r);
    {
      int g = lane >> 1, h0 = (lane & 1) * 8;
      int n = isP ? (r >> 4) : (1024 + (rs >> 2));
      int t = isP ? (r & 15) : (rs & 3);
      *(uint4*)(p.A2() + ((size_t)g * NSUB + n) * A2LD + t * 16 + h0) = c_u;
    }
    {
      float2 v[3];
      float ss = 0.f;
#pragma unroll
      for (int i = 0; i < 3; ++i) {
        v[i] = c_c[i];
        ss += v[i].x * v[i].x + v[i].y * v[i].y;
      }
      ss = wave_sum(ss);
      float rinv = rsqrtf(ss * (1.f / 384.f) + EPS);
      u32x3 oq;
#pragma unroll
      for (int i = 0; i < 3; ++i) oq[i] = pk2(v[i].x * rinv * gq6[2 * i], v[i].y * rinv * gq6[2 * i + 1]);
      *(u32x3*)(p.CQN() + (size_t)r * 384 + lane * 6) = oq;
    }
    {
      float4 v = c_kv;
      float ss = wave_sum(v.x * v.x + v.y * v.y + v.z * v.z + v.w * v.w);
      float rinv = rsqrtf(ss * (1.f / 256.f) + EPS);
      const float4 g = gkv4;
      float4 o = make_float4(v.x * rinv * g.x, v.y * rinv * g.y, v.z * rinv * g.z, v.w * rinv * g.w);
      float* dst = isP ? p.out + O_LATP + (size_t)r * 256 : p.out + O_LATS + (size_t)rs * 256;
      *(float4*)(dst + lane * 4) = o;
      *(uint2*)(p.CKV() + (size_t)r * 256 + lane * 4) = make_uint2(pk2(o.x, o.y), pk2(o.z, o.w));
    }
    {
      float v = (lane < 32) ? c_kr : 0.f;
      float ss = wave_sum(v * v);
      float rinv = rsqrtf(ss * (1.f / 32.f) + EPS);
      float xv = v * rinv * gkr1;
      float other = __shfl_xor(xv, 16);
      int i = lane & 15;
      float pos = isP ? (float)(r & 4095) : (float)(8192 + (rs & 3));
      float sn, cs;
      sincos_rev(pos * ropeinv, sn, cs);
      float o = (lane & 16) ? (xv * cs + other * sn) : (xv * cs - other * sn);
      if (lane < 32) {
        float* dst = isP ? p.out + O_KRP + (size_t)r * 32 : p.out + O_KRS + (size_t)rs * 32;
        dst[lane] = o;
        bf16_t ob = f2bf(o);
        if (isP) {
          int b = r >> 12, t = r & 4095;
#pragma unroll
          for (int h = 0; h < 8; ++h) p.Kcat()[((size_t)(b * 8 + h) * 4096 + t) * 96 + 64 + lane] = ob;
        } else {
          int seq = rs >> 2, t = rs & 3;
#pragma unroll
          for (int h = 0; h < 8; ++h) p.KcatS()[((size_t)(seq * 8 + h) * 4 + t) * 96 + 64 + lane] = ob;
        }
      }
    }
  }
}

__device__ __forceinline__ void phase_gemm4(const Params& p, char* smem) {
  const int ns = 32 * 9, nq = 8 * 6, nk = 8 * 4;
  int t0 = blockIdx.x, tcnt = (ns + nq + nk - (int)blockIdx.x + (int)gridDim.x - 1) / (int)gridDim.x, tstr = gridDim.x;
  if (gridDim.x == 256) {
    if (blockIdx.x >= 192) { t0 = ((int)blockIdx.x - 192) * 3; tcnt = 3; tstr = 1; }
    else if (blockIdx.x < 176) { t0 = 192 + (int)blockIdx.x; tcnt = 1; tstr = 1; }
    else tcnt = 0;
  }
  for (int ti = 0; ti < tcnt; ++ti) {
    const int t = t0 + ti * tstr;
    if (t < ns) {
      int g = t / 9, tm = t % 9;
      float* C = p.S() + (size_t)g * NSUB * 128;
      gemm_tile<4, 2, 1, 2>(p.A2() + (size_t)g * NSUB * A2LD, A2LD, p.Emat() + (size_t)g * 128 * 256, 256, 256, tm * 128, 0, smem,
                            [=](int m, int n, float v) { C[(size_t)m * 128 + n] = v; });
    } else if (t < ns + nq) {
      int u = t - ns, tm = u / 6, tn = u % 6;
      bf16_t* C = (bf16_t*)p.Qraw();
      gemm_tile<2, 4, 1, 1>(p.CQN(), 384, p.WuqT(), 384, 384, NP + tm * 64, tn * 128, smem, [=](int m, int n, float v) { C[(size_t)m * 768 + n] = f2bf(v); });
    } else {
      int u = t - ns - nq, tm = u / 4, tn = u % 4;
      bf16_t* C = (bf16_t*)p.KNraw();
      gemm_tile<2, 4, 1, 1>(p.CKV(), 256, p.WukT(), 256, 256, NP + tm * 64, tn * 128, smem, [=](int m, int n, float v) { C[(size_t)m * 512 + n] = f2bf(v); });
    }
  }
  big_gemm(p.CQN(), p.WuqT(), NP, 768, 384, smem, pg8::EpiFn<true, StBf16>{StBf16{(bf16_t*)p.Qraw(), 768}});
  big_gemm(p.CKV(), p.WukT(), NP, 512, 256, smem, pg8::EpiFn<true, StBf16>{StBf16{(bf16_t*)p.KNraw(), 512}});
  {
    pg8::Gemm g{p.WuvT(), p.CKV(), 512, NP, 256};
    pg8::StaticOrder S;
    S.init(512, NP, (int)gridDim.x, (int)((blockIdx.x + gridDim.x / 2) % gridDim.x));
    pg8::EpiFn<true, StBf16> E{StBf16{p.VT(), NP}};
    pg8::gemm_phase<pg8::EpiFn<true, StBf16>, pg8::StaticOrder, false>((PG8_LAS unsigned char*)smem, g, S, E, nullptr);
  }
}

__device__ __forceinline__ float sum8(float v) {
  v += __shfl_xor(v, 1); v += __shfl_xor(v, 2); v += __shfl_xor(v, 4);
  return v;
}
__device__ __forceinline__ void ssm_scan_prompt(const Params& p, int job);
__device__ __forceinline__ void ssm_sample(const Params& p, int job);
__device__ __forceinline__ void phase_post2(const Params& p) {
  const int lane = tidx() & 63, gw = blockIdx.x * 8 + (tidx() >> 6), GW = gridDim.x * 8;
  if (gw < 128) { ssm_scan_prompt(p, gw); }
  for (int j = gw; j < 4096; j += GW) ssm_sample(p, j);
  if (gw < 128) return;
  const int h = lane >> 3, a8 = lane & 7;
  float gq[8], gk[8], gr[4], inv[4];
#pragma unroll
  for (int e = 0; e < 8; ++e) { gq[e] = p.g_qn[a8 * 8 + e] * QSCALE; gk[e] = p.g_kn[a8 * 8 + e]; }
#pragma unroll
  for (int e = 0; e < 4; ++e) {
    gr[e] = p.g_qr[a8 * 4 + e] * QSCALE;
    inv[e] = exp2f(-(float)((a8 & 3) * 4 + e) * (13.287712379549449f / 16.f));
  }
  if (gw - 128 >= NT) return;
  uint4 n_x, n_k; uint2 n_w;
#define P2_LOAD(R_) do { const bf16_t* q_ = (const bf16_t*)p.Qraw() + (size_t)(R_) * 768 + h * 96; const bf16_t* kn_ = (const bf16_t*)p.KNraw() + (size_t)(R_) * 512 + h * 64 + a8 * 8; \
    n_x = *(const uint4*)(q_ + a8 * 8); n_w = *(const uint2*)(q_ + 64 + a8 * 4); n_k = *(const uint4*)kn_; } while (0)
  P2_LOAD(gw - 128);
  for (int r = gw - 128; r < NT; r += GW - 128) {
    const bool isP = r < NP;
    const int rs = r - NP;
    const float pos = isP ? (float)(r & 4095) : (float)(8192 + (rs & 3));
    const float4 c_x0 = make_float4(bflo(n_x.x), bfhi(n_x.x), bflo(n_x.y), bfhi(n_x.y)), c_x1 = make_float4(bflo(n_x.z), bfhi(n_x.z), bflo(n_x.w), bfhi(n_x.w));
    const float4 c_w = make_float4(bflo(n_w.x), bfhi(n_w.x), bflo(n_w.y), bfhi(n_w.y));
    const float4 c_k0 = make_float4(bflo(n_k.x), bfhi(n_k.x), bflo(n_k.y), bfhi(n_k.y)), c_k1 = make_float4(bflo(n_k.z), bfhi(n_k.z), bflo(n_k.w), bfhi(n_k.w));
    P2_LOAD(r + GW - 128 < NT ? r + GW - 128 : r);
    float4 x0 = c_x0, x1 = c_x1;
    float ss = sum8(x0.x * x0.x + x0.y * x0.y + x0.z * x0.z + x0.w * x0.w + x1.x * x1.x + x1.y * x1.y + x1.z * x1.z + x1.w * x1.w);
    float ri = rsqrtf(ss * (1.f / 64.f) + EPS);
    bf16_t* qo = p.Qb() + ((size_t)r * 8 + h) * 96;
    *(uint4*)(qo + a8 * 8) = make_uint4(pk2(x0.x * ri * gq[0], x0.y * ri * gq[1]), pk2(x0.z * ri * gq[2], x0.w * ri * gq[3]),
                                         pk2(x1.x * ri * gq[4], x1.y * ri * gq[5]), pk2(x1.z * ri * gq[6], x1.w * ri * gq[7]));
    float4 w = c_w;
    float s2 = sum8(w.x * w.x + w.y * w.y + w.z * w.z + w.w * w.w);
    float r2 = rsqrtf(s2 * (1.f / 32.f) + EPS);
    float xv[4] = {w.x * r2 * gr[0], w.y * r2 * gr[1], w.z * r2 * gr[2], w.w * r2 * gr[3]};
    float ov[4];
#pragma unroll
    for (int e = 0; e < 4; ++e) {
      float other = __shfl_xor(xv[e], 4);
      float sn, cs;
      sincos_rev(pos * inv[e], sn, cs);
      ov[e] = (a8 & 4) ? (xv[e] * cs + other * sn) : (xv[e] * cs - other * sn);
    }
    *(uint2*)(qo + 64 + a8 * 4) = make_uint2(pk2(ov[0], ov[1]), pk2(ov[2], ov[3]));
    float4 k0 = c_k0, k1 = c_k1;
    float ks = sum8(k0.x * k0.x + k0.y * k0.y + k0.z * k0.z + k0.w * k0.w + k1.x * k1.x + k1.y * k1.y + k1.z * k1.z + k1.w * k1.w);
    float kri = rsqrtf(ks * (1.f / 64.f) + EPS);
    bf16_t* ko = isP ? p.Kcat() + ((size_t)((r >> 12) * 8 + h) * 4096 + (r & 4095)) * 96 : p.KcatS() + ((size_t)((rs >> 2) * 8 + h) * 4 + (rs & 3)) * 96;
    *(uint4*)(ko + a8 * 8) = make_uint4(pk2(k0.x * kri * gk[0], k0.y * kri * gk[1]), pk2(k0.z * kri * gk[2], k0.w * kri * gk[3]),
                                         pk2(k1.x * kri * gk[4], k1.y * kri * gk[5]), pk2(k1.z * kri * gk[6], k1.w * kri * gk[7]));
  }
}

__device__ __forceinline__ float softmax_bound(const Params& p) {
  const int lane = tidx() & 63;
  float a = fabsf(p.g_qn[lane]), b = fabsf(p.g_kn[lane]), c = fabsf(p.g_qr[lane & 31]), d = fabsf(p.g_kr[lane & 31]);
#pragma unroll
  for (int o = 32; o >= 1; o >>= 1) {
    a = fmaxf(a, __shfl_xor(a, o)); b = fmaxf(b, __shfl_xor(b, o));
    c = fmaxf(c, __shfl_xor(c, o)); d = fmaxf(d, __shfl_xor(d, o));
  }
  return QSCALE * (64.f * a * b + 32.f * c * d);
}

#define KLD 104
#define VLD 68
__device__ __forceinline__ void attn_prompt_block(const Params& p, char* smem, int b, int h, int qi, float Mb) {
  bf16_t* Ks = (bf16_t*)smem;
  bf16_t* Vs = Ks + 2 * 64 * KLD;
  const int tid = tidx(), lane = tid & 63, wave = tid >> 6, lr = lane & 31, hh = lane >> 5;
  const int q0 = qi * 256 + wave * 32;
  const bf16_t* Kg = p.Kcat() + (size_t)(b * 8 + h) * 4096 * 96;
  const bf16_t* Vg = p.VT() + (size_t)(h * 64) * NP + b * 4096;
  bf16x8 qf[6];
  {
    const bf16_t* qp = p.Qb() + ((size_t)(b * 4096 + q0 + lr) * 8 + h) * 96 + hh * 8;
#pragma unroll
    for (int s = 0; s < 6; ++s) qf[s] = *(const bf16x8*)(qp + s * 16);
  }
  f32x16 ot[2];
#pragma unroll
  for (int i = 0; i < 2; ++i)
#pragma unroll
    for (int r = 0; r < 16; ++r) ot[i][r] = 0.f;
  float lsum = 0.f;
  const int nkt = 4 * (qi + 1);
  uint4 kA0, kA1, kB0, kB1;
  uint2 vA0, vA1, vB0, vB1;
#define PA_GLOAD(kt_, k0r, k1r, v0r, v1r) do { const int k0_ = ((kt_) < nkt ? (kt_) : nkt - 1) * 64; \
    { int c = tid; int row = c / 12, cc = c % 12; k0r = *(const uint4*)(Kg + (size_t)(k0_ + row) * 96 + cc * 8); } \
    { int c = tid + NTHR; c = c < 768 ? c : 767; int row = c / 12, cc = c % 12; k1r = *(const uint4*)(Kg + (size_t)(k0_ + row) * 96 + cc * 8); } \
    { int c = tid, row = c >> 4, cc = c & 15; v0r = *(const uint2*)(Vg + (size_t)row * NP + k0_ + cc * 4); } \
    { int c = tid + NTHR, row = c >> 4, cc = c & 15; v1r = *(const uint2*)(Vg + (size_t)row * NP + k0_ + cc * 4); } } while (0)
#define PA_LSTORE(buf_, k0r, k1r, v0r, v1r) do { \
    { int c = tid; int row = c / 12, cc = c % 12; *(uint4*)(Ks + ((buf_) * 64 + row) * KLD + cc * 8) = k0r; } \
    { int c = tid + NTHR; if (c < 768) { int row = c / 12, cc = c % 12; *(uint4*)(Ks + ((buf_) * 64 + row) * KLD + cc * 8) = k1r; } } \
    { int c = tid, row = c >> 4, cc = c & 15; *(uint2*)(Vs + ((buf_) * 64 + row) * VLD + cc * 4) = v0r; } \
    { int c = tid + NTHR, row = c >> 4, cc = c & 15; *(uint2*)(Vs + ((buf_) * 64 + row) * VLD + cc * 4) = v1r; } } while (0)
  auto compute = [&](int kt, int buf) __attribute__((always_inline)) {
    const int k0 = kt * 64;
    if (k0 <= q0 + 31) {
      const bool need_mask = (k0 + 63 > q0);
      bf16x8 pb[2][2];
#pragma unroll
      for (int kt2 = 0; kt2 < 2; ++kt2) {
        f32x16 st;
#pragma unroll
        for (int r = 0; r < 16; ++r) st[r] = -Mb;
#pragma unroll
        for (int s = 0; s < 6; ++s) {
          bf16x8 a = *(const bf16x8*)(Ks + (buf * 64 + kt2 * 32 + lr) * KLD + s * 16 + hh * 8);
          st = mfma32(a, qf[s], st);
        }
        float pv[16];
#pragma unroll
        for (int r = 0; r < 16; ++r) {
          float e = __builtin_amdgcn_exp2f(st[r]);
          if (need_mask) {
            int key = k0 + kt2 * 32 + (r & 3) + 8 * (r >> 2) + 4 * hh;
            e = (key <= q0 + lr) ? e : 0.f;
          }
          pv[r] = e;
          lsum += e;
        }
#pragma unroll
        for (int s2 = 0; s2 < 2; ++s2)
          pb[kt2][s2] = mk8(pk2(pv[8 * s2 + 0], pv[8 * s2 + 1]), pk2(pv[8 * s2 + 2], pv[8 * s2 + 3]),
                            pk2(pv[8 * s2 + 4], pv[8 * s2 + 5]), pk2(pv[8 * s2 + 6], pv[8 * s2 + 7]));
      }
#pragma unroll
      for (int dt = 0; dt < 2; ++dt)
#pragma unroll
        for (int kt2 = 0; kt2 < 2; ++kt2)
#pragma unroll
          for (int s2 = 0; s2 < 2; ++s2) {
            const bf16_t* vp = Vs + (buf * 64 + dt * 32 + lr) * VLD + kt2 * 32 + 16 * s2 + 4 * hh;
            uint2 lo = *(const uint2*)vp, hi = *(const uint2*)(vp + 8);
            bf16x8 a = mk8(lo.x, lo.y, hi.x, hi.y);
            ot[dt] = mfma32(a, pb[kt2][s2], ot[dt]);
          }
    }
  };
  PA_GLOAD(0, kA0, kA1, vA0, vA1);
  PA_GLOAD(1, kB0, kB1, vB0, vB1);
  PA_LSTORE(0, kA0, kA1, vA0, vA1);
  PA_GLOAD(2, kA0, kA1, vA0, vA1);
  __syncthreads();
#pragma unroll 1
  for (int kt = 0; kt < nkt; kt += 2) {
    compute(kt, 0);
    PA_LSTORE(1, kB0, kB1, vB0, vB1);
    PA_GLOAD(kt + 3, kB0, kB1, vB0, vB1);
    __syncthreads();
    compute(kt + 1, 1);
    PA_LSTORE(0, kA0, kA1, vA0, vA1);
    PA_GLOAD(kt + 4, kA0, kA1, vA0, vA1);
    __syncthreads();
  }
  lsum += __shfl_xor(lsum, 32);
  const float linv = 1.f / lsum;
  bf16_t* op = p.CAT() + (size_t)(b * 4096 + q0 + lr) * 1024 + 512 + h * 64;
#pragma unroll
  for (int dt = 0; dt < 2; ++dt)
#pragma unroll
    for (int rg = 0; rg < 4; ++rg) {
      int d = dt * 32 + 8 * rg + 4 * hh;
      *(uint2*)(op + d) = make_uint2(pk2(ot[dt][4 * rg] * linv, ot[dt][4 * rg + 1] * linv), pk2(ot[dt][4 * rg + 2] * linv, ot[dt][4 * rg + 3] * linv));
    }
}

#define LLD 264
#define L8LD 272
#define KRLD 40
#define PLD 72
#define DEC_TILE_BYTES (64 * LLD * 2 + 64 * L8LD + 64 * KRLD * 2 + 256)
typedef __attribute__((ext_vector_type(8))) int i32x8;
__device__ __forceinline__ f32x16 mfma8(i32x8 a, i32x8 b, f32x16 c) {
  return __builtin_amdgcn_mfma_scale_f32_32x32x64_f8f6f4(a, b, c, 0, 0, 0, 127, 0, 127);
}
__device__ __forceinline__ void attn_decode_unit(const Params& p, char* smem, int seq, int half, float Mb) {
  const int tid = tidx(), lane = tid & 63, wave = tid >> 6, lr = lane & 31, hh = lane >> 5;
  const int hd = wave;
  bf16_t* Psh = (bf16_t*)(smem + 2 * DEC_TILE_BYTES);
  bf16_t* Qs = Psh + 32 * PLD;
  for (int i = tid; i < 8 * 4 * 96; i += NTHR) {
    int h2 = i / 384, rem = i % 384, t = rem / 96, e = rem % 96;
    const bf16_t* qp = p.Qb() + ((size_t)(NP + seq * 4 + t) * 8 + h2) * 96;
    bf16_t val;
    if (e < 64) {
      int j = e & 7, hx = (e >> 3) & 1, sp = (e >> 4) & 1, dt = e >> 5;
      int d = 32 * dt + 16 * sp + 8 * (j >> 2) + 4 * hx + (j & 3);
      val = f2bf(bf2f(qp[d]) * p.g_kn[d]);
    } else val = qp[e];
    Qs[i] = val;
  }
  i32x8 wf8[2][4];
#pragma unroll
  for (int mt = 0; mt < 2; ++mt)
#pragma unroll
    for (int ks = 0; ks < 4; ++ks) {
      const unsigned char* wp = p.W8T() + (size_t)(hd * 64 + mt * 32 + lr) * 256 + ks * 64 + hh * 32;
      uint4 a = *(const uint4*)wp, b = *(const uint4*)(wp + 16);
      wf8[mt][ks][0] = a.x; wf8[mt][ks][1] = a.y; wf8[mt][ks][2] = a.z; wf8[mt][ks][3] = a.w;
      wf8[mt][ks][4] = b.x; wf8[mt][ks][5] = b.y; wf8[mt][ks][6] = b.z; wf8[mt][ks][7] = b.w;
    }
  const float eps_w = EPS * 256.f * __uint_as_float((unsigned)(2 * p.KW()[hd] + 127) << 23);
  f32x16 oacc;
#pragma unroll
  for (int r = 0; r < 16; ++r) oacc[r] = 0.f;
  float lsum[4] = {0.f, 0.f, 0.f, 0.f};
  float4 rlA[8], rkA;
  auto gload = [&](int i, float4 (&rl)[8], float4& rk) {
    int page = p.page_table[seq * 64 + half * 32 + (i >> 1)];
    const float* lp = p.cache_lat + ((size_t)page * 128 + (i & 1) * 64) * 256;
    const float* kp = p.cache_kr + ((size_t)page * 128 + (i & 1) * 64) * 32;
#pragma unroll
    for (int j = 0; j < 8; ++j) rl[j] = ((const float4*)lp)[tid + NTHR * j];
    rk = ((const float4*)kp)[tid];
  };
  int olane = lane, otid = tid;
  auto lstore = [&](char* tb, const float4 (&rl)[8], const float4& rk) {
    const int lane = olane, tid = otid, wave = otid >> 6;
    bf16_t* latB = (bf16_t*)tb;
    unsigned char* lat8 = (unsigned char*)(tb + 64 * LLD * 2);
    bf16_t* krB = (bf16_t*)(tb + 64 * LLD * 2 + 64 * L8LD);
#pragma unroll
    for (int j = 0; j < 8; ++j) {
      const int row = wave + 8 * j;
      float4 v = rl[j];
      int pk = 0;
      pk = __builtin_amdgcn_cvt_pk_fp8_f32(__builtin_amdgcn_fmed3f(v.x * 16.f, -448.f, 448.f), __builtin_amdgcn_fmed3f(v.y * 16.f, -448.f, 448.f), pk, false);
      pk = __builtin_amdgcn_cvt_pk_fp8_f32(__builtin_amdgcn_fmed3f(v.z * 16.f, -448.f, 448.f), __builtin_amdgcn_fmed3f(v.w * 16.f, -448.f, 448.f), pk, true);
      *(unsigned*)(lat8 + row * L8LD + lane * 4) = (unsigned)pk;
      *(uint2*)(latB + row * LLD + lane * 4) = make_uint2(pk2(v.x, v.y), pk2(v.z, v.w));
    }
    int row = tid >> 3, c4 = tid & 7;
    *(uint2*)(krB + row * KRLD + c4 * 4) = make_uint2(pk2(rk.x, rk.y), pk2(rk.z, rk.w));
  };
  auto lstore_new = [&](char* tb) {
    const int lane = olane, tid = otid, wave = otid >> 6;
    bf16_t* latB = (bf16_t*)tb;
    unsigned char* lat8 = (unsigned char*)(tb + 64 * LLD * 2);
    bf16_t* krB = (bf16_t*)(tb + 64 * LLD * 2 + 64 * L8LD);
#pragma unroll
    for (int j = 0; j < 8; ++j) {
      const int row = wave + 8 * j;
      uint2 v = make_uint2(0, 0);
      if (row < 4) v = *(const uint2*)(p.CKV() + (size_t)(NP + seq * 4 + row) * 256 + lane * 4);
      float f0 = bflo(v.x), f1 = bfhi(v.x), f2 = bflo(v.y), f3 = bfhi(v.y);
      int pk = 0;
      pk = __builtin_amdgcn_cvt_pk_fp8_f32(__builtin_amdgcn_fmed3f(f0 * 16.f, -448.f, 448.f), __builtin_amdgcn_fmed3f(f1 * 16.f, -448.f, 448.f), pk, false);
      pk = __builtin_amdgcn_cvt_pk_fp8_f32(__builtin_amdgcn_fmed3f(f2 * 16.f, -448.f, 448.f), __builtin_amdgcn_fmed3f(f3 * 16.f, -448.f, 448.f), pk, true);
      *(unsigned*)(lat8 + row * L8LD + lane * 4) = (unsigned)pk;
      *(uint2*)(latB + row * LLD + lane * 4) = v;
    }
    int row = tid >> 3, c4 = tid & 7;
    uint2 v = make_uint2(0, 0);
    if (row < 4) v = *(const uint2*)(p.KcatS() + ((size_t)(seq * 8) * 4 + row) * 96 + 64 + c4 * 4);
    *(uint2*)(krB + row * KRLD + c4 * 4) = v;
  };
  auto compute = [&](char* tb, bool isnew) {
    const int lane = olane, wave = otid >> 6, lr = olane & 31, hh = olane >> 5, hd = otid >> 6;
    const bf16_t* latB = (const bf16_t*)tb;
    const unsigned char* lat8 = (const unsigned char*)(tb + 64 * LLD * 2);
    const bf16_t* krB = (const bf16_t*)(tb + 64 * LLD * 2 + 64 * L8LD);
#pragma unroll 1
    for (int kt2 = 0; kt2 < 2; ++kt2) {
      float ss = 0.f;
      f32x16 s1;
#pragma unroll
      for (int r = 0; r < 16; ++r) s1[r] = 0.f;
      const unsigned char* bp = lat8 + (kt2 * 32 + lr) * L8LD + hh * 32;
#pragma unroll
      for (int mt = 0; mt < 2; ++mt) {
        f32x16 acc;
#pragma unroll
        for (int r = 0; r < 16; ++r) acc[r] = 0.f;
#pragma unroll
        for (int ks = 0; ks < 4; ++ks) {
          uint4 a = *(const uint4*)(bp + ks * 64), b = *(const uint4*)(bp + ks * 64 + 16);
          i32x8 bv;
          bv[0] = a.x; bv[1] = a.y; bv[2] = a.z; bv[3] = a.w; bv[4] = b.x; bv[5] = b.y; bv[6] = b.z; bv[7] = b.w;
          acc = mfma8(wf8[mt][ks], bv, acc);
        }
#pragma unroll
        for (int r = 0; r < 16; ++r) ss += acc[r] * acc[r];
#pragma unroll
        for (int sp = 0; sp < 2; ++sp) {
          bf16x8 bk = mk8(pk2(acc[8 * sp + 0], acc[8 * sp + 1]), pk2(acc[8 * sp + 2], acc[8 * sp + 3]),
                          pk2(acc[8 * sp + 4], acc[8 * sp + 5]), pk2(acc[8 * sp + 6], acc[8 * sp + 7]));
          uint4 qa = make_uint4(0, 0, 0, 0);
          if (lr < 4) qa = *(const uint4*)(Qs + (hd * 4 + lr) * 96 + ((mt * 2 + sp) * 2 + hh) * 8);
          s1 = mfma32(__builtin_bit_cast(bf16x8, qa), bk, s1);
        }
      }
      ss += __shfl_xor(ss, 32);
      const float rinv = rsqrtf(ss * (1.f / 64.f) + eps_w);
      float s1v[4] = {s1[0] * rinv, s1[1] * rinv, s1[2] * rinv, s1[3] * rinv};
      f32x16 s2;
#pragma unroll
      for (int r = 0; r < 16; ++r) s2[r] = 0.f;
#pragma unroll
      for (int s = 0; s < 2; ++s) {
        bf16x8 bk = *(const bf16x8*)(krB + (kt2 * 32 + lr) * KRLD + s * 16 + hh * 8);
        uint4 qa = make_uint4(0, 0, 0, 0);
        if (lr < 4) qa = *(const uint4*)(Qs + (hd * 4 + lr) * 96 + 64 + s * 16 + hh * 8);
        s2 = mfma32(__builtin_bit_cast(bf16x8, qa), bk, s2);
      }
      if (hh == 0) {
        const int kk = kt2 * 32 + lr;
#pragma unroll
        for (int t = 0; t < 4; ++t) {
          float e = __builtin_amdgcn_exp2f(s1v[t] + s2[t] - Mb);
          if (isnew) e = (kk < 4 && kk <= t) ? e : 0.f;
          lsum[t] += e;
          Psh[(hd * 4 + t) * PLD + kk] = f2bf(e);
        }
      }
    }
    __syncthreads();
    {
      const int n0 = wave * 32;
#pragma unroll
      for (int ks = 0; ks < 4; ++ks) {
        bf16x8 a = *(const bf16x8*)(Psh + lr * PLD + ks * 16 + hh * 8);
        const int key0 = ks * 16 + 8 * hh, c0 = n0 + 16 * ((lane >> 4) & 1);
        const int q = (lane & 15) >> 2, pp = lane & 3;
        const bf16_t* ap = latB + (key0 + q) * LLD + c0 + 4 * pp;
        s16x4 lo = __builtin_amdgcn_ds_read_tr16_b64_v4i16((__attribute__((address_space(3))) s16x4*)(ap));
        s16x4 hi = __builtin_amdgcn_ds_read_tr16_b64_v4i16((__attribute__((address_space(3))) s16x4*)(ap + 4 * LLD));
        bf16x8 bfr;
        bfr[0] = lo[0]; bfr[1] = lo[1]; bfr[2] = lo[2]; bfr[3] = lo[3];
        bfr[4] = hi[0]; bfr[5] = hi[1]; bfr[6] = hi[2]; bfr[7] = hi[3];
        oacc = mfma32(a, bfr, oacc);
      }
    }
  };
  gload(0, rlA, rkA);
  const int ntile = 64 + half;
#pragma unroll 1
  for (int i = 0; i < ntile; ++i) {
    char* tb = smem + (i & 1) * DEC_TILE_BYTES;
    asm volatile("" : "+v"(olane), "+v"(otid));
    if (i < 64) lstore(tb, rlA, rkA); else lstore_new(tb);
    if (i + 1 < 64) gload(i + 1, rlA, rkA);
    __syncthreads();
    compute(tb, i == 64);
  }
  float* Op = p.Opart() + ((size_t)(seq * 2 + half) * 32) * 256;
#pragma unroll
  for (int r = 0; r < 16; ++r) {
    int m = (r & 3) + 8 * (r >> 2) + 4 * hh;
    Op[(size_t)m * 256 + wave * 32 + lr] = oacc[r];
  }
#pragma unroll
  for (int t = 0; t < 4; ++t) {
    float v = (hh == 0) ? lsum[t] : 0.f;
    v = wave_sum(v);
    if (lane == 0) p.Lpart()[(seq * 2 + half) * 32 + hd * 4 + t] = v;
  }
  __syncthreads();
}

typedef unsigned lds_u4 __attribute__((ext_vector_type(4)));
typedef unsigned lds_u2 __attribute__((ext_vector_type(2)));
typedef float lds_f4 __attribute__((ext_vector_type(4)));
__device__ __forceinline__ uint4 ldl_u4(const LAS void* p) { lds_u4 v = *(const LAS lds_u4*)p; return make_uint4(v.x, v.y, v.z, v.w); }
__device__ __forceinline__ float4 ldl_f4(const LAS void* p) { lds_f4 v = *(const LAS lds_f4*)p; return make_float4(v.x, v.y, v.z, v.w); }
__device__ __forceinline__ void stl_u2(LAS void* p, unsigned a, unsigned b) { lds_u2 v = {a, b}; *(LAS lds_u2*)p = v; }
__device__ __forceinline__ void stl_u4(LAS void* p, uint4 a) { lds_u4 v = {a.x, a.y, a.z, a.w}; *(LAS lds_u4*)p = v; }
#define D_STAGE 36864
#define D_TB (3 * D_STAGE)
#define D_LAT8 (32 * LLD * 2)
#define D_KRB (D_LAT8 + 32 * L8LD)
#define D_TBSZ (D_KRB + 32 * KRLD * 2)
#define D_PLD 40
#define D_PSH (D_TB + D_TBSZ)
#define D_QS (D_PSH + 32 * D_PLD * 2)
#define D_END (D_QS + 8 * 4 * 96 * 2)
__device__ __forceinline__ void bar_lds() { asm volatile("s_waitcnt lgkmcnt(0)\n\ts_barrier" ::: "memory"); }
__device__ __forceinline__ void attn_decode_unit_dma(const Params& p, char* smem_generic, int seq, int half, float Mb) {
  LAS char* const smem = (LAS char*)smem_generic;
  const int tid = tidx(), lane = tid & 63, wave = tid >> 6, lr = lane & 31, hh = lane >> 5;
  const int hd = wave;
  LAS bf16_t* Psh = (LAS bf16_t*)(smem + D_PSH);
  LAS bf16_t* Qs = (LAS bf16_t*)(smem + D_QS);
  for (int i = tid; i < 8 * 4 * 96; i += NTHR) {
    int h2 = i / 384, rem = i % 384, t = rem / 96, e = rem % 96;
    const bf16_t* qp = p.Qb() + ((size_t)(NP + seq * 4 + t) * 8 + h2) * 96;
    bf16_t val;
    if (e < 64) {
      int j = e & 7, hx = (e >> 3) & 1, sp = (e >> 4) & 1, dt = e >> 5;
      int d = 32 * dt + 16 * sp + 8 * (j >> 2) + 4 * hx + (j & 3);
      val = f2bf(bf2f(qp[d]) * p.g_kn[d]);
    } else val = qp[e];
    Qs[i] = val;
  }
  i32x8 wf8[2][4];
#pragma unroll
  for (int mt = 0; mt < 2; ++mt)
#pragma unroll
    for (int ks = 0; ks < 4; ++ks) {
      const unsigned char* wp = p.W8T() + (size_t)(hd * 64 + mt * 32 + lr) * 256 + ks * 64 + hh * 32;
      uint4 a = *(const uint4*)wp, b = *(const uint4*)(wp + 16);
      wf8[mt][ks][0] = a.x; wf8[mt][ks][1] = a.y; wf8[mt][ks][2] = a.z; wf8[mt][ks][3] = a.w;
      wf8[mt][ks][4] = b.x; wf8[mt][ks][5] = b.y; wf8[mt][ks][6] = b.z; wf8[mt][ks][7] = b.w;
    }
  const float eps_w = EPS * __uint_as_float((unsigned)(2 * p.KW()[hd] + 127) << 23);
  const int ptv = p.page_table[seq * 64 + half * 32 + lr];
  f32x16 oacc;
#pragma unroll
  for (int r = 0; r < 16; ++r) oacc[r] = 0.f;
  float lsum[4] = {0.f, 0.f, 0.f, 0.f};
  constexpr int ntile = 128;
  asm volatile("s_waitcnt vmcnt(0)" ::: "memory");
  __syncthreads();
#define DD_ISSUE(t_, SLOT) do { \
    const int tt_ = (t_) < ntile ? (t_) : ntile - 1; \
    const int page_ = __builtin_amdgcn_readlane(ptv, tt_ >> 2); \
    const char* g_ = (const char*)(p.cache_lat + ((size_t)page_ * 128 + (tt_ & 3) * 32) * 256) + lane * 16; \
    LAS char* st_ = smem + (SLOT) * D_STAGE; \
    _Pragma("unroll") for (int j = 0; j < 4; ++j) { const int row = wave + 8 * j; \
      __builtin_amdgcn_global_load_lds((const unsigned*)(g_ + row * 1024), (LAS unsigned*)(st_ + row * 1024), 16, 0, 0); } \
    if (wave < 4) {     \
      const char* gk_ = (const char*)(p.cache_kr + ((size_t)page_ * 128 + (tt_ & 3) * 32) * 32) + wave * 1024 + lane * 16; \
      __builtin_amdgcn_global_load_lds((const unsigned*)gk_, (LAS unsigned*)(st_ + 32768 + wave * 1024), 16, 0, 0); } } while (0)
  const LAS bf16_t* latB = (const LAS bf16_t*)(smem + D_TB);
  const LAS unsigned char* lat8 = (const LAS unsigned char*)(smem + D_TB + D_LAT8);
  const LAS bf16_t* krB = (const LAS bf16_t*)(smem + D_TB + D_KRB);
  auto computeB = [&](bool isnew) __attribute__((always_inline)) {
#ifdef PROBE_DECB2
    for (int prep_ = 0; prep_ < 2; ++prep_)
#endif
    {
      f32x16 s2;
#pragma unroll
      for (int r = 0; r < 16; ++r) s2[r] = 0.f;
#pragma unroll
      for (int s = 0; s < 2; ++s) {
        bf16x8 bk = *(const LAS bf16x8*)(krB + lr * KRLD + s * 16 + hh * 8);
        uint4 qa = make_uint4(0, 0, 0, 0);
        if (lr < 4) qa = ldl_u4(Qs + (hd * 4 + lr) * 96 + 64 + s * 16 + hh * 8);
        s2 = mfma32(__builtin_bit_cast(bf16x8, qa), bk, s2);
      }
      const LAS unsigned char* bp = lat8 + lr * L8LD + hh * 32;
      f32x16 acc0, acc1;
#pragma unroll
      for (int r = 0; r < 16; ++r) { acc0[r] = 0.f; acc1[r] = 0.f; }
#pragma unroll
      for (int ks = 0; ks < 4; ++ks) {
        uint4 a = ldl_u4(bp + ks * 64), b = ldl_u4(bp + ks * 64 + 16);
        i32x8 bv;
        bv[0] = a.x; bv[1] = a.y; bv[2] = a.z; bv[3] = a.w; bv[4] = b.x; bv[5] = b.y; bv[6] = b.z; bv[7] = b.w;
        acc0 = mfma8(wf8[0][ks], bv, acc0);
        acc1 = mfma8(wf8[1][ks], bv, acc1);
      }
      uint4 qn[4];
#pragma unroll
      for (int f = 0; f < 4; ++f) {
        qn[f] = make_uint4(0, 0, 0, 0);
        if (lr < 4) qn[f] = ldl_u4(Qs + (hd * 4 + lr) * 96 + (f * 2 + hh) * 8);
      }
      float ss = 0.f;
      f32x16 s1;
#pragma unroll
      for (int r = 0; r < 16; ++r) s1[r] = 0.f;
#pragma unroll
      for (int r = 0; r < 16; ++r) ss += acc0[r] * acc0[r];
#pragma unroll
      for (int sp = 0; sp < 2; ++sp) {
        bf16x8 bk = mk8(pk2(acc0[8 * sp + 0], acc0[8 * sp + 1]), pk2(acc0[8 * sp + 2], acc0[8 * sp + 3]),
                        pk2(acc0[8 * sp + 4], acc0[8 * sp + 5]), pk2(acc0[8 * sp + 6], acc0[8 * sp + 7]));
        s1 = mfma32(__builtin_bit_cast(bf16x8, qn[sp]), bk, s1);
      }
#pragma unroll
      for (int r = 0; r < 16; ++r) ss += acc1[r] * acc1[r];
#pragma unroll
      for (int sp = 0; sp < 2; ++sp) {
        bf16x8 bk = mk8(pk2(acc1[8 * sp + 0], acc1[8 * sp + 1]), pk2(acc1[8 * sp + 2], acc1[8 * sp + 3]),
                        pk2(acc1[8 * sp + 4], acc1[8 * sp + 5]), pk2(acc1[8 * sp + 6], acc1[8 * sp + 7]));
        s1 = mfma32(__builtin_bit_cast(bf16x8, qn[2 + sp]), bk, s1);
      }
      ss += __shfl_xor(ss, 32);
      const float rinv = rsqrtf(ss * (1.f / 64.f) + eps_w);
      if (hh == 0) {
#pragma unroll
        for (int t = 0; t < 4; ++t) {
          float e = __builtin_amdgcn_exp2f(s1[t] * rinv + (s2[t] - Mb));
          if (isnew) e = (lr < 4 && lr <= t) ? e : 0.f;
#ifdef PROBE_DECB2
          if (prep_ == 0)
#endif
          lsum[t] += e;
          Psh[(hd * 4 + t) * D_PLD + lr] = f2bf(e);
        }
      }
    }
  };
  auto computeC = [&]() __attribute__((always_inline)) {
    {
      const int n0 = wave * 32;
      const int key0 = 8 * hh, c0 = n0 + 16 * ((lane >> 4) & 1);
      const int q = (lane & 15) >> 2, pp = lane & 3;
      const LAS bf16_t* ap = latB + (key0 + q) * LLD + c0 + 4 * pp;
      const LAS bf16_t* pa = Psh + lr * D_PLD + hh * 8;
      lds_u2 lo0, hi0, lo1, hi1;
      lds_u4 a0v, a1v;
      static_assert(4 * LLD * 2 == 2112 && 16 * LLD * 2 == 8448, "offsets of the transposed reads");
      asm volatile("ds_read_b128 %4, %7\n\tds_read_b128 %5, %7 offset:32\n\t"
                   "ds_read_b64_tr_b16 %0, %6\n\tds_read_b64_tr_b16 %1, %6 offset:2112\n\t"
                   "ds_read_b64_tr_b16 %2, %6 offset:8448\n\tds_read_b64_tr_b16 %3, %6 offset:10560\n\ts_waitcnt lgkmcnt(0)"
                   : "=&v"(lo0), "=&v"(hi0), "=&v"(lo1), "=&v"(hi1), "=&v"(a0v), "=&v"(a1v)
                   : "v"((unsigned)(__UINTPTR_TYPE__)ap), "v"((unsigned)(__UINTPTR_TYPE__)pa) : "memory");
      oacc = mfma32(__builtin_bit_cast(bf16x8, a0v), mk8(lo0.x, lo0.y, hi0.x, hi0.y), oacc);
      oacc = mfma32(__builtin_bit_cast(bf16x8, a1v), mk8(lo1.x, lo1.y, hi1.x, hi1.y), oacc);
    }
  };
#define DD_STEP(t_, SLOT) do { \
    if (wave < 4) asm volatile("s_waitcnt vmcnt(10)" ::: "memory");     \
    else asm volatile("s_waitcnt vmcnt(8)" ::: "memory"); \
    bar_lds();                                              \
    { const LAS char* st = smem + (SLOT) * D_STAGE; \
      LAS bf16_t* latB = (LAS bf16_t*)(smem + D_TB); \
      LAS unsigned char* lat8 = (LAS unsigned char*)(smem + D_TB + D_LAT8); \
      LAS bf16_t* krB = (LAS bf16_t*)(smem + D_TB + D_KRB); \
      float4 cv_[4], ck_ = make_float4(0.f, 0.f, 0.f, 0.f); \
      _Pragma("unroll") for (int j = 0; j < 4; ++j) cv_[j] = ldl_f4(st + (wave + 8 * j) * 1024 + lane * 16);     \
      if (tid < 256) ck_ = ldl_f4(st + 32768 + tid * 16); \
      _Pragma("unroll") for (int j = 0; j < 4; ++j) { \
        const int row = wave + 8 * j; \
        const float4 v = cv_[j]; \
        int pk = 0; \
        pk = __builtin_amdgcn_cvt_pk_fp8_f32(v.x, v.y, pk, false); \
        pk = __builtin_amdgcn_cvt_pk_fp8_f32(v.z, v.w, pk, true); \
        *(LAS unsigned*)(lat8 + row * L8LD + lane * 4) = (unsigned)pk; \
        stl_u2(latB + row * LLD + lane * 4, pk2(v.x, v.y), pk2(v.z, v.w)); } \
      if (tid < 256) stl_u2(krB + (tid >> 3) * KRLD + (tid & 7) * 4, pk2(ck_.x, ck_.y), pk2(ck_.z, ck_.w)); } \
    bar_lds();                                              \
      \
      \
    if (wave < 4) DD_ISSUE((t_) + 3, SLOT); \
    computeB(false); \
    if (wave >= 4) DD_ISSUE((t_) + 3, SLOT); \
    bar_lds(); \
    computeC(); } while (0)
  DD_ISSUE(0, 0);
  DD_ISSUE(1, 1);
  DD_ISSUE(2, 2);
#pragma unroll 1
  for (int t = 0; t < 126; t += 3) { DD_STEP(t, 0); DD_STEP(t + 1, 1); DD_STEP(t + 2, 2); }
  DD_STEP(126, 0);
  DD_STEP(127, 1);
  asm volatile("s_waitcnt vmcnt(0)" ::: "memory");
  bar_lds();
  if (half) {
    LAS bf16_t* latB = (LAS bf16_t*)(smem + D_TB);
    LAS unsigned char* lat8 = (LAS unsigned char*)(smem + D_TB + D_LAT8);
    LAS bf16_t* krB = (LAS bf16_t*)(smem + D_TB + D_KRB);
#pragma unroll
    for (int j = 0; j < 4; ++j) {
      const int row = wave + 8 * j;
      uint2 v = make_uint2(0, 0);
      if (row < 4) v = *(const uint2*)(p.CKV() + (size_t)(NP + seq * 4 + row) * 256 + lane * 4);
      float f0 = bflo(v.x), f1 = bfhi(v.x), f2 = bflo(v.y), f3 = bfhi(v.y);
      int pk = 0;
      pk = __builtin_amdgcn_cvt_pk_fp8_f32(f0, f1, pk, false);
      pk = __builtin_amdgcn_cvt_pk_fp8_f32(f2, f3, pk, true);
      *(LAS unsigned*)(lat8 + row * L8LD + lane * 4) = (unsigned)pk;
      stl_u2(latB + row * LLD + lane * 4, v.x, v.y);
    }
    if (tid < 256) {
      const int row = tid >> 3, c4 = tid & 7;
      uint2 v = make_uint2(0, 0);
      if (row < 4) v = *(const uint2*)(p.KcatS() + ((size_t)(seq * 8) * 4 + row) * 96 + 64 + c4 * 4);
      stl_u2(krB + row * KRLD + c4 * 4, v.x, v.y);
    }
    __syncthreads();
    computeB(true);
    bar_lds();
    computeC();
  }
  float* Op = p.Opart() + ((size_t)(seq * 2 + half) * 32) * 256;
#pragma unroll
  for (int r = 0; r < 16; ++r) {
    int m = (r & 3) + 8 * (r >> 2) + 4 * hh;
    Op[(size_t)m * 256 + wave * 32 + lr] = oacc[r];
  }
#pragma unroll
  for (int t = 0; t < 4; ++t) {
    float v = (hh == 0) ? lsum[t] : 0.f;
    v = wave_sum(v);
    if (lane == 0) p.Lpart()[(seq * 2 + half) * 32 + hd * 4 + t] = v;
  }
  __syncthreads();
}

__device__ __forceinline__ void ssm_scan_prompt(const Params& p, int job) {
  const int lane = tidx() & 63;
  const int b = job >> 5, g = job & 31;
  const float dt = __expf(p.log_dt[g]);
  const Cplx a16 = apow(p.a_re[g * 64 + lane], p.a_im[g * 64 + lane], dt, 16.f);
  Cplx H = {0.f, 0.f};
  const float* S = p.S() + ((size_t)g * NSUB + b * 256) * 128;
  bf16_t* A2 = p.A2() + ((size_t)g * NSUB + b * 256) * A2LD + 256;
  for (int n0 = 0; n0 < 256; n0 += 32) {
    float sr[32], si[32];
#pragma unroll
    for (int k = 0; k < 32; ++k) { sr[k] = S[(size_t)(n0 + k) * 128 + lane]; si[k] = S[(size_t)(n0 + k) * 128 + 64 + lane]; }
#pragma unroll
    for (int k = 0; k < 32; ++k) {
      A2[(size_t)(n0 + k) * A2LD + lane] = f2bf(H.re);
      A2[(size_t)(n0 + k) * A2LD + 64 + lane] = f2bf(H.im);
      Cplx t = cmul(a16, H);
      H.re = t.re + sr[k]; H.im = t.im + si[k];
    }
  }
  float* o = p.out + O_SSMP + ((size_t)(b * 32 + g) * 64 + lane) * 2;
  o[0] = H.re; o[1] = H.im;
}
__device__ __forceinline__ void ssm_sample(const Params& p, int job) {
  const int lane = tidx() & 63;
  const int seq = job >> 5, g = job & 31;
  const float dt = __expf(p.log_dt[g]);
  const float are = p.a_re[g * 64 + lane], aim = p.a_im[g * 64 + lane];
  const Cplx ab = apow(are, aim, dt, 1.f);
  const Cplx bs = bscale(are, aim, dt);
  const float* st = p.state_ssm + ((size_t)(seq * 32 + g) * 64 + lane) * 2;
  Cplx H = {st[0], st[1]};
  const Cplx H0 = H;
  bf16_t* A2 = p.A2() + ((size_t)g * NSUB + 1024 + seq) * A2LD + 256;
  Cplx bb[16];
#pragma unroll
  for (int h = 0; h < 16; ++h) {
    Cplx braw = {p.ssm_b[((g * 64 + lane) * 16 + h) * 2], p.ssm_b[((g * 64 + lane) * 16 + h) * 2 + 1]};
    bb[h] = cmul(bs, braw);
  }
#pragma unroll
  for (int t = 0; t < 4; ++t) {
    const bf16_t* u = (const bf16_t*)p.Z() + (size_t)(NP + seq * 4 + t) * INW + g * 16;
    const uint4 u0 = *(const uint4*)u, u1 = *(const uint4*)(u + 8);
    const float uf[16] = {bflo(u0.x), bfhi(u0.x), bflo(u0.y), bfhi(u0.y), bflo(u0.z), bfhi(u0.z), bflo(u0.w), bfhi(u0.w),
                          bflo(u1.x), bfhi(u1.x), bflo(u1.y), bfhi(u1.y), bflo(u1.z), bfhi(u1.z), bflo(u1.w), bfhi(u1.w)};
    Cplx bu = {0.f, 0.f};
#pragma unroll
    for (int h = 0; h < 16; ++h) { float uv = uf[h]; bu.re += uv * bb[h].re; bu.im += uv * bb[h].im; }
    Cplx tt = cmul(ab, H);
    H.re = tt.re + bu.re; H.im = tt.im + bu.im;
  }
  A2[lane] = f2bf(H0.re);
  A2[64 + lane] = f2bf(H0.im);
  float* o = p.out + O_SSMS + ((size_t)(seq * 32 + g) * 64 + lane) * 2;
  o[0] = H.re; o[1] = H.im;
}

__device__ __forceinline__ void ssm_y_gemm(const Params& p, char* smem);
__device__ __forceinline__ void phase_attn(const Params& p, char* smem) {
  const int wave = tidx() >> 6;
  const int gw = blockIdx.x * 8 + wave, GW = gridDim.x * 8;
  ssm_y_gemm(p, smem);
  __syncthreads();
  const float Mb = softmax_bound(p);
  __syncthreads();
#ifdef PROBE_PROMPT2
  for (int rep = 0; rep < 2; ++rep)
#endif
  for (int it = blockIdx.x; it < 256; it += gridDim.x) {
    const int xg = it & 7, rr = it >> 3, bh = xg * 4 + (rr >> 3), j = rr & 7;
    attn_prompt_block(p, smem, bh >> 3, bh & 7, j, Mb);
    attn_prompt_block(p, smem, bh >> 3, bh & 7, 15 - j, Mb);
  }
  for (int it = blockIdx.x; it < 256; it += gridDim.x) attn_decode_unit_dma(p, smem, it >> 1, it & 1, Mb);
}

struct SsmOrder {
  int G, c;
  __device__ bool next(int i, pg8::Unit& u) const {
    const int L = i * G + c;
    if (L >= 32 * 5) return false;
    u.pm = L; u.pn = L / 5;
    return true;
  }
  __device__ __forceinline__ void a_ready(const pg8::Unit&) const {}
  __device__ __forceinline__ void done(const pg8::Unit&) const {}
};
struct StSsmY { bf16_t* G; __device__ __forceinline__ void st8(int row, int col, pg8::f32x4 a, pg8::f32x4 b) const {
    const int g = col >> 8, n = col & 255, m = row - g * NSUB, tt = n >> 4, h = n & 15;
    const bool isP = m < 1024;
    const bool ok = isP || (tt < 4 && m < NSUBV);
    const int token = isP ? m * 16 + tt : NP + (m - 1024) * 4 + (tt & 3);
    const uint4 o = make_uint4(pk2(gelu_tanh(a[0]), gelu_tanh(a[1])), pk2(gelu_tanh(a[2]), gelu_tanh(a[3])),
                               pk2(gelu_tanh(b[0]), gelu_tanh(b[1])), pk2(gelu_tanh(b[2]), gelu_tanh(b[3])));
    if (ok) *(uint4*)(G + (unsigned)(token * 512 + g * 16 + h)) = o;
  } };
__device__ __forceinline__ void decode_combine(const Params& p, char* smem) {
  const int lane = tidx() & 63, wave = tidx() >> 6, half = wave >> 2, jw = wave & 3;
  float* osh = (float*)smem + wave * 512;
  float* red = (float*)smem + 8 * 512;
  for (int jb = blockIdx.x * 4; jb < 1024; jb += gridDim.x * 4) {
    const int job = jb + jw, seq = job >> 3, hd = job & 7;
    const float* O0 = p.Opart() + ((size_t)(seq * 2) * 32 + hd * 4) * 256 + half * 128;
    const float* O1 = O0 + 32 * 256;
    float lp[4];
#pragma unroll
    for (int t = 0; t < 4; ++t) lp[t] = p.Lpart()[(seq * 2) * 32 + hd * 4 + t] + p.Lpart()[(seq * 2 + 1) * 32 + hd * 4 + t];
#pragma unroll
    for (int i = 0; i < 4; ++i) {
      float2 a = *(const float2*)(O0 + i * 256 + lane * 2), b = *(const float2*)(O1 + i * 256 + lane * 2);
      *(float2*)(osh + i * 128 + lane * 2) = make_float2(a.x + b.x, a.y + b.y);
    }
    float acc[4] = {0.f, 0.f, 0.f, 0.f};
    const float* wp = p.w_uv + (size_t)(half * 128) * 512 + hd * 64 + lane;
#pragma unroll 1
    for (int c0 = 0; c0 < 128; c0 += 32) {
      float w[32];
#pragma unroll
      for (int c = 0; c < 32; ++c) w[c] = wp[(size_t)(c0 + c) * 512];
#pragma unroll
      for (int c = 0; c < 32; ++c)
#pragma unroll
        for (int t = 0; t < 4; ++t) acc[t] += osh[t * 128 + c0 + c] * w[c];
    }
    if (half == 1) {
#pragma unroll
      for (int t = 0; t < 4; ++t) red[(jw * 4 + t) * 64 + lane] = acc[t];
    }
    __syncthreads();
    if (half == 0) {
#pragma unroll
      for (int t = 0; t < 4; ++t)
        p.CAT()[(size_t)(NP + seq * 4 + t) * 1024 + 512 + hd * 64 + lane] = f2bf((acc[t] + red[(jw * 4 + t) * 64 + lane]) / lp[t]);
    }
    __syncthreads();
  }
}
__device__ __forceinline__ void ssm_y_gemm(const Params& p, char* smem) {
  pg8::Gemm g{p.A2(), p.Bt2(), 32 * NSUB, 32 * 256, 384};
  SsmOrder S{(int)gridDim.x, (int)((blockIdx.x + 160) % gridDim.x)};
  pg8::EpiFn<true, StSsmY> E{StSsmY{p.G()}};
  pg8::gemm_phase<pg8::EpiFn<true, StSsmY>, SsmOrder, false>((PG8_LAS unsigned char*)smem, g, S, E, nullptr);
}

struct EpiGlu {
  static constexpr bool PERM = true, AFTER_DRAIN = false;
  bf16_t* CAT;
  __device__ __forceinline__ void operator()(const pg8::f32x4 (&acc)[2][2][4][2], const pg8::Unit& u, int wr, int wc, int fr, int fq) const {
    const int row0 = u.pm * 256 + wr * 64 + fr, col0 = u.pn * 128 + wc * 32 + 8 * fq;
#pragma unroll
    for (int ai = 0; ai < 2; ++ai)
#pragma unroll
      for (int m = 0; m < 4; ++m) {
        const unsigned rb = (unsigned)((row0 + ai * 128 + m * 16) * 1024 + col0);
        float o[8];
#pragma unroll
        for (int n = 0; n < 2; ++n) {
          const pg8::f32x4 v = acc[ai][0][m][n], g = acc[ai][1][m][n];
#pragma unroll
          for (int q = 0; q < 4; ++q) o[n * 4 + q] = v[q] * __builtin_amdgcn_rcpf(1.f + __builtin_amdgcn_exp2f(-1.4426950408889634f * g[q]));
        }
        *(uint4*)(CAT + rb) = make_uint4(pk2(o[0], o[1]), pk2(o[2], o[3]), pk2(o[4], o[5]), pk2(o[6], o[7]));
      }
  }
};
__device__ __forceinline__ void phase_gemm_gl(const Params& p, char* smem) {
  decode_combine(p, smem);
  bf16_t* C = p.CAT();
  for (int t = blockIdx.x; t < 4 * 8; t += gridDim.x) {
    int tm = t / 8, tn = t % 8;
    gemm_tile<4, 2, 1, 2, true>(p.G(), 512, p.WgluS(), 512, 512, NP + tm * 128, tn * 128, smem, [=](int m, int c, float v, float g) {
      C[(size_t)m * 1024 + tn * 64 + c] = f2bf(v * __builtin_amdgcn_rcpf(1.f + __builtin_amdgcn_exp2f(-1.4426950408889634f * g)));
    });
  }
  pg8::Gemm g{p.G(), p.WgluT(), NP, 1024, 512};
  pg8::StaticOrder S;
  S.init(NP, 1024, (int)gridDim.x, (int)blockIdx.x);
  EpiGlu E{C};
  pg8::gemm_phase<EpiGlu, pg8::StaticOrder, false>((PG8_LAS unsigned char*)smem, g, S, E, nullptr);
}
__device__ __forceinline__ void phase_gemm_out(const Params& p, char* smem) {
  bf16_t* C = (bf16_t*)p.X1();
  const float* xs = p.x_sample;
  for (int t = blockIdx.x; t < 8 * 8; t += gridDim.x) {
    int tm = t / 8, tn = t % 8;
    gemm_tile<2, 4, 1, 1>(p.CAT(), 1024, p.WoutT(), 1024, 1024, NP + tm * 64, tn * 128, smem, [=](int m, int n, float v) {
      C[(size_t)m * 1024 + n] = f2bf(xs[(size_t)(m - NP) * 1024 + n] + v);
    });
  }
  big_gemm(p.CAT(), p.WoutT(), NP, 1024, 1024, smem, pg8::EpiFn<true, StX1>{StX1{C, p.x_prompt}});
}
__device__ __forceinline__ void phase_gemm_pq(const Params& p, char* smem) {
  bf16_t* C = p.PQ();
  for (int t = blockIdx.x; t < 8 * 16; t += gridDim.x) {
    int tm = t / 16, tn = t % 16;
    gemm_tile<2, 4, 1, 1>(p.XN(), 1024, p.WpqT(), 1024, 1024, NP + tm * 64, tn * 128, smem, [=](int m, int n, float v) { C[(size_t)m * 2048 + n] = f2bf(v); });
  }
  big_gemm(p.XN(), p.WpqT(), NP, 2048, 1024, smem, pg8::EpiFn<true, StBf16>{StBf16{C, 2048}});
}
__device__ __forceinline__ void ins16(float (&L)[16], float x) {
#pragma unroll
  for (int j = 15; j >= 1; --j) L[j] = __builtin_amdgcn_fmed3f(L[j - 1], L[j], x);
  L[0] = fmaxf(L[0], x);
}
#define CSD(a, b) do { const float hi_ = fmaxf(a, b), lo_ = fminf(a, b); a = hi_; b = lo_; } while (0)
__device__ __forceinline__ void sort16d(float (&v)[16]) {
  CSD(v[0], v[1]); CSD(v[2], v[3]); CSD(v[4], v[5]); CSD(v[6], v[7]); CSD(v[8], v[9]); CSD(v[10], v[11]); CSD(v[12], v[13]); CSD(v[14], v[15]); CSD(v[0], v[2]);
  CSD(v[1], v[3]); CSD(v[4], v[6]); CSD(v[5], v[7]); CSD(v[8], v[10]); CSD(v[9], v[11]); CSD(v[12], v[14]); CSD(v[13], v[15]); CSD(v[1], v[2]); CSD(v[5], v[6]);
  CSD(v[9], v[10]); CSD(v[13], v[14]); CSD(v[0], v[4]); CSD(v[1], v[5]); CSD(v[2], v[6]); CSD(v[3], v[7]); CSD(v[8], v[12]); CSD(v[9], v[13]); CSD(v[10], v[14]);
  CSD(v[11], v[15]); CSD(v[2], v[4]); CSD(v[3], v[5]); CSD(v[10], v[12]); CSD(v[11], v[13]); CSD(v[1], v[2]); CSD(v[3], v[4]); CSD(v[5], v[6]); CSD(v[9], v[10]);
  CSD(v[11], v[12]); CSD(v[13], v[14]); CSD(v[0], v[8]); CSD(v[1], v[9]); CSD(v[2], v[10]); CSD(v[3], v[11]); CSD(v[4], v[12]); CSD(v[5], v[13]); CSD(v[6], v[14]);
  CSD(v[7], v[15]); CSD(v[4], v[8]); CSD(v[5], v[9]); CSD(v[6], v[10]); CSD(v[7], v[11]); CSD(v[2], v[4]); CSD(v[3], v[5]); CSD(v[6], v[8]); CSD(v[7], v[9]);
  CSD(v[10], v[12]); CSD(v[11], v[13]); CSD(v[1], v[2]); CSD(v[3], v[4]); CSD(v[5], v[6]); CSD(v[7], v[8]); CSD(v[9], v[10]); CSD(v[11], v[12]); CSD(v[13], v[14]);
}
__device__ __forceinline__ void bitonic16d(float (&v)[16]) {
  CSD(v[0], v[8]); CSD(v[1], v[9]); CSD(v[2], v[10]); CSD(v[3], v[11]); CSD(v[4], v[12]); CSD(v[5], v[13]); CSD(v[6], v[14]); CSD(v[7], v[15]); CSD(v[0], v[4]);
  CSD(v[1], v[5]); CSD(v[2], v[6]); CSD(v[3], v[7]); CSD(v[8], v[12]); CSD(v[9], v[13]); CSD(v[10], v[14]); CSD(v[11], v[15]); CSD(v[0], v[2]); CSD(v[1], v[3]);
  CSD(v[4], v[6]); CSD(v[5], v[7]); CSD(v[8], v[10]); CSD(v[9], v[11]); CSD(v[12], v[14]); CSD(v[13], v[15]); CSD(v[0], v[1]); CSD(v[2], v[3]); CSD(v[4], v[5]);
  CSD(v[6], v[7]); CSD(v[8], v[9]); CSD(v[10], v[11]); CSD(v[12], v[13]); CSD(v[14], v[15]);
}
__device__ __forceinline__ void merge16d(float (&L)[16], const float (&R)[16]) {
#pragma unroll
  for (int i = 0; i < 16; ++i) L[i] = fmaxf(L[i], R[15 - i]);
  bitonic16d(L);
}
#define PKLD 136
__device__ __forceinline__ void phase_sctopk(const Params& p, char* smem) {
  bf16_t* keysS = (bf16_t*)smem;
  unsigned char* sidx = (unsigned char*)(smem + 2 * 128 * PKLD * 2);
  const int tid = tidx(), lane = tid & 63, wave = tid >> 6, lr = lane & 31, hh = lane >> 5;
  for (int c = tid; c < 2 * 128 * 16; c += NTHR) {
    int row = c >> 4, cc = c & 15;
    *(uint4*)(keysS + row * PKLD + cc * 8) = *(const uint4*)(p.PK() + row * 128 + cc * 8);
  }
  __syncthreads();
  const int ntask = NT * 8 / 32;
  const int GWv = gridDim.x * 8, gwv = blockIdx.x * 8 + wave;
  const int nfull = ntask / GWv, rem = ntask - nfull * GWv;
  const int rstride = rem > 0 ? (GWv / rem > 0 ? GWv / rem : 1) : 1;
  const bool hasx = rem > 0 && (gwv % rstride) == 0 && (gwv / rstride) < rem;
  const int nround = nfull + (hasx ? 1 : 0);
  for (int rd = 0; rd < nround; ++rd) {
    const int task = rd < nfull ? gwv + rd * GWv : nfull * GWv + gwv / rstride;
    const int m = task * 32 + lr;
    float L[2][16];
#pragma unroll
    for (int c = 0; c < 2; ++c) {
      bf16x8 qf[8];
#pragma unroll
      for (int s2 = 0; s2 < 8; ++s2) qf[s2] = *(const bf16x8*)(p.PQ() + (size_t)m * 256 + c * 128 + s2 * 16 + hh * 8);
      auto tile = [&](int kt, float (&ch)[16]) __attribute__((always_inline)) {
        f32x16 acc;
#pragma unroll
        for (int r = 0; r < 16; ++r) acc[r] = 0.f;
#pragma unroll
        for (int s2 = 0; s2 < 8; ++s2) {
          bf16x8 a = *(const bf16x8*)(keysS + (c * 128 + kt * 32 + lr) * PKLD + s2 * 16 + hh * 8);
          acc = mfma32(a, qf[s2], acc);
        }
#pragma unroll
        for (int r = 0; r < 16; ++r) {
          unsigned key = kt * 32 + (r & 3) + 8 * (r >> 2) + 4 * hh;
          ch[r] = __uint_as_float((__float_as_uint(acc[r]) & ~127u) | key);
        }
        sort16d(ch);
      };
      tile(0, L[c]);
#pragma unroll 1
      for (int kt = 1; kt < 4; ++kt) {
        float ch[16];
        tile(kt, ch);
        merge16d(L[c], ch);
      }
      float P[16];
#pragma unroll
      for (int j = 0; j < 16; ++j) P[j] = __shfl_xor(L[c][j], 32);
      merge16d(L[c], P);
    }
#pragma unroll
    for (int j = 0; j < 16; ++j) {
      sidx[j * NTHR + tid] = (unsigned char)(__float_as_uint(L[0][j]) & 127u);
      sidx[(16 + j) * NTHR + tid] = (unsigned char)(__float_as_uint(L[1][j]) & 127u);
    }
    float av[16], bv[16];
#pragma unroll
    for (int i = 0; i < 16; ++i) {
      av[i] = __uint_as_float(__float_as_uint(L[0][i]) & ~127u);
      bv[i] = __uint_as_float(__float_as_uint(L[1][i]) & ~127u);
    }
#define SC_CAND(i_, j_) __uint_as_float((__float_as_uint(av[i_] + bv[j_]) & ~255u) | (unsigned)(255 - ((i_) * 16 + (j_))))
    float T[16], Bq[16], Cq[16];
#pragma unroll
    for (int j = 0; j < 16; ++j) T[j] = SC_CAND(0, j);
#pragma unroll
    for (int j = 0; j < 8; ++j) { Bq[j] = SC_CAND(1, j); Bq[8 + j] = SC_CAND(15 - j, 0); }
    Cq[0] = SC_CAND(2, 0); Cq[1] = SC_CAND(2, 1); Cq[2] = SC_CAND(2, 2); Cq[3] = SC_CAND(2, 3); Cq[4] = SC_CAND(2, 4);
    Cq[5] = SC_CAND(3, 0); Cq[6] = SC_CAND(3, 1); Cq[7] = SC_CAND(3, 2); Cq[8] = SC_CAND(3, 3);
    Cq[9] = SC_CAND(4, 0); Cq[10] = SC_CAND(4, 1); Cq[11] = SC_CAND(4, 2);
    Cq[12] = SC_CAND(5, 0); Cq[13] = SC_CAND(5, 1); Cq[14] = SC_CAND(6, 0); Cq[15] = SC_CAND(6, 1);
    bitonic16d(Bq);
    merge16d(T, Bq);
    sort16d(Cq);
    merge16d(T, Cq);
    ins16(T, SC_CAND(7, 0));
    ins16(T, SC_CAND(7, 1));
#undef SC_CAND
    float mx = __uint_as_float(__float_as_uint(T[0]) & ~255u);
    float e[16], sum = 0.f;
    int id[16];
#pragma unroll
    for (int k = 0; k < 16; ++k) {
      unsigned bits = __float_as_uint(T[k]);
      float v = __uint_as_float(bits & ~255u);
      e[k] = __expf(v - mx);
      sum += e[k];
      unsigned ij = 255u - (bits & 255u);
      unsigned e1 = sidx[(ij >> 4) * NTHR + tid], e2 = sidx[(16 + (ij & 15)) * NTHR + tid];
      id[k] = (int)(e1 * 128 + e2);
    }
    float inv = 1.f / sum;
    if (hh == 0) {
#pragma unroll
      for (int k4 = 0; k4 < 4; ++k4)
        *(float4*)(p.GW() + (size_t)m * 16 + k4 * 4) = make_float4(e[k4 * 4] * inv, e[k4 * 4 + 1] * inv, e[k4 * 4 + 2] * inv, e[k4 * 4 + 3] * inv);
      unsigned short* ip16 = (unsigned short*)p.IDX() + (size_t)m * 16;
      *(uint4*)(ip16) = make_uint4(id[0] | (id[1] << 16), id[2] | (id[3] << 16), id[4] | (id[5] << 16), id[6] | (id[7] << 16));
      *(uint4*)(ip16 + 8) = make_uint4(id[8] | (id[9] << 16), id[10] | (id[11] << 16), id[12] | (id[13] << 16), id[14] | (id[15] << 16));
    }
  }
}
typedef __attribute__((ext_vector_type(4))) float f32x4;
#define GU_LDIDX(i_, EH0_, EH1_) do { const int r_ = wsl + ((i_) < ntok ? (i_) : ntok - 1) * nw; \
    const unsigned short* ip_ = (const unsigned short*)p.IDX() + (unsigned)(r_ * 128 + (lane >> 3) * 8 + ((lane & 4) ? 64 : 0)); \
    EH0_ = *(const uint4*)(ip_); } while (0)
#define GU_ID(Q_, k_) ((k_) == 0 ? (int)(Q_.x & 0xffffu) : (k_) == 1 ? (int)(Q_.x >> 16) : (k_) == 2 ? (int)(Q_.y & 0xffffu) : (k_) == 3 ? (int)(Q_.y >> 16) : \
                       (k_) == 4 ? (int)(Q_.z & 0xffffu) : (k_) == 5 ? (int)(Q_.z >> 16) : (k_) == 6 ? (int)(Q_.w & 0xffffu) : (int)(Q_.w >> 16))
#define GU_LDROWS(i_, EH0_, EH1_, RA_, RB_, XA_, XB_, XS_) do { const int r_ = wsl + ((i_) < ntok ? (i_) : ntok - 1) * nw; \
    const unsigned char* xp_ = p.X8() + (unsigned)(r_ * 1024 + j * 128 + kb * 16); \
    XA_ = *(const uint4*)(xp_ + ((lane & 8) ? 64 : 0)); XS_ = 127;     \
    const uint4 eo_ = make_uint4(__shfl_xor(EH0_.x, 4), __shfl_xor(EH0_.y, 4), __shfl_xor(EH0_.z, 4), __shfl_xor(EH0_.w, 4)); \
    const bool hi4_ = (lane & 4) != 0; \
    const uint4 q0_ = hi4_ ? eo_ : EH0_, q1_ = hi4_ ? EH0_ : eo_; \
    _Pragma("unroll") for (int mt = 0; mt < 8; ++mt) { \
      RA_[mt] = *(const uint4*)(p.U8() + (unsigned)((j * 16384 + GU_ID(q0_, mt)) * 128 + (lane & 7) * 16)); \
      RB_[mt] = *(const uint4*)(p.U8() + (unsigned)((j * 16384 + GU_ID(q1_, mt)) * 128 + (lane & 7) * 16)); } } while (0)
#define GU_COMPUTE(i_, RA_, RB_, XA_, XB_, XS_) do { const int r_ = wsl + ((i_) < ntok ? (i_) : ntok - 1) * nw; \
    const uint4 xo_ = make_uint4(__builtin_amdgcn_update_dpp(0, XA_.x, 0x128, 0xf, 0xf, false), __builtin_amdgcn_update_dpp(0, XA_.y, 0x128, 0xf, 0xf, false), \
                                 __builtin_amdgcn_update_dpp(0, XA_.z, 0x128, 0xf, 0xf, false), __builtin_amdgcn_update_dpp(0, XA_.w, 0x128, 0xf, 0xf, false));     \
    const bool hi8_ = (lane & 8) != 0; \
    const uint4 xlo_ = hi8_ ? xo_ : XA_, xhi_ = hi8_ ? XA_ : xo_; \
    i32x8 xb_; xb_[0] = xlo_.x; xb_[1] = xlo_.y; xb_[2] = xlo_.z; xb_[3] = xlo_.w; xb_[4] = xhi_.x; xb_[5] = xhi_.y; xb_[6] = xhi_.z; xb_[7] = xhi_.w; \
    bf16_t* pd_ = (bf16_t*)p.Pd() + ((size_t)j * NT + r_) * 128; \
    _Pragma("unroll") for (int mt = 0; mt < 8; ++mt) { \
      stl_u4(ltile + wr0, RA_[mt]); stl_u4(ltile + wr1, RB_[mt]); \
      const uint4 pa_ = ldl_u4(ltile + rd0), pb_ = ldl_u4(ltile + rd1); \
      i32x8 av_; av_[0] = pa_.x; av_[1] = pa_.y; av_[2] = pa_.z; av_[3] = pa_.w; av_[4] = pb_.x; av_[5] = pb_.y; av_[6] = pb_.z; av_[7] = pb_.w; \
      f32x4 acc_ = {0.f, 0.f, 0.f, 0.f}; \
      acc_ = __builtin_amdgcn_mfma_scale_f32_16x16x128_f8f6f4(av_, xb_, acc_, 0, 0, 0, 127, 0, XS_); \
      if (lrow == 0) {   \
        *(LAS float*)(lpd + (kb * 32 + mt) * 4) = acc_[0]; *(LAS float*)(lpd + (kb * 32 + 8 + mt) * 4) = acc_[1]; \
        *(LAS float*)(lpd + (kb * 32 + 16 + mt) * 4) = acc_[2]; *(LAS float*)(lpd + (kb * 32 + 24 + mt) * 4) = acc_[3]; } } \
    if (lane < 32) { const lds_f4 pv_ = *(const LAS lds_f4*)(lpd + lane * 16); *(uint2*)(pd_ + lane * 4) = make_uint2(pk2(pv_.x, pv_.y), pk2(pv_.z, pv_.w)); } } while (0)
__device__ __forceinline__ void phase_gather_u(const Params& p, char* smem) {
  const int lane = tidx() & 63, wave = tidx() >> 6;
  const int j = blockIdx.x & 7, wsl = (blockIdx.x >> 3) * 8 + wave, nw = (gridDim.x >> 3) * 8;
  const int lrow = lane & 15, kb = lane >> 4;
  const int ntok = (NT - wsl + nw - 1) / nw;
  if (ntok <= 0) return;
  LAS char* ltile = (LAS char*)smem + wave * 2048;
  LAS char* lpd = (LAS char*)smem + 16384 + wave * 512;
  const int wrow = lane >> 3, wpc = lane & 7;
  const int wr0 = wrow * 128 + ((wpc ^ ((wrow >> 1) & 7)) << 4), wr1 = (wrow + 8) * 128 + ((wpc ^ (((wrow + 8) >> 1) & 7)) << 4);
  const int rsw = (lrow >> 1) & 7;
  const int rd0 = lrow * 128 + ((kb ^ rsw) << 4), rd1 = lrow * 128 + (((4 + kb) ^ rsw) << 4);
  uint4 e0a, e0b, e1a, e1b; int xs0, xs1;
  uint4 a0[8], b0[8], a1[8], b1[8], xa0, xb0, xa1, xb1;
  GU_LDIDX(0, e0a, e0b);
  GU_LDIDX(1, e1a, e1b);
  asm volatile("" ::: "memory");
  GU_LDROWS(0, e0a, e0b, a0, b0, xa0, xb0, xs0);
  asm volatile("" ::: "memory");
#pragma unroll 1
  for (int i = 0; i < ntok; i += 2) {
    GU_LDIDX(i + 2, e0a, e0b);
    asm volatile("" ::: "memory");
    GU_LDROWS(i + 1, e1a, e1b, a1, b1, xa1, xb1, xs1);
    asm volatile("" ::: "memory");
    GU_COMPUTE(i, a0, b0, xa0, xb0, xs0);
    asm volatile("" ::: "memory");
    GU_LDIDX(i + 3, e1a, e1b);
    asm volatile("" ::: "memory");
    GU_LDROWS(i + 2, e0a, e0b, a0, b0, xa0, xb0, xs0);
    asm volatile("" ::: "memory");
    GU_COMPUTE(i + 1, a1, b1, xa1, xb1, xs1);
    asm volatile("" ::: "memory");
  }
}
__device__ __forceinline__ void phase_gather_w(const Params& p) {
  const unsigned gt = (unsigned)blockIdx.x * NTHR + tidx(), GT = (unsigned)gridDim.x * NTHR;
  const unsigned tot = (unsigned)NT * 32;
  const bf16_t* PdB = (const bf16_t*)p.Pd();
  for (unsigned i0 = gt; i0 < tot; i0 += 2 * GT) {
    const unsigned i1r = i0 + GT;
    const bool has1 = i1r < tot;
    const unsigned i1 = has1 ? i1r : i0;
    uint2 pa[8], pb[8];
#pragma unroll
    for (int jj = 0; jj < 8; ++jj) {
      pa[jj] = ((const uint2*)(PdB + (size_t)jj * NT * 128))[i0];
      pb[jj] = ((const uint2*)(PdB + (size_t)jj * NT * 128))[i1];
    }
    const float4 ga = ((const float4*)p.GW())[i0], gb = ((const float4*)p.GW())[i1];
    const uint2 ea = ((const uint2*)p.IDX())[i0], eb = ((const uint2*)p.IDX())[i1];
    const int ev[8] = {(int)(ea.x & 0xffffu), (int)(ea.x >> 16), (int)(ea.y & 0xffffu), (int)(ea.y >> 16),
                       (int)(eb.x & 0xffffu), (int)(eb.x >> 16), (int)(eb.y & 0xffffu), (int)(eb.y >> 16)};
    const float gv[8] = {ga.x, ga.y, ga.z, ga.w, gb.x, gb.y, gb.z, gb.w};
    unsigned usc[8];
    float vsc[8];
    unsigned scw[8];
#pragma unroll
    for (int q = 0; q < 8; ++q) scw[q] = ((const unsigned*)p.USC())[ev[q]];
    const float xsa = __uint_as_float((unsigned)p.XSC()[i0 >> 5] << 23), xsb = __uint_as_float((unsigned)p.XSC()[i1 >> 5] << 23);
#pragma unroll
    for (int q = 0; q < 8; ++q) { usc[q] = scw[q] & 0xffffu; vsc[q] = __uint_as_float((scw[q] >> 16) << 23); }
    float sv[8] = {0.f, 0.f, 0.f, 0.f, 0.f, 0.f, 0.f, 0.f};
#pragma unroll
    for (int jj = 0; jj < 8; ++jj) {
      sv[0] += bflo(pa[jj].x); sv[1] += bfhi(pa[jj].x); sv[2] += bflo(pa[jj].y); sv[3] += bfhi(pa[jj].y);
      sv[4] += bflo(pb[jj].x); sv[5] += bfhi(pb[jj].x); sv[6] += bflo(pb[jj].y); sv[7] += bfhi(pb[jj].y);
    }
    float o[8];
#pragma unroll
    for (int q = 0; q < 8; ++q) {
      const float us = __uint_as_float(usc[q] << 23) * (q < 4 ? xsa : xsb);
      o[q] = gv[q] * gelu_tanh(sv[q] * us) * vsc[q];
    }
    ((uint2*)p.Wt())[i0] = make_uint2(pk2(o[0], o[1]), pk2(o[2], o[3]));
    if (has1) ((uint2*)p.Wt())[i1] = make_uint2(pk2(o[4], o[5]), pk2(o[6], o[7]));
  }
}
__device__ __forceinline__ void phase_gather_v(const Params& p) {
  const int lane = tidx() & 63, wave = tidx() >> 6;
  const int j = blockIdx.x & 7, wsl = (blockIdx.x >> 3) * 8 + wave, nw = (gridDim.x >> 3) * 8;
  const int sub = lane >> 3, c16 = (lane & 7) * 16;
  const int ntok = (NT - wsl + nw - 1) / nw, nit = ntok * 2;
  auto ldidx = [&](int it, uint4& e) {
    const int itc = it < nit ? it : nit - 1;
    const unsigned base = (unsigned)((wsl + (itc >> 1) * nw) * 128 + sub * 16 + (itc & 1) * 8);
    e = *(const uint4*)((const unsigned short*)p.IDX() + base);
  };
  auto ldrows = [&](int it, const uint4& e, uint4 (&v)[8], uint4& w) {
    const int itc = it < nit ? it : nit - 1;
    const unsigned base = (unsigned)((wsl + (itc >> 1) * nw) * 128 + sub * 16 + (itc & 1) * 8);
    w = *(const uint4*)((const bf16_t*)p.Wt() + base);
    const int ev[8] = {(int)(e.x & 0xffffu), (int)(e.x >> 16), (int)(e.y & 0xffffu), (int)(e.y >> 16),
                       (int)(e.z & 0xffffu), (int)(e.z >> 16), (int)(e.w & 0xffffu), (int)(e.w >> 16)};
#pragma unroll
    for (int k = 0; k < 8; ++k) v[k] = *(const uint4*)(p.V8() + (unsigned)((j * 16384 + ev[k]) * 128 + c16));
  };
  f2v o2[8];
  uint2 xr;
  const int fo = c16 + ((lane >> 5) & 1) * 8 + ((lane >> 4) & 1) * 4;
  auto accum = [&](const uint4 (&vv)[8], const uint4& wq) {
    const float ww[8] = {bflo(wq.x), bfhi(wq.x), bflo(wq.y), bfhi(wq.y), bflo(wq.z), bfhi(wq.z), bflo(wq.w), bfhi(wq.w)};
#pragma unroll
    for (int k = 0; k < 8; ++k) {
      const f2v w = {ww[k], ww[k]};
      const uint4 v = vv[k];
      o2[0] += w * __builtin_amdgcn_cvt_pk_f32_fp8((int)v.x, false); o2[1] += w * __builtin_amdgcn_cvt_pk_f32_fp8((int)v.x, true);
      o2[2] += w * __builtin_amdgcn_cvt_pk_f32_fp8((int)v.y, false); o2[3] += w * __builtin_amdgcn_cvt_pk_f32_fp8((int)v.y, true);
      o2[4] += w * __builtin_amdgcn_cvt_pk_f32_fp8((int)v.z, false); o2[5] += w * __builtin_amdgcn_cvt_pk_f32_fp8((int)v.z, true);
      o2[6] += w * __builtin_amdgcn_cvt_pk_f32_fp8((int)v.w, false); o2[7] += w * __builtin_amdgcn_cvt_pk_f32_fp8((int)v.w, true);
    }
  };
  auto finish = [&](int i) {
    const int r = wsl + i * nw;
    float r8[8], r4[4];
#pragma unroll
    for (int q = 0; q < 8; ++q) {
      auto s = __builtin_amdgcn_permlane32_swap(__float_as_uint(o2[q >> 1][q & 1]), __float_as_uint(o2[(q + 8) >> 1][q & 1]), false, false);
      r8[q] = __uint_as_float(s[0]) + __uint_as_float(s[1]);
    }
#pragma unroll
    for (int q = 0; q < 4; ++q) {
      auto s = __builtin_amdgcn_permlane16_swap(__float_as_uint(r8[q]), __float_as_uint(r8[q + 4]), false, false);
      r4[q] = __uint_as_float(s[0]) + __uint_as_float(s[1]);
    }
#pragma unroll
    for (int q = 0; q < 4; ++q) r4[q] += __uint_as_float(__builtin_amdgcn_update_dpp(0, __float_as_uint(r4[q]), 0x128, 0xf, 0xf, false));
    if ((lane & 8) == 0 && i < ntok) {
      const unsigned off = (unsigned)(r * 1024 + j * 128 + fo);
      float* yo = ((r < NP) ? p.out + O_YP : p.out + O_YS - (size_t)NP * 1024) + off;
      *(float4*)(yo) = make_float4(bflo(xr.x) + r4[0], bfhi(xr.x) + r4[1], bflo(xr.y) + r4[2], bfhi(xr.y) + r4[3]);
    }
  };
  if (ntok <= 0) return;
  uint4 eA, eB, eC;
  uint4 wA, wB, wC;
  uint4 vA[8], vB[8], vC[8];
  ldidx(0, eA);
  ldidx(1, eB);
  ldidx(2, eC);
  asm volatile("" ::: "memory");
  ldrows(0, eA, vA, wA);
  asm volatile("" ::: "memory");
  ldrows(1, eB, vB, wB);
  asm volatile("" :: "v"(vB[7].x) : "memory");
#define GV_STEP(k_, EX, VX, WX, EY, VY, WY) do { \
    ldidx((k_) + 3, EX); \
    asm volatile("" ::: "memory"); \
    ldrows((k_) + 2, EY, VY, WY); \
    asm volatile("" : "+v"(WX.x), "+v"(WX.y), "+v"(WX.z), "+v"(WX.w) :: "memory"); \
    accum(VX, WX); } while (0)
#define GV_TOKEN(i_) do { \
    _Pragma("unroll") for (int q = 0; q < 8; ++q) { o2[q][0] = 0.f; o2[q][1] = 0.f; } \
    xr = *(const uint2*)((const bf16_t*)p.X1() + (unsigned)((wsl + ((i_) < ntok ? (i_) : ntok - 1) * nw) * 1024 + j * 128 + fo)); \
    asm volatile("" ::: "memory"); } while (0)
#pragma unroll 1
  for (int i = 0; i < ntok; i += 3) {
    const int k = 2 * i;
    GV_TOKEN(i);
    GV_STEP(k, eA, vA, wA, eC, vC, wC);
    GV_STEP(k + 1, eB, vB, wB, eA, vA, wA);
    finish(i);
    asm volatile("" ::: "memory");
    GV_TOKEN(i + 1);
    GV_STEP(k + 2, eC, vC, wC, eB, vB, wB);
    GV_STEP(k + 3, eA, vA, wA, eC, vC, wC);
    finish(i + 1);
    asm volatile("" ::: "memory");
    GV_TOKEN(i + 2);
    GV_STEP(k + 4, eB, vB, wB, eA, vA, wA);
    GV_STEP(k + 5, eC, vC, wC, eB, vB, wB);
    finish(i + 2);
    asm volatile("" ::: "memory");
  }
}

extern __shared__ __attribute__((aligned(16))) char dyn_smem[];
#define LDS_BYTES 147456
__global__ void __launch_bounds__(NTHR, 2) k_mega(Params p) {
  char* smem = dyn_smem;
  uint4* xbw = (uint4*)(dyn_smem + LDS_BYTES);
  if (threadIdx.x == 0) *xbw = make_uint4(0u, 0u, 0u, 0u);
  __syncthreads();
  XcdBarrier bar = xcd_barrier_post(p.bar(), (volatile LAS unsigned*)xbw);
  phase0(p, smem);
  phase_rmsnorm<false>(p.x_prompt, p.x_sample, p.norm_mix, p.XN(), nullptr, nullptr);
  xcd_barrier(bar);
  phase_gemm_z(p, smem);
  xcd_barrier(bar);
  phase_post1(p);
  xcd_barrier(bar);
  phase_gemm4(p, smem);
  xcd_barrier(bar);
  phase_post2(p);
  xcd_barrier(bar);
  phase_attn(p, smem);
  xcd_barrier(bar);
  phase_gemm_gl(p, smem);
  xcd_barrier(bar);
  phase_gemm_out(p, smem);
  xcd_barrier(bar);
  phase_rmsnorm_x1((const bf16_t*)p.X1(), p.norm_ffn, p.XN(), p.X8(), p.XSC());
  xcd_barrier(bar);
  phase_gemm_pq(p, smem);
  xcd_barrier(bar);
  phase_sctopk(p, smem);
  xcd_barrier(bar);
  phase_gather_u(p, smem);
  xcd_barrier(bar);
  phase_gather_w(p);
  xcd_barrier(bar);
  phase_gather_v(p);
}


#ifdef PROBE_MULTI
template <int PH>
__global__ void __launch_bounds__(NTHR, 2) k_phase(Params p) {
  char* smem = dyn_smem;
  if constexpr (PH == 0) { phase0(p, smem); phase_rmsnorm<false>(p.x_prompt, p.x_sample, p.norm_mix, p.XN(), nullptr, nullptr); }
  if constexpr (PH == 1) phase_gemm_z(p, smem);
  if constexpr (PH == 2) phase_post1(p);
  if constexpr (PH == 3) phase_gemm4(p, smem);
  if constexpr (PH == 4) phase_post2(p);
  if constexpr (PH == 5) phase_attn(p, smem);
  if constexpr (PH == 7) phase_gemm_gl(p, smem);
  if constexpr (PH == 9) phase_gemm_out(p, smem);
  if constexpr (PH == 10) phase_rmsnorm<true>(p.X1(), p.X1() + (size_t)NP * 1024, p.norm_ffn, p.XN(), p.X8(), p.XSC());
  if constexpr (PH == 11) phase_gemm_pq(p, smem);
  if constexpr (PH == 12) phase_sctopk(p, smem);
  if constexpr (PH == 13) phase_gather_u(p, smem);
  if constexpr (PH == 14) phase_gather_w(p);
  if constexpr (PH == 15) phase_gather_v(p);
}
template <int PH>
static void launch_phase(const Params& p, hipStream_t stream) {
  (void)hipFuncSetAttribute((const void*)k_phase<PH>, hipFuncAttributeMaxDynamicSharedMemorySize, LDS_BYTES + 16);
  const int reps = (PH == PROBE_MULTI) ? 2 : 1;
  for (int i = 0; i < reps; ++i) hipLaunchKernelGGL(k_phase<PH>, dim3(256), dim3(NTHR), LDS_BYTES + 16, stream, p);
}
#endif

extern "C" void kernel_launch(void* const* d_in, const int* in_sizes, int n_in, void* d_out, int out_size, void* d_ws, size_t ws_size,
                              hipStream_t stream) {
  Params p{};
  p.x_prompt = (const float*)d_in[0]; p.x_sample = (const float*)d_in[1]; p.cache_lat = (const float*)d_in[2];
  p.cache_kr = (const float*)d_in[3]; p.state_ssm = (const float*)d_in[4]; p.page_table = (const int*)d_in[5];
  p.norm_mix = (const float*)d_in[6]; p.w_in = (const float*)d_in[7]; p.norm_q_lora = (const float*)d_in[8];
  p.w_uq = (const float*)d_in[9]; p.norm_kv_lora = (const float*)d_in[10]; p.w_uk = (const float*)d_in[11];
  p.w_uv = (const float*)d_in[12]; p.g_qn = (const float*)d_in[13]; p.g_qr = (const float*)d_in[14];
  p.g_kn = (const float*)d_in[15]; p.g_kr = (const float*)d_in[16]; p.a_re = (const float*)d_in[17];
  p.a_im = (const float*)d_in[18]; p.log_dt = (const float*)d_in[19]; p.ssm_b = (const float*)d_in[20];
  p.ssm_c = (const float*)d_in[21]; p.ssm_d = (const float*)d_in[22]; p.w_glu = (const float*)d_in[23];
  p.w_out = (const float*)d_in[24]; p.norm_ffn = (const float*)d_in[25]; p.peer_wq = (const float*)d_in[26];
  p.peer_keys = (const float*)d_in[27]; p.peer_u = (const float*)d_in[28]; p.peer_v = (const float*)d_in[29];
  p.out = (float*)d_out;
  p.ws = (char*)d_ws;
  const size_t off = WS_TOTAL;
  if (off > ws_size) { fprintf(stderr, "workspace too small: need %zu have %zu\n", off, ws_size); return; }
#ifdef PROBE_MULTI
  launch_phase<0>(p, stream); launch_phase<1>(p, stream); launch_phase<2>(p, stream); launch_phase<3>(p, stream);
  launch_phase<4>(p, stream); launch_phase<5>(p, stream); launch_phase<6>(p, stream); launch_phase<7>(p, stream);
  launch_phase<8>(p, stream); launch_phase<9>(p, stream); launch_phase<10>(p, stream); launch_phase<11>(p, stream);
  launch_phase<12>(p, stream); launch_phase<13>(p, stream); launch_phase<14>(p, stream); launch_phase<15>(p, stream);
  return;
#endif
  static int grid = 0;
  if (!grid) {
    int dev = 0, cus = 0, per_cu = 0;
    (void)hipGetDevice(&dev);
    (void)hipDeviceGetAttribute(&cus, hipDeviceAttributeMultiprocessorCount, dev);
    (void)hipFuncSetAttribute((const void*)k_mega, hipFuncAttributeMaxDynamicSharedMemorySize, LDS_BYTES + 16);
    (void)hipOccupancyMaxActiveBlocksPerMultiprocessor(&per_cu, k_mega, NTHR, LDS_BYTES + 16);
    if (per_cu < 1) { fprintf(stderr, "k_mega does not fit a CU\n"); return; }
    grid = cus;
  }
  (void)hipMemsetAsync(p.ws + WSO_bar, 0, XCD_BAR_WORDS * sizeof(unsigned), stream);
  hipLaunchKernelGGL(k_mega, dim3(grid), dim3(NTHR), LDS_BYTES + 16, stream, p);
}
```

```cpp
#include <hip/hip_runtime.h>
#include <stdint.h>
#include <stdio.h>
#include <type_traits>

typedef __attribute__((ext_vector_type(8))) short bf16x8;
typedef __attribute__((ext_vector_type(4))) short s16x4;
typedef __attribute__((ext_vector_type(16))) float f32x16;
typedef __attribute__((ext_vector_type(2))) __bf16 bf2;
typedef __attribute__((ext_vector_type(2))) float f2v;
typedef unsigned short bf16_t;

#define NTHR 512
#define D_MODEL 1024
#define NP 16384
#define NS 512
#define NT 16896
#define INW 1184
#define NSUB 1280
#define NSUBV 1152
#define A2LD 384
#define EPS 1e-6f
#define QSCALE 0.14724466f

#define O_YP 0
#define O_YS 16777216
#define O_LATP 17301504
#define O_KRP 21495808
#define O_SSMP 22020096
#define O_LATS 22036480
#define O_KRS 22167552
#define O_SSMS 22183936

constexpr size_t ws_al(size_t b) { return (b + 255) & ~(size_t)255; }
constexpr size_t WSO_bar = 0;
constexpr size_t WSO_WinT = WSO_bar + ws_al(16384);
constexpr size_t WSO_WuqT = WSO_WinT + ws_al((size_t)1280 * 1024 * 2);
constexpr size_t WSO_WukT = WSO_WuqT + ws_al((size_t)768 * 384 * 2);
constexpr size_t WSO_WuvT = WSO_WukT + ws_al((size_t)512 * 256 * 2);
constexpr size_t WSO_WgluT = WSO_WuvT + ws_al((size_t)512 * 256 * 2);
constexpr size_t WSO_WoutT = WSO_WgluT + ws_al((size_t)1024 * 512 * 2);
constexpr size_t WSO_WpqT = WSO_WoutT + ws_al((size_t)1024 * 1024 * 2);
constexpr size_t WSO_PK = WSO_WpqT + ws_al((size_t)2048 * 1024 * 2);
constexpr size_t WSO_U8 = WSO_PK + ws_al((size_t)2 * 128 * 128 * 2);
constexpr size_t WSO_V8 = WSO_U8 + ws_al((size_t)16384 * 1024);
constexpr size_t WSO_X8 = WSO_V8 + ws_al((size_t)16384 * 1024);
constexpr size_t WSO_USC = WSO_X8 + ws_al((size_t)NT * 1024);
constexpr size_t WSO_W8T = WSO_USC + ws_al(16384 * 4);
constexpr size_t WSO_KW = WSO_W8T + ws_al(512 * 256);
constexpr size_t WSO_XSC = WSO_KW + ws_al(256);
constexpr size_t WSO_VSCF = WSO_XSC + ws_al(NT * 4);
constexpr size_t WSO_Bt2 = WSO_VSCF + ws_al(16384 * 4);
constexpr size_t WSO_Emat = WSO_Bt2 + ws_al((size_t)32 * 256 * A2LD * 2);
constexpr size_t WSO_XN = WSO_Emat + ws_al((size_t)32 * 128 * 256 * 2);
constexpr size_t WSO_A2 = WSO_XN + ws_al((size_t)NT * 1024 * 2);
constexpr size_t WSO_CQN = WSO_A2 + ws_al((size_t)32 * NSUB * A2LD * 2);
constexpr size_t WSO_CKV = WSO_CQN + ws_al((size_t)NT * 384 * 2);
constexpr size_t WSO_Kcat = WSO_CKV + ws_al((size_t)NT * 256 * 2);
constexpr size_t WSO_KcatS = WSO_Kcat + ws_al((size_t)32 * 4096 * 96 * 2);
constexpr size_t WSO_Qb = WSO_KcatS + ws_al((size_t)128 * 8 * 4 * 96 * 2);
constexpr size_t WSO_VT = WSO_Qb + ws_al((size_t)NT * 8 * 96 * 2);
constexpr size_t WSO_WgluS = WSO_VT + ws_al((size_t)512 * NP * 2);
constexpr size_t WSO_G = WSO_WgluS + ws_al((size_t)1024 * 512 * 2);
constexpr size_t WSO_CAT = WSO_G + ws_al((size_t)NT * 512 * 2);
constexpr size_t WSO_PQ = WSO_CAT + ws_al((size_t)NT * 1024 * 2);
constexpr size_t WSO_Z = WSO_PQ + ws_al((size_t)NT * 2048 * 2);
constexpr size_t WSO_Qraw = WSO_Z + ws_al((size_t)NT * INW * 4);
constexpr size_t WSO_KNraw = WSO_Qraw + ws_al((size_t)NT * 768 * 4);
constexpr size_t WSO_S = WSO_KNraw + ws_al((size_t)NT * 512 * 4);
constexpr size_t WSO_GL = WSO_S + ws_al((size_t)32 * NSUB * 128 * 4);
constexpr size_t WSO_X1 = WSO_GL + ws_al((size_t)NT * 1024 * 4);
constexpr size_t WSO_GW = WSO_X1 + ws_al((size_t)NT * 1024 * 4);
constexpr size_t WSO_Pd = WSO_GW + ws_al((size_t)NT * 128 * 4);
constexpr size_t WSO_Wt = WSO_Pd + ws_al((size_t)8 * NT * 128 * 4);
constexpr size_t WSO_Opart = WSO_Wt + ws_al((size_t)NT * 128 * 4);
constexpr size_t WSO_Lpart = WSO_Opart + ws_al((size_t)128 * 2 * 32 * 256 * 4);
constexpr size_t WSO_IDX = WSO_Lpart + ws_al((size_t)128 * 2 * 32 * 4);
constexpr size_t WS_TOTAL = WSO_IDX + ws_al((size_t)NT * 128 * 4);
struct Params {
  const float *x_prompt, *x_sample, *cache_lat, *cache_kr, *state_ssm;
  const int* page_table;
  const float *norm_mix, *w_in, *norm_q_lora, *w_uq, *norm_kv_lora, *w_uk, *w_uv, *g_qn, *g_qr, *g_kn, *g_kr;
  const float *a_re, *a_im, *log_dt, *ssm_b, *ssm_c, *ssm_d, *w_glu, *w_out, *norm_ffn, *peer_wq, *peer_keys, *peer_u, *peer_v;
  float* out;
  char* ws;
  __device__ __forceinline__ unsigned* bar() const { return (unsigned*)(ws + WSO_bar); }
  __device__ __forceinline__ bf16_t* WinT() const { return (bf16_t*)(ws + WSO_WinT); }
  __device__ __forceinline__ bf16_t* WuqT() const { return (bf16_t*)(ws + WSO_WuqT); }
  __device__ __forceinline__ bf16_t* WukT() const { return (bf16_t*)(ws + WSO_WukT); }
  __device__ __forceinline__ bf16_t* WuvT() const { return (bf16_t*)(ws + WSO_WuvT); }
  __device__ __forceinline__ bf16_t* WgluT() const { return (bf16_t*)(ws + WSO_WgluT); }
  __device__ __forceinline__ bf16_t* WoutT() const { return (bf16_t*)(ws + WSO_WoutT); }
  __device__ __forceinline__ bf16_t* WpqT() const { return (bf16_t*)(ws + WSO_WpqT); }
  __device__ __forceinline__ bf16_t* PK() const { return (bf16_t*)(ws + WSO_PK); }
  __device__ __forceinline__ unsigned char* U8() const { return (unsigned char*)(ws + WSO_U8); }
  __device__ __forceinline__ unsigned char* V8() const { return (unsigned char*)(ws + WSO_V8); }
  __device__ __forceinline__ unsigned char* X8() const { return (unsigned char*)(ws + WSO_X8); }
  __device__ __forceinline__ int* USC() const { return (int*)(ws + WSO_USC); }
  __device__ __forceinline__ unsigned char* W8T() const { return (unsigned char*)(ws + WSO_W8T); }
  __device__ __forceinline__ int* KW() const { return (int*)(ws + WSO_KW); }
  __device__ __forceinline__ int* XSC() const { return (int*)(ws + WSO_XSC); }
  __device__ __forceinline__ float* VSCF() const { return (float*)(ws + WSO_VSCF); }
  __device__ __forceinline__ bf16_t* Bt2() const { return (bf16_t*)(ws + WSO_Bt2); }
  __device__ __forceinline__ bf16_t* Emat() const { return (bf16_t*)(ws + WSO_Emat); }
  __device__ __forceinline__ bf16_t* XN() const { return (bf16_t*)(ws + WSO_XN); }
  __device__ __forceinline__ bf16_t* A2() const { return (bf16_t*)(ws + WSO_A2); }
  __device__ __forceinline__ bf16_t* CQN() const { return (bf16_t*)(ws + WSO_CQN); }
  __device__ __forceinline__ bf16_t* CKV() const { return (bf16_t*)(ws + WSO_CKV); }
  __device__ __forceinline__ bf16_t* Kcat() const { return (bf16_t*)(ws + WSO_Kcat); }
  __device__ __forceinline__ bf16_t* KcatS() const { return (bf16_t*)(ws + WSO_KcatS); }
  __device__ __forceinline__ bf16_t* Qb() const { return (bf16_t*)(ws + WSO_Qb); }
  __device__ __forceinline__ bf16_t* VT() const { return (bf16_t*)(ws + WSO_VT); }
  __device__ __forceinline__ bf16_t* WgluS() const { return (bf16_t*)(ws + WSO_WgluS); }
  __device__ __forceinline__ bf16_t* G() const { return (bf16_t*)(ws + WSO_G); }
  __device__ __forceinline__ bf16_t* CAT() const { return (bf16_t*)(ws + WSO_CAT); }
  __device__ __forceinline__ bf16_t* PQ() const { return (bf16_t*)(ws + WSO_PQ); }
  __device__ __forceinline__ float* Z() const { return (float*)(ws + WSO_Z); }
  __device__ __forceinline__ float* Qraw() const { return (float*)(ws + WSO_Qraw); }
  __device__ __forceinline__ float* KNraw() const { return (float*)(ws + WSO_KNraw); }
  __device__ __forceinline__ float* S() const { return (float*)(ws + WSO_S); }
  __device__ __forceinline__ float* GL() const { return (float*)(ws + WSO_GL); }
  __device__ __forceinline__ float* X1() const { return (float*)(ws + WSO_X1); }
  __device__ __forceinline__ float* GW() const { return (float*)(ws + WSO_GW); }
  __device__ __forceinline__ float* Pd() const { return (float*)(ws + WSO_Pd); }
  __device__ __forceinline__ float* Wt() const { return (float*)(ws + WSO_Wt); }
  __device__ __forceinline__ float* Opart() const { return (float*)(ws + WSO_Opart); }
  __device__ __forceinline__ float* Lpart() const { return (float*)(ws + WSO_Lpart); }
  __device__ __forceinline__ int* IDX() const { return (int*)(ws + WSO_IDX); }
};


#define XB_TMO      128
#define XB_XCNT(j)  (256  + 64 * (j))
#define XB_XSUB(j)  (1280 + 64 * (j))
#define XB_XGEN(j)  (2304 + 64 * (j))
#define XB_TOP      3328
#define XB_TOPGEN   3392
#define XCD_BAR_WORDS 3456
#define XB_SPIN_CAP (1u << 18)
#define LAS __attribute__((address_space(3)))

__device__ __forceinline__ unsigned xb_ld(unsigned* p)              { return __hip_atomic_load(p, __ATOMIC_RELAXED, __HIP_MEMORY_SCOPE_AGENT); }
__device__ __forceinline__ unsigned xb_add(unsigned* p, unsigned v) { return __hip_atomic_fetch_add(p, v, __ATOMIC_RELAXED, __HIP_MEMORY_SCOPE_AGENT); }
__device__ __forceinline__ unsigned xb_xcc_id() { return (unsigned)__builtin_amdgcn_s_getreg((3 << 11) | 20) & 0xFu; }
#define XB_SPIN(cond, bar) do { unsigned _sp = 0; while (cond) { __builtin_amdgcn_s_sleep(1); \
    if ((++_sp & 255u) == 0u) { if (xb_ld(&(bar)[XB_TMO])) break; if (_sp > XB_SPIN_CAP) { atomicAdd(&(bar)[XB_TMO], 1u); break; } } } } while (0)

struct XcdBarrier {
    unsigned* bar; unsigned x;
    volatile LAS unsigned* st;
};

__device__ __forceinline__ XcdBarrier xcd_barrier_post(unsigned* bar, volatile LAS unsigned* st) {
    XcdBarrier b; b.bar = bar; b.x = xb_xcc_id(); b.st = st;
    if (threadIdx.x == 0) (void)xb_add(&bar[XB_XCNT(b.x)], 1u);
    return b;
}
__device__ __forceinline__ void xcd_barrier_complete(unsigned* bar, unsigned x, unsigned& nloc, unsigned& nx) {
    const unsigned G = gridDim.x * gridDim.y * gridDim.z;
    unsigned sum, cnt, mine, sp = 0u;
    for (;;) {
        sum = 0u; cnt = 0u; mine = 0u;
#pragma unroll
        for (unsigned j = 0; j < 16; ++j) { const unsigned c = xb_ld(&bar[XB_XCNT(j)]); sum += c; cnt += (c > 0u) ? 1u : 0u; mine = (j == x) ? c : mine; }
        if (sum == G) break;
        __builtin_amdgcn_s_sleep(1);
        if ((++sp & 255u) == 0u) { if (xb_ld(&bar[XB_TMO])) break; if (sp > XB_SPIN_CAP) { atomicAdd(&bar[XB_TMO], 1u); break; } }
    }
    nloc = mine > 0u ? mine : 1u; nx = cnt > 0u ? cnt : 1u;
}

__device__ __forceinline__ void xcd_barrier(const XcdBarrier& b) {
    asm volatile("s_waitcnt vmcnt(0)" ::: "memory");
    __syncthreads();
    if (threadIdx.x == 0) {
        unsigned* bar = b.bar;
        __builtin_amdgcn_s_waitcnt(0);
        unsigned nloc = b.st[0], nx = b.st[1];
        if (nloc == 0u) { xcd_barrier_complete(bar, b.x, nloc, nx); b.st[0] = nloc; b.st[1] = nx; }
        const unsigned old = xb_add(&bar[XB_XSUB(b.x)], 1u);
        const unsigned gen = old / nloc;
        if (old + 1u == (gen + 1u) * nloc) {
            __builtin_amdgcn_fence(__ATOMIC_RELEASE, "agent");
            asm volatile("s_waitcnt vmcnt(0)" ::: "memory");
            const unsigned og = xb_add(&bar[XB_TOP], 1u);
            const unsigned tg = og / nx;
            if (og + 1u == (tg + 1u) * nx) xb_add(&bar[XB_TOPGEN], 1u);
            else XB_SPIN(xb_ld(&bar[XB_TOPGEN]) == tg, bar);
            __builtin_amdgcn_fence(__ATOMIC_ACQUIRE, "agent");
            xb_add(&bar[XB_XGEN(b.x)], 1u);
            asm volatile("s_waitcnt vmcnt(0)" ::: "memory");
        } else {
            XB_SPIN(xb_ld(&bar[XB_XGEN(b.x)]) == gen, bar);
            __builtin_amdgcn_fence(__ATOMIC_ACQUIRE, "agent");
            asm volatile("s_waitcnt vmcnt(0)" ::: "memory");
        }
    }
    __syncthreads();
}

__device__ __forceinline__ int tidx() { int t = threadIdx.x; asm volatile("" : "+v"(t)); return t; }
__device__ __forceinline__ unsigned pk2(float a, float b) {
  f2v v = {a, b};
  bf2 r = __builtin_convertvector(v, bf2);
  return __builtin_bit_cast(unsigned, r);
}
__device__ __forceinline__ bf16_t f2bf(float a) { return (bf16_t)(pk2(a, 0.f) & 0xffffu); }
__device__ __forceinline__ float bf2f(bf16_t x) { return __uint_as_float(((unsigned)x) << 16); }
__device__ __forceinline__ float bflo(unsigned x) { return __uint_as_float(x << 16); }
__device__ __forceinline__ float bfhi(unsigned x) { return __uint_as_float(x & 0xffff0000u); }
__device__ __forceinline__ float wave_sum(float v) {
  v += __shfl_xor(v, 32); v += __shfl_xor(v, 16); v += __shfl_xor(v, 8);
  v += __shfl_xor(v, 4);  v += __shfl_xor(v, 2);  v += __shfl_xor(v, 1);
  return v;
}
__device__ __forceinline__ float gelu_tanh(float x) {
  const float k0 = -2.f * 0.7978845608028654f * 1.4426950408889634f, k1 = k0 * 0.044715f;
  float e = __builtin_amdgcn_exp2f(x * (k0 + k1 * x * x));
  return x * __builtin_amdgcn_rcpf(1.f + e);
}
__device__ __forceinline__ void sincos_rev(float ang, float& s, float& c) {
  float rev = ang * 0.15915494309189535f;
  rev = rev - floorf(rev);
  s = __builtin_amdgcn_sinf(rev);
  c = __builtin_amdgcn_cosf(rev);
}
__device__ __forceinline__ f32x16 mfma32(bf16x8 a, bf16x8 b, f32x16 c) {
  return __builtin_amdgcn_mfma_f32_32x32x16_bf16(a, b, c, 0, 0, 0);
}
__device__ __forceinline__ bf16x8 mk8(unsigned a, unsigned b, unsigned c, unsigned d) {
  uint4 u = make_uint4(a, b, c, d);
  return __builtin_bit_cast(bf16x8, u);
}

#define GLD 72
template <int WM, int WN, int TM, int TN, bool PAIR = false, class Epi>
__device__ __forceinline__ void gemm_tile(const bf16_t* __restrict__ A, int lda, const bf16_t* __restrict__ Bt, int ldb,
                                          int K, int m0, int n0, char* smem, Epi epi) {
  static_assert(WM * WN == 8, "8 waves");
  constexpr int BM = 32 * WM * TM, BN = 32 * WN * TN, NA = BM * 8 / NTHR, NB = BN * 8 / NTHR;
  static_assert(NA >= 1 && NB >= 1, "tile too small");
  bf16_t* As = (bf16_t*)smem;
  bf16_t* Bs = As + 2 * BM * GLD;
  const int tid = tidx(), lane = tid & 63, wave = tid >> 6;
  const int wm = wave / WN, wn = wave % WN, lr = lane & 31, hh = lane >> 5;
  f32x16 acc[TM][TN];
#pragma unroll
  for (int i = 0; i < TM; ++i)
#pragma unroll
    for (int j = 0; j < TN; ++j)
#pragma unroll
      for (int r = 0; r < 16; ++r) acc[i][j][r] = 0.f;
  const int nk = K / 64;
  static_assert(NA <= 2 && NB <= 2, "staging registers are scalarised for at most 2+2 chunks per thread");
  uint4 pa0, pa1, pb0, pb1, qa0, qa1, qb0, qb1;
#define GT_LD1(dst, P, ld, r0, i_) do { int c = tid + NTHR * (i_), row = c >> 3, cc = c & 7; dst = *(const uint4*)(P + (size_t)(r0 + row) * ld + k0_ + cc * 8); } while (0)
#define GT_GLOAD(kt_, A0, A1, B0, B1) do { const int k0_ = ((kt_) < nk ? (kt_) : nk - 1) * 64; \
    GT_LD1(A0, A, lda, m0, 0); if constexpr (NA > 1) GT_LD1(A1, A, lda, m0, 1); \
    GT_LD1(B0, Bt, ldb, n0, 0); if constexpr (NB > 1) GT_LD1(B1, Bt, ldb, n0, 1); } while (0)
#define GT_ST1(src, S, bm, i_) do { int c = tid + NTHR * (i_), row = c >> 3, cc = c & 7; *(uint4*)(S + (bm + row) * GLD + cc * 8) = src; } while (0)
#define GT_LSTORE(buf_, A0, A1, B0, B1) do { \
    GT_ST1(A0, As, (buf_) * BM, 0); if constexpr (NA > 1) GT_ST1(A1, As, (buf_) * BM, 1); \
    GT_ST1(B0, Bs, (buf_) * BN, 0); if constexpr (NB > 1) GT_ST1(B1, Bs, (buf_) * BN, 1); } while (0)
#define GT_COMPUTE(buf_) do { \
    _Pragma("unroll") for (int ks = 0; ks < 4; ++ks) { bf16x8 a[TM], b[TN]; \
      _Pragma("unroll") for (int i = 0; i < TM; ++i) a[i] = *(const bf16x8*)(As + ((buf_) * BM + wm * 32 * TM + i * 32 + lr) * GLD + ks * 16 + hh * 8); \
      _Pragma("unroll") for (int j = 0; j < TN; ++j) b[j] = *(const bf16x8*)(Bs + ((buf_) * BN + wn * 32 * TN + j * 32 + lr) * GLD + ks * 16 + hh * 8); \
      _Pragma("unroll") for (int i = 0; i < TM; ++i) _Pragma("unroll") for (int j = 0; j < TN; ++j) acc[i][j] = mfma32(a[i], b[j], acc[i][j]); } } while (0)
  GT_GLOAD(0, pa0, pa1, pb0, pb1);
  GT_GLOAD(1, qa0, qa1, qb0, qb1);
  GT_LSTORE(0, pa0, pa1, pb0, pb1);
  GT_GLOAD(2, pa0, pa1, pb0, pb1);
  __syncthreads();
#pragma unroll 1
  for (int kt = 0; kt < nk; kt += 2) {
    GT_COMPUTE(0);
    GT_LSTORE(1, qa0, qa1, qb0, qb1);
    GT_GLOAD(kt + 3, qa0, qa1, qb0, qb1);
    __syncthreads();
    GT_COMPUTE(1);
    GT_LSTORE(0, pa0, pa1, pb0, pb1);
    GT_GLOAD(kt + 4, pa0, pa1, pb0, pb1);
    __syncthreads();
  }
#undef GT_GLOAD
#undef GT_LSTORE
#undef GT_COMPUTE
#undef GT_LD1
#undef GT_ST1
  if constexpr (PAIR) {
    static_assert(TN == 2, "paired epilogue needs two column tiles per wave");
#pragma unroll
    for (int i = 0; i < TM; ++i)
#pragma unroll
      for (int r = 0; r < 16; ++r) {
        int m = m0 + wm * 32 * TM + i * 32 + (r & 3) + 8 * (r >> 2) + 4 * hh;
        epi(m, wn * 32 + lr, acc[i][0][r], acc[i][1][r]);
      }
  } else {
#pragma unroll
    for (int i = 0; i < TM; ++i)
#pragma unroll
      for (int j = 0; j < TN; ++j)
#pragma unroll
        for (int r = 0; r < 16; ++r) {
          int m = m0 + wm * 32 * TM + i * 32 + (r & 3) + 8 * (r >> 2) + 4 * hh;
          int n = n0 + wn * 32 * TN + j * 32 + lr;
          epi(m, n, acc[i][j][r]);
        }
  }
}

namespace pg8 {
#define PG8_LAS __attribute__((address_space(3)))
typedef unsigned short bf16_t;
typedef short bf16x8 __attribute__((ext_vector_type(8)));
typedef float f32x4 __attribute__((ext_vector_type(4)));
typedef unsigned u32x4 __attribute__((ext_vector_type(4)));
constexpr int BM = 256, BK = 64, HALF = 128, HTB = HALF * BK * 2  , STAGE_BYTES = 8 * HTB, NXCD = 8, WGM = 8;

__host__ __device__ __forceinline__ int lds_byte(int r, int c) { const int st = (r >> 4) * 2 + (c >> 5), rr = r & 15, cc = c & 31, ob = rr * 64 + cc * 2; return st * 1024 + (ob ^ (((ob >> 9) & 1) << 5)); }
__host__ __device__ __forceinline__ void stage_rc(int b, int& R, int& C) { const int st = b / 1024, sb = b % 1024, swz = sb ^ (((sb >> 9) & 1) << 5); R = (st >> 1) * 16 + swz / 64; C = (st & 1) * 32 + (swz % 64) / 2; }
__host__ __device__ __forceinline__ int perm32(int rho) { const int n = rho >> 4, i = rho & 15; return 8 * (i >> 2) + 4 * n + (i & 3); }

struct Unit { int pm, pn; };
struct Gemm { const bf16_t* A; const bf16_t* Bt; int M, N, K; };

struct StaticOrder {
    int nM, nN, nwg, G, c;
    __host__ __device__ void init(int M, int N, int G_, int c_) { nM = M / BM; nN = N / BM; nwg = nM * nN; G = G_; c = c_; }
    __host__ __device__ bool next(int i, Unit& u) const {
        const long L = (long)i * G + c; if (L >= nwg) return false;
        int wgid = (int)L; { const int q = nwg / NXCD, r = nwg % NXCD, xcd = wgid % NXCD, off = wgid / NXCD; wgid = (xcd < r ? xcd * (q + 1) : r * (q + 1) + (xcd - r) * q) + off; }
        const int nig = WGM * nN, gid = wgid / nig, fm = gid * WGM, gsz = (nM - fm) < WGM ? (nM - fm) : WGM;
        u.pm = fm + ((wgid % nig) % gsz); u.pn = (wgid % nig) / gsz; return true;
    }
    __device__ __forceinline__ void a_ready(const Unit&) const {}
    __device__ __forceinline__ void done(const Unit&) const {}
};
__device__ __forceinline__ unsigned cvt_pk_bf16(float lo, float hi) { unsigned r; asm volatile("v_cvt_pk_bf16_f32 %0, %1, %2" : "=v"(r) : "v"(lo), "v"(hi)); return r; }

template <bool PERM_, class F> struct EpiFn {
    static constexpr bool PERM = PERM_, AFTER_DRAIN = false;
    F f;
    __device__ __forceinline__ void operator()(const f32x4 (&acc)[2][2][4][2], const Unit& u, int wr, int wc, int fr, int fq) const {
        const int row0 = u.pm * BM + wr * 64 + fr;
#pragma unroll
        for (int ai = 0; ai < 2; ++ai)
#pragma unroll
            for (int m = 0; m < 4; ++m) {
                const int row = row0 + ai * HALF + m * 16;
#pragma unroll
                for (int bj = 0; bj < 2; ++bj) {
                    if constexpr (PERM_) {
                        f.st8(row, u.pn * BM + wc * 32 + 8 * fq + bj * HALF, acc[ai][bj][m][0], acc[ai][bj][m][1]);
                    } else {
#pragma unroll
                        for (int n = 0; n < 2; ++n) f.st4(row, u.pn * BM + wc * 32 + 4 * fq + bj * HALF + n * 16, acc[ai][bj][m][n]);
                    }
                }
            }
    }
};
template <class Epi, class Sched, bool STAMP = false>
__device__ __forceinline__ void gemm_phase(PG8_LAS unsigned char* lds, const Gemm g, const Sched& S, const Epi& E, unsigned long long* stamps) {
    const int tid = tidx(), wid = __builtin_amdgcn_readfirstlane(tid >> 6), lane = tid & 63, wr = wid >> 2, wc = wid & 3, fr = lane & 15, fq = lane >> 4;
    const int K = g.K, nt = K / BK;
    int ts_lo = 0, ts_hi = 0, nts = 0; const unsigned long long rt_entry = STAMP ? (unsigned long long)wall_clock64() : 0ull;
#define PG8_STAMP() do { if (STAMP && wid == 0 && nts < 64) { const unsigned long long _c = (unsigned long long)clock64(); \
        ts_lo = (lane == nts) ? (int)(unsigned)_c : ts_lo; ts_hi = (lane == nts) ? (int)(unsigned)(_c >> 32) : ts_hi; ++nts; } } while (0)
    PG8_STAMP();
    unsigned voffA[2], voffB[2];
#pragma unroll
    for (int i = 0; i < 2; ++i) { int R, C; stage_rc(tid * 16 + i * 8192, R, C); const int Rb = Epi::PERM ? ((R & ~31) + perm32(R & 31)) : R;
        voffA[i] = (unsigned)(R * K + C) * 2u; voffB[i] = (unsigned)(Rb * K + C) * 2u; }
    const size_t kstep = (size_t)(BK * 2);
    const size_t hstep = (size_t)HALF * K * 2;
    const size_t tstep = 2 * hstep;
    const unsigned ldsw = (unsigned)wid * 1024u;
    const int aoff = lds_byte(wr * 64 + fr, fq * 8), boff = lds_byte(wc * 32 + fr, fq * 8);
#define PG8_SA(b, h) (((b) * 2 + (h)) * HTB)
#define PG8_SB(b, h) ((4 + (b) * 2 + (h)) * HTB)
#define PG8_STAGE(bufoff, gbase, voff) do { _Pragma("unroll") for (int _i = 0; _i < 2; ++_i) \
        __builtin_amdgcn_global_load_lds((const unsigned*)((const char*)(gbase) + (voff)[_i]), (PG8_LAS unsigned*)(lds + (bufoff) + ldsw + _i * 8192), 16, 0, 0); } while (0)
#define PG8_LDA(dst, b, h) do { _Pragma("unroll") for (int m = 0; m < 4; ++m) _Pragma("unroll") for (int k = 0; k < 2; ++k) dst[m][k] = *(const PG8_LAS bf16x8*)(lds + PG8_SA(b, h) + aoff + m * 2048 + k * 1024); } while (0)
#define PG8_LDB(dst, b, h) do { _Pragma("unroll") for (int n = 0; n < 2; ++n) _Pragma("unroll") for (int k = 0; k < 2; ++k) dst[n][k] = *(const PG8_LAS bf16x8*)(lds + PG8_SB(b, h) + boff + n * 2048 + k * 1024); } while (0)
#define PG8_MMA(ai, bj, At, Bt) do { __builtin_amdgcn_s_setprio(1); _Pragma("unroll") for (int m = 0; m < 4; ++m) _Pragma("unroll") for (int n = 0; n < 2; ++n) _Pragma("unroll") for (int k = 0; k < 2; ++k) \
        acc[ai][bj][m][n] = __builtin_amdgcn_mfma_f32_16x16x32_bf16(Bt[n][k], At[m][k], acc[ai][bj][m][n], 0, 0, 0); __builtin_amdgcn_s_setprio(0); } while (0)
#define PG8_WAIT_V(n) asm volatile("s_waitcnt vmcnt(" #n ")" ::: "memory")
#define PG8_WAIT_L(n) asm volatile("s_waitcnt lgkmcnt(" #n ")" ::: "memory")
#define PG8_BAR __builtin_amdgcn_s_barrier()
#define PG8_SCHED __builtin_amdgcn_sched_barrier(0)
    Unit cur, nxt; int ui = 0;
    if (!S.next(0, cur)) return;
    f32x4 acc[2][2][4][2];
#pragma unroll
    for (int a = 0; a < 2; ++a)
#pragma unroll
        for (int b = 0; b < 2; ++b)
#pragma unroll
            for (int m = 0; m < 4; ++m)
#pragma unroll
                for (int n = 0; n < 2; ++n) acc[a][b][m][n] = (f32x4){0.f, 0.f, 0.f, 0.f};
    bf16x8 At[4][2], B0[2][2], B1[2][2];
    const char* cA = (const char*)g.A + (size_t)cur.pm * tstep; const char* cB = (const char*)g.Bt + (size_t)cur.pn * tstep;
    S.a_ready(cur);
    PG8_STAGE(PG8_SB(0, 0), cB, voffB); PG8_STAGE(PG8_SA(0, 0), cA, voffA); PG8_STAGE(PG8_SB(0, 1), cB + hstep, voffB); PG8_STAGE(PG8_SA(0, 1), cA + hstep, voffA);
    if (wr == 1) PG8_BAR;
    PG8_WAIT_V(4); PG8_BAR;
    PG8_STAGE(PG8_SB(1, 0), cB + kstep, voffB); PG8_STAGE(PG8_SA(1, 0), cA + kstep, voffA); PG8_STAGE(PG8_SB(1, 1), cB + hstep + kstep, voffB);
    PG8_WAIT_V(6); PG8_BAR;
    PG8_STAMP();
    for (;;) {
        const bool has_next = S.next(ui + 1, nxt);
        const char* nA = has_next ? (const char*)g.A + (size_t)nxt.pm * tstep : cA; const char* nB = has_next ? (const char*)g.Bt + (size_t)nxt.pn * tstep : cB;
        for (int t = 0; t < nt; t += 2) {
            const bool last = (t == nt - 2);
            const char* a1 = cA + (size_t)(t + 1) * kstep;
            const char* a2 = last ? nA : cA + (size_t)(t + 2) * kstep; const char* b2 = last ? nB : cB + (size_t)(t + 2) * kstep;
            const char* a3 = a2 + kstep; const char* b3 = b2 + kstep;
            if (last && has_next) S.a_ready(nxt);
            PG8_LDB(B0, 0, 0); PG8_SCHED; PG8_LDA(At, 0, 0); PG8_STAGE(PG8_SA(1, 1), a1 + hstep, voffA);
            PG8_WAIT_L(8); PG8_BAR; PG8_WAIT_L(0); PG8_MMA(0, 0, At, B0); PG8_BAR; PG8_SCHED;
            PG8_LDB(B1, 0, 1); PG8_STAGE(PG8_SB(0, 0), b2, voffB);
            PG8_BAR; PG8_WAIT_L(0); PG8_MMA(0, 1, At, B1); PG8_BAR;
            PG8_LDA(At, 0, 1); PG8_STAGE(PG8_SA(0, 0), a2, voffA);
            PG8_BAR; PG8_WAIT_L(0); PG8_MMA(1, 0, At, B0); PG8_BAR; PG8_SCHED;
            PG8_STAGE(PG8_SB(0, 1), b2 + hstep, voffB);
            PG8_WAIT_V(6); PG8_BAR; PG8_MMA(1, 1, At, B1); PG8_BAR;
            PG8_LDB(B0, 1, 0); PG8_SCHED; PG8_LDA(At, 1, 0); PG8_STAGE(PG8_SA(0, 1), a2 + hstep, voffA);
            PG8_WAIT_L(8); PG8_BAR; PG8_WAIT_L(0); PG8_MMA(0, 0, At, B0); PG8_BAR; PG8_SCHED;
            PG8_LDB(B1, 1, 1); PG8_STAGE(PG8_SB(1, 0), b3, voffB);
            PG8_BAR; PG8_WAIT_L(0); PG8_MMA(0, 1, At, B1); PG8_BAR;
            PG8_LDA(At, 1, 1); PG8_STAGE(PG8_SA(1, 0), a3, voffA);
            PG8_BAR; PG8_WAIT_L(0); PG8_MMA(1, 0, At, B0); PG8_BAR; PG8_SCHED;
            PG8_STAGE(PG8_SB(1, 1), b3 + hstep, voffB);
            PG8_WAIT_V(6); PG8_BAR; PG8_MMA(1, 1, At, B1); PG8_BAR;
        }
        PG8_STAMP();
        if constexpr (!Epi::AFTER_DRAIN) { E(acc, cur, wr, wc, fr, fq); S.done(cur); }
        PG8_STAMP();
        if (!has_next) break;
#pragma unroll
        for (int a = 0; a < 2; ++a)
#pragma unroll
            for (int b = 0; b < 2; ++b)
#pragma unroll
                for (int m = 0; m < 4; ++m)
#pragma unroll
                    for (int n = 0; n < 2; ++n) acc[a][b][m][n] = (f32x4){0.f, 0.f, 0.f, 0.f};
        cur = nxt; cA = nA; cB = nB; ++ui;
    }
    PG8_WAIT_V(0);
    if (wr == 0) PG8_BAR;
    PG8_BAR;
    if constexpr (Epi::AFTER_DRAIN) { E.fused(acc, cur, wr, wc, fr, fq, lds, wid, lane); S.done(cur); }
    PG8_STAMP();
    if (STAMP && wid == 0) { stamps[lane] = lane < nts ? (((unsigned long long)(unsigned)ts_hi << 32) | (unsigned)ts_lo) : 0ull;
        if (lane == 62) stamps[62] = rt_entry; if (lane == 63) stamps[63] = (unsigned long long)wall_clock64(); }
#undef PG8_STAMP
#undef PG8_SA
#undef PG8_SB
#undef PG8_STAGE
#undef PG8_LDA
#undef PG8_LDB
#undef PG8_MMA
#undef PG8_WAIT_V
#undef PG8_WAIT_L
#undef PG8_BAR
#undef PG8_SCHED
}
}

struct Cplx { float re, im; };
__device__ __forceinline__ Cplx cmul(Cplx a, Cplx b) { return {a.re * b.re - a.im * b.im, a.re * b.im + a.im * b.re}; }
__device__ __forceinline__ Cplx apow(float are, float aim, float dt, float m) {
  float mag = __expf(m * dt * are);
  float s, c;
  sincos_rev(m * dt * aim, s, c);
  return {mag * c, mag * s};
}
__device__ __forceinline__ Cplx bscale(float are, float aim, float dt) {
  Cplx ab = apow(are, aim, dt, 1.f);
  float nr = ab.re - 1.f, ni = ab.im;
  float den = are * are + aim * aim;
  return {(nr * are + ni * aim) / den, (ni * are - nr * aim) / den};
}

__device__ __forceinline__ void convert_tables(const Params& p, int gw, int GWv) {
  const int lane = tidx() & 63;
  auto ldrow = [&](int row, float4 (&v)[4]) {
    const int rc = row < 2 * 16384 ? row : 2 * 16384 - 1;
    const bool isU = rc < 16384;
    const int e = isU ? rc : rc - 16384;
    const float* src = (isU ? p.peer_u : p.peer_v) + (size_t)e * 1024 + lane * 16;
#pragma unroll
    for (int i = 0; i < 4; ++i) v[i] = ((const float4*)src)[i];
  };
  auto cvrow = [&](int row, const float4 (&v)[4]) {
    const bool isU = row < 16384;
    const int e = isU ? row : row - 16384;
    float am = 0.f;
#pragma unroll
    for (int i = 0; i < 4; ++i) am = fmaxf(am, fmaxf(fmaxf(fabsf(v[i].x), fabsf(v[i].y)), fmaxf(fabsf(v[i].z), fabsf(v[i].w))));
#pragma unroll
    for (int o = 32; o >= 1; o >>= 1) am = fmaxf(am, __shfl_xor(am, o));
    int E = (int)((__float_as_uint(am) >> 23) & 0xffu) - 127;
    E = E < -60 ? -60 : E;
    const int k = 7 - E;
    const float sc = __uint_as_float((unsigned)(k + 127) << 23);
    unsigned w[4];
#pragma unroll
    for (int i = 0; i < 4; ++i) {
      int pk = 0;
      pk = __builtin_amdgcn_cvt_pk_fp8_f32(v[i].x * sc, v[i].y * sc, pk, false);
      pk = __builtin_amdgcn_cvt_pk_fp8_f32(v[i].z * sc, v[i].w * sc, pk, true);
      w[i] = (unsigned)pk;
    }
    unsigned char* dst = (isU ? p.U8() : p.V8()) + ((size_t)(lane >> 3) * 16384 + e) * 128 + (lane & 7) * 16;
    *(uint4*)dst = make_uint4(w[0], w[1], w[2], w[3]);
    if (lane == 0) {
      ((unsigned short*)p.USC())[e * 2 + (isU ? 0 : 1)] = (unsigned short)(127 - k);
    }
  };
  if (gw >= 2 * 16384) return;
  float4 b0[4], b1[4], c[4];
  ldrow(gw, b0);
  ldrow(gw + GWv, b1);
  for (int row = gw; row < 2 * 16384; row += 2 * GWv) {
#pragma unroll
    for (int i = 0; i < 4; ++i) c[i] = b0[i];
    ldrow(row + 2 * GWv, b0);
    cvrow(row, c);
    if (row + GWv < 2 * 16384) {
#pragma unroll
      for (int i = 0; i < 4; ++i) c[i] = b1[i];
      ldrow(row + 3 * GWv, b1);
      cvrow(row + GWv, c);
    }
  }
}

__device__ __forceinline__ void tr_cvt(const float* __restrict__ W, bf16_t* __restrict__ Wt, int K, int N, int Npad, size_t gt, size_t GT) {
  size_t tot = (size_t)K * Npad;
  for (size_t i = gt; i < tot; i += GT) {
    int n = (int)(i / K), k = (int)(i % K);
    Wt[i] = (n < N) ? f2bf(W[(size_t)k * N + n]) : (bf16_t)0;
  }
}
__device__ __forceinline__ void cvt_flat(const float* __restrict__ W, bf16_t* __restrict__ Wb, size_t n4, size_t gt, size_t GT) {
  for (size_t i = gt; i < n4; i += GT) {
    float4 v = ((const float4*)W)[i];
    ((uint2*)Wb)[i] = make_uint2(pk2(v.x, v.y), pk2(v.z, v.w));
  }
}
__device__ __forceinline__ void phase0(const Params& p, char* smem) {
  if (blockIdx.x < 8) {
    float* red = (float*)smem;
    const int h = blockIdx.x, tid = tidx(), d = tid & 63, c0 = (tid >> 6) * 32;
    float v[32];
    float am = 0.f;
#pragma unroll
    for (int i = 0; i < 32; ++i) { v[i] = p.w_uk[(size_t)(c0 + i) * 512 + h * 64 + d]; am = fmaxf(am, fabsf(v[i])); }
#pragma unroll
    for (int o = 32; o >= 1; o >>= 1) am = fmaxf(am, __shfl_xor(am, o));
    if ((tid & 63) == 0) red[tid >> 6] = am;
    __syncthreads();
    am = red[0];
#pragma unroll
    for (int i = 1; i < 8; ++i) am = fmaxf(am, red[i]);
    int E = (int)((__float_as_uint(am) >> 23) & 0xffu) - 127;
    E = E < -60 ? -60 : E;
    const int k = 7 - E;
    const float sc = __uint_as_float((unsigned)(k + 127) << 23);
    unsigned w[8];
#pragma unroll
    for (int i = 0; i < 8; ++i) {
      int pk = 0;
      pk = __builtin_amdgcn_cvt_pk_fp8_f32(v[4 * i] * sc, v[4 * i + 1] * sc, pk, false);
      pk = __builtin_amdgcn_cvt_pk_fp8_f32(v[4 * i + 2] * sc, v[4 * i + 3] * sc, pk, true);
      w[i] = (unsigned)pk;
    }
    unsigned char* dst = p.W8T() + (size_t)(h * 64 + d) * 256 + c0;
    *(uint4*)dst = make_uint4(w[0], w[1], w[2], w[3]);
    *(uint4*)(dst + 16) = make_uint4(w[4], w[5], w[6], w[7]);
    if (tid == 0) p.KW()[h] = k;
    __syncthreads();
  }
  const size_t gt = (size_t)blockIdx.x * NTHR + tidx(), GT = (size_t)gridDim.x * NTHR;
  {
    const int lane = tidx() & 63, wave = tidx() >> 6;
    float* tl = (float*)smem + wave * (64 * 65);
    const int woff = gridDim.x > 8 ? 64 : 0;
    const int gwv = blockIdx.x * 8 + wave - woff, GWv = gridDim.x * 8 - woff;
    for (int t = gwv; t < 1480 && gwv >= 0; t += GWv) {
      const float* W; bf16_t* Wt; int K, N, tk, mode, tt;
      if (t < 320)       { W = p.w_in;    Wt = p.WinT();  K = 1024; N = INW;  tk = 16; mode = 0; tt = t; }
      else if (t < 392)  { W = p.w_uq;    Wt = p.WuqT();  K = 384;  N = 768;  tk = 6;  mode = 0; tt = t - 320; }
      else if (t < 424)  { W = p.w_uk;    Wt = p.WukT();  K = 256;  N = 512;  tk = 4;  mode = 0; tt = t - 392; }
      else if (t < 456)  { W = p.w_uv;    Wt = p.WuvT();  K = 256;  N = 512;  tk = 4;  mode = 0; tt = t - 424; }
      else if (t < 584)  { W = p.w_glu;   Wt = p.WgluT(); K = 512;  N = 1024; tk = 8;  mode = 1; tt = t - 456; }
      else if (t < 712)  { W = p.w_glu;   Wt = p.WgluS(); K = 512;  N = 1024; tk = 8;  mode = 2; tt = t - 584; }
      else if (t < 968)  { W = p.w_out;   Wt = p.WoutT(); K = 1024; N = 1024; tk = 16; mode = 0; tt = t - 712; }
      else               { W = p.peer_wq; Wt = p.WpqT();  K = 1024; N = 2048; tk = 16; mode = 0; tt = t - 968; }
      const int k0 = (tt % tk) * 64, n0 = (tt / tk) * 64;
      const int n = n0 + lane;
      int sn = n;
      if (mode == 1) sn = ((n & 255) >> 7) * 512 + (n >> 8) * 128 + (n & 127);
      if (mode == 2) sn = (((n & 63) >> 5)) * 512 + (n >> 7) * 64 + (((n & 127) >> 6)) * 32 + (n & 31);
      const bool okn = n < N;
      const float* wp = W + (size_t)k0 * N + (okn ? sn : 0);
#pragma unroll
      for (int rb = 0; rb < 64; rb += 16) {
        float v[16];
#pragma unroll
        for (int r = 0; r < 16; ++r) v[r] = wp[(size_t)(rb + r) * N];
#pragma unroll
        for (int r = 0; r < 16; ++r) tl[lane * 65 + rb + r] = okn ? v[r] : 0.f;
      }
      const int kl = (lane & 31) * 2, nh = lane >> 5;
#pragma unroll 8
      for (int i = 0; i < 32; ++i) {
        const int nl = 2 * i + nh;
        *(unsigned*)(Wt + (size_t)(n0 + nl) * K + k0 + kl) = pk2(tl[nl * 65 + kl], tl[nl * 65 + kl + 1]);
      }
    }
  }
  cvt_flat(p.peer_keys, p.PK(), 2 * 128 * 128 / 4, gt, GT);
  {
    size_t tot = (size_t)32 * 128 * 256 / 8;
    for (size_t i = gt; i < tot; i += GT) {
      int g = (int)(i / (128 * 32)), rem = (int)(i % (128 * 32)), n = rem / 32, c8 = rem % 32;
      *(uint4*)(p.A2() + ((size_t)g * NSUB + 1024 + n) * A2LD + c8 * 8) = make_uint4(0, 0, 0, 0);
    }
  }
  {
    size_t tot = (size_t)32 * 16 * 256;
    float* xs = (float*)smem;
    __syncthreads();
    for (size_t base = (size_t)blockIdx.x * NTHR; base < tot; base += GT) {
      const int tid = tidx();
      const int g = (int)(base / 4096), m0 = (int)((base % 4096) >> 8);
      if (tid < 128) {
        const int mm = tid >> 6, pp = tid & 63;
        float dt = __expf(p.log_dt[g]);
        float are = p.a_re[g * 64 + pp], aim = p.a_im[g * 64 + pp];
        Cplx x = cmul(apow(are, aim, dt, (float)(m0 + mm)), bscale(are, aim, dt));
        xs[(mm * 64 + pp) * 2] = x.re; xs[(mm * 64 + pp) * 2 + 1] = x.im;
      }
      __syncthreads();
      const int mm = tid >> 8, m = m0 + mm, h = (tid >> 4) & 15, h2 = tid & 15;
      float acc = 0.f;
#pragma unroll 4
      for (int pp = 0; pp < 64; ++pp) {
        Cplx ab = {xs[(mm * 64 + pp) * 2], xs[(mm * 64 + pp) * 2 + 1]};
        Cplx bb = {p.ssm_b[((g * 64 + pp) * 16 + h2) * 2], p.ssm_b[((g * 64 + pp) * 16 + h2) * 2 + 1]};
        Cplx cc = {p.ssm_c[((g * 16 + h) * 64 + pp) * 2], p.ssm_c[((g * 16 + h) * 64 + pp) * 2 + 1]};
        Cplx x = cmul(ab, bb);
        acc += cc.re * x.re - cc.im * x.im;
      }
      if (m == 0 && h == h2) acc += p.ssm_d[g * 16 + h];
      bf16_t v = f2bf(acc);
      for (int t = m; t < 16; ++t) {
        int j = t - m;
        p.Bt2()[((size_t)g * 256 + t * 16 + h) * A2LD + j * 16 + h2] = v;
      }
      if (m == 0) {
        for (int t = 0; t < 16; ++t)
          for (int j = t + 1; j < 16; ++j) p.Bt2()[((size_t)g * 256 + t * 16 + h) * A2LD + j * 16 + h2] = 0;
      }
      __syncthreads();
    }
    tot = (size_t)32 * 256 * 64;
    for (size_t i = gt; i < tot; i += GT) {
      int g = (int)(i / 16384), rem = (int)(i % 16384), th = rem >> 6, pp = rem & 63, t = th >> 4, h = th & 15;
      float dt = __expf(p.log_dt[g]);
      float are = p.a_re[g * 64 + pp], aim = p.a_im[g * 64 + pp];
      Cplx am = apow(are, aim, dt, (float)(t + 1));
      Cplx cc = {p.ssm_c[((g * 16 + h) * 64 + pp) * 2], p.ssm_c[((g * 16 + h) * 64 + pp) * 2 + 1]};
      p.Bt2()[((size_t)g * 256 + th) * A2LD + 256 + pp] = f2bf(cc.re * am.re - cc.im * am.im);
      p.Bt2()[((size_t)g * 256 + th) * A2LD + 320 + pp] = f2bf(-(cc.re * am.im + cc.im * am.re));
    }
    tot = (size_t)32 * 64 * 256;
    for (size_t i = gt; i < tot; i += GT) {
      int g = (int)(i / 16384), rem = (int)(i % 16384), pp = rem >> 8, jh = rem & 255, j = jh >> 4, h2 = jh & 15;
      float dt = __expf(p.log_dt[g]);
      float are = p.a_re[g * 64 + pp], aim = p.a_im[g * 64 + pp];
      Cplx am = apow(are, aim, dt, (float)(15 - j));
      Cplx bs = bscale(are, aim, dt);
      Cplx bb = {p.ssm_b[((g * 64 + pp) * 16 + h2) * 2], p.ssm_b[((g * 64 + pp) * 16 + h2) * 2 + 1]};
      Cplx x = cmul(cmul(am, bs), bb);
      p.Emat()[((size_t)g * 128 + pp) * 256 + jh] = f2bf(x.re);
      p.Emat()[((size_t)g * 128 + 64 + pp) * 256 + jh] = f2bf(x.im);
    }
  }
}

template <bool FP8OUT, bool SRCBF = false>
__device__ __forceinline__ void phase_rmsnorm(const float* __restrict__ srcP, const float* __restrict__ srcS, const float* __restrict__ gain,
                              bf16_t* __restrict__ dst, unsigned char* __restrict__ dst8, int* __restrict__ xsc) {
  const int lane = tidx() & 63, gw = blockIdx.x * 8 + (tidx() >> 6), GW = gridDim.x * 8;
  float4 g[4];
#pragma unroll
  for (int i = 0; i < 4; ++i) g[i] = *(const float4*)(gain + lane * 4 + 256 * i);
  if (gw >= NT) return;
  float4 nx[4];
  uint2 nxb[4];
#define RN_LOAD(R_) do { const int rr_ = (R_); \
    if constexpr (SRCBF) { const bf16_t* s_ = (rr_ < NP) ? (const bf16_t*)srcP + (size_t)rr_ * 1024 : (const bf16_t*)srcS + (size_t)(rr_ - NP) * 1024; \
      _Pragma("unroll") for (int i = 0; i < 4; ++i) nxb[i] = *(const uint2*)(s_ + lane * 4 + 256 * i); } \
    else { const float* s_ = (rr_ < NP) ? srcP + (size_t)rr_ * 1024 : srcS + (size_t)(rr_ - NP) * 1024; \
      _Pragma("unroll") for (int i = 0; i < 4; ++i) nx[i] = *(const float4*)(s_ + lane * 4 + 256 * i); } } while (0)
  RN_LOAD(gw);
  for (int r = gw; r < NT; r += GW) {
    float4 v[4];
    float ss = 0.f;
#pragma unroll
    for (int i = 0; i < 4; ++i) {
      if constexpr (SRCBF) v[i] = make_float4(bflo(nxb[i].x), bfhi(nxb[i].x), bflo(nxb[i].y), bfhi(nxb[i].y));
      else v[i] = nx[i];
    }
    RN_LOAD(r + GW < NT ? r + GW : r);
#pragma unroll
    for (int i = 0; i < 4; ++i) ss += v[i].x * v[i].x + v[i].y * v[i].y + v[i].z * v[i].z + v[i].w * v[i].w;
    ss = wave_sum(ss);
    float rinv = rsqrtf(ss * (1.f / 1024.f) + EPS);
#pragma unroll
    for (int i = 0; i < 4; ++i) {
      uint2 o = make_uint2(pk2(v[i].x * rinv * g[i].x, v[i].y * rinv * g[i].y), pk2(v[i].z * rinv * g[i].z, v[i].w * rinv * g[i].w));
      *(uint2*)(dst + (size_t)r * 1024 + lane * 4 + 256 * i) = o;
    }
    if constexpr (FP8OUT) {
      float am = 0.f;
#pragma unroll
      for (int i = 0; i < 4; ++i) {
        v[i].x *= rinv * g[i].x; v[i].y *= rinv * g[i].y; v[i].z *= rinv * g[i].z; v[i].w *= rinv * g[i].w;
        am = fmaxf(am, fmaxf(fmaxf(fabsf(v[i].x), fabsf(v[i].y)), fmaxf(fabsf(v[i].z), fabsf(v[i].w))));
      }
#pragma unroll
      for (int o = 32; o >= 1; o >>= 1) am = fmaxf(am, __shfl_xor(am, o));
      int E = (int)((__float_as_uint(am) >> 23) & 0xffu) - 127;
      E = E < -60 ? -60 : E;
      const int k = 7 - E;
      const float sc = __uint_as_float((unsigned)(k + 127) << 23);
#pragma unroll
      for (int i = 0; i < 4; ++i) {
        int pk = 0;
        pk = __builtin_amdgcn_cvt_pk_fp8_f32(v[i].x * sc, v[i].y * sc, pk, false);
        pk = __builtin_amdgcn_cvt_pk_fp8_f32(v[i].z * sc, v[i].w * sc, pk, true);
        *(unsigned*)(dst8 + (size_t)r * 1024 + lane * 4 + 256 * i) = (unsigned)pk;
      }
      if (lane == 0) xsc[r] = 127 - k;
    }
  }
}

struct StZ { bf16_t* Z; __device__ __forceinline__ void st8(int row, int col, pg8::f32x4 a, pg8::f32x4 b) const {
    if (col < INW) *(uint4*)(Z + (unsigned)(row * INW + col)) = make_uint4(pk2(a[0], a[1]), pk2(a[2], a[3]), pk2(b[0], b[1]), pk2(b[2], b[3])); } };
struct StF32 { float* C; int ldc; __device__ __forceinline__ void st4(int row, int col, pg8::f32x4 v) const { *(pg8::f32x4*)(C + (unsigned)(row * ldc + col)) = v; } };
struct StBf16 { bf16_t* C; int ldc; __device__ __forceinline__ void st8(int row, int col, pg8::f32x4 a, pg8::f32x4 b) const {
    *(uint4*)(C + (unsigned)(row * ldc + col)) = make_uint4(pk2(a[0], a[1]), pk2(a[2], a[3]), pk2(b[0], b[1]), pk2(b[2], b[3])); } };
struct StX1 { bf16_t* C; const float* x; __device__ __forceinline__ void st8(int row, int col, pg8::f32x4 a, pg8::f32x4 b) const {
    const unsigned o = (unsigned)(row * 1024 + col); const pg8::f32x4 xa = *(const pg8::f32x4*)(x + o) + a, xb = *(const pg8::f32x4*)(x + o + 4) + b;
    *(uint4*)(C + o) = make_uint4(pk2(xa[0], xa[1]), pk2(xa[2], xa[3]), pk2(xb[0], xb[1]), pk2(xb[2], xb[3])); } };
__device__ __forceinline__ void phase_rmsnorm_x1(const bf16_t* __restrict__ src, const float* __restrict__ gain, bf16_t* __restrict__ dst,
                                                 unsigned char* __restrict__ dst8, int* __restrict__ xsc) {
  const int lane = tidx() & 63, gw = blockIdx.x * 8 + (tidx() >> 6), GW = gridDim.x * 8;
  float g[16];
#pragma unroll
  for (int i = 0; i < 2; ++i) {
    const float4 a = *(const float4*)(gain + lane * 8 + 512 * i), b = *(const float4*)(gain + lane * 8 + 512 * i + 4);
    g[i * 8 + 0] = a.x; g[i * 8 + 1] = a.y; g[i * 8 + 2] = a.z; g[i * 8 + 3] = a.w; g[i * 8 + 4] = b.x; g[i * 8 + 5] = b.y; g[i * 8 + 6] = b.z; g[i * 8 + 7] = b.w;
  }
  if (gw >= NT) return;
  uint4 n0 = *(const uint4*)(src + (size_t)gw * 1024 + lane * 8), n1 = *(const uint4*)(src + (size_t)gw * 1024 + 512 + lane * 8);
  for (int r = gw; r < NT; r += GW) {
    const uint4 c0 = n0, c1 = n1;
    {
      const int rn = r + GW < NT ? r + GW : r;
      n0 = *(const uint4*)(src + (size_t)rn * 1024 + lane * 8); n1 = *(const uint4*)(src + (size_t)rn * 1024 + 512 + lane * 8);
    }
    float v[16] = {bflo(c0.x), bfhi(c0.x), bflo(c0.y), bfhi(c0.y), bflo(c0.z), bfhi(c0.z), bflo(c0.w), bfhi(c0.w),
                   bflo(c1.x), bfhi(c1.x), bflo(c1.y), bfhi(c1.y), bflo(c1.z), bfhi(c1.z), bflo(c1.w), bfhi(c1.w)};
    float ss = 0.f;
#pragma unroll
    for (int k = 0; k < 16; ++k) ss += v[k] * v[k];
    ss = wave_sum(ss);
    const float rinv = rsqrtf(ss * (1.f / 1024.f) + EPS);
    float am = 0.f;
#pragma unroll
    for (int k = 0; k < 16; ++k) { v[k] *= rinv * g[k]; am = fmaxf(am, fabsf(v[k])); }
#pragma unroll
    for (int i = 0; i < 2; ++i)
      *(uint4*)(dst + (size_t)r * 1024 + 512 * i + lane * 8) = make_uint4(pk2(v[i * 8], v[i * 8 + 1]), pk2(v[i * 8 + 2], v[i * 8 + 3]), pk2(v[i * 8 + 4], v[i * 8 + 5]), pk2(v[i * 8 + 6], v[i * 8 + 7]));
#pragma unroll
    for (int o = 32; o >= 1; o >>= 1) am = fmaxf(am, __shfl_xor(am, o));
    int E = (int)((__float_as_uint(am) >> 23) & 0xffu) - 127;
    E = E < -60 ? -60 : E;
    const int k = 7 - E;
    const float sc = __uint_as_float((unsigned)(k + 127) << 23);
#pragma unroll
    for (int i = 0; i < 2; ++i) {
      int p0 = 0, p1 = 0;
      p0 = __builtin_amdgcn_cvt_pk_fp8_f32(v[i * 8] * sc, v[i * 8 + 1] * sc, p0, false);
      p0 = __builtin_amdgcn_cvt_pk_fp8_f32(v[i * 8 + 2] * sc, v[i * 8 + 3] * sc, p0, true);
      p1 = __builtin_amdgcn_cvt_pk_fp8_f32(v[i * 8 + 4] * sc, v[i * 8 + 5] * sc, p1, false);
      p1 = __builtin_amdgcn_cvt_pk_fp8_f32(v[i * 8 + 6] * sc, v[i * 8 + 7] * sc, p1, true);
      *(uint2*)(dst8 + (size_t)r * 1024 + 512 * i + lane * 8) = make_uint2((unsigned)p0, (unsigned)p1);
    }
    if (lane == 0) xsc[r] = 127 - k;
  }
}
template <class Epi>
__device__ __forceinline__ void big_gemm(const bf16_t* A, const bf16_t* Bt, int M, int N, int K, char* smem, const Epi& E) {
  pg8::Gemm g{A, Bt, M, N, K};
  pg8::StaticOrder S;
  S.init(M, N, (int)gridDim.x, (int)blockIdx.x);
  pg8::gemm_phase<Epi, pg8::StaticOrder, false>((PG8_LAS unsigned char*)smem, g, S, E, nullptr);
}
__device__ __forceinline__ void phase_gemm_z(const Params& p, char* smem) {
  bf16_t* Z = (bf16_t*)p.Z();
  for (int t = blockIdx.x; t < 8 * 10; t += gridDim.x) {
    int tm = t / 10, tn = t % 10;
    gemm_tile<2, 4, 1, 1>(p.XN(), 1024, p.WinT(), 1024, 1024, NP + tm * 64, tn * 128, smem, [=](int m, int n, float v) {
      if (n < INW) Z[(size_t)m * INW + n] = f2bf(v);
    });
  }
  big_gemm(p.XN(), p.WinT(), NP, 1280, 1024, smem, pg8::EpiFn<true, StZ>{StZ{Z}});
  if (gridDim.x > 64) {
    if (blockIdx.x >= 64) convert_tables(p, (blockIdx.x - 64) * 8 + (tidx() >> 6), (gridDim.x - 64) * 8);
  } else {
    convert_tables(p, blockIdx.x * 8 + (tidx() >> 6), gridDim.x * 8);
  }
}

__device__ __forceinline__ void phase_post1(const Params& p) {
  const int lane = tidx() & 63, gw = blockIdx.x * 8 + (tidx() >> 6), GW = gridDim.x * 8;
  if (gw >= NT) return;
  typedef unsigned u32x3 __attribute__((ext_vector_type(3)));
  uint4 n_u; uint2 n_kvb; u32x3 n_cb; bf16_t n_krb;
#define P1_LOAD(R_) do { const bf16_t* z_ = (const bf16_t*)p.Z() + (size_t)(R_) * INW; \
    n_u = *(const uint4*)(z_ + lane * 8); \
    n_cb = *(const u32x3*)(z_ + 512 + lane * 6); \
    n_kvb = *(const uint2*)(z_ + 896 + lane * 4); n_krb = z_[1152 + (lane & 31)]; } while (0)
  float gq6[6];
#pragma unroll
  for (int e = 0; e < 6; ++e) gq6[e] = p.norm_q_lora[lane * 6 + e];
  const float4 gkv4 = *(const float4*)(p.norm_kv_lora + lane * 4);
  const float gkr1 = (lane < 32) ? p.g_kr[lane] : 0.f;
  const float ropeinv = exp2f(-(float)(lane & 15) * (13.287712379549449f / 16.f));
  P1_LOAD(gw);
  for (int r = gw; r < NT; r += GW) {
    const bool isP = r < NP;
    const int rs = r - NP;
    const uint4 c_u = n_u;
    const float4 c_kv = make_float4(bflo(n_kvb.x), bfhi(n_kvb.x), bflo(n_kvb.y), bfhi(n_kvb.y));
    const float2 c_c[3] = {make_float2(bflo(n_cb[0]), bfhi(n_cb[0])), make_float2(bflo(n_cb[1]), bfhi(n_cb[1])), make_float2(bflo(n_cb[2]), bfhi(n_cb[2]))};
    const float c_kr = __uint_as_float((unsigned)n_krb << 16);
    P1_LOAD(r + GW < NT ? r + GW : r);
    {
      int g = lane >> 1, h0 = (lane & 1) * 8;
      int n = isP ? (r >> 4) : (1024 + (rs >> 2));
      int t = isP ? (r & 15) : (rs & 3);
      *(uint4*)(p.A2() + ((size_t)g * NSUB + n) * A2LD + t * 16 + h0) = c_u;
    }
    {
      float2 v[3];
      float ss = 0.f;
#pragma unroll
      for (int i = 0; i < 3; ++i) {
        v[i] = c_c[i];
        ss += v[i].x * v[i].x + v[i].y * v[i].y;
      }
      ss = wave_sum(ss);
      float rinv = rsqrtf(ss * (1.f / 384.f) + EPS);
      u32x3 oq;
#pragma unroll
      for (int i = 0; i < 3; ++i) oq[i] = pk2(v[i].x * rinv * gq6[2 * i], v[i].y * rinv * gq6[2 * i + 1]);
      *(u32x3*)(p.CQN() + (size_t)r * 384 + lane * 6) = oq;
    }
    {
      float4 v = c_kv;
      float ss = wave_sum(v.x * v.x + v.y * v.y + v.z * v.z + v.w * v.w);
      float rinv = rsqrtf(ss * (1.f / 256.f) + EPS);
      const float4 g = gkv4;
      float4 o = make_float4(v.x * rinv * g.x, v.y * rinv * g.y, v.z * rinv * g.z, v.w * rinv * g.w);
      float* dst = isP ? p.out + O_LATP + (size_t)r * 256 : p.out + O_LATS + (size_t)rs * 256;
      *(float4*)(dst + lane * 4) = o;
      *(uint2*)(p.CKV() + (size_t)r * 256 + lane * 4) = make_uint2(pk2(o.x, o.y), pk2(o.z, o.w));
    }
    {
      float v = (lane < 32) ? c_kr : 0.f;
      float ss = wave_sum(v * v);
      float rinv = rsqrtf(ss * (1.f / 32.f) + EPS);
      float xv = v * rinv * gkr1;
      float other = __shfl_xor(xv, 16);
      int i = lane & 15;
      float pos = isP ? (float)(r & 4095) : (float)(8192 + (rs & 3));
      float sn, cs;
      sincos_rev(pos * ropeinv, sn, cs);
      float o = (lane & 16) ? (xv * cs + other * sn) : (xv * cs - other * sn);
      if (lane < 32) {
        float* dst = isP ? p.out + O_KRP + (size_t)r * 32 : p.out + O_KRS + (size_t)rs * 32;
        dst[lane] = o;
        bf16_t ob = f2bf(o);
        if (isP) {
          int b = r >> 12, t = r & 4095;
#pragma unroll
          for (int h = 0; h < 8; ++h) p.Kcat()[((size_t)(b * 8 + h) * 4096 + t) * 96 + 64 + lane] = ob;
        } else {
          int seq = rs >> 2, t = rs & 3;
#pragma unroll
          for (int h = 0; h < 8; ++h) p.KcatS()[((size_t)(seq * 8 + h) * 4 + t) * 96 + 64 + lane] = ob;
        }
      }
    }
  }
}

__device__ __forceinline__ void phase_gemm4(const Params& p, char* smem) {
  const int ns = 32 * 9, nq = 8 * 6, nk = 8 * 4;
  int t0 = blockIdx.x, tcnt = (ns + nq + nk - (int)blockIdx.x + (int)gridDim.x - 1) / (int)gridDim.x, tstr = gridDim.x;
  if (gridDim.x == 256) {
    if (blockIdx.x >= 192) { t0 = ((int)blockIdx.x - 192) * 3; tcnt = 3; tstr = 1; }
    else if (blockIdx.x < 176) { t0 = 192 + (int)blockIdx.x; tcnt = 1; tstr = 1; }
    else tcnt = 0;
  }
  for (int ti = 0; ti < tcnt; ++ti) {
    const int t = t0 + ti * tstr;
    if (t < ns) {
      int g = t / 9, tm = t % 9;
      float* C = p.S() + (size_t)g * NSUB * 128;
      gemm_tile<4, 2, 1, 2>(p.A2() + (size_t)g * NSUB * A2LD, A2LD, p.Emat() + (size_t)g * 128 * 256, 256, 256, tm * 128, 0, smem,
                            [=](int m, int n, float v) { C[(size_t)m * 128 + n] = v; });
    } else if (t < ns + nq) {
      int u = t - ns, tm = u / 6, tn = u % 6;
      bf16_t* C = (bf16_t*)p.Qraw();
      gemm_tile<2, 4, 1, 1>(p.CQN(), 384, p.WuqT(), 384, 384, NP + tm * 64, tn * 128, smem, [=](int m, int n, float v) { C[(size_t)m * 768 + n] = f2bf(v); });
    } else {
      int u = t - ns - nq, tm = u / 4, tn = u % 4;
      bf16_t* C = (bf16_t*)p.KNraw();
      gemm_tile<2, 4, 1, 1>(p.CKV(), 256, p.WukT(), 256, 256, NP + tm * 64, tn * 128, smem, [=](int m, int n, float v) { C[(size_t)m * 512 + n] = f2bf(v); });
    }
  }
  big_gemm(p.CQN(), p.WuqT(), NP, 768, 384, smem, pg8::EpiFn<true, StBf16>{StBf16{(bf16_t*)p.Qraw(), 768}});
  big_gemm(p.CKV(), p.WukT(), NP, 512, 256, smem, pg8::EpiFn<true, StBf16>{StBf16{(bf16_t*)p.KNraw(), 512}});
  {
    pg8::Gemm g{p.WuvT(), p.CKV(), 512, NP, 256};
    pg8::StaticOrder S;
    S.init(512, NP, (int)gridDim.x, (int)((blockIdx.x + gridDim.x / 2) % gridDim.x));
    pg8::EpiFn<true, StBf16> E{StBf16{p.VT(), NP}};
    pg8::gemm_phase<pg8::EpiFn<true, StBf16>, pg8::StaticOrder, false>((PG8_LAS unsigned char*)smem, g, S, E, nullptr);
  }
}

__device__ __forceinline__ float sum8(float v) {
  v += __shfl_xor(v, 1); v += __shfl_xor(v, 2); v += __shfl_xor(v, 4);
  return v;
}
__device__ __forceinline__ void ssm_scan_prompt(const Params& p, int job);
__device__ __forceinline__ void ssm_sample(const Params& p, int job);
__device__ __forceinline__ void phase_post2(const Params& p) {
  const int lane = tidx() & 63, gw = blockIdx.x * 8 + (tidx() >> 6), GW = gridDim.x * 8;
  if (gw < 128) { ssm_scan_prompt(p, gw); }
  for (int j = gw; j < 4096; j += GW) ssm_sample(p, j);
  if (gw < 128) return;
  const int h = lane >> 3, a8 = lane & 7;
  float gq[8], gk[8], gr[4], inv[4];
#pragma unroll
  for (int e = 0; e < 8; ++e) { gq[e] = p.g_qn[a8 * 8 + e] * QSCALE; gk[e] = p.g_kn[a8 * 8 + e]; }
#pragma unroll
  for (int e = 0; e < 4; ++e) {
    gr[e] = p.g_qr[a8 * 4 + e] * QSCALE;
    inv[e] = exp2f(-(float)((a8 & 3) * 4 + e) * (13.287712379549449f / 16.f));
  }
  if (gw - 128 >= NT) return;
  uint4 n_x, n_k; uint2 n_w;
#define P2_LOAD(R_) do { const bf16_t* q_ = (const bf16_t*)p.Qraw() + (size_t)(R_) * 768 + h * 96; const bf16_t* kn_ = (const bf16_t*)p.KNraw() + (size_t)(R_) * 512 + h * 64 + a8 * 8; \
    n_x = *(const uint4*)(q_ + a8 * 8); n_w = *(const uint2*)(q_ + 64 + a8 * 4); n_k = *(const uint4*)kn_; } while (0)
  P2_LOAD(gw - 128);
  for (int r = gw - 128; r < NT; r += GW - 128) {
    const bool isP = r < NP;
    const int rs = r - NP;
    const float pos = isP ? (float)(r & 4095) : (float)(8192 + (rs & 3));
    const float4 c_x0 = make_float4(bflo(n_x.x), bfhi(n_x.x), bflo(n_x.y), bfhi(n_x.y)), c_x1 = make_float4(bflo(n_x.z), bfhi(n_x.z), bflo(n_x.w), bfhi(n_x.w));
    const float4 c_w = make_float4(bflo(n_w.x), bfhi(n_w.x), bflo(n_w.y), bfhi(n_w.y));
    const float4 c_k0 = make_float4(bflo(n_k.x), bfhi(n_k.x), bflo(n_k.y), bfhi(n_k.y)), c_k1 = make_float4(bflo(n_k.z), bfhi(n_k.z), bflo(n_k.w), bfhi(n_k.w));
    P2_LOAD(r + GW - 128 < NT ? r + GW - 128 : r);
    float4 x0 = c_x0, x1 = c_x1;
    float ss = sum8(x0.x * x0.x + x0.y * x0.y + x0.z * x0.z + x0.w * x0.w + x1.x * x1.x + x1.y * x1.y + x1.z * x1.z + x1.w * x1.w);
    float ri = rsqrtf(ss * (1.f / 64.f) + EPS);
    bf16_t* qo = p.Qb() + ((size_t)r * 8 + h) * 96;
    *(uint4*)(qo + a8 * 8) = make_uint4(pk2(x0.x * ri * gq[0], x0.y * ri * gq[1]), pk2(x0.z * ri * gq[2], x0.w * ri * gq[3]),
                                         pk2(x1.x * ri * gq[4], x1.y * ri * gq[5]), pk2(x1.z * ri * gq[6], x1.w * ri * gq[7]));
    float4 w = c_w;
    float s2 = sum8(w.x * w.x + w.y * w.y + w.z * w.z + w.w * w.w);
    float r2 = rsqrtf(s2 * (1.f / 32.f) + EPS);
    float xv[4] = {w.x * r2 * gr[0], w.y * r2 * gr[1], w.z * r2 * gr[2], w.w * r2 * gr[3]};
    float ov[4];
#pragma unroll
    for (int e = 0; e < 4; ++e) {
      float other = __shfl_xor(xv[e], 4);
      float sn, cs;
      sincos_rev(pos * inv[e], sn, cs);
      ov[e] = (a8 & 4) ? (xv[e] * cs + other * sn) : (xv[e] * cs - other * sn);
    }
    *(uint2*)(qo + 64 + a8 * 4) = make_uint2(pk2(ov[0], ov[1]), pk2(ov[2], ov[3]));
    float4 k0 = c_k0, k1 = c_k1;
    float ks = sum8(k0.x * k0.x + k0.y * k0.y + k0.z * k0.z + k0.w * k0.w + k1.x * k1.x + k1.y * k1.y + k1.z * k1.z + k1.w * k1.w);
    float kri = rsqrtf(ks * (1.f / 64.f) + EPS);
    bf16_t* ko = isP ? p.Kcat() + ((size_t)((r >> 12) * 8 + h) * 4096 + (r & 4095)) * 96 : p.KcatS() + ((size_t)((rs >> 2) * 8 + h) * 4 + (rs & 3)) * 96;
    *(uint4*)(ko + a8 * 8) = make_uint4(pk2(k0.x * kri * gk[0], k0.y * kri * gk[1]), pk2(k0.z * kri * gk[2], k0.w * kri * gk[3]),
                                         pk2(k1.x * kri * gk[4], k1.y * kri * gk[5]), pk2(k1.z * kri * gk[6], k1.w * kri * gk[7]));
  }
}

__device__ __forceinline__ float softmax_bound(const Params& p) {
  const int lane = tidx() & 63;
  float a = fabsf(p.g_qn[lane]), b = fabsf(p.g_kn[lane]), c = fabsf(p.g_qr[lane & 31]), d = fabsf(p.g_kr[lane & 31]);
#pragma unroll
  for (int o = 32; o >= 1; o >>= 1) {
    a = fmaxf(a, __shfl_xor(a, o)); b = fmaxf(b, __shfl_xor(b, o));
    c = fmaxf(c, __shfl_xor(c, o)); d = fmaxf(d, __shfl_xor(d, o));
  }
  return QSCALE * (64.f * a * b + 32.f * c * d);
}

#define KLD 104
#define VLD 68
__device__ __forceinline__ void attn_prompt_block(const Params& p, char* smem, int b, int h, int qi, float Mb) {
  bf16_t* Ks = (bf16_t*)smem;
  bf16_t* Vs = Ks + 2 * 64 * KLD;
  const int tid = tidx(), lane = tid & 63, wave = tid >> 6, lr = lane & 31, hh = lane >> 5;
  const int q0 = qi * 256 + wave * 32;
  const bf16_t* Kg = p.Kcat() + (size_t)(b * 8 + h) * 4096 * 96;
  const bf16_t* Vg = p.VT() + (size_t)(h * 64) * NP + b * 4096;
  bf16x8 qf[6];
  {
    const bf16_t* qp = p.Qb() + ((size_t)(b * 4096 + q0 + lr) * 8 + h) * 96 + hh * 8;
#pragma unroll
    for (int s = 0; s < 6; ++s) qf[s] = *(const bf16x8*)(qp + s * 16);
  }
  f32x16 ot[2];
#pragma unroll
  for (int i = 0; i < 2; ++i)
#pragma unroll
    for (int r = 0; r < 16; ++r) ot[i][r] = 0.f;
  float lsum = 0.f;
  const int nkt = 4 * (qi + 1);
  uint4 kA0, kA1, kB0, kB1;
  uint2 vA0, vA1, vB0, vB1;
#define PA_GLOAD(kt_, k0r, k1r, v0r, v1r) do { const int k0_ = ((kt_) < nkt ? (kt_) : nkt - 1) * 64; \
    { int c = tid; int row = c / 12, cc = c % 12; k0r = *(const uint4*)(Kg + (size_t)(k0_ + row) * 96 + cc * 8); } \
    { int c = tid + NTHR; c = c < 768 ? c : 767; int row = c / 12, cc = c % 12; k1r = *(const uint4*)(Kg + (size_t)(k0_ + row) * 96 + cc * 8); } \
    { int c = tid, row = c >> 4, cc = c & 15; v0r = *(const uint2*)(Vg + (size_t)row * NP + k0_ + cc * 4); } \
    { int c = tid + NTHR, row = c >> 4, cc = c & 15; v1r = *(const uint2*)(Vg + (size_t)row * NP + k0_ + cc * 4); } } while (0)
#define PA_LSTORE(buf_, k0r, k1r, v0r, v1r) do { \
    { int c = tid; int row = c / 12, cc = c % 12; *(uint4*)(Ks + ((buf_) * 64 + row) * KLD + cc * 8) = k0r; } \
    { int c = tid + NTHR; if (c < 768) { int row = c / 12, cc = c % 12; *(uint4*)(Ks + ((buf_) * 64 + row) * KLD + cc * 8) = k1r; } } \
    { int c = tid, row = c >> 4, cc = c & 15; *(uint2*)(Vs + ((buf_) * 64 + row) * VLD + cc * 4) = v0r; } \
    { int c = tid + NTHR, row = c >> 4, cc = c & 15; *(uint2*)(Vs + ((buf_) * 64 + row) * VLD + cc * 4) = v1r; } } while (0)
  auto compute = [&](int kt, int buf) __attribute__((always_inline)) {
    const int k0 = kt * 64;
    if (k0 <= q0 + 31) {
      const bool need_mask = (k0 + 63 > q0);
      bf16x8 pb[2][2];
#pragma unroll
      for (int kt2 = 0; kt2 < 2; ++kt2) {
        f32x16 st;
#pragma unroll
        for (int r = 0; r < 16; ++r) st[r] = -Mb;
#pragma unroll
        for (int s = 0; s < 6; ++s) {
          bf16x8 a = *(const bf16x8*)(Ks + (buf * 64 + kt2 * 32 + lr) * KLD + s * 16 + hh * 8);
          st = mfma32(a, qf[s], st);
        }
        float pv[16];
#pragma unroll
        for (int r = 0; r < 16; ++r) {
          float e = __builtin_amdgcn_exp2f(st[r]);
          if (need_mask) {
            int key = k0 + kt2 * 32 + (r & 3) + 8 * (r >> 2) + 4 * hh;
            e = (key <= q0 + lr) ? e : 0.f;
          }
          pv[r] = e;
          lsum += e;
        }
#pragma unroll
        for (int s2 = 0; s2 < 2; ++s2)
          pb[kt2][s2] = mk8(pk2(pv[8 * s2 + 0], pv[8 * s2 + 1]), pk2(pv[8 * s2 + 2], pv[8 * s2 + 3]),
                            pk2(pv[8 * s2 + 4], pv[8 * s2 + 5]), pk2(pv[8 * s2 + 6], pv[8 * s2 + 7]));
      }
#pragma unroll
      for (int dt = 0; dt < 2; ++dt)
#pragma unroll
        for (int kt2 = 0; kt2 < 2; ++kt2)
#pragma unroll
          for (int s2 = 0; s2 < 2; ++s2) {
            const bf16_t* vp = Vs + (buf * 64 + dt * 32 + lr) * VLD + kt2 * 32 + 16 * s2 + 4 * hh;
            uint2 lo = *(const uint2*)vp, hi = *(const uint2*)(vp + 8);
            bf16x8 a = mk8(lo.x, lo.y, hi.x, hi.y);
            ot[dt] = mfma32(a, pb[kt2][s2], ot[dt]);
          }
    }
  };
  PA_GLOAD(0, kA0, kA1, vA0, vA1);
  PA_GLOAD(1, kB0, kB1, vB0, vB1);
  PA_LSTORE(0, kA0, kA1, vA0, vA1);
  PA_GLOAD(2, kA0, kA1, vA0, vA1);
  __syncthreads();
#pragma unroll 1
  for (int kt = 0; kt < nkt; kt += 2) {
    compute(kt, 0);
    PA_LSTORE(1, kB0, kB1, vB0, vB1);
    PA_GLOAD(kt + 3, kB0, kB1, vB0, vB1);
    __syncthreads();
    compute(kt + 1, 1);
    PA_LSTORE(0, kA0, kA1, vA0, vA1);
    PA_GLOAD(kt + 4, kA0, kA1, vA0, vA1);
    __syncthreads();
  }
  lsum += __shfl_xor(lsum, 32);
  const float linv = 1.f / lsum;
  bf16_t* op = p.CAT() + (size_t)(b * 4096 + q0 + lr) * 1024 + 512 + h * 64;
#pragma unroll
  for (int dt = 0; dt < 2; ++dt)
#pragma unroll
    for (int rg = 0; rg < 4; ++rg) {
      int d = dt * 32 + 8 * rg + 4 * hh;
      *(uint2*)(op + d) = make_uint2(pk2(ot[dt][4 * rg] * linv, ot[dt][4 * rg + 1] * linv), pk2(ot[dt][4 * rg + 2] * linv, ot[dt][4 * rg + 3] * linv));
    }
}

#define LLD 264
#define L8LD 272
#define KRLD 40
#define PLD 72
#define DEC_TILE_BYTES (64 * LLD * 2 + 64 * L8LD + 64 * KRLD * 2 + 256)
typedef __attribute__((ext_vector_type(8))) int i32x8;
__device__ __forceinline__ f32x16 mfma8(i32x8 a, i32x8 b, f32x16 c) {
  return __builtin_amdgcn_mfma_scale_f32_32x32x64_f8f6f4(a, b, c, 0, 0, 0, 127, 0, 127);
}
__device__ __forceinline__ void attn_decode_unit(const Params& p, char* smem, int seq, int half, float Mb) {
  const int tid = tidx(), lane = tid & 63, wave = tid >> 6, lr = lane & 31, hh = lane >> 5;
  const int hd = wave;
  bf16_t* Psh = (bf16_t*)(smem + 2 * DEC_TILE_BYTES);
  bf16_t* Qs = Psh + 32 * PLD;
  for (int i = tid; i < 8 * 4 * 96; i += NTHR) {
    int h2 = i / 384, rem = i % 384, t = rem / 96, e = rem % 96;
    const bf16_t* qp = p.Qb() + ((size_t)(NP + seq * 4 + t) * 8 + h2) * 96;
    bf16_t val;
    if (e < 64) {
      int j = e & 7, hx = (e >> 3) & 1, sp = (e >> 4) & 1, dt = e >> 5;
      int d = 32 * dt + 16 * sp + 8 * (j >> 2) + 4 * hx + (j & 3);
      val = f2bf(bf2f(qp[d]) * p.g_kn[d]);
    } else val = qp[e];
    Qs[i] = val;
  }
  i32x8 wf8[2][4];
#pragma unroll
  for (int mt = 0; mt < 2; ++mt)
#pragma unroll
    for (int ks = 0; ks < 4; ++ks) {
      const unsigned char* wp = p.W8T() + (size_t)(hd * 64 + mt * 32 + lr) * 256 + ks * 64 + hh * 32;
      uint4 a = *(const uint4*)wp, b = *(const uint4*)(wp + 16);
      wf8[mt][ks][0] = a.x; wf8[mt][ks][1] = a.y; wf8[mt][ks][2] = a.z; wf8[mt][ks][3] = a.w;
      wf8[mt][ks][4] = b.x; wf8[mt][ks][5] = b.y; wf8[mt][ks][6] = b.z; wf8[mt][ks][7] = b.w;
    }
  const float eps_w = EPS * 256.f * __uint_as_float((unsigned)(2 * p.KW()[hd] + 127) << 23);
  f32x16 oacc;
#pragma unroll
  for (int r = 0; r < 16; ++r) oacc[r] = 0.f;
  float lsum[4] = {0.f, 0.f, 0.f, 0.f};
  float4 rlA[8], rkA;
  auto gload = [&](int i, float4 (&rl)[8], float4& rk) {
    int page = p.page_table[seq * 64 + half * 32 + (i >> 1)];
    const float* lp = p.cache_lat + ((size_t)page * 128 + (i & 1) * 64) * 256;
    const float* kp = p.cache_kr + ((size_t)page * 128 + (i & 1) * 64) * 32;
#pragma unroll
    for (int j = 0; j < 8; ++j) rl[j] = ((const float4*)lp)[tid + NTHR * j];
    rk = ((const float4*)kp)[tid];
  };
  int olane = lane, otid = tid;
  auto lstore = [&](char* tb, const float4 (&rl)[8], const float4& rk) {
    const int lane = olane, tid = otid, wave = otid >> 6;
    bf16_t* latB = (bf16_t*)tb;
    unsigned char* lat8 = (unsigned char*)(tb + 64 * LLD * 2);
    bf16_t* krB = (bf16_t*)(tb + 64 * LLD * 2 + 64 * L8LD);
#pragma unroll
    for (int j = 0; j < 8; ++j) {
      const int row = wave + 8 * j;
      float4 v = rl[j];
      int pk = 0;
      pk = __builtin_amdgcn_cvt_pk_fp8_f32(__builtin_amdgcn_fmed3f(v.x * 16.f, -448.f, 448.f), __builtin_amdgcn_fmed3f(v.y * 16.f, -448.f, 448.f), pk, false);
      pk = __builtin_amdgcn_cvt_pk_fp8_f32(__builtin_amdgcn_fmed3f(v.z * 16.f, -448.f, 448.f), __builtin_amdgcn_fmed3f(v.w * 16.f, -448.f, 448.f), pk, true);
      *(unsigned*)(lat8 + row * L8LD + lane * 4) = (unsigned)pk;
      *(uint2*)(latB + row * LLD + lane * 4) = make_uint2(pk2(v.x, v.y), pk2(v.z, v.w));
    }
    int row = tid >> 3, c4 = tid & 7;
    *(uint2*)(krB + row * KRLD + c4 * 4) = make_uint2(pk2(rk.x, rk.y), pk2(rk.z, rk.w));
  };
  auto lstore_new = [&](char* tb) {
    const int lane = olane, tid = otid, wave = otid >> 6;
    bf16_t* latB = (bf16_t*)tb;
    unsigned char* lat8 = (unsigned char*)(tb + 64 * LLD * 2);
    bf16_t* krB = (bf16_t*)(tb + 64 * LLD * 2 + 64 * L8LD);
#pragma unroll
    for (int j = 0; j < 8; ++j) {
      const int row = wave + 8 * j;
      uint2 v = make_uint2(0, 0);
      if (row < 4) v = *(const uint2*)(p.CKV() + (size_t)(NP + seq * 4 + row) * 256 + lane * 4);
      float f0 = bflo(v.x), f1 = bfhi(v.x), f2 = bflo(v.y), f3 = bfhi(v.y);
      int pk = 0;
      pk = __builtin_amdgcn_cvt_pk_fp8_f32(__builtin_amdgcn_fmed3f(f0 * 16.f, -448.f, 448.f), __builtin_amdgcn_fmed3f(f1 * 16.f, -448.f, 448.f), pk, false);
      pk = __builtin_amdgcn_cvt_pk_fp8_f32(__builtin_amdgcn_fmed3f(f2 * 16.f, -448.f, 448.f), __builtin_amdgcn_fmed3f(f3 * 16.f, -448.f, 448.f), pk, true);
      *(unsigned*)(lat8 + row * L8LD + lane * 4) = (unsigned)pk;
      *(uint2*)(latB + row * LLD + lane * 4) = v;
    }
    int row = tid >> 3, c4 = tid & 7;
    uint2 v = make_uint2(0, 0);
    if (row < 4) v = *(const uint2*)(p.KcatS() + ((size_t)(seq * 8) * 4 + row) * 96 + 64 + c4 * 4);
    *(uint2*)(krB + row * KRLD + c4 * 4) = v;
  };
  auto compute = [&](char* tb, bool isnew) {
    const int lane = olane, wave = otid >> 6, lr = olane & 31, hh = olane >> 5, hd = otid >> 6;
    const bf16_t* latB = (const bf16_t*)tb;
    const unsigned char* lat8 = (const unsigned char*)(tb + 64 * LLD * 2);
    const bf16_t* krB = (const bf16_t*)(tb + 64 * LLD * 2 + 64 * L8LD);
#pragma unroll 1
    for (int kt2 = 0; kt2 < 2; ++kt2) {
      float ss = 0.f;
      f32x16 s1;
#pragma unroll
      for (int r = 0; r < 16; ++r) s1[r] = 0.f;
      const unsigned char* bp = lat8 + (kt2 * 32 + lr) * L8LD + hh * 32;
#pragma unroll
      for (int mt = 0; mt < 2; ++mt) {
        f32x16 acc;
#pragma unroll
        for (int r = 0; r < 16; ++r) acc[r] = 0.f;
#pragma unroll
        for (int ks = 0; ks < 4; ++ks) {
          uint4 a = *(const uint4*)(bp + ks * 64), b = *(const uint4*)(bp + ks * 64 + 16);
          i32x8 bv;
          bv[0] = a.x; bv[1] = a.y; bv[2] = a.z; bv[3] = a.w; bv[4] = b.x; bv[5] = b.y; bv[6] = b.z; bv[7] = b.w;
          acc = mfma8(wf8[mt][ks], bv, acc);
        }
#pragma unroll
        for (int r = 0; r < 16; ++r) ss += acc[r] * acc[r];
#pragma unroll
        for (int sp = 0; sp < 2; ++sp) {
          bf16x8 bk = mk8(pk2(acc[8 * sp + 0], acc[8 * sp + 1]), pk2(acc[8 * sp + 2], acc[8 * sp + 3]),
                          pk2(acc[8 * sp + 4], acc[8 * sp + 5]), pk2(acc[8 * sp + 6], acc[8 * sp + 7]));
          uint4 qa = make_uint4(0, 0, 0, 0);
          if (lr < 4) qa = *(const uint4*)(Qs + (hd * 4 + lr) * 96 + ((mt * 2 + sp) * 2 + hh) * 8);
          s1 = mfma32(__builtin_bit_cast(bf16x8, qa), bk, s1);
        }
      }
      ss += __shfl_xor(ss, 32);
      const float rinv = rsqrtf(ss * (1.f / 64.f) + eps_w);
      float s1v[4] = {s1[0] * rinv, s1[1] * rinv, s1[2] * rinv, s1[3] * rinv};
      f32x16 s2;
#pragma unroll
      for (int r = 0; r < 16; ++r) s2[r] = 0.f;
#pragma unroll
      for (int s = 0; s < 2; ++s) {
        bf16x8 bk = *(const bf16x8*)(krB + (kt2 * 32 + lr) * KRLD + s * 16 + hh * 8);
        uint4 qa = make_uint4(0, 0, 0, 0);
        if (lr < 4) qa = *(const uint4*)(Qs + (hd * 4 + lr) * 96 + 64 + s * 16 + hh * 8);
        s2 = mfma32(__builtin_bit_cast(bf16x8, qa), bk, s2);
      }
      if (hh == 0) {
        const int kk = kt2 * 32 + lr;
#pragma unroll
        for (int t = 0; t < 4; ++t) {
          float e = __builtin_amdgcn_exp2f(s1v[t] + s2[t] - Mb);
          if (isnew) e = (kk < 4 && kk <= t) ? e : 0.f;
          lsum[t] += e;
          Psh[(hd * 4 + t) * PLD + kk] = f2bf(e);
        }
      }
    }
    __syncthreads();
    {
      const int n0 = wave * 32;
#pragma unroll
      for (int ks = 0; ks < 4; ++ks) {
        bf16x8 a = *(const bf16x8*)(Psh + lr * PLD + ks * 16 + hh * 8);
        const int key0 = ks * 16 + 8 * hh, c0 = n0 + 16 * ((lane >> 4) & 1);
        const int q = (lane & 15) >> 2, pp = lane & 3;
        const bf16_t* ap = latB + (key0 + q) * LLD + c0 + 4 * pp;
        s16x4 lo = __builtin_amdgcn_ds_read_tr16_b64_v4i16((__attribute__((address_space(3))) s16x4*)(ap));
        s16x4 hi = __builtin_amdgcn_ds_read_tr16_b64_v4i16((__attribute__((address_space(3))) s16x4*)(ap + 4 * LLD));
        bf16x8 bfr;
        bfr[0] = lo[0]; bfr[1] = lo[1]; bfr[2] = lo[2]; bfr[3] = lo[3];
        bfr[4] = hi[0]; bfr[5] = hi[1]; bfr[6] = hi[2]; bfr[7] = hi[3];
        oacc = mfma32(a, bfr, oacc);
      }
    }
  };
  gload(0, rlA, rkA);
  const int ntile = 64 + half;
#pragma unroll 1
  for (int i = 0; i < ntile; ++i) {
    char* tb = smem + (i & 1) * DEC_TILE_BYTES;
    asm volatile("" : "+v"(olane), "+v"(otid));
    if (i < 64) lstore(tb, rlA, rkA); else lstore_new(tb);
    if (i + 1 < 64) gload(i + 1, rlA, rkA);
    __syncthreads();
    compute(tb, i == 64);
  }
  float* Op = p.Opart() + ((size_t)(seq * 2 + half) * 32) * 256;
#pragma unroll
  for (int r = 0; r < 16; ++r) {
    int m = (r & 3) + 8 * (r >> 2) + 4 * hh;
    Op[(size_t)m * 256 + wave * 32 + lr] = oacc[r];
  }
#pragma unroll
  for (int t = 0; t < 4; ++t) {
    float v = (hh == 0) ? lsum[t] : 0.f;
    v = wave_sum(v);
    if (lane == 0) p.Lpart()[(seq * 2 + half) * 32 + hd * 4 + t] = v;
  }
  __syncthreads();
}

typedef unsigned lds_u4 __attribute__((ext_vector_type(4)));
typedef unsigned lds_u2 __attribute__((ext_vector_type(2)));
typedef float lds_f4 __attribute__((ext_vector_type(4)));
__device__ __forceinline__ uint4 ldl_u4(const LAS void* p) { lds_u4 v = *(const LAS lds_u4*)p; return make_uint4(v.x, v.y, v.z, v.w); }
__device__ __forceinline__ float4 ldl_f4(const LAS void* p) { lds_f4 v = *(const LAS lds_f4*)p; return make_float4(v.x, v.y, v.z, v.w); }
__device__ __forceinline__ void stl_u2(LAS void* p, unsigned a, unsigned b) { lds_u2 v = {a, b}; *(LAS lds_u2*)p = v; }
__device__ __forceinline__ void stl_u4(LAS void* p, uint4 a) { lds_u4 v = {a.x, a.y, a.z, a.w}; *(LAS lds_u4*)p = v; }
#define D_STAGE 36864
#define D_TB (3 * D_STAGE)
#define D_LAT8 (32 * LLD * 2)
#define D_KRB (D_LAT8 + 32 * L8LD)
#define D_TBSZ (D_KRB + 32 * KRLD * 2)
#define D_PLD 40
#define D_PSH (D_TB + D_TBSZ)
#define D_QS (D_PSH + 32 * D_PLD * 2)
#define D_END (D_QS + 8 * 4 * 96 * 2)
__device__ __forceinline__ void bar_lds() { asm volatile("s_waitcnt lgkmcnt(0)\n\ts_barrier" ::: "memory"); }
__device__ __forceinline__ void attn_decode_unit_dma(const Params& p, char* smem_generic, int seq, int half, float Mb) {
  LAS char* const smem = (LAS char*)smem_generic;
  const int tid = tidx(), lane = tid & 63, wave = tid >> 6, lr = lane & 31, hh = lane >> 5;
  const int hd = wave;
  LAS bf16_t* Psh = (LAS bf16_t*)(smem + D_PSH);
  LAS bf16_t* Qs = (LAS bf16_t*)(smem + D_QS);
  for (int i = tid; i < 8 * 4 * 96; i += NTHR) {
    int h2 = i / 384, rem = i % 384, t = rem / 96, e = rem % 96;
    const bf16_t* qp = p.Qb() + ((size_t)(NP + seq * 4 + t) * 8 + h2) * 96;
    bf16_t val;
    if (e < 64) {
      int j = e & 7, hx = (e >> 3) & 1, sp = (e >> 4) & 1, dt = e >> 5;
      int d = 32 * dt + 16 * sp + 8 * (j >> 2) + 4 * hx + (j & 3);
      val = f2bf(bf2f(qp[d]) * p.g_kn[d]);
    } else val = qp[e];
    Qs[i] = val;
  }
  i32x8 wf8[2][4];
#pragma unroll
  for (int mt = 0; mt < 2; ++mt)
#pragma unroll
    for (int ks = 0; ks < 4; ++ks) {
      const unsigned char* wp = p.W8T() + (size_t)(hd * 64 + mt * 32 + lr) * 256 + ks * 64 + hh * 32;
      uint4 a = *(const uint4*)wp, b = *(const uint4*)(wp + 16);
      wf8[mt][ks][0] = a.x; wf8[mt][ks][1] = a.y; wf8[mt][ks][2] = a.z; wf8[mt][ks][3] = a.w;
      wf8[mt][ks][4] = b.x; wf8[mt][ks][5] = b.y; wf8[mt][ks][6] = b.z; wf8[mt][ks][7] = b.w;
    }
  const float eps_w = EPS * __uint_as_float((unsigned)(2 * p.KW()[hd] + 127) << 23);
  const int ptv = p.page_table[seq * 64 + half * 32 + lr];
  f32x16 oacc;
#pragma unroll
  for (int r = 0; r < 16; ++r) oacc[r] = 0.f;
  float lsum[4] = {0.f, 0.f, 0.f, 0.f};
  constexpr int ntile = 128;
  asm volatile("s_waitcnt vmcnt(0)" ::: "memory");
  __syncthreads();
#define DD_ISSUE(t_, SLOT) do { \
    const int tt_ = (t_) < ntile ? (t_) : ntile - 1; \
    const int page_ = __builtin_amdgcn_readlane(ptv, tt_ >> 2); \
    const char* g_ = (const char*)(p.cache_lat + ((size_t)page_ * 128 + (tt_ & 3) * 32) * 256) + lane * 16; \
    LAS char* st_ = smem + (SLOT) * D_STAGE; \
    _Pragma("unroll") for (int j = 0; j < 4; ++j) { const int row = wave + 8 * j; \
      __builtin_amdgcn_global_load_lds((const unsigned*)(g_ + row * 1024), (LAS unsigned*)(st_ + row * 1024), 16, 0, 0); } \
    if (wave < 4) {     \
      const char* gk_ = (const char*)(p.cache_kr + ((size_t)page_ * 128 + (tt_ & 3) * 32) * 32) + wave * 1024 + lane * 16; \
      __builtin_amdgcn_global_load_lds((const unsigned*)gk_, (LAS unsigned*)(st_ + 32768 + wave * 1024), 16, 0, 0); } } while (0)
  const LAS bf16_t* latB = (const LAS bf16_t*)(smem + D_TB);
  const LAS unsigned char* lat8 = (const LAS unsigned char*)(smem + D_TB + D_LAT8);
  const LAS bf16_t* krB = (const LAS bf16_t*)(smem + D_TB + D_KRB);
  auto computeB = [&](bool isnew) __attribute__((always_inline)) {
#ifdef PROBE_DECB2
    for (int prep_ = 0; prep_ < 2; ++prep_)
#endif
    {
      f32x16 s2;
#pragma unroll
      for (int r = 0; r < 16; ++r) s2[r] = 0.f;
#pragma unroll
      for (int s = 0; s < 2; ++s) {
        bf16x8 bk = *(const LAS bf16x8*)(krB + lr * KRLD + s * 16 + hh * 8);
        uint4 qa = make_uint4(0, 0, 0, 0);
        if (lr < 4) qa = ldl_u4(Qs + (hd * 4 + lr) * 96 + 64 + s * 16 + hh * 8);
        s2 = mfma32(__builtin_bit_cast(bf16x8, qa), bk, s2);
      }
      const LAS unsigned char* bp = lat8 + lr * L8LD + hh * 32;
      f32x16 acc0, acc1;
#pragma unroll
      for (int r = 0; r < 16; ++r) { acc0[r] = 0.f; acc1[r] = 0.f; }
#pragma unroll
      for (int ks = 0; ks < 4; ++ks) {
        uint4 a = ldl_u4(bp + ks * 64), b = ldl_u4(bp + ks * 64 + 16);
        i32x8 bv;
        bv[0] = a.x; bv[1] = a.y; bv[2] = a.z; bv[3] = a.w; bv[4] = b.x; bv[5] = b.y; bv[6] = b.z; bv[7] = b.w;
        acc0 = mfma8(wf8[0][ks], bv, acc0);
        acc1 = mfma8(wf8[1][ks], bv, acc1);
      }
      uint4 qn[4];
#pragma unroll
      for (int f = 0; f < 4; ++f) {
        qn[f] = make_uint4(0, 0, 0, 0);
        if (lr < 4) qn[f] = ldl_u4(Qs + (hd * 4 + lr) * 96 + (f * 2 + hh) * 8);
      }
      float ss = 0.f;
      f32x16 s1;
#pragma unroll
      for (int r = 0; r < 16; ++r) s1[r] = 0.f;
#pragma unroll
      for (int r = 0; r < 16; ++r) ss += acc0[r] * acc0[r];
#pragma unroll
      for (int sp = 0; sp < 2; ++sp) {
        bf16x8 bk = mk8(pk2(acc0[8 * sp + 0], acc0[8 * sp + 1]), pk2(acc0[8 * sp + 2], acc0[8 * sp + 3]),
                        pk2(acc0[8 * sp + 4], acc0[8 * sp + 5]), pk2(acc0[8 * sp + 6], acc0[8 * sp + 7]));
        s1 = mfma32(__builtin_bit_cast(bf16x8, qn[sp]), bk, s1);
      }
#pragma unroll
      for (int r = 0; r < 16; ++r) ss += acc1[r] * acc1[r];
#pragma unroll
      for (int sp = 0; sp < 2; ++sp) {
        bf16x8 bk = mk8(pk2(acc1[8 * sp + 0], acc1[8 * sp + 1]), pk2(acc1[8 * sp + 2], acc1[8 * sp + 3]),
                        pk2(acc1[8 * sp + 4], acc1[8 * sp + 5]), pk2(acc1[8 * sp + 6], acc1[8 * sp + 7]));
        s1 = mfma32(__builtin_bit_cast(bf16x8, qn[2 + sp]), bk, s1);
      }
      ss += __shfl_xor(ss, 32);
      const float rinv = rsqrtf(ss * (1.f / 64.f) + eps_w);
      if (hh == 0) {
#pragma unroll
        for (int t = 0; t < 4; ++t) {
          float e = __builtin_amdgcn_exp2f(s1[t] * rinv + (s2[t] - Mb));
          if (isnew) e = (lr < 4 && lr <= t) ? e : 0.f;
#ifdef PROBE_DECB2
          if (prep_ == 0)
#endif
          lsum[t] += e;
          Psh[(hd * 4 + t) * D_PLD + lr] = f2bf(e);
        }
      }
    }
  };
  auto computeC = [&]() __attribute__((always_inline)) {
    {
      const int n0 = wave * 32;
      const int key0 = 8 * hh, c0 = n0 + 16 * ((lane >> 4) & 1);
      const int q = (lane & 15) >> 2, pp = lane & 3;
      const LAS bf16_t* ap = latB + (key0 + q) * LLD + c0 + 4 * pp;
      const LAS bf16_t* pa = Psh + lr * D_PLD + hh * 8;
      lds_u2 lo0, hi0, lo1, hi1;
      lds_u4 a0v, a1v;
      static_assert(4 * LLD * 2 == 2112 && 16 * LLD * 2 == 8448, "offsets of the transposed reads");
      asm volatile("ds_read_b128 %4, %7\n\tds_read_b128 %5, %7 offset:32\n\t"
                   "ds_read_b64_tr_b16 %0, %6\n\tds_read_b64_tr_b16 %1, %6 offset:2112\n\t"
                   "ds_read_b64_tr_b16 %2, %6 offset:8448\n\tds_read_b64_tr_b16 %3, %6 offset:10560\n\ts_waitcnt lgkmcnt(0)"
                   : "=&v"(lo0), "=&v"(hi0), "=&v"(lo1), "=&v"(hi1), "=&v"(a0v), "=&v"(a1v)
                   : "v"((unsigned)(__UINTPTR_TYPE__)ap), "v"((unsigned)(__UINTPTR_TYPE__)pa) : "memory");
      oacc = mfma32(__builtin_bit_cast(bf16x8, a0v), mk8(lo0.x, lo0.y, hi0.x, hi0.y), oacc);
      oacc = mfma32(__builtin_bit_cast(bf16x8, a1v), mk8(lo1.x, lo1.y, hi1.x, hi1.y), oacc);
    }
  };
#define DD_STEP(t_, SLOT) do { \
    if (wave < 4) asm volatile("s_waitcnt vmcnt(10)" ::: "memory");     \
    else asm volatile("s_waitcnt vmcnt(8)" ::: "memory"); \
    bar_lds();                                              \
    { const LAS char* st = smem + (SLOT) * D_STAGE; \
      LAS bf16_t* latB = (LAS bf16_t*)(smem + D_TB); \
      LAS unsigned char* lat8 = (LAS unsigned char*)(smem + D_TB + D_LAT8); \
      LAS bf16_t* krB = (LAS bf16_t*)(smem + D_TB + D_KRB); \
      float4 cv_[4], ck_ = make_float4(0.f, 0.f, 0.f, 0.f); \
      _Pragma("unroll") for (int j = 0; j < 4; ++j) cv_[j] = ldl_f4(st + (wave + 8 * j) * 1024 + lane * 16);     \
      if (tid < 256) ck_ = ldl_f4(st + 32768 + tid * 16); \
      _Pragma("unroll") for (int j = 0; j < 4; ++j) { \
        const int row = wave + 8 * j; \
        const float4 v = cv_[j]; \
        int pk = 0; \
        pk = __builtin_amdgcn_cvt_pk_fp8_f32(v.x, v.y, pk, false); \
        pk = __builtin_amdgcn_cvt_pk_fp8_f32(v.z, v.w, pk, true); \
        *(LAS unsigned*)(lat8 + row * L8LD + lane * 4) = (unsigned)pk; \
        stl_u2(latB + row * LLD + lane * 4, pk2(v.x, v.y), pk2(v.z, v.w)); } \
      if (tid < 256) stl_u2(krB + (tid >> 3) * KRLD + (tid & 7) * 4, pk2(ck_.x, ck_.y), pk2(ck_.z, ck_.w)); } \
    bar_lds();                                              \
      \
      \
    if (wave < 4) DD_ISSUE((t_) + 3, SLOT); \
    computeB(false); \
    if (wave >= 4) DD_ISSUE((t_) + 3, SLOT); \
    bar_lds(); \
    computeC(); } while (0)
  DD_ISSUE(0, 0);
  DD_ISSUE(1, 1);
  DD_ISSUE(2, 2);
#pragma unroll 1
  for (int t = 0; t < 126; t += 3) { DD_STEP(t, 0); DD_STEP(t + 1, 1); DD_STEP(t + 2, 2); }
  DD_STEP(126, 0);
  DD_STEP(127, 1);
  asm volatile("s_waitcnt vmcnt(0)" ::: "memory");
  bar_lds();
  if (half) {
    LAS bf16_t* latB = (LAS bf16_t*)(smem + D_TB);
    LAS unsigned char* lat8 = (LAS unsigned char*)(smem + D_TB + D_LAT8);
    LAS bf16_t* krB = (LAS bf16_t*)(smem + D_TB + D_KRB);
#pragma unroll
    for (int j = 0; j < 4; ++j) {
      const int row = wave + 8 * j;
      uint2 v = make_uint2(0, 0);
      if (row < 4) v = *(const uint2*)(p.CKV() + (size_t)(NP + seq * 4 + row) * 256 + lane * 4);
      float f0 = bflo(v.x), f1 = bfhi(v.x), f2 = bflo(v.y), f3 = bfhi(v.y);
      int pk = 0;
      pk = __builtin_amdgcn_cvt_pk_fp8_f32(f0, f1, pk, false);
      pk = __builtin_amdgcn_cvt_pk_fp8_f32(f2, f3, pk, true);
      *(LAS unsigned*)(lat8 + row * L8LD + lane * 4) = (unsigned)pk;
      stl_u2(latB + row * LLD + lane * 4, v.x, v.y);
    }
    if (tid < 256) {
      const int row = tid >> 3, c4 = tid & 7;
      uint2 v = make_uint2(0, 0);
      if (row < 4) v = *(const uint2*)(p.KcatS() + ((size_t)(seq * 8) * 4 + row) * 96 + 64 + c4 * 4);
      stl_u2(krB + row * KRLD + c4 * 4, v.x, v.y);
    }
    __syncthreads();
    computeB(true);
    bar_lds();
    computeC();
  }
  float* Op = p.Opart() + ((size_t)(seq * 2 + half) * 32) * 256;
#pragma unroll
  for (int r = 0; r < 16; ++r) {
    int m = (r & 3) + 8 * (r >> 2) + 4 * hh;
    Op[(size_t)m * 256 + wave * 32 + lr] = oacc[r];
  }
#pragma unroll
  for (int t = 0; t < 4; ++t) {
    float v = (hh == 0) ? lsum[t] : 0.f;
    v = wave_sum(v);
    if (lane == 0) p.Lpart()[(seq * 2 + half) * 32 + hd * 4 + t] = v;
  }
  __syncthreads();
}

__device__ __forceinline__ void ssm_scan_prompt(const Params& p, int job) {
  const int lane = tidx() & 63;
  const int b = job >> 5, g = job & 31;
  const float dt = __expf(p.log_dt[g]);
  const Cplx a16 = apow(p.a_re[g * 64 + lane], p.a_im[g * 64 + lane], dt, 16.f);
  Cplx H = {0.f, 0.f};
  const float* S = p.S() + ((size_t)g * NSUB + b * 256) * 128;
  bf16_t* A2 = p.A2() + ((size_t)g * NSUB + b * 256) * A2LD + 256;
  for (int n0 = 0; n0 < 256; n0 += 32) {
    float sr[32], si[32];
#pragma unroll
    for (int k = 0; k < 32; ++k) { sr[k] = S[(size_t)(n0 + k) * 128 + lane]; si[k] = S[(size_t)(n0 + k) * 128 + 64 + lane]; }
#pragma unroll
    for (int k = 0; k < 32; ++k) {
      A2[(size_t)(n0 + k) * A2LD + lane] = f2bf(H.re);
      A2[(size_t)(n0 + k) * A2LD + 64 + lane] = f2bf(H.im);
      Cplx t = cmul(a16, H);
      H.re = t.re + sr[k]; H.im = t.im + si[k];
    }
  }
  float* o = p.out + O_SSMP + ((size_t)(b * 32 + g) * 64 + lane) * 2;
  o[0] = H.re; o[1] = H.im;
}
__device__ __forceinline__ void ssm_sample(const Params& p, int job) {
  const int lane = tidx() & 63;
  const int seq = job >> 5, g = job & 31;
  const float dt = __expf(p.log_dt[g]);
  const float are = p.a_re[g * 64 + lane], aim = p.a_im[g * 64 + lane];
  const Cplx ab = apow(are, aim, dt, 1.f);
  const Cplx bs = bscale(are, aim, dt);
  const float* st = p.state_ssm + ((size_t)(seq * 32 + g) * 64 + lane) * 2;
  Cplx H = {st[0], st[1]};
  const Cplx H0 = H;
  bf16_t* A2 = p.A2() + ((size_t)g * NSUB + 1024 + seq) * A2LD + 256;
  Cplx bb[16];
#pragma unroll
  for (int h = 0; h < 16; ++h) {
    Cplx braw = {p.ssm_b[((g * 64 + lane) * 16 + h) * 2], p.ssm_b[((g * 64 + lane) * 16 + h) * 2 + 1]};
    bb[h] = cmul(bs, braw);
  }
#pragma unroll
  for (int t = 0; t < 4; ++t) {
    const bf16_t* u = (const bf16_t*)p.Z() + (size_t)(NP + seq * 4 + t) * INW + g * 16;
    const uint4 u0 = *(const uint4*)u, u1 = *(const uint4*)(u + 8);
    const float uf[16] = {bflo(u0.x), bfhi(u0.x), bflo(u0.y), bfhi(u0.y), bflo(u0.z), bfhi(u0.z), bflo(u0.w), bfhi(u0.w),
                          bflo(u1.x), bfhi(u1.x), bflo(u1.y), bfhi(u1.y), bflo(u1.z), bfhi(u1.z), bflo(u1.w), bfhi(u1.w)};
    Cplx bu = {0.f, 0.f};
#pragma unroll
    for (int h = 0; h < 16; ++h) { float uv = uf[h]; bu.re += uv * bb[h].re; bu.im += uv * bb[h].im; }
    Cplx tt = cmul(ab, H);
    H.re = tt.re + bu.re; H.im = tt.im + bu.im;
  }
  A2[lane] = f2bf(H0.re);
  A2[64 + lane] = f2bf(H0.im);
  float* o = p.out + O_SSMS + ((size_t)(seq * 32 + g) * 64 + lane) * 2;
  o[0] = H.re; o[1] = H.im;
}

__device__ __forceinline__ void ssm_y_gemm(const Params& p, char* smem);
__device__ __forceinline__ void phase_attn(const Params& p, char* smem) {
  const int wave = tidx() >> 6;
  const int gw = blockIdx.x * 8 + wave, GW = gridDim.x * 8;
  ssm_y_gemm(p, smem);
  __syncthreads();
  const float Mb = softmax_bound(p);
  __syncthreads();
#ifdef PROBE_PROMPT2
  for (int rep = 0; rep < 2; ++rep)
#endif
  for (int it = blockIdx.x; it < 256; it += gridDim.x) {
    const int xg = it & 7, rr = it >> 3, bh = xg * 4 + (rr >> 3), j = rr & 7;
    attn_prompt_block(p, smem, bh >> 3, bh & 7, j, Mb);
    attn_prompt_block(p, smem, bh >> 3, bh & 7, 15 - j, Mb);
  }
  for (int it = blockIdx.x; it < 256; it += gridDim.x) attn_decode_unit_dma(p, smem, it >> 1, it & 1, Mb);
}

struct SsmOrder {
  int G, c;
  __device__ bool next(int i, pg8::Unit& u) const {
    const int L = i * G + c;
    if (L >= 32 * 5) return false;
    u.pm = L; u.pn = L / 5;
    return true;
  }
  __device__ __forceinline__ void a_ready(const pg8::Unit&) const {}
  __device__ __forceinline__ void done(const pg8::Unit&) const {}
};
struct StSsmY { bf16_t* G; __device__ __forceinline__ void st8(int row, int col, pg8::f32x4 a, pg8::f32x4 b) const {
    const int g = col >> 8, n = col & 255, m = row - g * NSUB, tt = n >> 4, h = n & 15;
    const bool isP = m < 1024;
    const bool ok = isP || (tt < 4 && m < NSUBV);
    const int token = isP ? m * 16 + tt : NP + (m - 1024) * 4 + (tt & 3);
    const uint4 o = make_uint4(pk2(gelu_tanh(a[0]), gelu_tanh(a[1])), pk2(gelu_tanh(a[2]), gelu_tanh(a[3])),
                               pk2(gelu_tanh(b[0]), gelu_tanh(b[1])), pk2(gelu_tanh(b[2]), gelu_tanh(b[3])));
    if (ok) *(uint4*)(G + (unsigned)(token * 512 + g * 16 + h)) = o;
  } };
__device__ __forceinline__ void decode_combine(const Params& p, char* smem) {
  const int lane = tidx() & 63, wave = tidx() >> 6, half = wave >> 2, jw = wave & 3;
  float* osh = (float*)smem + wave * 512;
  float* red = (float*)smem + 8 * 512;
  for (int jb = blockIdx.x * 4; jb < 1024; jb += gridDim.x * 4) {
    const int job = jb + jw, seq = job >> 3, hd = job & 7;
    const float* O0 = p.Opart() + ((size_t)(seq * 2) * 32 + hd * 4) * 256 + half * 128;
    const float* O1 = O0 + 32 * 256;
    float lp[4];
#pragma unroll
    for (int t = 0; t < 4; ++t) lp[t] = p.Lpart()[(seq * 2) * 32 + hd * 4 + t] + p.Lpart()[(seq * 2 + 1) * 32 + hd * 4 + t];
#pragma unroll
    for (int i = 0; i < 4; ++i) {
      float2 a = *(const float2*)(O0 + i * 256 + lane * 2), b = *(const float2*)(O1 + i * 256 + lane * 2);
      *(float2*)(osh + i * 128 + lane * 2) = make_float2(a.x + b.x, a.y + b.y);
    }
    float acc[4] = {0.f, 0.f, 0.f, 0.f};
    const float* wp = p.w_uv + (size_t)(half * 128) * 512 + hd * 64 + lane;
#pragma unroll 1
    for (int c0 = 0; c0 < 128; c0 += 32) {
      float w[32];
#pragma unroll
      for (int c = 0; c < 32; ++c) w[c] = wp[(size_t)(c0 + c) * 512];
#pragma unroll
      for (int c = 0; c < 32; ++c)
#pragma unroll
        for (int t = 0; t < 4; ++t) acc[t] += osh[t * 128 + c0 + c] * w[c];
    }
    if (half == 1) {
#pragma unroll
      for (int t = 0; t < 4; ++t) red[(jw * 4 + t) * 64 + lane] = acc[t];
    }
    __syncthreads();
    if (half == 0) {
#pragma unroll
      for (int t = 0; t < 4; ++t)
        p.CAT()[(size_t)(NP + seq * 4 + t) * 1024 + 512 + hd * 64 + lane] = f2bf((acc[t] + red[(jw * 4 + t) * 64 + lane]) / lp[t]);
    }
    __syncthreads();
  }
}
__device__ __forceinline__ void ssm_y_gemm(const Params& p, char* smem) {
  pg8::Gemm g{p.A2(), p.Bt2(), 32 * NSUB, 32 * 256, 384};
  SsmOrder S{(int)gridDim.x, (int)((blockIdx.x + 160) % gridDim.x)};
  pg8::EpiFn<true, StSsmY> E{StSsmY{p.G()}};
  pg8::gemm_phase<pg8::EpiFn<true, StSsmY>, SsmOrder, false>((PG8_LAS unsigned char*)smem, g, S, E, nullptr);
}

struct EpiGlu {
  static constexpr bool PERM = true, AFTER_DRAIN = false;
  bf16_t* CAT;
  __device__ __forceinline__ void operator()(const pg8::f32x4 (&acc)[2][2][4][2], const pg8::Unit& u, int wr, int wc, int fr, int fq) const {
    const int row0 = u.pm * 256 + wr * 64 + fr, col0 = u.pn * 128 + wc * 32 + 8 * fq;
#pragma unroll
    for (int ai = 0; ai < 2; ++ai)
#pragma unroll
      for (int m = 0; m < 4; ++m) {
        const unsigned rb = (unsigned)((row0 + ai * 128 + m * 16) * 1024 + col0);
        float o[8];
#pragma unroll
        for (int n = 0; n < 2; ++n) {
          const pg8::f32x4 v = acc[ai][0][m][n], g = acc[ai][1][m][n];
#pragma unroll
          for (int q = 0; q < 4; ++q) o[n * 4 + q] = v[q] * __builtin_amdgcn_rcpf(1.f + __builtin_amdgcn_exp2f(-1.4426950408889634f * g[q]));
        }
        *(uint4*)(CAT + rb) = make_uint4(pk2(o[0], o[1]), pk2(o[2], o[3]), pk2(o[4], o[5]), pk2(o[6], o[7]));
      }
  }
};
__device__ __forceinline__ void phase_gemm_gl(const Params& p, char* smem) {
  decode_combine(p, smem);
  bf16_t* C = p.CAT();
  for (int t = blockIdx.x; t < 4 * 8; t += gridDim.x) {
    int tm = t / 8, tn = t % 8;
    gemm_tile<4, 2, 1, 2, true>(p.G(), 512, p.WgluS(), 512, 512, NP + tm * 128, tn * 128, smem, [=](int m, int c, float v, float g) {
      C[(size_t)m * 1024 + tn * 64 + c] = f2bf(v * __builtin_amdgcn_rcpf(1.f + __builtin_amdgcn_exp2f(-1.4426950408889634f * g)));
    });
  }
  pg8::Gemm g{p.G(), p.WgluT(), NP, 1024, 512};
  pg8::StaticOrder S;
  S.init(NP, 1024, (int)gridDim.x, (int)blockIdx.x);
  EpiGlu E{C};
  pg8::gemm_phase<EpiGlu, pg8::StaticOrder, false>((PG8_LAS unsigned char*)smem, g, S, E, nullptr);
}
__device__ __forceinline__ void phase_gemm_out(const Params& p, char* smem) {
  bf16_t* C = (bf16_t*)p.X1();
  const float* xs = p.x_sample;
  for (int t = blockIdx.x; t < 8 * 8; t += gridDim.x) {
    int tm = t / 8, tn = t % 8;
    gemm_tile<2, 4, 1, 1>(p.CAT(), 1024, p.WoutT(), 1024, 1024, NP + tm * 64, tn * 128, smem, [=](int m, int n, float v) {
      C[(size_t)m * 1024 + n] = f2bf(xs[(size_t)(m - NP) * 1024 + n] + v);
    });
  }
  big_gemm(p.CAT(), p.WoutT(), NP, 1024, 1024, smem, pg8::EpiFn<true, StX1>{StX1{C, p.x_prompt}});
}
__device__ __forceinline__ void phase_gemm_pq(const Params& p, char* smem) {
  bf16_t* C = p.PQ();
  for (int t = blockIdx.x; t < 8 * 16; t += gridDim.x) {
    int tm = t / 16, tn = t % 16;
    gemm_tile<2, 4, 1, 1>(p.XN(), 1024, p.WpqT(), 1024, 1024, NP + tm * 64, tn * 128, smem, [=](int m, int n, float v) { C[(size_t)m * 2048 + n] = f2bf(v); });
  }
  big_gemm(p.XN(), p.WpqT(), NP, 2048, 1024, smem, pg8::EpiFn<true, StBf16>{StBf16{C, 2048}});
}
__device__ __forceinline__ void ins16(float (&L)[16], float x) {
#pragma unroll
  for (int j = 15; j >= 1; --j) L[j] = __builtin_amdgcn_fmed3f(L[j - 1], L[j], x);
  L[0] = fmaxf(L[0], x);
}
#define CSD(a, b) do { const float hi_ = fmaxf(a, b), lo_ = fminf(a, b); a = hi_; b = lo_; } while (0)
__device__ __forceinline__ void sort16d(float (&v)[16]) {
  CSD(v[0], v[1]); CSD(v[2], v[3]); CSD(v[4], v[5]); CSD(v[6], v[7]); CSD(v[8], v[9]); CSD(v[10], v[11]); CSD(v[12], v[13]); CSD(v[14], v[15]); CSD(v[0], v[2]);
  CSD(v[1], v[3]); CSD(v[4], v[6]); CSD(v[5], v[7]); CSD(v[8], v[10]); CSD(v[9], v[11]); CSD(v[12], v[14]); CSD(v[13], v[15]); CSD(v[1], v[2]); CSD(v[5], v[6]);
  CSD(v[9], v[10]); CSD(v[13], v[14]); CSD(v[0], v[4]); CSD(v[1], v[5]); CSD(v[2], v[6]); CSD(v[3], v[7]); CSD(v[8], v[12]); CSD(v[9], v[13]); CSD(v[10], v[14]);
  CSD(v[11], v[15]); CSD(v[2], v[4]); CSD(v[3], v[5]); CSD(v[10], v[12]); CSD(v[11], v[13]); CSD(v[1], v[2]); CSD(v[3], v[4]); CSD(v[5], v[6]); CSD(v[9], v[10]);
  CSD(v[11], v[12]); CSD(v[13], v[14]); CSD(v[0], v[8]); CSD(v[1], v[9]); CSD(v[2], v[10]); CSD(v[3], v[11]); CSD(v[4], v[12]); CSD(v[5], v[13]); CSD(v[6], v[14]);
  CSD(v[7], v[15]); CSD(v[4], v[8]); CSD(v[5], v[9]); CSD(v[6], v[10]); CSD(v[7], v[11]); CSD(v[2], v[4]); CSD(v[3], v[5]); CSD(v[6], v[8]); CSD(v[7], v[9]);
  CSD(v[10], v[12]); CSD(v[11], v[13]); CSD(v[1], v[2]); CSD(v[3], v[4]); CSD(v[5], v[6]); CSD(v[7], v[8]); CSD(v[9], v[10]); CSD(v[11], v[12]); CSD(v[13], v[14]);
}
__device__ __forceinline__ void bitonic16d(float (&v)[16]) {
  CSD(v[0], v[8]); CSD(v[1], v[9]); CSD(v[2], v[10]); CSD(v[3], v[11]); CSD(v[4], v[12]); CSD(v[5], v[13]); CSD(v[6], v[14]); CSD(v[7], v[15]); CSD(v[0], v[4]);
  CSD(v[1], v[5]); CSD(v[2], v[6]); CSD(v[3], v[7]); CSD(v[8], v[12]); CSD(v[9], v[13]); CSD(v[10], v[14]); CSD(v[11], v[15]); CSD(v[0], v[2]); CSD(v[1], v[3]);
  CSD(v[4], v[6]); CSD(v[5], v[7]); CSD(v[8], v[10]); CSD(v[9], v[11]); CSD(v[12], v[14]); CSD(v[13], v[15]); CSD(v[0], v[1]); CSD(v[2], v[3]); CSD(v[4], v[5]);
  CSD(v[6], v[7]); CSD(v[8], v[9]); CSD(v[10], v[11]); CSD(v[12], v[13]); CSD(v[14], v[15]);
}
__device__ __forceinline__ void merge16d(float (&L)[16], const float (&R)[16]) {
#pragma unroll
  for (int i = 0; i < 16; ++i) L[i] = fmaxf(L[i], R[15 - i]);
  bitonic16d(L);
}
#define PKLD 136
__device__ __forceinline__ void phase_sctopk(const Params& p, char* smem) {
  bf16_t* keysS = (bf16_t*)smem;
  unsigned char* sidx = (unsigned char*)(smem + 2 * 128 * PKLD * 2);
  const int tid = tidx(), lane = tid & 63, wave = tid >> 6, lr = lane & 31, hh = lane >> 5;
  for (int c = tid; c < 2 * 128 * 16; c += NTHR) {
    int row = c >> 4, cc = c & 15;
    *(uint4*)(keysS + row * PKLD + cc * 8) = *(const uint4*)(p.PK() + row * 128 + cc * 8);
  }
  __syncthreads();
  const int ntask = NT * 8 / 32;
  const int GWv = gridDim.x * 8, gwv = blockIdx.x * 8 + wave;
  const int nfull = ntask / GWv, rem = ntask - nfull * GWv;
  const int rstride = rem > 0 ? (GWv / rem > 0 ? GWv / rem : 1) : 1;
  const bool hasx = rem > 0 && (gwv % rstride) == 0 && (gwv / rstride) < rem;
  const int nround = nfull + (hasx ? 1 : 0);
  for (int rd = 0; rd < nround; ++rd) {
    const int task = rd < nfull ? gwv + rd * GWv : nfull * GWv + gwv / rstride;
    const int m = task * 32 + lr;
    float L[2][16];
#pragma unroll
    for (int c = 0; c < 2; ++c) {
      bf16x8 qf[8];
#pragma unroll
      for (int s2 = 0; s2 < 8; ++s2) qf[s2] = *(const bf16x8*)(p.PQ() + (size_t)m * 256 + c * 128 + s2 * 16 + hh * 8);
      auto tile = [&](int kt, float (&ch)[16]) __attribute__((always_inline)) {
        f32x16 acc;
#pragma unroll
        for (int r = 0; r < 16; ++r) acc[r] = 0.f;
#pragma unroll
        for (int s2 = 0; s2 < 8; ++s2) {
          bf16x8 a = *(const bf16x8*)(keysS + (c * 128 + kt * 32 + lr) * PKLD + s2 * 16 + hh * 8);
          acc = mfma32(a, qf[s2], acc);
        }
#pragma unroll
        for (int r = 0; r < 16; ++r) {
          unsigned key = kt * 32 + (r & 3) + 8 * (r >> 2) + 4 * hh;
          ch[r] = __uint_as_float((__float_as_uint(acc[r]) & ~127u) | key);
        }
        sort16d(ch);
      };
      tile(0, L[c]);
#pragma unroll 1
      for (int kt = 1; kt < 4; ++kt) {
        float ch[16];
        tile(kt, ch);
        merge16d(L[c], ch);
      }
      float P[16];
#pragma unroll
      for (int j = 0; j < 16; ++j) P[j] = __shfl_xor(L[c][j], 32);
      merge16d(L[c], P);
    }
#pragma unroll
    for (int j = 0; j < 16; ++j) {
      sidx[j * NTHR + tid] = (unsigned char)(__float_as_uint(L[0][j]) & 127u);
      sidx[(16 + j) * NTHR + tid] = (unsigned char)(__float_as_uint(L[1][j]) & 127u);
    }
    float av[16], bv[16];
#pragma unroll
    for (int i = 0; i < 16; ++i) {
      av[i] = __uint_as_float(__float_as_uint(L[0][i]) & ~127u);
      bv[i] = __uint_as_float(__float_as_uint(L[1][i]) & ~127u);
    }
#define SC_CAND(i_, j_) __uint_as_float((__float_as_uint(av[i_] + bv[j_]) & ~255u) | (unsigned)(255 - ((i_) * 16 + (j_))))
    float T[16], Bq[16], Cq[16];
#pragma unroll
    for (int j = 0; j < 16; ++j) T[j] = SC_CAND(0, j);
#pragma unroll
    for (int j = 0; j < 8; ++j) { Bq[j] = SC_CAND(1, j); Bq[8 + j] = SC_CAND(15 - j, 0); }
    Cq[0] = SC_CAND(2, 0); Cq[1] = SC_CAND(2, 1); Cq[2] = SC_CAND(2, 2); Cq[3] = SC_CAND(2, 3); Cq[4] = SC_CAND(2, 4);
    Cq[5] = SC_CAND(3, 0); Cq[6] = SC_CAND(3, 1); Cq[7] = SC_CAND(3, 2); Cq[8] = SC_CAND(3, 3);
    Cq[9] = SC_CAND(4, 0); Cq[10] = SC_CAND(4, 1); Cq[11] = SC_CAND(4, 2);
    Cq[12] = SC_CAND(5, 0); Cq[13] = SC_CAND(5, 1); Cq[14] = SC_CAND(6, 0); Cq[15] = SC_CAND(6, 1);
    bitonic16d(Bq);
    merge16d(T, Bq);
    sort16d(Cq);
    merge16d(T, Cq);
    ins16(T, SC_CAND(7, 0));
    ins16(T, SC_CAND(7, 1));
#undef SC_CAND
    float mx = __uint_as_float(__float_as_uint(T[0]) & ~255u);
    float e[16], sum = 0.f;
    int id[16];
#pragma unroll
    for (int k = 0; k < 16; ++k) {
      unsigned bits = __float_as_uint(T[k]);
      float v = __uint_as_float(bits & ~255u);
      e[k] = __expf(v - mx);
      sum += e[k];
      unsigned ij = 255u - (bits & 255u);
      unsigned e1 = sidx[(ij >> 4) * NTHR + tid], e2 = sidx[(16 + (ij & 15)) * NTHR + tid];
      id[k] = (int)(e1 * 128 + e2);
    }
    float inv = 1.f / sum;
    if (hh == 0) {
#pragma unroll
      for (int k4 = 0; k4 < 4; ++k4)
        *(float4*)(p.GW() + (size_t)m * 16 + k4 * 4) = make_float4(e[k4 * 4] * inv, e[k4 * 4 + 1] * inv, e[k4 * 4 + 2] * inv, e[k4 * 4 + 3] * inv);
      unsigned short* ip16 = (unsigned short*)p.IDX() + (size_t)m * 16;
      *(uint4*)(ip16) = make_uint4(id[0] | (id[1] << 16), id[2] | (id[3] << 16), id[4] | (id[5] << 16), id[6] | (id[7] << 16));
      *(uint4*)(ip16 + 8) = make_uint4(id[8] | (id[9] << 16), id[10] | (id[11] << 16), id[12] | (id[13] << 16), id[14] | (id[15] << 16));
    }
  }
}
typedef __attribute__((ext_vector_type(4))) float f32x4;
#define GU_LDIDX(i_, EH0_, EH1_) do { const int r_ = wsl + ((i_) < ntok ? (i_) : ntok - 1) * nw; \
    const unsigned short* ip_ = (const unsigned short*)p.IDX() + (unsigned)(r_ * 128 + (lane >> 3) * 8); \
    EH0_ = *(const uint4*)(ip_); EH1_ = *(const uint4*)(ip_ + 64); } while (0)
#define GU_ID(Q_, k_) ((k_) == 0 ? (int)(Q_.x & 0xffffu) : (k_) == 1 ? (int)(Q_.x >> 16) : (k_) == 2 ? (int)(Q_.y & 0xffffu) : (k_) == 3 ? (int)(Q_.y >> 16) : \
                       (k_) == 4 ? (int)(Q_.z & 0xffffu) : (k_) == 5 ? (int)(Q_.z >> 16) : (k_) == 6 ? (int)(Q_.w & 0xffffu) : (int)(Q_.w >> 16))
#define GU_LDROWS(i_, EH0_, EH1_, RA_, RB_, XA_, XB_, XS_) do { const int r_ = wsl + ((i_) < ntok ? (i_) : ntok - 1) * nw; \
    const unsigned char* xp_ = p.X8() + (unsigned)(r_ * 1024 + j * 128 + kb * 16); \
    XA_ = *(const uint4*)(xp_ + ((lane & 8) ? 64 : 0)); XS_ = 127;     \
    _Pragma("unroll") for (int mt = 0; mt < 8; ++mt) { \
      RA_[mt] = *(const uint4*)(p.U8() + (unsigned)((j * 16384 + GU_ID(EH0_, mt)) * 128 + (lane & 7) * 16)); \
      RB_[mt] = *(const uint4*)(p.U8() + (unsigned)((j * 16384 + GU_ID(EH1_, mt)) * 128 + (lane & 7) * 16)); } } while (0)
#define GU_COMPUTE(i_, RA_, RB_, XA_, XB_, XS_) do { const int r_ = wsl + ((i_) < ntok ? (i_) : ntok - 1) * nw; \
    const uint4 xo_ = make_uint4(__builtin_amdgcn_update_dpp(0, XA_.x, 0x128, 0xf, 0xf, false), __builtin_amdgcn_update_dpp(0, XA_.y, 0x128, 0xf, 0xf, false), \
                                 __builtin_amdgcn_update_dpp(0, XA_.z, 0x128, 0xf, 0xf, false), __builtin_amdgcn_update_dpp(0, XA_.w, 0x128, 0xf, 0xf, false));     \
    const bool hi8_ = (lane & 8) != 0; \
    const uint4 xlo_ = hi8_ ? xo_ : XA_, xhi_ = hi8_ ? XA_ : xo_; \
    i32x8 xb_; xb_[0] = xlo_.x; xb_[1] = xlo_.y; xb_[2] = xlo_.z; xb_[3] = xlo_.w; xb_[4] = xhi_.x; xb_[5] = xhi_.y; xb_[6] = xhi_.z; xb_[7] = xhi_.w; \
    bf16_t* pd_ = (bf16_t*)p.Pd() + ((size_t)j * NT + r_) * 128; \
    _Pragma("unroll") for (int mt = 0; mt < 8; ++mt) { \
      stl_u4(ltile + wr0, RA_[mt]); stl_u4(ltile + wr1, RB_[mt]); \
      const uint4 pa_ = ldl_u4(ltile + rd0), pb_ = ldl_u4(ltile + rd1); \
      i32x8 av_; av_[0] = pa_.x; av_[1] = pa_.y; av_[2] = pa_.z; av_[3] = pa_.w; av_[4] = pb_.x; av_[5] = pb_.y; av_[6] = pb_.z; av_[7] = pb_.w; \
      f32x4 acc_ = {0.f, 0.f, 0.f, 0.f}; \
      acc_ = __builtin_amdgcn_mfma_scale_f32_16x16x128_f8f6f4(av_, xb_, acc_, 0, 0, 0, 127, 0, XS_); \
      if (lrow == 0) {   \
        *(LAS float*)(lpd + (kb * 32 + mt) * 4) = acc_[0]; *(LAS float*)(lpd + (kb * 32 + 8 + mt) * 4) = acc_[1]; \
        *(LAS float*)(lpd + (kb * 32 + 16 + mt) * 4) = acc_[2]; *(LAS float*)(lpd + (kb * 32 + 24 + mt) * 4) = acc_[3]; } } \
    if (lane < 32) { const lds_f4 pv_ = *(const LAS lds_f4*)(lpd + lane * 16); *(uint2*)(pd_ + lane * 4) = make_uint2(pk2(pv_.x, pv_.y), pk2(pv_.z, pv_.w)); } } while (0)
__device__ __forceinline__ void phase_gather_u(const Params& p, char* smem) {
  const int lane = tidx() & 63, wave = tidx() >> 6;
  const int j = blockIdx.x & 7, wsl = (blockIdx.x >> 3) * 8 + wave, nw = (gridDim.x >> 3) * 8;
  const int lrow = lane & 15, kb = lane >> 4;
  const int ntok = (NT - wsl + nw - 1) / nw;
  if (ntok <= 0) return;
  LAS char* ltile = (LAS char*)smem + wave * 2048;
  LAS char* lpd = (LAS char*)smem + 16384 + wave * 512;
  const int wrow = lane >> 3, wpc = lane & 7;
  const int wr0 = wrow * 128 + ((wpc ^ ((wrow >> 1) & 7)) << 4), wr1 = (wrow + 8) * 128 + ((wpc ^ (((wrow + 8) >> 1) & 7)) << 4);
  const int rsw = (lrow >> 1) & 7;
  const int rd0 = lrow * 128 + ((kb ^ rsw) << 4), rd1 = lrow * 128 + (((4 + kb) ^ rsw) << 4);
  uint4 e0a, e0b, e1a, e1b; int xs0, xs1;
  uint4 a0[8], b0[8], a1[8], b1[8], xa0, xb0, xa1, xb1;
  GU_LDIDX(0, e0a, e0b);
  GU_LDIDX(1, e1a, e1b);
  asm volatile("" ::: "memory");
  GU_LDROWS(0, e0a, e0b, a0, b0, xa0, xb0, xs0);
  asm volatile("" ::: "memory");
#pragma unroll 1
  for (int i = 0; i < ntok; i += 2) {
    GU_LDIDX(i + 2, e0a, e0b);
    asm volatile("" ::: "memory");
    GU_LDROWS(i + 1, e1a, e1b, a1, b1, xa1, xb1, xs1);
    asm volatile("" ::: "memory");
    GU_COMPUTE(i, a0, b0, xa0, xb0, xs0);
    asm volatile("" ::: "memory");
    GU_LDIDX(i + 3, e1a, e1b);
    asm volatile("" ::: "memory");
    GU_LDROWS(i + 2, e0a, e0b, a0, b0, xa0, xb0, xs0);
    asm volatile("" ::: "memory");
    GU_COMPUTE(i + 1, a1, b1, xa1, xb1, xs1);
    asm volatile("" ::: "memory");
  }
}
__device__ __forceinline__ void phase_gather_w(const Params& p) {
  const unsigned gt = (unsigned)blockIdx.x * NTHR + tidx(), GT = (unsigned)gridDim.x * NTHR;
  const unsigned tot = (unsigned)NT * 32;
  const bf16_t* PdB = (const bf16_t*)p.Pd();
  for (unsigned i0 = gt; i0 < tot; i0 += 2 * GT) {
    const unsigned i1r = i0 + GT;
    const bool has1 = i1r < tot;
    const unsigned i1 = has1 ? i1r : i0;
    uint2 pa[8], pb[8];
#pragma unroll
    for (int jj = 0; jj < 8; ++jj) {
      pa[jj] = ((const uint2*)(PdB + (size_t)jj * NT * 128))[i0];
      pb[jj] = ((const uint2*)(PdB + (size_t)jj * NT * 128))[i1];
    }
    const float4 ga = ((const float4*)p.GW())[i0], gb = ((const float4*)p.GW())[i1];
    const uint2 ea = ((const uint2*)p.IDX())[i0], eb = ((const uint2*)p.IDX())[i1];
    const int ev[8] = {(int)(ea.x & 0xffffu), (int)(ea.x >> 16), (int)(ea.y & 0xffffu), (int)(ea.y >> 16),
                       (int)(eb.x & 0xffffu), (int)(eb.x >> 16), (int)(eb.y & 0xffffu), (int)(eb.y >> 16)};
    const float gv[8] = {ga.x, ga.y, ga.z, ga.w, gb.x, gb.y, gb.z, gb.w};
    unsigned usc[8];
    float vsc[8];
    unsigned scw[8];
#pragma unroll
    for (int q = 0; q < 8; ++q) scw[q] = ((const unsigned*)p.USC())[ev[q]];
    const float xsa = __uint_as_float((unsigned)p.XSC()[i0 >> 5] << 23), xsb = __uint_as_float((unsigned)p.XSC()[i1 >> 5] << 23);
#pragma unroll
    for (int q = 0; q < 8; ++q) { usc[q] = scw[q] & 0xffffu; vsc[q] = __uint_as_float((scw[q] >> 16) << 23); }
    float sv[8] = {0.f, 0.f, 0.f, 0.f, 0.f, 0.f, 0.f, 0.f};
#pragma unroll
    for (int jj = 0; jj < 8; ++jj) {
      sv[0] += bflo(pa[jj].x); sv[1] += bfhi(pa[jj].x); sv[2] += bflo(pa[jj].y); sv[3] += bfhi(pa[jj].y);
      sv[4] += bflo(pb[jj].x); sv[5] += bfhi(pb[jj].x); sv[6] += bflo(pb[jj].y); sv[7] += bfhi(pb[jj].y);
    }
    float o[8];
#pragma unroll
    for (int q = 0; q < 8; ++q) {
      const float us = __uint_as_float(usc[q] << 23) * (q < 4 ? xsa : xsb);
      o[q] = gv[q] * gelu_tanh(sv[q] * us) * vsc[q];
    }
    ((uint2*)p.Wt())[i0] = make_uint2(pk2(o[0], o[1]), pk2(o[2], o[3]));
    if (has1) ((uint2*)p.Wt())[i1] = make_uint2(pk2(o[4], o[5]), pk2(o[6], o[7]));
  }
}
__device__ __forceinline__ void phase_gather_v(const Params& p) {
  const int lane = tidx() & 63, wave = tidx() >> 6;
  const int j = blockIdx.x & 7, wsl = (blockIdx.x >> 3) * 8 + wave, nw = (gridDim.x >> 3) * 8;
  const int sub = lane >> 3, c16 = (lane & 7) * 16;
  const int ntok = (NT - wsl + nw - 1) / nw, nit = ntok * 2;
  auto ldidx = [&](int it, uint4& e) {
    const int itc = it < nit ? it : nit - 1;
    const unsigned base = (unsigned)((wsl + (itc >> 1) * nw) * 128 + sub * 16 + (itc & 1) * 8);
    e = *(const uint4*)((const unsigned short*)p.IDX() + base);
  };
  auto ldrows = [&](int it, const uint4& e, uint4 (&v)[8], uint4& w) {
    const int itc = it < nit ? it : nit - 1;
    const unsigned base = (unsigned)((wsl + (itc >> 1) * nw) * 128 + sub * 16 + (itc & 1) * 8);
    w = *(const uint4*)((const bf16_t*)p.Wt() + base);
    const int ev[8] = {(int)(e.x & 0xffffu), (int)(e.x >> 16), (int)(e.y & 0xffffu), (int)(e.y >> 16),
                       (int)(e.z & 0xffffu), (int)(e.z >> 16), (int)(e.w & 0xffffu), (int)(e.w >> 16)};
#pragma unroll
    for (int k = 0; k < 8; ++k) v[k] = *(const uint4*)(p.V8() + (unsigned)((j * 16384 + ev[k]) * 128 + c16));
  };
  f2v o2[8];
  uint2 xr;
  const int fo = c16 + ((lane >> 5) & 1) * 8 + ((lane >> 4) & 1) * 4;
  auto accum = [&](const uint4 (&vv)[8], const uint4& wq) {
    const float ww[8] = {bflo(wq.x), bfhi(wq.x), bflo(wq.y), bfhi(wq.y), bflo(wq.z), bfhi(wq.z), bflo(wq.w), bfhi(wq.w)};
#pragma unroll
    for (int k = 0; k < 8; ++k) {
      const f2v w = {ww[k], ww[k]};
      const uint4 v = vv[k];
      o2[0] += w * __builtin_amdgcn_cvt_pk_f32_fp8((int)v.x, false); o2[1] += w * __builtin_amdgcn_cvt_pk_f32_fp8((int)v.x, true);
      o2[2] += w * __builtin_amdgcn_cvt_pk_f32_fp8((int)v.y, false); o2[3] += w * __builtin_amdgcn_cvt_pk_f32_fp8((int)v.y, true);
      o2[4] += w * __builtin_amdgcn_cvt_pk_f32_fp8((int)v.z, false); o2[5] += w * __builtin_amdgcn_cvt_pk_f32_fp8((int)v.z, true);
      o2[6] += w * __builtin_amdgcn_cvt_pk_f32_fp8((int)v.w, false); o2[7] += w * __builtin_amdgcn_cvt_pk_f32_fp8((int)v.w, true);
    }
  };
  auto finish = [&](int i) {
    const int r = wsl + i * nw;
    float r8[8], r4[4];
#pragma unroll
    for (int q = 0; q < 8; ++q) {
      auto s = __builtin_amdgcn_permlane32_swap(__float_as_uint(o2[q >> 1][q & 1]), __float_as_uint(o2[(q + 8) >> 1][q & 1]), false, false);
      r8[q] = __uint_as_float(s[0]) + __uint_as_float(s[1]);
    }
#pragma unroll
    for (int q = 0; q < 4; ++q) {
      auto s = __builtin_amdgcn_permlane16_swap(__float_as_uint(r8[q]), __float_as_uint(r8[q + 4]), false, false);
      r4[q] = __uint_as_float(s[0]) + __uint_as_float(s[1]);
    }
#pragma unroll
    for (int q = 0; q < 4; ++q) r4[q] += __uint_as_float(__builtin_amdgcn_update_dpp(0, __float_as_uint(r4[q]), 0x128, 0xf, 0xf, false));
    if ((lane & 8) == 0 && i < ntok) {
      const unsigned off = (unsigned)(r * 1024 + j * 128 + fo);
      float* yo = ((r < NP) ? p.out + O_YP : p.out + O_YS - (size_t)NP * 1024) + off;
      *(float4*)(yo) = make_float4(bflo(xr.x) + r4[0], bfhi(xr.x) + r4[1], bflo(xr.y) + r4[2], bfhi(xr.y) + r4[3]);
    }
  };
  if (ntok <= 0) return;
  uint4 eA, eB, eC;
  uint4 wA, wB, wC;
  uint4 vA[8], vB[8], vC[8];
  ldidx(0, eA);
  ldidx(1, eB);
  ldidx(2, eC);
  asm volatile("" ::: "memory");
  ldrows(0, eA, vA, wA);
  asm volatile("" ::: "memory");
  ldrows(1, eB, vB, wB);
  asm volatile("" :: "v"(vB[7].x) : "memory");
#define GV_STEP(k_, EX, VX, WX, EY, VY, WY) do { \
    ldidx((k_) + 3, EX); \
    asm volatile("" ::: "memory"); \
    ldrows((k_) + 2, EY, VY, WY); \
    asm volatile("" : "+v"(WX.x), "+v"(WX.y), "+v"(WX.z), "+v"(WX.w) :: "memory"); \
    accum(VX, WX); } while (0)
#define GV_TOKEN(i_) do { \
    _Pragma("unroll") for (int q = 0; q < 8; ++q) { o2[q][0] = 0.f; o2[q][1] = 0.f; } \
    xr = *(const uint2*)((const bf16_t*)p.X1() + (unsigned)((wsl + ((i_) < ntok ? (i_) : ntok - 1) * nw) * 1024 + j * 128 + fo)); \
    asm volatile("" ::: "memory"); } while (0)
#pragma unroll 1
  for (int i = 0; i < ntok; i += 3) {
    const int k = 2 * i;
    GV_TOKEN(i);
    GV_STEP(k, eA, vA, wA, eC, vC, wC);
    GV_STEP(k + 1, eB, vB, wB, eA, vA, wA);
    finish(i);
    asm volatile("" ::: "memory");
    GV_TOKEN(i + 1);
    GV_STEP(k + 2, eC, vC, wC, eB, vB, wB);
    GV_STEP(k + 3, eA, vA, wA, eC, vC, wC);
    finish(i + 1);
    asm volatile("" ::: "memory");
    GV_TOKEN(i + 2);
    GV_STEP(k + 4, eB, vB, wB, eA, vA, wA);
    GV_STEP(k + 5, eC, vC, wC, eB, vB, wB);
    finish(i + 2);
    asm volatile("" ::: "memory");
  }
}

extern __shared__ __attribute__((aligned(16))) char dyn_smem[];
#define LDS_BYTES 147456
__global__ void __launch_bounds__(NTHR, 2) k_mega(Params p) {
  char* smem = dyn_smem;
  uint4* xbw = (uint4*)(dyn_smem + LDS_BYTES);
  if (threadIdx.x == 0) *xbw = make_uint4(0u, 0u, 0u, 0u);
  __syncthreads();
  XcdBarrier bar = xcd_barrier_post(p.bar(), (volatile LAS unsigned*)xbw);
  phase0(p, smem);
  phase_rmsnorm<false>(p.x_prompt, p.x_sample, p.norm_mix, p.XN(), nullptr, nullptr);
  xcd_barrier(bar);
  phase_gemm_z(p, smem);
  xcd_barrier(bar);
  phase_post1(p);
  xcd_barrier(bar);
  phase_gemm4(p, smem);
  xcd_barrier(bar);
  phase_post2(p);
  xcd_barrier(bar);
  phase_attn(p, smem);
  xcd_barrier(bar);
  phase_gemm_gl(p, smem);
  xcd_barrier(bar);
  phase_gemm_out(p, smem);
  xcd_barrier(bar);
  phase_rmsnorm_x1((const bf16_t*)p.X1(), p.norm_ffn, p.XN(), p.X8(), p.XSC());
  xcd_barrier(bar);
  phase_gemm_pq(p, smem);
  xcd_barrier(bar);
  phase_sctopk(p, smem);
  xcd_barrier(bar);
  phase_gather_u(p, smem);
  xcd_barrier(bar);
  phase_gather_w(p);
  xcd_barrier(bar);
  phase_gather_v(p);
}


#ifdef PROBE_MULTI
template <int PH>
__global__ void __launch_bounds__(NTHR, 2) k_phase(Params p) {
  char* smem = dyn_smem;
  if constexpr (PH == 0) { phase0(p, smem); phase_rmsnorm<false>(p.x_prompt, p.x_sample, p.norm_mix, p.XN(), nullptr, nullptr); }
  if constexpr (PH == 1) phase_gemm_z(p, smem);
  if constexpr (PH == 2) phase_post1(p);
  if constexpr (PH == 3) phase_gemm4(p, smem);
  if constexpr (PH == 4) phase_post2(p);
  if constexpr (PH == 5) phase_attn(p, smem);
  if constexpr (PH == 7) phase_gemm_gl(p, smem);
  if constexpr (PH == 9) phase_gemm_out(p, smem);
  if constexpr (PH == 10) phase_rmsnorm<true>(p.X1(), p.X1() + (size_t)NP * 1024, p.norm_ffn, p.XN(), p.X8(), p.XSC());
  if constexpr (PH == 11) phase_gemm_pq(p, smem);
  if constexpr (PH == 12) phase_sctopk(p, smem);
  if constexpr (PH == 13) phase_gather_u(p, smem);
  if constexpr (PH == 14) phase_gather_w(p);
  if constexpr (PH == 15) phase_gather_v(p);
}
template <int PH>
static void launch_phase(const Params& p, hipStream_t stream) {
  (void)hipFuncSetAttribute((const void*)k_phase<PH>, hipFuncAttributeMaxDynamicSharedMemorySize, LDS_BYTES + 16);
  const int reps = (PH == PROBE_MULTI) ? 2 : 1;
  for (int i = 0; i < reps; ++i) hipLaunchKernelGGL(k_phase<PH>, dim3(256), dim3(NTHR), LDS_BYTES + 16, stream, p);
}
#endif

extern "C" void kernel_launch(void* const* d_in, const int* in_sizes, int n_in, void* d_out, int out_size, void* d_ws, size_t ws_size,
                              hipStream_t stream) {
  Params p{};
  p.x_prompt = (const float*)d_in[0]; p.x_sample = (const float*)d_in[1]; p.cache_lat = (const float*)d_in[2];
  p.cache_kr = (const float*)d_in[3]; p.state_ssm = (const float*)d_in[4]; p.page_table = (const int*)d_in[5];
  p.norm_mix = (const float*)d_in[6]; p.w_in = (const float*)d_in[7]; p.norm_q_lora = (const float*)d_in[8];
  p.w_uq = (const float*)d_in[9]; p.norm_kv_lora = (const float*)d_in[10]; p.w_uk = (const float*)d_in[11];
  p.w_uv = (const float*)d_in[12]; p.g_qn = (const float*)d_in[13]; p.g_qr = (const float*)d_in[14];
  p.g_kn = (const float*)d_in[15]; p.g_kr = (const float*)d_in[16]; p.a_re = (const float*)d_in[17];
  p.a_im = (const float*)d_in[18]; p.log_dt = (const float*)d_in[19]; p.ssm_b = (const float*)d_in[20];
  p.ssm_c = (const float*)d_in[21]; p.ssm_d = (const float*)d_in[22]; p.w_glu = (const float*)d_in[23];
  p.w_out = (const float*)d_in[24]; p.norm_ffn = (const float*)d_in[25]; p.peer_wq = (const float*)d_in[26];
  p.peer_keys = (const float*)d_in[27]; p.peer_u = (const float*)d_in[28]; p.peer_v = (const float*)d_in[29];
  p.out = (float*)d_out;
  p.ws = (char*)d_ws;
  const size_t off = WS_TOTAL;
  if (off > ws_size) { fprintf(stderr, "workspace too small: need %zu have %zu\n", off, ws_size); return; }
#ifdef PROBE_MULTI
  launch_phase<0>(p, stream); launch_phase<1>(p, stream); launch_phase<2>(p, stream); launch_phase<3>(p, stream);
  launch_phase<4>(p, stream); launch_phase<5>(p, stream); launch_phase<6>(p, stream); launch_phase<7>(p, stream);
  launch_phase<8>(p, stream); launch_phase<9>(p, stream); launch_phase<10>(p, stream); launch_phase<11>(p, stream);
  launch_phase<12>(p, stream); launch_phase<13>(p, stream); launch_phase<14>(p, stream); launch_phase<15>(p, stream);
  return;
#endif
  static int grid = 0;
  if (!grid) {
    int dev = 0, cus = 0, per_cu = 0;
    (void)hipGetDevice(&dev);
    (void)hipDeviceGetAttribute(&cus, hipDeviceAttributeMultiprocessorCount, dev);
    (void)hipFuncSetAttribute((const void*)k_mega, hipFuncAttributeMaxDynamicSharedMemorySize, LDS_BYTES + 16);
    (void)hipOccupancyMaxActiveBlocksPerMultiprocessor(&per_cu, k_mega, NTHR, LDS_BYTES + 16);
    if (per_cu < 1) { fprintf(stderr, "k_mega does not fit a CU\n"); return; }
    grid = cus;
  }
  (void)hipMemsetAsync(p.ws + WSO_bar, 0, XCD_BAR_WORDS * sizeof(unsigned), stream);
  hipLaunchKernelGGL(k_mega, dim3(grid), dim3(NTHR), LDS_BYTES + 16, stream, p);
}
```
